# Optimizing an MI355X kernel written in HIP

```python
import math
import jax, jax.numpy as jnp
from jax import lax
import numpy as np

D_MODEL = 1024
BATCH = 2
SEQ = 8192
DEPTH = 1

HEAD_DIM = 64
N_DIFF_HEADS = D_MODEL // 256
DIFF_WIDTH = N_DIFF_HEADS * 2 * HEAD_DIM
N_NAT_HEADS = D_MODEL // 128
NAT_WIDTH = N_NAT_HEADS * HEAD_DIM
MIX_WIDTH = DIFF_WIDTH + NAT_WIDTH
GRID_W = 64
NAT_KH_MAX = 8
NAT_KW = 16
Q_BLOCK = 128
N_EXPERTS = 32
TOP_K = 4
D_FF_EXPERT = D_MODEL
SWIGLU_LIMIT = 7.0
SWIGLU_ALPHA = 1.702
MOE_BLOCK = 128
RMS_EPS = 1e-6

kernel_name = "hybrid_diffattn_natten_moe_encoder"


def rms_norm(x, g):
    xf = x.astype(jnp.float32)
    y = xf * lax.rsqrt(jnp.mean(xf * xf, axis=-1, keepdims=True) + RMS_EPS)
    return (y * g.astype(jnp.float32)).astype(x.dtype)


def alibi_slopes(n_heads):
    i = jnp.arange(1, n_heads + 1, dtype=jnp.float32)
    return jnp.exp2(-8.0 * i / n_heads)


def diff_attention(q, k, v, lam, lam_init, g_sub):
    B, L, H, _, Dh = q.shape
    nb = L // Q_BLOCK
    slopes = alibi_slopes(H)
    kpos = jnp.arange(L, dtype=jnp.float32)
    scale = Dh ** -0.5
    qb = q.reshape(B, nb, Q_BLOCK, H, 2, Dh).transpose(1, 0, 2, 3, 4, 5)

    def block(args):
        q_blk, i = args
        s = jnp.einsum('bqhmd,bkhmd->bhmqk', q_blk, k).astype(jnp.float32) * scale
        qpos = (i * Q_BLOCK + jnp.arange(Q_BLOCK)).astype(jnp.float32)
        dist = jnp.abs(qpos[:, None] - kpos[None, :])
        s = s - slopes[None, :, None, None, None] * dist[None, None, None]
        p = jax.nn.softmax(s, axis=-1)
        a = p[:, :, 0] - lam * p[:, :, 1]
        return jnp.einsum('bhqk,bkhe->bqhe', a.astype(v.dtype), v)

    o = lax.map(block, (qb, jnp.arange(nb)))
    o = o.transpose(1, 0, 2, 3, 4).reshape(B, L, H, 2 * Dh)
    o = rms_norm(o, g_sub) * (1.0 - lam_init)
    return o.reshape(B, L, H * 2 * Dh)


def neighbourhood_attention(q, k, v, rpb):
    B, L, H, Dh = q.shape
    rows = L // GRID_W
    kh = min(NAT_KH_MAX, rows)
    scale = Dh ** -0.5
    qg = q.reshape(B, rows, GRID_W, H, Dh)
    kg = k.reshape(B, rows, GRID_W, H, Dh)
    vg = v.reshape(B, rows, GRID_W, H, Dh)
    r = jnp.arange(rows)
    row_start = jnp.clip(r - kh // 2, 0, rows - kh)
    row_idx = row_start[:, None] + jnp.arange(kh)[None, :]
    k_rows = kg[:, row_idx]
    v_rows = vg[:, row_idx]
    c = jnp.arange(GRID_W)
    col_start = jnp.clip(c - NAT_KW // 2, 0, GRID_W - NAT_KW)
    col_in = (c[None, :] >= col_start[:, None]) & (c[None, :] < col_start[:, None] + NAT_KW)
    dr = row_idx - r[:, None] + (NAT_KH_MAX - 1)
    dc = jnp.clip(c[None, :] - c[:, None], -(NAT_KW - 1), NAT_KW - 1) + (NAT_KW - 1)
    bias = rpb.astype(jnp.float32)[:, dr[:, None, :, None], dc[None, :, None, :]]
    s = jnp.einsum('brqhd,brkwhd->bhrqkw', qg, k_rows).astype(jnp.float32) * scale + bias[None]
    s = jnp.where(col_in[:, None, :], s, -jnp.inf)
    p = jax.nn.softmax(s.reshape(B, H, rows, GRID_W, kh * GRID_W), axis=-1)
    p = p.reshape(B, H, rows, GRID_W, kh, GRID_W).astype(v.dtype)
    o = jnp.einsum('bhrqkw,brkwhd->brqhd', p, v_rows)
    return o.reshape(B, L, H * Dh)


def swiglu_clamped(hh):
    x_glu = jnp.minimum(hh[..., ::2], SWIGLU_LIMIT)
    x_lin = jnp.clip(hh[..., 1::2], -SWIGLU_LIMIT, SWIGLU_LIMIT)
    return x_glu * jax.nn.sigmoid(SWIGLU_ALPHA * x_glu) * (x_lin + 1.0)


def moe_ffn(h, w_router, b_router, w1, b1, w2, b2):
    B, L, D = h.shape
    T = B * L
    hf = h.reshape(T, D)
    logits = (hf @ w_router + b_router).astype(jnp.float32)
    top_val, top_idx = lax.top_k(logits, TOP_K)
    gates = jax.nn.softmax(top_val, axis=-1)
    n_assign = T * TOP_K
    flat_e = top_idx.reshape(-1).astype(jnp.int32)
    flat_tok = jnp.arange(n_assign, dtype=jnp.int32) // TOP_K
    order = jnp.argsort(flat_e, stable=True)
    sorted_e = flat_e[order]
    counts = jnp.bincount(flat_e, length=N_EXPERTS).astype(jnp.int32)
    padded = (counts + MOE_BLOCK - 1) // MOE_BLOCK * MOE_BLOCK
    pad_end = jnp.cumsum(padded)
    pad_start = pad_end - padded
    grp_start = jnp.cumsum(counts) - counts
    rank = jnp.arange(n_assign, dtype=jnp.int32) - grp_start[sorted_e]
    dest_sorted = (pad_start[sorted_e] + rank).astype(jnp.int32)
    cap = (n_assign + N_EXPERTS * (MOE_BLOCK - 1) + MOE_BLOCK - 1) // MOE_BLOCK * MOE_BLOCK
    n_blocks = cap // MOE_BLOCK
    tok_buf = jnp.zeros((cap,), jnp.int32).at[dest_sorted].set(flat_tok[order])
    blk_start = jnp.arange(n_blocks, dtype=jnp.int32) * MOE_BLOCK
    blk_expert = jnp.minimum(jnp.searchsorted(pad_end, blk_start, side='right'), N_EXPERTS - 1)
    x_buf = hf[tok_buf].reshape(n_blocks, MOE_BLOCK, D)

    def expert_block(args):
        xb, e = args
        hh = xb @ w1[e] + b1[e]
        return swiglu_clamped(hh) @ w2[e] + b2[e]

    y_buf = lax.map(expert_block, (x_buf, blk_expert)).reshape(cap, D)
    dest = jnp.zeros((n_assign,), jnp.int32).at[order].set(dest_sorted)
    y = y_buf[dest].reshape(T, TOP_K, D)
    out = jnp.einsum('tk,tkd->td', gates.astype(y.dtype), y)
    return out.reshape(B, L, D)


def setup_inputs(seed: int = 0) -> dict:
    key = jax.random.key(seed)
    ks = jax.random.split(key, 24)
    f32 = jnp.float32
    D, F = D_MODEL, D_FF_EXPERT
    n = lambda k, shape, s: jax.random.normal(k, shape, f32) * s
    return {
        "x": n(ks[0], (BATCH, SEQ, D), 1.0),
        "c": n(ks[1], (BATCH, D), 1.0),
        "w_ada": n(ks[2], (DEPTH, D, 6 * D), 0.5 * D ** -0.5),
        "b_ada": n(ks[3], (DEPTH, 6 * D), 0.02),
        "g_pre_mix": 1.0 + n(ks[4], (DEPTH, D), 0.02),
        "g_post_mix": 1.0 + n(ks[5], (DEPTH, D), 0.02),
        "w_in": n(ks[6], (DEPTH, D, 3 * MIX_WIDTH), D ** -0.5),
        "w_out": n(ks[7], (DEPTH, MIX_WIDTH, D), MIX_WIDTH ** -0.5),
        "lam_q1": n(ks[8], (DEPTH, HEAD_DIM), 0.1),
        "lam_k1": n(ks[9], (DEPTH, HEAD_DIM), 0.1),
        "lam_q2": n(ks[10], (DEPTH, HEAD_DIM), 0.1),
        "lam_k2": n(ks[11], (DEPTH, HEAD_DIM), 0.1),
        "g_subln": 1.0 + n(ks[12], (DEPTH, 2 * HEAD_DIM), 0.02),
        "nat_rpb": n(ks[13], (DEPTH, N_NAT_HEADS, 2 * NAT_KH_MAX - 1, 2 * NAT_KW - 1), 0.02),
        "g_pre_ffn": 1.0 + n(ks[14], (DEPTH, D), 0.02),
        "g_post_ffn": 1.0 + n(ks[15], (DEPTH, D), 0.02),
        "w_router": n(ks[16], (DEPTH, D, N_EXPERTS), D ** -0.5),
        "b_router": n(ks[17], (DEPTH, N_EXPERTS), 0.01),
        "w1": n(ks[18], (DEPTH, N_EXPERTS, D, 2 * F), D ** -0.5),
        "b1": n(ks[19], (DEPTH, N_EXPERTS, 2 * F), 0.01),
        "w2": n(ks[20], (DEPTH, N_EXPERTS, F, D), F ** -0.5),
        "b2": n(ks[21], (DEPTH, N_EXPERTS, D), 0.01),
    }


def reference(x, c, w_ada, b_ada, g_pre_mix, g_post_mix, w_in, w_out,
              lam_q1, lam_k1, lam_q2, lam_k2, g_subln, nat_rpb,
              g_pre_ffn, g_post_ffn, w_router, b_router, w1, b1, w2, b2):
    B, L, D = x.shape
    splits = [DIFF_WIDTH, 2 * DIFF_WIDTH, 3 * DIFF_WIDTH,
              3 * DIFF_WIDTH + NAT_WIDTH, 3 * DIFF_WIDTH + 2 * NAT_WIDTH]
    for l in range(DEPTH):
        lam_init = 0.8 - 0.6 * math.exp(-0.3 * l)
        mod = jax.nn.silu(c) @ w_ada[l] + b_ada[l]
        sh1, sc1, gt1, sh2, sc2, gt2 = jnp.split(mod[:, None, :], 6, axis=-1)

        h = rms_norm(x, g_pre_mix[l]) * (1.0 + sc1) + sh1
        proj = h @ w_in[l]
        dq, dk, dv, nq, nk, nv = jnp.split(proj, splits, axis=-1)
        dq = dq.reshape(B, L, N_DIFF_HEADS, 2, HEAD_DIM)
        dk = dk.reshape(B, L, N_DIFF_HEADS, 2, HEAD_DIM)
        dv = dv.reshape(B, L, N_DIFF_HEADS, 2 * HEAD_DIM)
        lam = (jnp.exp(jnp.sum(lam_q1[l].astype(jnp.float32) * lam_k1[l].astype(jnp.float32)))
               - jnp.exp(jnp.sum(lam_q2[l].astype(jnp.float32) * lam_k2[l].astype(jnp.float32)))
               + lam_init)
        o_diff = diff_attention(dq, dk, dv, lam, lam_init, g_subln[l])
        o_nat = neighbourhood_attention(nq.reshape(B, L, N_NAT_HEADS, HEAD_DIM),
                                        nk.reshape(B, L, N_NAT_HEADS, HEAD_DIM),
                                        nv.reshape(B, L, N_NAT_HEADS, HEAD_DIM),
                                        nat_rpb[l])
        mix = jnp.concatenate([o_diff, o_nat], axis=-1) @ w_out[l]
        x = x + gt1 * rms_norm(mix, g_post_mix[l])

        h2 = rms_norm(x, g_pre_ffn[l]) * (1.0 + sc2) + sh2
        f = moe_ffn(h2, w_router[l], b_router[l], w1[l], b1[l], w2[l], b2[l])
        x = x + gt2 * rms_norm(f, g_post_ffn[l])
    return x
```

```cpp
#include <hip/hip_runtime.h>
#include <stdint.h>
#include <stdio.h>

typedef unsigned short bf16_t;
typedef unsigned u32x4 __attribute__((ext_vector_type(4)));
typedef float f32x4 __attribute__((ext_vector_type(4)));

constexpr int NB = 2, SEQ = 8192, D = 1024, M = NB * SEQ;
constexpr int NPROJ = 3072, NE = 32, TOPK = 4, FF = 1024;
constexpr int NASSIGN = M * TOPK;
constexpr int CAP = NASSIGN + NE * 256;
constexpr int MAXTILES = CAP / 256;
constexpr float RMS_EPS = 1e-6f;

constexpr size_t MiB = 1u << 20;
constexpr size_t WS_CTL = 0;
constexpr size_t WS_MODP = 1 * MiB;
constexpr size_t WS_MOD = 2 * MiB;
constexpr size_t WS_TOPI = 3 * MiB;
constexpr size_t WS_GATE = 3 * MiB + 512 * 1024;
constexpr size_t WS_DEST = 4 * MiB;
constexpr size_t WS_TOK = 4 * MiB + 512 * 1024;
constexpr size_t WS_XN = 16 * MiB;
constexpr size_t WS_PROJ = 48 * MiB;
constexpr size_t WS_ODIFF = 144 * MiB;
constexpr size_t WS_CONCAT = 208 * MiB;
constexpr size_t WS_MIX = 240 * MiB;
constexpr size_t WS_X1 = 304 * MiB;
constexpr size_t WS_H2 = 368 * MiB;
constexpr size_t WS_ACT = 400 * MiB;
constexpr size_t WS_YBUF = 544 * MiB;
constexpr size_t WS_END = 688 * MiB;
constexpr int CW_CNT = 64;
constexpr int CW_CUR = 128;
constexpr int CW_PADSTART = 192;
constexpr int CW_TOTAL = 256;
constexpr int CW_TILEEXP = 320;

__device__ __forceinline__ float bf2f(bf16_t v) { return __uint_as_float(((unsigned)v) << 16); }
__device__ __forceinline__ bf16_t f2bf(float f) { unsigned u = __float_as_uint(f); return (bf16_t)((u + 0x7fffu + ((u >> 16) & 1u)) >> 16); }
__device__ __forceinline__ float wave_sum(float v) {
#pragma unroll
    for (int o = 1; o < 64; o <<= 1) v += __shfl_xor(v, o);
    return v;
}

__global__ void __launch_bounds__(256) k_mod(const float* __restrict__ c, const float* __restrict__ w_ada, float* __restrict__ modp) {
    const int j = blockIdx.x * 256 + threadIdx.x, kc = blockIdx.y;
    float a0 = 0.f, a1 = 0.f;
    for (int k = kc * 64; k < kc * 64 + 64; ++k) {
        const float w = w_ada[(size_t)k * 6144 + j];
        const float c0 = c[k], c1 = c[1024 + k];
        a0 += (c0 / (1.f + __expf(-c0))) * w; a1 += (c1 / (1.f + __expf(-c1))) * w;
    }
    modp[(kc * 2 + 0) * 6144 + j] = a0; modp[(kc * 2 + 1) * 6144 + j] = a1;
}
__global__ void __launch_bounds__(256) k_modsum(const float* __restrict__ modp, const float* __restrict__ b_ada, float* __restrict__ mod) {
    const int i = blockIdx.x * 256 + threadIdx.x; if (i >= 2 * 6144) return;
    const int b = i / 6144, j = i % 6144; float s = b_ada[j];
    for (int kc = 0; kc < 16; ++kc) s += modp[(kc * 2 + b) * 6144 + j];
    mod[i] = s;
}
__global__ void __launch_bounds__(256) k_xn(const float* __restrict__ x, const float* __restrict__ g, const float* __restrict__ mod, bf16_t* __restrict__ xn) {
    const int lane = threadIdx.x & 63, row = blockIdx.x * 4 + (threadIdx.x >> 6), b = row / SEQ;
    const float* xr = x + (size_t)row * D; const float* sh = mod + b * 6144; const float* sc = sh + 1024;
    f32x4 v[4]; float ss = 0.f;
#pragma unroll
    for (int i = 0; i < 4; ++i) { v[i] = *(const f32x4*)(xr + i * 256 + lane * 4); ss += v[i].x * v[i].x + v[i].y * v[i].y + v[i].z * v[i].z + v[i].w * v[i].w; }
    const float rstd = rsqrtf(wave_sum(ss) * (1.f / D) + RMS_EPS);
#pragma unroll
    for (int i = 0; i < 4; ++i) { const int c0 = i * 256 + lane * 4;
#pragma unroll
        for (int e = 0; e < 4; ++e) xn[(size_t)row * D + c0 + e] = f2bf(v[i][e] * rstd * g[c0 + e] * (1.f + sc[c0 + e]) + sh[c0 + e]); }
}
template <class AF, class BF, class EF>
__global__ void __launch_bounds__(256) k_gemm(long K, AF af, BF bf, EF ef) {
    __shared__ float As[16][68], Bs[16][68];
    const int tid = threadIdx.x, tx = tid & 15, ty = tid >> 4, m0 = blockIdx.y * 64, n0 = blockIdx.x * 64;
    if (!af.active(m0)) return;
    float acc[4][4];
#pragma unroll
    for (int i = 0; i < 4; ++i)
#pragma unroll
        for (int j = 0; j < 4; ++j) acc[i][j] = 0.f;
    const int ar = tid >> 2, ak = (tid & 3) * 4, br = tid >> 4, bn = (tid & 15) * 4;
    for (int k0 = 0; k0 < (int)K; k0 += 16) {
#pragma unroll
        for (int i = 0; i < 4; ++i) As[ak + i][ar] = af(m0 + ar, k0 + ak + i);
#pragma unroll
        for (int i = 0; i < 4; ++i) Bs[br][bn + i] = bf(m0, k0 + br, n0 + bn + i);
        __syncthreads();
#pragma unroll
        for (int kk = 0; kk < 16; ++kk) { float a[4], b[4];
#pragma unroll
            for (int i = 0; i < 4; ++i) { a[i] = As[kk][ty * 4 + i]; b[i] = Bs[kk][tx * 4 + i]; }
#pragma unroll
            for (int i = 0; i < 4; ++i)
#pragma unroll
                for (int j = 0; j < 4; ++j) acc[i][j] += a[i] * b[j]; }
        __syncthreads();
    }
#pragma unroll
    for (int i = 0; i < 4; ++i) ef(m0 + ty * 4 + i, n0 + tx * 4, acc[i]);
}
struct A_bf16 { const bf16_t* A; long lda; __device__ bool active(int) const { return true; } __device__ float operator()(int m, int k) const { return bf2f(A[(size_t)m * lda + k]); } };
struct B_f32 { const float* B; long ldb; __device__ float operator()(int, int k, int n) const { return B[(size_t)k * ldb + n]; } };
struct E_bf16 { bf16_t* O; long ldo; __device__ void operator()(int m, int n, const float (&v)[4]) const {
#pragma unroll
    for (int j = 0; j < 4; ++j) O[(size_t)m * ldo + n + j] = f2bf(v[j]); } };
struct E_f32 { float* O; long ldo; __device__ void operator()(int m, int n, const float (&v)[4]) const {
#pragma unroll
    for (int j = 0; j < 4; ++j) O[(size_t)m * ldo + n + j] = v[j]; } };
struct A_gather { const bf16_t* H2; const int* tok; const unsigned* ctl; __device__ bool active(int m0) const { return (unsigned)m0 < ctl[CW_TOTAL]; }
    __device__ float operator()(int m, int k) const { return bf2f(H2[(size_t)tok[m] * D + k]); } };
struct A_act { const bf16_t* A; const unsigned* ctl; __device__ bool active(int m0) const { return (unsigned)m0 < ctl[CW_TOTAL]; }
    __device__ float operator()(int m, int k) const { return bf2f(A[(size_t)m * FF + k]); } };
struct B_exp { const float* W; long ldb; size_t estride; const unsigned* ctl; __device__ float operator()(int m0, int k, int n) const { const unsigned e = ctl[CW_TILEEXP + (m0 >> 8)]; return W[e * estride + (size_t)k * ldb + n]; } };
struct E_swiglu { bf16_t* act; const float* b1; const unsigned* ctl; __device__ void operator()(int m, int n, const float (&v)[4]) const {
    const unsigned e = ctl[CW_TILEEXP + (m >> 8)];
#pragma unroll
    for (int p = 0; p < 2; ++p) { float g = v[2 * p] + b1[e * 2048 + n + 2 * p], l = v[2 * p + 1] + b1[e * 2048 + n + 2 * p + 1];
        g = fminf(g, 7.f); l = fminf(fmaxf(l, -7.f), 7.f);
        act[(size_t)m * FF + (n >> 1) + p] = f2bf(g / (1.f + __expf(-1.702f * g)) * (l + 1.f)); } } };
struct E_y { bf16_t* y; const float* b2; const unsigned* ctl; __device__ void operator()(int m, int n, const float (&v)[4]) const {
    const unsigned e = ctl[CW_TILEEXP + (m >> 8)];
#pragma unroll
    for (int j = 0; j < 4; ++j) y[(size_t)m * D + n + j] = f2bf(v[j] + b2[e * 1024 + n + j]); } };

__global__ void __launch_bounds__(256) k_diffattn(const bf16_t* __restrict__ proj, float* __restrict__ odiff) {
    __shared__ float Ks[32][64], Vs[32][128];
    const int tid = threadIdx.x, map = blockIdx.y, b = blockIdx.z >> 2, h = blockIdx.z & 3;
    const int qi = blockIdx.x * 256 + tid; const size_t qrow = (size_t)b * SEQ + qi;
    const float slope = exp2f(-2.f * (float)(h + 1));
    float q[64], o[128];
#pragma unroll
    for (int d = 0; d < 64; ++d) q[d] = bf2f(proj[qrow * NPROJ + h * 128 + map * 64 + d]) * 0.125f;
#pragma unroll
    for (int e = 0; e < 128; ++e) o[e] = 0.f;
    float m = -INFINITY, l = 0.f;
    for (int k0 = 0; k0 < SEQ; k0 += 32) {
        __syncthreads();
        for (int i = tid; i < 32 * 64; i += 256) { const int r = i >> 6, d = i & 63; Ks[r][d] = bf2f(proj[((size_t)b * SEQ + k0 + r) * NPROJ + 512 + h * 128 + map * 64 + d]); }
        for (int i = tid; i < 32 * 128; i += 256) { const int r = i >> 7, e = i & 127; Vs[r][e] = bf2f(proj[((size_t)b * SEQ + k0 + r) * NPROJ + 1024 + h * 128 + e]); }
        __syncthreads();
#pragma unroll 1
        for (int c0 = 0; c0 < 32; c0 += 8) {
            float s[8]; float mx = -INFINITY;
#pragma unroll
            for (int c = 0; c < 8; ++c) { float a = 0.f;
#pragma unroll
                for (int d = 0; d < 64; ++d) a += q[d] * Ks[c0 + c][d];
                s[c] = a - slope * fabsf((float)(qi - (k0 + c0 + c))); mx = fmaxf(mx, s[c]); }
            if (mx > m) { const float f = __expf(m - mx); l *= f;
#pragma unroll
                for (int e = 0; e < 128; ++e) o[e] *= f;
                m = mx; }
#pragma unroll
            for (int c = 0; c < 8; ++c) { const float p = __expf(s[c] - m); l += p;
#pragma unroll
                for (int e = 0; e < 128; ++e) o[e] += p * Vs[c0 + c][e]; }
        }
    }
    const float rl = 1.f / l;
#pragma unroll
    for (int e = 0; e < 128; ++e) odiff[((size_t)map * M + qrow) * 512 + h * 128 + e] = o[e] * rl;
}
__global__ void __launch_bounds__(256) k_diffcomb(const float* __restrict__ odiff, const float* lq1, const float* lk1, const float* lq2, const float* lk2, const float* __restrict__ gsub, bf16_t* __restrict__ concat) {
    const int lane = threadIdx.x & 63, row = blockIdx.x * 4 + (threadIdx.x >> 6);
    float s1 = 0.f, s2 = 0.f;
    for (int i = 0; i < 64; ++i) { s1 += lq1[i] * lk1[i]; s2 += lq2[i] * lk2[i]; }
    const float lam_init = 0.2f, lam = __expf(s1) - __expf(s2) + lam_init;
    const int c0 = lane * 8;
    float v[8]; float ss = 0.f;
#pragma unroll
    for (int e = 0; e < 8; ++e) { v[e] = odiff[(size_t)row * 512 + c0 + e] - lam * odiff[((size_t)M + row) * 512 + c0 + e]; ss += v[e] * v[e]; }
    ss += __shfl_xor(ss, 1); ss += __shfl_xor(ss, 2); ss += __shfl_xor(ss, 4); ss += __shfl_xor(ss, 8);
    const float rstd = rsqrtf(ss * (1.f / 128.f) + RMS_EPS);
#pragma unroll
    for (int e = 0; e < 8; ++e) concat[(size_t)row * D + c0 + e] = f2bf(v[e] * rstd * gsub[(c0 + e) & 127] * (1.f - lam_init));
}
__global__ void __launch_bounds__(256) k_nat(const bf16_t* __restrict__ proj, const float* __restrict__ rpb, bf16_t* __restrict__ concat) {
    const int gid = blockIdx.x * 256 + threadIdx.x, t = gid >> 3, h = gid & 7;
    const int b = t / SEQ, tl = t % SEQ, r = tl >> 6, c = tl & 63;
    const int rs = min(max(r - 4, 0), 120), cs = min(max(c - 8, 0), 48);
    float q[64], o[64];
#pragma unroll
    for (int d = 0; d < 64; ++d) { q[d] = bf2f(proj[(size_t)t * NPROJ + 1536 + h * 64 + d]) * 0.125f; o[d] = 0.f; }
    float m = -INFINITY, l = 0.f;
#pragma unroll 1
    for (int kr = 0; kr < 8; ++kr) {
#pragma unroll 1
        for (int kc0 = 0; kc0 < 16; kc0 += 4) {
            float s[4]; float mx = -INFINITY;
#pragma unroll
            for (int j = 0; j < 4; ++j) { const int kc = kc0 + j; const size_t kt = (size_t)b * SEQ + (rs + kr) * 64 + cs + kc;
                const bf16_t* kp = proj + kt * NPROJ + 2048 + h * 64; float a = 0.f;
#pragma unroll
                for (int d = 0; d < 64; ++d) a += q[d] * bf2f(kp[d]);
                s[j] = a + rpb[(h * 15 + (rs + kr - r + 7)) * 31 + (cs + kc - c + 15)]; mx = fmaxf(mx, s[j]); }
            if (mx > m) { const float f = __expf(m - mx); l *= f;
#pragma unroll
                for (int d = 0; d < 64; ++d) o[d] *= f;
                m = mx; }
#pragma unroll
            for (int j = 0; j < 4; ++j) { const int kc = kc0 + j; const size_t kt = (size_t)b * SEQ + (rs + kr) * 64 + cs + kc;
                const bf16_t* vp = proj + kt * NPROJ + 2560 + h * 64; const float p = __expf(s[j] - m); l += p;
#pragma unroll
                for (int d = 0; d < 64; ++d) o[d] += p * bf2f(vp[d]); }
        }
    }
    const float rl = 1.f / l;
#pragma unroll
    for (int d = 0; d < 64; ++d) concat[(size_t)t * D + 512 + h * 64 + d] = f2bf(o[d] * rl);
}
__global__ void __launch_bounds__(256) k_post(const float* __restrict__ x, const float* __restrict__ mix, const float* __restrict__ mod, const float* __restrict__ g_post_mix,
                                              const float* __restrict__ g_pre_ffn, const float* __restrict__ w_router, const float* __restrict__ b_router,
                                              float* __restrict__ x1, bf16_t* __restrict__ h2, int* __restrict__ topi, float* __restrict__ gate, unsigned* __restrict__ ctl) {
    const int lane = threadIdx.x & 63, row = blockIdx.x * 4 + (threadIdx.x >> 6), b = row / SEQ;
    const float* mb = mod + b * 6144; const float* gt1 = mb + 2048; const float* sh2 = mb + 3072; const float* sc2 = mb + 4096;
    f32x4 mv[4], xv[4]; float ss = 0.f;
#pragma unroll
    for (int i = 0; i < 4; ++i) { mv[i] = *(const f32x4*)(mix + (size_t)row * D + i * 256 + lane * 4); xv[i] = *(const f32x4*)(x + (size_t)row * D + i * 256 + lane * 4);
        ss += mv[i].x * mv[i].x + mv[i].y * mv[i].y + mv[i].z * mv[i].z + mv[i].w * mv[i].w; }
    float rstd = rsqrtf(wave_sum(ss) * (1.f / D) + RMS_EPS); ss = 0.f;
#pragma unroll
    for (int i = 0; i < 4; ++i) { const int c0 = i * 256 + lane * 4;
#pragma unroll
        for (int e = 0; e < 4; ++e) { xv[i][e] = xv[i][e] + gt1[c0 + e] * (mv[i][e] * rstd * g_post_mix[c0 + e]); ss += xv[i][e] * xv[i][e]; }
        *(f32x4*)(x1 + (size_t)row * D + c0) = xv[i]; }
    rstd = rsqrtf(wave_sum(ss) * (1.f / D) + RMS_EPS);
    float lg[32];
#pragma unroll
    for (int e = 0; e < 32; ++e) lg[e] = 0.f;
#pragma unroll
    for (int i = 0; i < 4; ++i) { const int c0 = i * 256 + lane * 4;
#pragma unroll
        for (int j = 0; j < 4; ++j) { const float hv = xv[i][j] * rstd * g_pre_ffn[c0 + j] * (1.f + sc2[c0 + j]) + sh2[c0 + j];
            h2[(size_t)row * D + c0 + j] = f2bf(hv); const float* wr = w_router + (size_t)(c0 + j) * 32;
#pragma unroll
            for (int e = 0; e < 32; ++e) lg[e] += hv * wr[e]; } }
#pragma unroll
    for (int e = 0; e < 32; ++e) lg[e] = wave_sum(lg[e]) + b_router[e];
    unsigned taken = 0u; float tv[4]; int ti[4];
#pragma unroll
    for (int p = 0; p < 4; ++p) { float best = -INFINITY; int bi = 0;
#pragma unroll
        for (int e = 0; e < 32; ++e) { const bool ok = !((taken >> e) & 1u) && (lg[e] > best); best = ok ? lg[e] : best; bi = ok ? e : bi; }
        taken |= 1u << bi; tv[p] = best; ti[p] = bi; }
    if (lane == 0) { float e0 = 1.f, e1 = __expf(tv[1] - tv[0]), e2 = __expf(tv[2] - tv[0]), e3 = __expf(tv[3] - tv[0]); const float rs = 1.f / (e0 + e1 + e2 + e3);
        const float gg[4] = {e0 * rs, e1 * rs, e2 * rs, e3 * rs};
#pragma unroll
        for (int p = 0; p < 4; ++p) { topi[row * 4 + p] = ti[p]; gate[row * 4 + p] = gg[p]; atomicAdd(&ctl[CW_CNT + ti[p]], 1u); } }
}
__global__ void k_scan(unsigned* ctl) {
    if (threadIdx.x == 0) { unsigned off = 0;
        for (int e = 0; e < NE; ++e) { const unsigned cnt = ctl[CW_CNT + e], pad = (cnt + 255u) & ~255u; ctl[CW_PADSTART + e] = off;
            for (unsigned tl = 0; tl < pad / 256; ++tl) ctl[CW_TILEEXP + off / 256 + tl] = e; off += pad; }
        ctl[CW_TOTAL] = off; }
}
__global__ void __launch_bounds__(256) k_scatter(const int* __restrict__ topi, int* __restrict__ dest, int* __restrict__ tok, unsigned* ctl) {
    const int a = blockIdx.x * 256 + threadIdx.x; const int e = topi[a];
    const unsigned pos = atomicAdd(&ctl[CW_CUR + e], 1u); const int dd = (int)(ctl[CW_PADSTART + e] + pos);
    dest[a] = dd; tok[dd] = a >> 2;
}
__global__ void __launch_bounds__(256) k_final(const float* __restrict__ x1, const bf16_t* __restrict__ ybuf, const int* __restrict__ dest, const float* __restrict__ gate,
                                               const float* __restrict__ mod, const float* __restrict__ g_post_ffn, float* __restrict__ out) {
    const int lane = threadIdx.x & 63, row = blockIdx.x * 4 + (threadIdx.x >> 6), b = row / SEQ;
    const float* gt2 = mod + b * 6144 + 5120;
    float f[16]; float ss = 0.f;
#pragma unroll
    for (int i = 0; i < 16; ++i) f[i] = 0.f;
#pragma unroll
    for (int p = 0; p < 4; ++p) { const float gp = gate[row * 4 + p]; const bf16_t* yr = ybuf + (size_t)dest[row * 4 + p] * D;
#pragma unroll
        for (int i = 0; i < 4; ++i)
#pragma unroll
            for (int e = 0; e < 4; ++e) f[i * 4 + e] += gp * bf2f(yr[i * 256 + lane * 4 + e]); }
#pragma unroll
    for (int i = 0; i < 16; ++i) ss += f[i] * f[i];
    const float rstd = rsqrtf(wave_sum(ss) * (1.f / D) + RMS_EPS);
#pragma unroll
    for (int i = 0; i < 4; ++i) { const int c0 = i * 256 + lane * 4; f32x4 xv = *(const f32x4*)(x1 + (size_t)row * D + c0), ov;
#pragma unroll
        for (int e = 0; e < 4; ++e) ov[e] = xv[e] + gt2[c0 + e] * (f[i * 4 + e] * rstd * g_post_ffn[c0 + e]);
        *(f32x4*)(out + (size_t)row * D + c0) = ov; }
}

extern "C" void kernel_launch(void* const* d_in, const int* in_sizes, int n_in, void* d_out, int out_size, void* d_ws, size_t ws_size, hipStream_t stream) {
    if (n_in != 22 || ws_size < WS_END) { fprintf(stderr, "kernel_launch: unexpected n_in %d / ws %zu\n", n_in, ws_size); return; }
    const float* x = (const float*)d_in[0]; const float* c = (const float*)d_in[1]; const float* w_ada = (const float*)d_in[2]; const float* b_ada = (const float*)d_in[3];
    const float* g_pre_mix = (const float*)d_in[4]; const float* g_post_mix = (const float*)d_in[5]; const float* w_in = (const float*)d_in[6]; const float* w_out = (const float*)d_in[7];
    const float* lq1 = (const float*)d_in[8]; const float* lk1 = (const float*)d_in[9]; const float* lq2 = (const float*)d_in[10]; const float* lk2 = (const float*)d_in[11];
    const float* g_sub = (const float*)d_in[12]; const float* rpb = (const float*)d_in[13]; const float* g_pre_ffn = (const float*)d_in[14]; const float* g_post_ffn = (const float*)d_in[15];
    const float* w_router = (const float*)d_in[16]; const float* b_router = (const float*)d_in[17]; const float* w1 = (const float*)d_in[18]; const float* b1 = (const float*)d_in[19];
    const float* w2 = (const float*)d_in[20]; const float* b2 = (const float*)d_in[21];
    unsigned char* ws = (unsigned char*)d_ws; float* out = (float*)d_out;
    unsigned* ctl = (unsigned*)(ws + WS_CTL); float* modp = (float*)(ws + WS_MODP); float* mod = (float*)(ws + WS_MOD);
    int* topi = (int*)(ws + WS_TOPI); float* gate = (float*)(ws + WS_GATE); int* dest = (int*)(ws + WS_DEST); int* tok = (int*)(ws + WS_TOK);
    bf16_t* xn = (bf16_t*)(ws + WS_XN); bf16_t* proj = (bf16_t*)(ws + WS_PROJ); float* odiff = (float*)(ws + WS_ODIFF); bf16_t* concat = (bf16_t*)(ws + WS_CONCAT);
    float* mix = (float*)(ws + WS_MIX); float* x1 = (float*)(ws + WS_X1); bf16_t* h2 = (bf16_t*)(ws + WS_H2); bf16_t* act = (bf16_t*)(ws + WS_ACT); bf16_t* ybuf = (bf16_t*)(ws + WS_YBUF);

    (void)hipMemsetAsync(ws + WS_CTL, 0, 1 * MiB, stream);
    (void)hipMemsetAsync(tok, 0, CAP * sizeof(int), stream);
    k_mod<<<dim3(24, 16), 256, 0, stream>>>(c, w_ada, modp);
    k_modsum<<<48, 256, 0, stream>>>(modp, b_ada, mod);
    k_xn<<<M / 4, 256, 0, stream>>>(x, g_pre_mix, mod, xn);
    k_gemm<<<dim3(NPROJ / 64, M / 64), 256, 0, stream>>>((long)D, A_bf16{xn, D}, B_f32{w_in, NPROJ}, E_bf16{proj, NPROJ});
    k_diffattn<<<dim3(SEQ / 256, 2, 8), 256, 0, stream>>>(proj, odiff);
    k_diffcomb<<<M / 4, 256, 0, stream>>>(odiff, lq1, lk1, lq2, lk2, g_sub, concat);
    k_nat<<<M * 8 / 256, 256, 0, stream>>>(proj, rpb, concat);
    k_gemm<<<dim3(D / 64, M / 64), 256, 0, stream>>>((long)D, A_bf16{concat, D}, B_f32{w_out, D}, E_f32{mix, D});
    k_post<<<M / 4, 256, 0, stream>>>(x, mix, mod, g_post_mix, g_pre_ffn, w_router, b_router, x1, h2, topi, gate, ctl);
    k_scan<<<1, 64, 0, stream>>>(ctl);
    k_scatter<<<NASSIGN / 256, 256, 0, stream>>>(topi, dest, tok, ctl);
    k_gemm<<<dim3(2048 / 64, CAP / 64), 256, 0, stream>>>((long)D, A_gather{h2, tok, ctl}, B_exp{w1, 2048, (size_t)1024 * 2048, ctl}, E_swiglu{act, b1, ctl});
    k_gemm<<<dim3(D / 64, CAP / 64), 256, 0, stream>>>((long)FF, A_act{act, ctl}, B_exp{w2, 1024, (size_t)1024 * 1024, ctl}, E_y{ybuf, b2, ctl});
    k_final<<<M / 4, 256, 0, stream>>>(x1, ybuf, dest, gate, mod, g_post_ffn, out);
}
```

```cpp
#include <hip/hip_runtime.h>
#include <stdint.h>
#include <stdio.h>

#define GAS __attribute__((address_space(1)))
#define LAS __attribute__((address_space(3)))
typedef unsigned short bf16;
typedef unsigned v4u __attribute__((ext_vector_type(4)));
typedef float f32x4 __attribute__((ext_vector_type(4)));
typedef GAS unsigned gu32;
#define LDS_WAIT() asm volatile("s_waitcnt lgkmcnt(0)" ::: "memory")
#define VM_WAIT() asm volatile("s_waitcnt vmcnt(0)" ::: "memory")

constexpr int NB = 2, SEQ = 8192, D = 1024, M = NB * SEQ;
constexpr int NPROJ = 3072, NE = 32, TOPK = 4, FF = 1024;
constexpr int NASSIGN = M * TOPK;
constexpr int CAP = NASSIGN + NE * 256;
constexpr int MAXTILES = CAP / 256;
constexpr int NCHUNK = M / 64;
constexpr float RMS_EPS = 1e-6f;
constexpr int NWAVES = 8, NTHR = 512;

constexpr size_t MiB = 1u << 20;
constexpr size_t WS_CTL = 0;
constexpr size_t WS_MODP = 1 * MiB;
constexpr size_t WS_HIST = 2 * MiB;
constexpr size_t WS_TOPI = 3 * MiB;
constexpr size_t WS_GATE = 3 * MiB + 512 * 1024;
constexpr size_t WS_DEST = 4 * MiB;
constexpr size_t WS_WIN = 6 * MiB;
constexpr size_t WS_WOUT = 12 * MiB;
constexpr size_t WS_XN = 16 * MiB;
constexpr size_t WS_PROJ = 48 * MiB;
constexpr size_t WS_ODIFF = 144 * MiB;
constexpr size_t WS_XBUF = 48 * MiB;
constexpr size_t WS_CONCAT = 208 * MiB;
constexpr size_t WS_MIX = 240 * MiB;
constexpr size_t WS_X1 = 304 * MiB;
constexpr size_t WS_H2 = 368 * MiB;
constexpr size_t WS_ACT = 400 * MiB;
constexpr size_t WS_YBUF = 544 * MiB;
constexpr size_t WS_W1T = 688 * MiB;
constexpr size_t WS_W2T = 816 * MiB;
constexpr size_t WS_END = 880 * MiB;
static_assert(WS_XBUF + (size_t)CAP * D * 2 <= WS_CONCAT, "XBUF overlay");
constexpr int CW_TOTAL = 64;
constexpr int CW_TILEEXP = 128;
constexpr int CW_BAR = 4096;

constexpr int RING_OFF = 0, RING_BYTES = 131072;
constexpr int LDSCTL_OFF = RING_BYTES, MISC_OFF = LDSCTL_OFF + 320, TAB_OFF = LDSCTL_OFF + 1024;
constexpr int LDS_BYTES = 147456;

__device__ __forceinline__ float bf2f(bf16 v) { return __uint_as_float(((unsigned)v) << 16); }
__device__ __forceinline__ unsigned f2bf(float f) { unsigned u = __builtin_bit_cast(unsigned, f); return (u + 0x7fffu + ((u >> 16) & 1u)) >> 16; }
__device__ __forceinline__ unsigned pk2(float lo, float hi) { return f2bf(lo) | (f2bf(hi) << 16); }
namespace pg8 {
#define PG8_LAS __attribute__((address_space(3)))
typedef unsigned short bf16_t;
typedef short bf16x8 __attribute__((ext_vector_type(8)));
typedef float f32x4 __attribute__((ext_vector_type(4)));
typedef unsigned u32x4 __attribute__((ext_vector_type(4)));
constexpr int BM = 256, BK = 64, HALF = 128, HTB = HALF * BK * 2  , STAGE_BYTES = 8 * HTB, NXCD = 8, WGM = 8;

__host__ __device__ __forceinline__ int lds_byte(int r, int c) { const int st = (r >> 4) * 2 + (c >> 5), rr = r & 15, cc = c & 31, ob = rr * 64 + cc * 2; return st * 1024 + (ob ^ (((ob >> 9) & 1) << 5)); }
__host__ __device__ __forceinline__ void stage_rc(int b, int& R, int& C) { const int st = b / 1024, sb = b % 1024, swz = sb ^ (((sb >> 9) & 1) << 5); R = (st >> 1) * 16 + swz / 64; C = (st & 1) * 32 + (swz % 64) / 2; }
__host__ __device__ __forceinline__ int perm32(int rho) { const int n = rho >> 4, i = rho & 15; return 8 * (i >> 2) + 4 * n + (i & 3); }

struct Unit { int pm, pn; };
struct Gemm { const bf16_t* A; const bf16_t* Bt; int M, N, K; };

struct StaticOrder {
    int nM, nN, nwg, G, c;
    __host__ __device__ void init(int M, int N, int G_, int c_) { nM = M / BM; nN = N / BM; nwg = nM * nN; G = G_; c = c_; }
    __host__ __device__ bool next(int i, Unit& u) const {
        const long L = (long)i * G + c; if (L >= nwg) return false;
        int wgid = (int)L; { const int q = nwg / NXCD, r = nwg % NXCD, xcd = wgid % NXCD, off = wgid / NXCD; wgid = (xcd < r ? xcd * (q + 1) : r * (q + 1) + (xcd - r) * q) + off; }
        const int nig = WGM * nN, gid = wgid / nig, fm = gid * WGM, gsz = (nM - fm) < WGM ? (nM - fm) : WGM;
        u.pm = fm + ((wgid % nig) % gsz); u.pn = (wgid % nig) / gsz; return true;
    }
    __device__ __forceinline__ void a_ready(const Unit&) const {}
    __device__ __forceinline__ void done(const Unit&) const {}
};

__device__ __forceinline__ unsigned cvt_pk_bf16(float lo, float hi) { unsigned r; asm volatile("v_cvt_pk_bf16_f32 %0, %1, %2" : "=v"(r) : "v"(lo), "v"(hi)); return r; }
struct EpiStoreBf16 {
    static constexpr bool PERM = true, AFTER_DRAIN = false;
    bf16_t* O; int ldc; int scale_cols; float scale0;
    __device__ __forceinline__ void operator()(const f32x4 (&acc)[2][2][4][2], const Unit& u, int wr, int wc, int fr, int fq) const {
        const int row0 = u.pm * BM + wr * 64 + fr, colt = u.pn * BM, col0 = colt + wc * 32 + 8 * fq; const float sc = colt < scale_cols ? scale0 : 1.f;
#pragma unroll
        for (int ai = 0; ai < 2; ++ai)
#pragma unroll
            for (int m = 0; m < 4; ++m) { bf16_t* rowp = O + (size_t)(row0 + ai * HALF + m * 16) * ldc + col0;
#pragma unroll
                for (int bj = 0; bj < 2; ++bj) { const f32x4 v0 = acc[ai][bj][m][0] * sc, v1 = acc[ai][bj][m][1] * sc;
                    u32x4 w; w.x = cvt_pk_bf16(v0[0], v0[1]); w.y = cvt_pk_bf16(v0[2], v0[3]); w.z = cvt_pk_bf16(v1[0], v1[1]); w.w = cvt_pk_bf16(v1[2], v1[3]);
                    *(u32x4*)(rowp + bj * HALF) = w; } }
    }
};
struct EpiStoreF32 {
    static constexpr bool PERM = true, AFTER_DRAIN = false;
    float* O; int ldc;
    __device__ __forceinline__ void operator()(const f32x4 (&acc)[2][2][4][2], const Unit& u, int wr, int wc, int fr, int fq) const {
        const int row0 = u.pm * BM + wr * 64 + fr, col0 = u.pn * BM + wc * 32 + 8 * fq;
#pragma unroll
        for (int ai = 0; ai < 2; ++ai)
#pragma unroll
            for (int m = 0; m < 4; ++m) { float* rowp = O + (size_t)(row0 + ai * HALF + m * 16) * ldc + col0;
#pragma unroll
                for (int bj = 0; bj < 2; ++bj) { *(f32x4*)(rowp + bj * HALF) = acc[ai][bj][m][0]; *(f32x4*)(rowp + bj * HALF + 4) = acc[ai][bj][m][1]; } }
    }
};
struct EpiSwiglu {
    static constexpr bool PERM = true, AFTER_DRAIN = false;
    bf16_t* act; const float* b1;
    __device__ __forceinline__ void operator()(const f32x4 (&acc)[2][2][4][2], const Unit& u, int wr, int wc, int fr, int fq) const {
        const int e = u.pn >> 3, pnl = u.pn & 7, row0 = u.pm * BM + wr * 64 + fr, hc0 = pnl * BM + wc * 32 + 8 * fq;
        f32x4 bv[2][2];
#pragma unroll
        for (int bj = 0; bj < 2; ++bj)
#pragma unroll
            for (int n = 0; n < 2; ++n) bv[bj][n] = *(const f32x4*)(b1 + e * 2048 + hc0 + bj * HALF + 4 * n);
#pragma unroll
        for (int ai = 0; ai < 2; ++ai)
#pragma unroll
            for (int m = 0; m < 4; ++m) { bf16_t* rowp = act + (size_t)(row0 + ai * HALF + m * 16) * 1024 + (hc0 >> 1);
#pragma unroll
                for (int bj = 0; bj < 2; ++bj) { const f32x4 v0 = acc[ai][bj][m][0] + bv[bj][0], v1 = acc[ai][bj][m][1] + bv[bj][1];
                    float r[4];
                    const float gg[4] = {v0[0], v0[2], v1[0], v1[2]}, ll[4] = {v0[1], v0[3], v1[1], v1[3]};
#pragma unroll
                    for (int p = 0; p < 4; ++p) { float g = gg[p], l = ll[p];
                        g = fminf(g, 7.f); l = fminf(fmaxf(l, -7.f), 7.f);
                        r[p] = g * __builtin_amdgcn_rcpf(1.f + __expf(-1.702f * g)) * (l + 1.f); }
                    uint2 w; w.x = cvt_pk_bf16(r[0], r[1]); w.y = cvt_pk_bf16(r[2], r[3]);
                    *(uint2*)(rowp + bj * (HALF / 2)) = w; } }
    }
};
struct EpiY {
    static constexpr bool PERM = true, AFTER_DRAIN = false;
    bf16_t* y; const float* b2;
    __device__ __forceinline__ void operator()(const f32x4 (&acc)[2][2][4][2], const Unit& u, int wr, int wc, int fr, int fq) const {
        const int e = u.pn >> 2, pnl = u.pn & 3, row0 = u.pm * BM + wr * 64 + fr, col0 = pnl * BM + wc * 32 + 8 * fq;
        f32x4 bv[2][2];
#pragma unroll
        for (int bj = 0; bj < 2; ++bj)
#pragma unroll
            for (int n = 0; n < 2; ++n) bv[bj][n] = *(const f32x4*)(b2 + e * 1024 + col0 + bj * HALF + 4 * n);
#pragma unroll
        for (int ai = 0; ai < 2; ++ai)
#pragma unroll
            for (int m = 0; m < 4; ++m) { bf16_t* rowp = y + (size_t)(row0 + ai * HALF + m * 16) * 1024 + col0;
#pragma unroll
                for (int bj = 0; bj < 2; ++bj) { const f32x4 v0 = acc[ai][bj][m][0] + bv[bj][0], v1 = acc[ai][bj][m][1] + bv[bj][1];
                    u32x4 w; w.x = cvt_pk_bf16(v0[0], v0[1]); w.y = cvt_pk_bf16(v0[2], v0[3]); w.z = cvt_pk_bf16(v1[0], v1[1]); w.w = cvt_pk_bf16(v1[2], v1[3]);
                    *(u32x4*)(rowp + bj * HALF) = w; } }
    }
};
template <int NN> struct MoeOrder {
    int nunit, G, c; const PG8_LAS int* texp;
    __device__ __forceinline__ bool next(int i, Unit& u) const {
        const int L = i * G + c; if (L >= nunit) return false;
        const int pm = L / NN, pnl = L % NN; u.pm = pm; u.pn = __builtin_amdgcn_readfirstlane(texp[pm]) * NN + pnl; return true;
    }
    __device__ __forceinline__ void a_ready(const Unit&) const {}
    __device__ __forceinline__ void done(const Unit&) const {}
};
template <class Epi, class Sched, bool ALIGN_EPI = false, bool SP2 = false>
__device__ __forceinline__ void gemm_phase(PG8_LAS unsigned char* lds, const Gemm g, const Sched& S, const Epi& E) {
    int tid_ = threadIdx.x; asm volatile("" : "+v"(tid_));
    const int tid = tid_, wid = __builtin_amdgcn_readfirstlane(tid >> 6), lane = tid & 63, wr = wid >> 2, wc = wid & 3, fr = lane & 15, fq = lane >> 4;
    const int K = g.K, nt = K / BK;
    unsigned voffA[2], voffB[2];
#pragma unroll
    for (int i = 0; i < 2; ++i) { int R, C; stage_rc(tid * 16 + i * 8192, R, C); const int Rb = Epi::PERM ? ((R & ~31) + perm32(R & 31)) : R;
        voffA[i] = (unsigned)(R * K + C) * 2u; voffB[i] = (unsigned)(Rb * K + C) * 2u; }
    const size_t kstep = (size_t)(BK * 2);
    const size_t hstep = (size_t)HALF * K * 2;
    const size_t tstep = 2 * hstep;
    const unsigned ldsw = (unsigned)wid * 1024u;
    const int aoff = lds_byte(wr * 64 + fr, fq * 8), boff = lds_byte(wc * 32 + fr, fq * 8);
#define PG8_SA(b, h) (((b) * 2 + (h)) * HTB)
#define PG8_SB(b, h) ((4 + (b) * 2 + (h)) * HTB)
#define PG8_STAGE(bufoff, gbase, voff) do { _Pragma("unroll") for (int _i = 0; _i < 2; ++_i) \
        __builtin_amdgcn_global_load_lds((const unsigned*)((const char*)(gbase) + (voff)[_i]), (PG8_LAS unsigned*)(lds + (bufoff) + ldsw + _i * 8192), 16, 0, 0); } while (0)
#define PG8_LDA(dst, b, h) do { _Pragma("unroll") for (int m = 0; m < 4; ++m) _Pragma("unroll") for (int k = 0; k < 2; ++k) dst[m][k] = *(const PG8_LAS bf16x8*)(lds + PG8_SA(b, h) + aoff + m * 2048 + k * 1024); } while (0)
#define PG8_LDB(dst, b, h) do { _Pragma("unroll") for (int n = 0; n < 2; ++n) _Pragma("unroll") for (int k = 0; k < 2; ++k) dst[n][k] = *(const PG8_LAS bf16x8*)(lds + PG8_SB(b, h) + boff + n * 2048 + k * 1024); } while (0)
#define PG8_MMA(ai, bj, At, Bt) do { __builtin_amdgcn_s_setprio(1); _Pragma("unroll") for (int m = 0; m < 4; ++m) _Pragma("unroll") for (int n = 0; n < 2; ++n) _Pragma("unroll") for (int k = 0; k < 2; ++k) \
        acc[ai][bj][m][n] = __builtin_amdgcn_mfma_f32_16x16x32_bf16(Bt[n][k], At[m][k], acc[ai][bj][m][n], 0, 0, 0); __builtin_amdgcn_s_setprio(0); } while (0)
#define PG8_WAIT_V(n) asm volatile("s_waitcnt vmcnt(" #n ")" ::: "memory")
#define PG8_WAIT_L(n) asm volatile("s_waitcnt lgkmcnt(" #n ")" ::: "memory")
#define PG8_BAR __builtin_amdgcn_s_barrier()
#define PG8_SCHED __builtin_amdgcn_sched_barrier(0)
    Unit cur, nxt; int ui = 0;
    if (!S.next(0, cur)) return;
    f32x4 acc[2][2][4][2];
#pragma unroll
    for (int a = 0; a < 2; ++a)
#pragma unroll
        for (int b = 0; b < 2; ++b)
#pragma unroll
            for (int m = 0; m < 4; ++m)
#pragma unroll
                for (int n = 0; n < 2; ++n) acc[a][b][m][n] = (f32x4){0.f, 0.f, 0.f, 0.f};
    bf16x8 At[4][2], B0[2][2], B1[2][2];
    const char* cA = (const char*)g.A + (size_t)cur.pm * tstep; const char* cB = (const char*)g.Bt + (size_t)cur.pn * tstep;
    S.a_ready(cur);
    if constexpr (SP2) {
        PG8_STAGE(PG8_SB(0, 0), cB, voffB); PG8_STAGE(PG8_SB(0, 1), cB + hstep, voffB); PG8_STAGE(PG8_SA(0, 0), cA, voffA); PG8_STAGE(PG8_SA(0, 1), cA + hstep, voffA);
        if (wr == 1) PG8_BAR;
        PG8_WAIT_V(2); PG8_BAR;
        PG8_STAGE(PG8_SB(1, 0), cB + kstep, voffB); PG8_STAGE(PG8_SA(1, 0), cA + kstep, voffA); PG8_STAGE(PG8_SB(1, 1), cB + hstep + kstep, voffB);
        PG8_WAIT_V(6); PG8_BAR;
    } else {
        PG8_STAGE(PG8_SB(0, 0), cB, voffB); PG8_STAGE(PG8_SA(0, 0), cA, voffA); PG8_STAGE(PG8_SB(0, 1), cB + hstep, voffB); PG8_STAGE(PG8_SA(0, 1), cA + hstep, voffA);
        if (wr == 1) PG8_BAR;
        PG8_WAIT_V(4); PG8_BAR;
        PG8_STAGE(PG8_SB(1, 0), cB + kstep, voffB); PG8_STAGE(PG8_SA(1, 0), cA + kstep, voffA); PG8_STAGE(PG8_SB(1, 1), cB + hstep + kstep, voffB);
        PG8_WAIT_V(6); PG8_BAR;
    }
    for (;;) {
        const bool has_next = S.next(ui + 1, nxt);
        const char* nA = has_next ? (const char*)g.A + (size_t)nxt.pm * tstep : cA; const char* nB = has_next ? (const char*)g.Bt + (size_t)nxt.pn * tstep : cB;
        for (int t = 0; t < nt; t += 2) {
            const bool last = (t == nt - 2);
            const char* a1 = cA + (size_t)(t + 1) * kstep;
            const char* a2 = last ? nA : cA + (size_t)(t + 2) * kstep; const char* b2 = last ? nB : cB + (size_t)(t + 2) * kstep;
            const char* a3 = a2 + kstep; const char* b3 = b2 + kstep;
            if (last && has_next) S.a_ready(nxt);
            if constexpr (SP2) {
            PG8_LDB(B0, 0, 0); PG8_LDB(B1, 0, 1); PG8_SCHED; PG8_LDA(At, 0, 0); PG8_STAGE(PG8_SA(1, 1), a1 + hstep, voffA);
            PG8_WAIT_V(8); PG8_WAIT_L(0); PG8_BAR; PG8_MMA(0, 0, At, B0); PG8_MMA(0, 1, At, B1); PG8_BAR; PG8_SCHED;
            PG8_LDA(At, 0, 1); PG8_STAGE(PG8_SB(0, 0), b2, voffB); PG8_STAGE(PG8_SB(0, 1), b2 + hstep, voffB); PG8_STAGE(PG8_SA(0, 0), a2, voffA);
            PG8_WAIT_V(8); PG8_WAIT_L(0); PG8_BAR; PG8_MMA(1, 0, At, B0); PG8_MMA(1, 1, At, B1); PG8_BAR; PG8_SCHED;
            PG8_LDB(B0, 1, 0); PG8_LDB(B1, 1, 1); PG8_SCHED; PG8_LDA(At, 1, 0); PG8_STAGE(PG8_SA(0, 1), a2 + hstep, voffA);
            PG8_WAIT_V(8); PG8_WAIT_L(0); PG8_BAR; PG8_MMA(0, 0, At, B0); PG8_MMA(0, 1, At, B1); PG8_BAR; PG8_SCHED;
            PG8_LDA(At, 1, 1); PG8_STAGE(PG8_SB(1, 0), b3, voffB); PG8_STAGE(PG8_SB(1, 1), b3 + hstep, voffB); PG8_STAGE(PG8_SA(1, 0), a3, voffA);
            PG8_WAIT_V(8); PG8_WAIT_L(0); PG8_BAR; PG8_MMA(1, 0, At, B0); PG8_MMA(1, 1, At, B1); PG8_BAR; PG8_SCHED;
            } else {
            PG8_LDB(B0, 0, 0); PG8_SCHED; PG8_LDA(At, 0, 0); PG8_STAGE(PG8_SA(1, 1), a1 + hstep, voffA);
            PG8_WAIT_L(8); PG8_BAR; PG8_WAIT_L(0); PG8_MMA(0, 0, At, B0); PG8_BAR; PG8_SCHED;
            PG8_LDB(B1, 0, 1); PG8_STAGE(PG8_SB(0, 0), b2, voffB);
            PG8_BAR; PG8_WAIT_L(0); PG8_MMA(0, 1, At, B1); PG8_BAR;
            PG8_LDA(At, 0, 1); PG8_STAGE(PG8_SA(0, 0), a2, voffA);
            PG8_BAR; PG8_WAIT_L(0); PG8_MMA(1, 0, At, B0); PG8_BAR; PG8_SCHED;
            PG8_STAGE(PG8_SB(0, 1), b2 + hstep, voffB);
            PG8_WAIT_V(6); PG8_BAR; PG8_MMA(1, 1, At, B1); PG8_BAR;
            PG8_LDB(B0, 1, 0); PG8_SCHED; PG8_LDA(At, 1, 0); PG8_STAGE(PG8_SA(0, 1), a2 + hstep, voffA);
            PG8_WAIT_L(8); PG8_BAR; PG8_WAIT_L(0); PG8_MMA(0, 0, At, B0); PG8_BAR; PG8_SCHED;
            PG8_LDB(B1, 1, 1); PG8_STAGE(PG8_SB(1, 0), b3, voffB);
            PG8_BAR; PG8_WAIT_L(0); PG8_MMA(0, 1, At, B1); PG8_BAR;
            PG8_LDA(At, 1, 1); PG8_STAGE(PG8_SA(1, 0), a3, voffA);
            PG8_BAR; PG8_WAIT_L(0); PG8_MMA(1, 0, At, B0); PG8_BAR; PG8_SCHED;
            PG8_STAGE(PG8_SB(1, 1), b3 + hstep, voffB);
            PG8_WAIT_V(6); PG8_BAR; PG8_MMA(1, 1, At, B1); PG8_BAR;
            }
        }
        if constexpr (ALIGN_EPI) { if (wr == 0) PG8_BAR; }
        if constexpr (!Epi::AFTER_DRAIN) { E(acc, cur, wr, wc, fr, fq); S.done(cur); }
        if (!has_next) break;
#pragma unroll
        for (int a = 0; a < 2; ++a)
#pragma unroll
            for (int b = 0; b < 2; ++b)
#pragma unroll
                for (int m = 0; m < 4; ++m)
#pragma unroll
                    for (int n = 0; n < 2; ++n) acc[a][b][m][n] = (f32x4){0.f, 0.f, 0.f, 0.f};
        cur = nxt; cA = nA; cB = nB; ++ui;
        if constexpr (ALIGN_EPI) { if (wr == 1) PG8_BAR; }
    }
    PG8_WAIT_V(0);
    if constexpr (!ALIGN_EPI) { if (wr == 0) PG8_BAR; }
    PG8_BAR;
    if constexpr (Epi::AFTER_DRAIN) { E.fused(acc, cur, wr, wc, fr, fq, lds, wid, lane); S.done(cur); }
#undef PG8_SA
#undef PG8_SB
#undef PG8_STAGE
#undef PG8_LDA
#undef PG8_LDB
#undef PG8_MMA
#undef PG8_WAIT_V
#undef PG8_WAIT_L
#undef PG8_BAR
#undef PG8_SCHED
}
}
#define XB_TMO      128
#define XB_XCNT(j)  (256  + 64 * (j))
#define XB_XSUB(j)  (1280 + 64 * (j))
#define XB_XGEN(j)  (2304 + 64 * (j))
#define XB_TOP      3328
#define XB_TOPGEN   3392
#define XCD_BAR_WORDS 3456
#define XB_SPIN_CAP (1u << 18)

__device__ __forceinline__ unsigned xb_ld(unsigned* p)              { return __hip_atomic_load(p, __ATOMIC_RELAXED, __HIP_MEMORY_SCOPE_AGENT); }
__device__ __forceinline__ unsigned xb_add(unsigned* p, unsigned v) { return __hip_atomic_fetch_add(p, v, __ATOMIC_RELAXED, __HIP_MEMORY_SCOPE_AGENT); }
__device__ __forceinline__ unsigned xb_xcc_id() { return (unsigned)__builtin_amdgcn_s_getreg((3 << 11) | 20) & 0xFu; }
#define XB_SPIN(cond, bar) do { unsigned _sp = 0; while (cond) { __builtin_amdgcn_s_sleep(1); \
    if ((++_sp & 255u) == 0u) { if (xb_ld(&(bar)[XB_TMO])) break; if (_sp > XB_SPIN_CAP) { atomicAdd(&(bar)[XB_TMO], 1u); break; } } } } while (0)

struct XcdBarrier {
    unsigned* bar; unsigned x;
    volatile LAS unsigned* st;
};

__device__ __forceinline__ XcdBarrier xcd_barrier_post(unsigned* bar, volatile LAS unsigned* st) {
    XcdBarrier b; b.bar = bar; b.x = xb_xcc_id(); b.st = st;
    if (threadIdx.x == 0) (void)xb_add(&bar[XB_XCNT(b.x)], 1u);
    return b;
}
__device__ __forceinline__ void xcd_barrier_complete(unsigned* bar, unsigned x, unsigned& nloc, unsigned& nx) {
    const unsigned G = gridDim.x * gridDim.y * gridDim.z;
    unsigned sum, cnt, mine, sp = 0u;
    for (;;) {
        sum = 0u; cnt = 0u; mine = 0u;
#pragma unroll
        for (unsigned j = 0; j < 16; ++j) { const unsigned c = xb_ld(&bar[XB_XCNT(j)]); sum += c; cnt += (c > 0u) ? 1u : 0u; mine = (j == x) ? c : mine; }
        if (sum == G) break;
        __builtin_amdgcn_s_sleep(1);
        if ((++sp & 255u) == 0u) { if (xb_ld(&bar[XB_TMO])) break; if (sp > XB_SPIN_CAP) { atomicAdd(&bar[XB_TMO], 1u); break; } }
    }
    nloc = mine > 0u ? mine : 1u; nx = cnt > 0u ? cnt : 1u;
}

__device__ __forceinline__ void xcd_barrier(const XcdBarrier& b) {
    asm volatile("s_waitcnt vmcnt(0)" ::: "memory");
    __syncthreads();
    if (threadIdx.x == 0) {
        unsigned* bar = b.bar;
        __builtin_amdgcn_s_waitcnt(0);
        unsigned nloc = b.st[0], nx = b.st[1];
        if (nloc == 0u) { xcd_barrier_complete(bar, b.x, nloc, nx); b.st[0] = nloc; b.st[1] = nx; }
        const unsigned old = xb_add(&bar[XB_XSUB(b.x)], 1u);
        const unsigned gen = old / nloc;
        if (old + 1u == (gen + 1u) * nloc) {
            __builtin_amdgcn_fence(__ATOMIC_RELEASE, "agent");
            asm volatile("s_waitcnt vmcnt(0)" ::: "memory");
            const unsigned og = xb_add(&bar[XB_TOP], 1u);
            const unsigned tg = og / nx;
            if (og + 1u == (tg + 1u) * nx) xb_add(&bar[XB_TOPGEN], 1u);
            else XB_SPIN(xb_ld(&bar[XB_TOPGEN]) == tg, bar);
            __builtin_amdgcn_fence(__ATOMIC_ACQUIRE, "agent");
            xb_add(&bar[XB_XGEN(b.x)], 1u);
            asm volatile("s_waitcnt vmcnt(0)" ::: "memory");
        } else {
            XB_SPIN(xb_ld(&bar[XB_XGEN(b.x)]) == gen, bar);
            __builtin_amdgcn_fence(__ATOMIC_ACQUIRE, "agent");
            asm volatile("s_waitcnt vmcnt(0)" ::: "memory");
        }
    }
    __syncthreads();
}
__device__ __forceinline__ float wave_sum(float v) {
#pragma unroll
    for (int o = 1; o < 64; o <<= 1) v += __shfl_xor(v, o);
    return v;
}
__device__ __forceinline__ void p0_transpose_item(const float* W, int K, int N, bf16* WT, int row_off, LAS float* scr, int item, int lane) {
    const int nblk = N / 32, kb = item / nblk, nb = item % nblk, k0 = 64 * kb, n0 = 32 * nb;
#pragma unroll 8
    for (int i = 0; i < 32; ++i) { const int kk = 2 * i + (lane >> 5); scr[kk * 33 + (lane & 31)] = W[(size_t)(k0 + kk) * N + n0 + (lane & 31)]; }
    LDS_WAIT(); asm volatile("" ::: "memory");
    const int c = lane & 7;
#pragma unroll
    for (int j = 0; j < 4; ++j) { const int n = (lane >> 3) + 8 * j; const LAS float* s = scr + (8 * c) * 33 + n;
        v4u o; o.x = pk2(s[0 * 33], s[1 * 33]); o.y = pk2(s[2 * 33], s[3 * 33]); o.z = pk2(s[4 * 33], s[5 * 33]); o.w = pk2(s[6 * 33], s[7 * 33]);
        *(GAS v4u*)(WT + (size_t)(row_off + n0 + n) * K + k0 + 8 * c) = o; }
    LDS_WAIT(); asm volatile("" ::: "memory");
}
struct Params { const float* in[22]; float* out; unsigned char* ws; };

__device__ __forceinline__ float mod_val(const float* __restrict__ modp, const float* __restrict__ b_ada, int b, int j) {
    return b_ada[j] + ((modp[(0 * 2 + b) * 6144 + j] + modp[(1 * 2 + b) * 6144 + j]) + (modp[(2 * 2 + b) * 6144 + j] + modp[(3 * 2 + b) * 6144 + j]));
}

__device__ __forceinline__ int opaque_v(int i) { asm volatile("" : "+v"(i)); return i; }
__device__ __forceinline__ int opaque_i(int i) { asm volatile("" : "+s"(i)); return i; }
__device__ __forceinline__ unsigned char* launder_ws(unsigned char* p) { asm volatile("" : "+s"(p)); return p; }
__global__ void __launch_bounds__(NTHR, 2) mk_fwd(Params P) {
    extern __shared__ __attribute__((aligned(16))) unsigned char lds_raw[];
    LAS unsigned char* lds = (LAS unsigned char*)lds_raw;
    const int tid0 = threadIdx.x, wave = __builtin_amdgcn_readfirstlane(tid0 >> 6);
#define PH_TID const int tid = opaque_v(tid0), lane = tid & 63; (void)lane
    const int G = gridDim.x, bx = blockIdx.x, vcu = (G % 8 == 0) ? (bx % 8) * (G / 8) + bx / 8 : bx;
    const int gw = vcu * NWAVES + wave, NGW = G * NWAVES;
    unsigned char* const ws0 = P.ws;
#define WSP(name, type, off) type* name = (type*)(launder_ws(ws0) + (off))
#define INP(name, i) const float* name = P.in[opaque_i(i)]
    LAS int* tab = (LAS int*)(lds + TAB_OFF);

    for (int u = tid0; u < (LDS_BYTES - LDSCTL_OFF) / 4; u += NTHR) ((LAS unsigned*)(lds + LDSCTL_OFF))[u] = 0u;
    __syncthreads();
    XcdBarrier bar = xcd_barrier_post((unsigned*)((gu32*)(ws0 + WS_CTL) + CW_BAR), (volatile LAS unsigned*)(lds + MISC_OFF) + 8);

    if (bx < 48) {
        PH_TID;
        INP(cvec, 1); INP(w_ada, 2); WSP(modp, float, WS_MODP);
        LAS float* sl = (LAS float*)lds;
        for (int i = tid; i < 2048; i += NTHR) { const float c0 = cvec[i]; sl[i] = c0 / (1.f + __expf(-c0)); }
        __syncthreads();
        for (int it = bx; it < 48; it += G) {
            const int j = (it % 12) * 512 + tid, kq = it / 12; float a0 = 0.f, a1 = 0.f;
#pragma unroll 8
            for (int k = kq * 256; k < kq * 256 + 256; ++k) { const float w = w_ada[(size_t)k * 6144 + j]; a0 += sl[k] * w; a1 += sl[1024 + k] * w; }
            modp[(kq * 2 + 0) * 6144 + j] = a0; modp[(kq * 2 + 1) * 6144 + j] = a1;
        }
        __syncthreads();
    }
    {
        LAS float* scr = (LAS float*)(lds + RING_OFF + wave * 16384);
        PH_TID;
        INP(w_in, 6); INP(w_out, 7); INP(w1, 18); INP(w2, 20); WSP(win_t, bf16, WS_WIN); WSP(wout_t, bf16, WS_WOUT); WSP(w1_t, bf16, WS_W1T); WSP(w2_t, bf16, WS_W2T);
        constexpr int I_IN = 16 * 96, I_OUT = 16 * 32, I_W1 = 16 * 64, I_W2 = 16 * 32;
        constexpr int NITEMS = I_IN + I_OUT + NE * (I_W1 + I_W2);
        for (int it = gw; it < NITEMS; it += NGW) {
            int r = it;
            if (r < I_IN) { p0_transpose_item(w_in, D, NPROJ, win_t, 0, scr, r, lane); continue; } r -= I_IN;
            if (r < I_OUT) { p0_transpose_item(w_out, D, D, wout_t, 0, scr, r, lane); continue; } r -= I_OUT;
            if (r < NE * I_W1) { const int e = r / I_W1; p0_transpose_item(w1 + (size_t)e * D * 2048, D, 2048, w1_t, e * 2048, scr, r % I_W1, lane); continue; } r -= NE * I_W1;
            { const int e = r / I_W2; p0_transpose_item(w2 + (size_t)e * FF * D, FF, D, w2_t, e * 1024, scr, r % I_W2, lane); }
        }
    }
    xcd_barrier(bar);

    {
        LAS float* mv = (LAS float*)lds;
        PH_TID;
        INP(x, 0); INP(b_ada, 3); INP(g_pre_mix, 4); WSP(modp, float, WS_MODP); WSP(xn, bf16, WS_XN);
        for (int i = tid; i < 4096; i += NTHR) mv[i] = mod_val(modp, b_ada, i >> 11, i & 2047);
        __syncthreads();
        for (int row = gw; row < M; row += NGW) {
            const int b = row / SEQ; const float* xr = x + (size_t)row * D; const LAS float* sh = mv + b * 2048; const LAS float* sc = sh + 1024;
            f32x4 v[4]; float ss = 0.f;
#pragma unroll
            for (int i = 0; i < 4; ++i) { v[i] = *(const f32x4*)(xr + i * 256 + lane * 4); ss += v[i].x * v[i].x + v[i].y * v[i].y + v[i].z * v[i].z + v[i].w * v[i].w; }
            const float rstd = rsqrtf(wave_sum(ss) * (1.f / D) + RMS_EPS);
#pragma unroll
            for (int i = 0; i < 4; ++i) { const int c0 = i * 256 + lane * 4; float o[4];
#pragma unroll
                for (int e = 0; e < 4; ++e) o[e] = v[i][e] * rstd * g_pre_mix[c0 + e] * (1.f + sc[c0 + e]) + sh[c0 + e];
                uint2 w; w.x = pk2(o[0], o[1]); w.y = pk2(o[2], o[3]); *(uint2*)(xn + (size_t)row * D + c0) = w; }
        }
        __syncthreads();
    }
    xcd_barrier(bar);

    {
        WSP(xn, bf16, WS_XN); WSP(win_t, bf16, WS_WIN); WSP(proj, bf16, WS_PROJ);
        pg8::Gemm g{xn, win_t, M, NPROJ, D}; pg8::StaticOrder S; S.init(M, NPROJ, G, bx);
        pg8::EpiStoreBf16 E{proj, NPROJ, 0, 1.f};
        pg8::gemm_phase<pg8::EpiStoreBf16, pg8::StaticOrder, true, true>(lds + RING_OFF, g, S, E);
    }
    xcd_barrier(bar);

    {
        LAS float* Ks = (LAS float*)lds; LAS float* Vs = Ks + 32 * 64;
        PH_TID;
        WSP(proj, bf16, WS_PROJ); WSP(odiff, float, WS_ODIFF);
        for (int it = bx; it < 512; it += G) {
            const int qb = it & 15, vh = (it >> 4) & 1, map = (it >> 5) & 1, bh = it >> 6, b = bh >> 2, h = bh & 3;
            const int qi = qb * 512 + tid; const size_t qrow = (size_t)b * SEQ + qi;
            const float slope = exp2f(-2.f * (float)(h + 1));
            float q[64], o[64];
#pragma unroll
            for (int d8 = 0; d8 < 8; ++d8) { const v4u w = *(const v4u*)(proj + qrow * NPROJ + h * 128 + map * 64 + d8 * 8);
#pragma unroll
                for (int j = 0; j < 4; ++j) { q[d8 * 8 + 2 * j] = __uint_as_float(w[j] << 16) * 0.125f; q[d8 * 8 + 2 * j + 1] = __uint_as_float(w[j] & 0xffff0000u) * 0.125f; } }
#pragma unroll
            for (int e = 0; e < 64; ++e) o[e] = 0.f;
            float m = -INFINITY, l = 0.f;
            for (int k0 = 0; k0 < SEQ; k0 += 32) {
                __syncthreads();
                { const int r = tid >> 4, d4 = (tid & 15) * 4; const size_t krow = ((size_t)b * SEQ + k0 + r) * NPROJ;
                  const uint2 kw = *(const uint2*)(proj + krow + 512 + h * 128 + map * 64 + d4), vw = *(const uint2*)(proj + krow + 1024 + h * 128 + vh * 64 + d4);
                  Ks[r * 64 + d4] = __uint_as_float(kw.x << 16); Ks[r * 64 + d4 + 1] = __uint_as_float(kw.x & 0xffff0000u); Ks[r * 64 + d4 + 2] = __uint_as_float(kw.y << 16); Ks[r * 64 + d4 + 3] = __uint_as_float(kw.y & 0xffff0000u);
                  Vs[r * 64 + d4] = __uint_as_float(vw.x << 16); Vs[r * 64 + d4 + 1] = __uint_as_float(vw.x & 0xffff0000u); Vs[r * 64 + d4 + 2] = __uint_as_float(vw.y << 16); Vs[r * 64 + d4 + 3] = __uint_as_float(vw.y & 0xffff0000u); }
                __syncthreads();
#pragma unroll 1
                for (int c0 = 0; c0 < 32; c0 += 8) {
                    float s[8]; float mx = -INFINITY;
#pragma unroll
                    for (int c = 0; c < 8; ++c) { float a = 0.f;
#pragma unroll
                        for (int d = 0; d < 64; ++d) a += q[d] * Ks[(c0 + c) * 64 + d];
                        s[c] = a - slope * fabsf((float)(qi - (k0 + c0 + c))); mx = fmaxf(mx, s[c]); }
                    if (mx > m) { const float f = __expf(m - mx); l *= f;
#pragma unroll
                        for (int e = 0; e < 64; ++e) o[e] *= f;
                        m = mx; }
#pragma unroll
                    for (int c = 0; c < 8; ++c) { const float p = __expf(s[c] - m); l += p;
#pragma unroll
                        for (int e = 0; e < 64; ++e) o[e] += p * Vs[(c0 + c) * 64 + e]; }
                }
            }
            const float rl = 1.f / l; float* op = odiff + ((size_t)map * M + qrow) * 512 + h * 128 + vh * 64;
#pragma unroll
            for (int e = 0; e < 64; e += 4) *(f32x4*)(op + e) = (f32x4){o[e] * rl, o[e + 1] * rl, o[e + 2] * rl, o[e + 3] * rl};
        }
        __syncthreads();
    }
    { PH_TID; INP(rpb, 13); WSP(proj, bf16, WS_PROJ); WSP(concat, bf16, WS_CONCAT);
    for (int it = bx; it < M * 8 / NTHR; it += G) {
        const int gid = it * NTHR + tid, t = gid >> 3, h = gid & 7;
        const int b = t / SEQ, tl = t % SEQ, r = tl >> 6, c = tl & 63;
        const int rs = min(max(r - 4, 0), 120), cs = min(max(c - 8, 0), 48);
        float q[64], o[64];
#pragma unroll
        for (int d8 = 0; d8 < 8; ++d8) { const v4u w = *(const v4u*)(proj + (size_t)t * NPROJ + 1536 + h * 64 + d8 * 8);
#pragma unroll
            for (int j = 0; j < 4; ++j) { q[d8 * 8 + 2 * j] = __uint_as_float(w[j] << 16) * 0.125f; q[d8 * 8 + 2 * j + 1] = __uint_as_float(w[j] & 0xffff0000u) * 0.125f; } }
#pragma unroll
        for (int d = 0; d < 64; ++d) o[d] = 0.f;
        float m = -INFINITY, l = 0.f;
#pragma unroll 1
        for (int kr = 0; kr < 8; ++kr) {
#pragma unroll 1
            for (int kc = 0; kc < 16; ++kc) {
                const size_t kt = (size_t)b * SEQ + (rs + kr) * 64 + cs + kc;
                const v4u* kp = (const v4u*)(proj + kt * NPROJ + 2048 + h * 64); float a = 0.f;
#pragma unroll
                for (int d8 = 0; d8 < 8; ++d8) { const v4u w = kp[d8];
#pragma unroll
                    for (int jj = 0; jj < 4; ++jj) a += q[d8 * 8 + 2 * jj] * __uint_as_float(w[jj] << 16) + q[d8 * 8 + 2 * jj + 1] * __uint_as_float(w[jj] & 0xffff0000u); }
                const float sv = a + rpb[(h * 15 + (rs + kr - r + 7)) * 31 + (cs + kc - c + 15)];
                if (sv > m) { const float f = __expf(m - sv); l *= f;
#pragma unroll
                    for (int d = 0; d < 64; ++d) o[d] *= f;
                    m = sv; }
                const v4u* vp = (const v4u*)(proj + kt * NPROJ + 2560 + h * 64); const float p = __expf(sv - m); l += p;
#pragma unroll
                for (int d8 = 0; d8 < 8; ++d8) { const v4u w = vp[d8];
#pragma unroll
                    for (int jj = 0; jj < 4; ++jj) { o[d8 * 8 + 2 * jj] += p * __uint_as_float(w[jj] << 16); o[d8 * 8 + 2 * jj + 1] += p * __uint_as_float(w[jj] & 0xffff0000u); } }
            }
        }
        const float rl = 1.f / l; bf16* op = concat + (size_t)t * D + 512 + h * 64;
#pragma unroll
        for (int d8 = 0; d8 < 8; ++d8) { v4u w;
#pragma unroll
            for (int jj = 0; jj < 4; ++jj) w[jj] = pk2(o[d8 * 8 + 2 * jj] * rl, o[d8 * 8 + 2 * jj + 1] * rl);
            *(v4u*)(op + d8 * 8) = w; }
    } }
    xcd_barrier(bar);

    {
        PH_TID;
        INP(lq1, 8); INP(lk1, 9); INP(lq2, 10); INP(lk2, 11); INP(g_sub, 12); WSP(odiff, float, WS_ODIFF); WSP(concat, bf16, WS_CONCAT);
        float s1 = 0.f, s2 = 0.f;
        for (int i = 0; i < 64; ++i) { s1 += lq1[i] * lk1[i]; s2 += lq2[i] * lk2[i]; }
        const float lam_init = 0.2f, lam = __expf(s1) - __expf(s2) + lam_init;
        for (int row = gw; row < M; row += NGW) {
            const int c0 = lane * 8;
            float v[8]; float ss = 0.f;
#pragma unroll
            for (int e = 0; e < 8; ++e) { v[e] = odiff[(size_t)row * 512 + c0 + e] - lam * odiff[((size_t)M + row) * 512 + c0 + e]; ss += v[e] * v[e]; }
            ss += __shfl_xor(ss, 1); ss += __shfl_xor(ss, 2); ss += __shfl_xor(ss, 4); ss += __shfl_xor(ss, 8);
            const float rstd = rsqrtf(ss * (1.f / 128.f) + RMS_EPS); v4u w;
#pragma unroll
            for (int e = 0; e < 4; ++e) w[e] = pk2(v[2 * e] * rstd * g_sub[(c0 + 2 * e) & 127] * (1.f - lam_init), v[2 * e + 1] * rstd * g_sub[(c0 + 2 * e + 1) & 127] * (1.f - lam_init));
            *(v4u*)(concat + (size_t)row * D + c0) = w;
        }
    }
    xcd_barrier(bar);

    {
        WSP(concat, bf16, WS_CONCAT); WSP(wout_t, bf16, WS_WOUT); WSP(mix, float, WS_MIX);
        pg8::Gemm g{concat, wout_t, M, D, D}; pg8::StaticOrder S; S.init(M, D, G, bx);
        pg8::EpiStoreF32 E{mix, D};
        pg8::gemm_phase<pg8::EpiStoreF32, pg8::StaticOrder, true, true>(lds + RING_OFF, g, S, E);
    }
    xcd_barrier(bar);

    {
        LAS float* mv = (LAS float*)lds;
        PH_TID;
        INP(x, 0); INP(b_ada, 3); INP(g_post_mix, 5); INP(g_pre_ffn, 14); INP(w_router, 16); INP(b_router, 17);
        WSP(modp, float, WS_MODP); WSP(mix, float, WS_MIX); WSP(x1, float, WS_X1); WSP(h2, bf16, WS_H2); WSP(topi, int, WS_TOPI); WSP(gate, float, WS_GATE); WSP(hist, int, WS_HIST);
        LAS int* ltop = (LAS int*)(lds + 32768);
        for (int i = tid; i < 6144; i += NTHR) { const int b = i / 3072, r = i % 3072; mv[i] = mod_val(modp, b_ada, b, 2048 + r); }
        __syncthreads();
        for (int ch = bx; ch < NCHUNK; ch += G) {
            for (int i8 = 0; i8 < 8; ++i8) {
                const int row = ch * 64 + wave * 8 + i8, b = row / SEQ;
                const LAS float* gt1 = mv + b * 3072; const LAS float* sh2 = gt1 + 1024; const LAS float* sc2 = gt1 + 2048;
                f32x4 mvv[4], xv[4]; float ss = 0.f;
#pragma unroll
                for (int i = 0; i < 4; ++i) { mvv[i] = *(const f32x4*)(mix + (size_t)row * D + i * 256 + lane * 4); xv[i] = *(const f32x4*)(x + (size_t)row * D + i * 256 + lane * 4);
                    ss += mvv[i].x * mvv[i].x + mvv[i].y * mvv[i].y + mvv[i].z * mvv[i].z + mvv[i].w * mvv[i].w; }
                float rstd = rsqrtf(wave_sum(ss) * (1.f / D) + RMS_EPS); ss = 0.f;
#pragma unroll
                for (int i = 0; i < 4; ++i) { const int c0 = i * 256 + lane * 4;
#pragma unroll
                    for (int e = 0; e < 4; ++e) { xv[i][e] = xv[i][e] + gt1[c0 + e] * (mvv[i][e] * rstd * g_post_mix[c0 + e]); ss += xv[i][e] * xv[i][e]; }
                    *(f32x4*)(x1 + (size_t)row * D + c0) = xv[i]; }
                rstd = rsqrtf(wave_sum(ss) * (1.f / D) + RMS_EPS);
                float lg[32];
#pragma unroll
                for (int e = 0; e < 32; ++e) lg[e] = 0.f;
#pragma unroll
                for (int i = 0; i < 4; ++i) { const int c0 = i * 256 + lane * 4; float hv[4];
#pragma unroll
                    for (int j = 0; j < 4; ++j) hv[j] = xv[i][j] * rstd * g_pre_ffn[c0 + j] * (1.f + sc2[c0 + j]) + sh2[c0 + j];
                    uint2 w; w.x = pk2(hv[0], hv[1]); w.y = pk2(hv[2], hv[3]); *(uint2*)(h2 + (size_t)row * D + c0) = w;
#pragma unroll
                    for (int j = 0; j < 4; ++j) { const f32x4* wr = (const f32x4*)(w_router + (size_t)(c0 + j) * 32);
#pragma unroll
                        for (int e4 = 0; e4 < 8; ++e4) { const f32x4 wv = wr[e4]; lg[e4 * 4] += hv[j] * wv.x; lg[e4 * 4 + 1] += hv[j] * wv.y; lg[e4 * 4 + 2] += hv[j] * wv.z; lg[e4 * 4 + 3] += hv[j] * wv.w; } } }
#pragma unroll
                for (int e = 0; e < 32; ++e) lg[e] = wave_sum(lg[e]) + b_router[e];
                unsigned taken = 0u; float tv[4]; int ti[4];
#pragma unroll
                for (int p = 0; p < 4; ++p) { float best = -INFINITY; int bi = 0;
#pragma unroll
                    for (int e = 0; e < 32; ++e) { const bool ok = !((taken >> e) & 1u) && (lg[e] > best); best = ok ? lg[e] : best; bi = ok ? e : bi; }
                    taken |= 1u << bi; tv[p] = best; ti[p] = bi; }
                if (lane == 0) { const float e1 = __expf(tv[1] - tv[0]), e2 = __expf(tv[2] - tv[0]), e3 = __expf(tv[3] - tv[0]); const float rs = 1.f / (1.f + e1 + e2 + e3);
                    *(int4*)(topi + row * 4) = make_int4(ti[0], ti[1], ti[2], ti[3]); *(f32x4*)(gate + row * 4) = (f32x4){rs, e1 * rs, e2 * rs, e3 * rs};
                    const int lr = (wave * 8 + i8) * 4; ltop[lr] = ti[0]; ltop[lr + 1] = ti[1]; ltop[lr + 2] = ti[2]; ltop[lr + 3] = ti[3]; }
            }
            __syncthreads();
            if (tid < 32) { int cnt = 0; for (int i = 0; i < 256; ++i) cnt += (ltop[i] == tid) ? 1 : 0; hist[ch * 32 + tid] = cnt; }
            __syncthreads();
        }
    }
    xcd_barrier(bar);

    {
        LAS int* le = (LAS int*)(lds + 4096); LAS int* ld = (LAS int*)(lds + 8192);
        PH_TID;
        WSP(hist, int, WS_HIST); WSP(topi, int, WS_TOPI); WSP(dest, int, WS_DEST); WSP(h2, bf16, WS_H2); WSP(xbuf, bf16, WS_XBUF); gu32* ctl = (gu32*)(launder_ws(ws0) + WS_CTL);
        for (int ch = bx; ch < NCHUNK; ch += G) {
            if (tid < 32) { int tot = 0, base = 0; for (int c2 = 0; c2 < NCHUNK; ++c2) { const int hv = hist[c2 * 32 + tid]; tot += hv; base += (c2 < ch) ? hv : 0; } tab[32 + tid] = base; tab[tid] = (tot + 255) & ~255; }
            if (tid < 256) le[tid] = topi[ch * 256 + tid];
            __syncthreads();
            if (tid == 0) { int off = 0; for (int e = 0; e < NE; ++e) { const int pad = tab[e]; tab[e] = off;
                    if (ch == 0) for (int tl = 0; tl < pad / 256; ++tl) ctl[CW_TILEEXP + off / 256 + tl] = (unsigned)e;
                    off += pad; }
                if (ch == 0) ctl[CW_TOTAL] = (unsigned)off; }
            __syncthreads();
            if (tid < 256) { const int e = le[tid]; int rank = 0; for (int i = 0; i < tid; ++i) rank += (le[i] == e) ? 1 : 0;
                const int dd = tab[e] + tab[32 + e] + rank; dest[ch * 256 + tid] = dd; ld[tid] = dd; }
            __syncthreads();
            for (int i = 0; i < 32; ++i) { const int a = wave * 32 + i; const int dd = ld[a]; const size_t tok = (size_t)(ch * 256 + a) >> 2;
                const v4u* src = (const v4u*)(h2 + tok * D); v4u* dst = (v4u*)(xbuf + (size_t)dd * D);
                const v4u a0 = src[lane], a1 = src[64 + lane]; dst[lane] = a0; dst[64 + lane] = a1; }
            __syncthreads();
        }
    }
    xcd_barrier(bar);

    {
        PH_TID;
        gu32* ctl = (gu32*)(launder_ws(ws0) + WS_CTL);
        for (int i = tid; i < MAXTILES; i += NTHR) tab[64 + i] = (int)ctl[CW_TILEEXP + i];
        if (tid == 0) tab[352] = (int)ctl[CW_TOTAL];
        __syncthreads();
        const int ntile = __builtin_amdgcn_readfirstlane(tab[352]) >> 8;
        {
            INP(b1, 19); WSP(xbuf, bf16, WS_XBUF); WSP(w1_t, bf16, WS_W1T); WSP(act, bf16, WS_ACT);
            pg8::Gemm g{xbuf, w1_t, CAP, 2048, D}; pg8::MoeOrder<8> S{ntile * 8, G, vcu, (const LAS int*)(tab + 64)};
            pg8::EpiSwiglu E{act, b1};
            pg8::gemm_phase<pg8::EpiSwiglu, pg8::MoeOrder<8>, true, true>(lds + RING_OFF, g, S, E);
        }
        xcd_barrier(bar);
        {
            INP(b2, 21); WSP(act, bf16, WS_ACT); WSP(w2_t, bf16, WS_W2T); WSP(ybuf, bf16, WS_YBUF);
            pg8::Gemm g{act, w2_t, CAP, 1024, FF}; pg8::MoeOrder<4> S{ntile * 4, G, vcu, (const LAS int*)(tab + 64)};
            pg8::EpiY E{ybuf, b2};
            pg8::gemm_phase<pg8::EpiY, pg8::MoeOrder<4>, true, true>(lds + RING_OFF, g, S, E);
        }
    }
    xcd_barrier(bar);

    {
        LAS float* mv = (LAS float*)lds;
        PH_TID;
        INP(b_ada, 3); INP(g_post_ffn, 15); WSP(modp, float, WS_MODP); WSP(x1, float, WS_X1); WSP(ybuf, bf16, WS_YBUF); WSP(dest, int, WS_DEST); WSP(gate, float, WS_GATE); float* out = P.out;
        for (int i = tid; i < 2048; i += NTHR) mv[i] = mod_val(modp, b_ada, i >> 10, 5120 + (i & 1023));
        __syncthreads();
        for (int row = gw; row < M; row += NGW) {
            const int b = row / SEQ; const LAS float* gt2 = mv + b * 1024;
            float f[16]; float ss = 0.f;
#pragma unroll
            for (int i = 0; i < 16; ++i) f[i] = 0.f;
            const int4 dd = *(const int4*)(dest + row * 4); const f32x4 gg = *(const f32x4*)(gate + row * 4);
            const int dda[4] = {dd.x, dd.y, dd.z, dd.w};
#pragma unroll
            for (int p = 0; p < 4; ++p) { const float gp = gg[p]; const bf16* yr = ybuf + (size_t)dda[p] * D;
#pragma unroll
                for (int i = 0; i < 4; ++i) { const uint2 w = *(const uint2*)(yr + i * 256 + lane * 4);
                    f[i * 4] += gp * __uint_as_float(w.x << 16); f[i * 4 + 1] += gp * __uint_as_float(w.x & 0xffff0000u); f[i * 4 + 2] += gp * __uint_as_float(w.y << 16); f[i * 4 + 3] += gp * __uint_as_float(w.y & 0xffff0000u); } }
#pragma unroll
            for (int i = 0; i < 16; ++i) ss += f[i] * f[i];
            const float rstd = rsqrtf(wave_sum(ss) * (1.f / D) + RMS_EPS);
#pragma unroll
            for (int i = 0; i < 4; ++i) { const int c0 = i * 256 + lane * 4; const f32x4 xv = *(const f32x4*)(x1 + (size_t)row * D + c0); f32x4 ov;
#pragma unroll
                for (int e = 0; e < 4; ++e) ov[e] = xv[e] + gt2[c0 + e] * (f[i * 4 + e] * rstd * g_post_ffn[c0 + e]);
                *(f32x4*)(out + (size_t)row * D + c0) = ov; }
        }
    }
}

extern "C" void kernel_launch(void* const* d_in, const int* in_sizes, int n_in, void* d_out, int out_size, void* d_ws, size_t ws_size, hipStream_t stream) {
    static int grid = 0;
    if (grid == 0) {
        if (n_in != 22 || ws_size < WS_END) { fprintf(stderr, "kernel_launch: unexpected n_in %d / ws %zu\n", n_in, ws_size); grid = -1; return; }
        int dev = 0, cus = 0, per_cu = 0;
        if (hipGetDevice(&dev) != hipSuccess || hipDeviceGetAttribute(&cus, hipDeviceAttributeMultiprocessorCount, dev) != hipSuccess) { grid = -1; return; }
        if (hipFuncSetAttribute((const void*)mk_fwd, hipFuncAttributeMaxDynamicSharedMemorySize, LDS_BYTES) != hipSuccess) { fprintf(stderr, "kernel_launch: hipFuncSetAttribute failed\n"); grid = -1; return; }
        if (hipOccupancyMaxActiveBlocksPerMultiprocessor(&per_cu, (const void*)mk_fwd, NTHR, LDS_BYTES) != hipSuccess || per_cu < 1) { fprintf(stderr, "kernel_launch: occupancy query says %d\n", per_cu); }
        (void)hipGetLastError();
        grid = cus;
    }
    if (grid < 0) return;
    if (hipMemsetAsync((char*)d_ws + WS_CTL, 0, 1 * MiB, stream) != hipSuccess) return;
    Params p{};
    for (int i = 0; i < 22; ++i) p.in[i] = (const float*)d_in[i];
    p.out = (float*)d_out; p.ws = (unsigned char*)d_ws;
    hipLaunchKernelGGL(mk_fwd, dim3(grid), dim3(NTHR), LDS_BYTES, stream, p);
}
```

```cpp
#include <hip/hip_runtime.h>
#include <stdint.h>
#include <stdio.h>

#define GAS __attribute__((address_space(1)))
#define LAS __attribute__((address_space(3)))
typedef unsigned short bf16;
typedef unsigned v4u __attribute__((ext_vector_type(4)));
typedef float f32x4 __attribute__((ext_vector_type(4)));
typedef GAS unsigned gu32;
#define LDS_WAIT() asm volatile("s_waitcnt lgkmcnt(0)" ::: "memory")
#define VM_WAIT() asm volatile("s_waitcnt vmcnt(0)" ::: "memory")

#define DUP_P0 0
#define DUP_ATT 0
#define DUP_NAT 0
#define DUP_G1 0
#define DUP_G2 0
constexpr int NB = 2, SEQ = 8192, D = 1024, M = NB * SEQ;
constexpr int NPROJ = 3072, NE = 32, TOPK = 4, FF = 1024;
constexpr int NASSIGN = M * TOPK;
constexpr int CAP = NASSIGN + NE * 256;
constexpr int MAXTILES = CAP / 256;
constexpr int NCHUNK = M / 64;
constexpr float RMS_EPS = 1e-6f;
constexpr int NWAVES = 8, NTHR = 512;

constexpr size_t MiB = 1u << 20;
constexpr size_t WS_CTL = 0;
constexpr size_t WS_MODP = 1 * MiB;
constexpr size_t WS_HIST = 2 * MiB;
constexpr size_t WS_TOPI = 3 * MiB;
constexpr size_t WS_GATE = 3 * MiB + 512 * 1024;
constexpr size_t WS_DEST = 4 * MiB;
constexpr size_t WS_WIN = 6 * MiB;
constexpr size_t WS_WOUT = 12 * MiB;
constexpr size_t WS_XN = 16 * MiB;
constexpr size_t WS_PROJ = 48 * MiB;
constexpr size_t WS_ODIFF = 144 * MiB;
constexpr size_t WS_XBUF = 48 * MiB;
constexpr size_t WS_CONCAT = 208 * MiB;
constexpr size_t WS_MIX = 240 * MiB;
constexpr size_t WS_X1 = 304 * MiB;
constexpr size_t WS_H2 = 368 * MiB;
constexpr size_t WS_ACT = 400 * MiB;
constexpr size_t WS_YBUF = 544 * MiB;
constexpr size_t WS_W1T = 688 * MiB;
constexpr size_t WS_W2T = 816 * MiB;
constexpr size_t WS_END = 880 * MiB;
static_assert(WS_XBUF + (size_t)CAP * D * 2 <= WS_CONCAT, "XBUF overlay");
constexpr int CW_TOTAL = 64;
constexpr int CW_TILEEXP = 128;
constexpr int CW_BAR = 4096;

constexpr int RING_OFF = 0, RING_BYTES = 131072;
constexpr int LDSCTL_OFF = RING_BYTES, MISC_OFF = LDSCTL_OFF + 320, TAB_OFF = LDSCTL_OFF + 1024;
constexpr int LDS_BYTES = 147456;

__device__ __forceinline__ float bf2f(bf16 v) { return __uint_as_float(((unsigned)v) << 16); }
__device__ __forceinline__ unsigned f2bf(float f) { unsigned u = __builtin_bit_cast(unsigned, f); return (u + 0x7fffu + ((u >> 16) & 1u)) >> 16; }
__device__ __forceinline__ unsigned pk2(float lo, float hi) { return f2bf(lo) | (f2bf(hi) << 16); }
namespace pg8 {
#define PG8_LAS __attribute__((address_space(3)))
typedef unsigned short bf16_t;
typedef short bf16x8 __attribute__((ext_vector_type(8)));
typedef float f32x4 __attribute__((ext_vector_type(4)));
typedef unsigned u32x4 __attribute__((ext_vector_type(4)));
constexpr int BM = 256, BK = 64, HALF = 128, HTB = HALF * BK * 2  , STAGE_BYTES = 8 * HTB, NXCD = 8, WGM = 8;

__host__ __device__ __forceinline__ int lds_byte(int r, int c) { const int st = (r >> 4) * 2 + (c >> 5), rr = r & 15, cc = c & 31, ob = rr * 64 + cc * 2; return st * 1024 + (ob ^ (((ob >> 9) & 1) << 5)); }
__host__ __device__ __forceinline__ void stage_rc(int b, int& R, int& C) { const int st = b / 1024, sb = b % 1024, swz = sb ^ (((sb >> 9) & 1) << 5); R = (st >> 1) * 16 + swz / 64; C = (st & 1) * 32 + (swz % 64) / 2; }
__host__ __device__ __forceinline__ int perm32(int rho) { const int n = rho >> 4, i = rho & 15; return 8 * (i >> 2) + 4 * n + (i & 3); }

struct Unit { int pm, pn; };
struct Gemm { const bf16_t* A; const bf16_t* Bt; int M, N, K; };

struct StaticOrder {
    int nM, nN, nwg, G, c;
    __host__ __device__ void init(int M, int N, int G_, int c_) { nM = M / BM; nN = N / BM; nwg = nM * nN; G = G_; c = c_; }
    __host__ __device__ bool next(int i, Unit& u) const {
        const long L = (long)i * G + c; if (L >= nwg) return false;
        int wgid = (int)L; { const int q = nwg / NXCD, r = nwg % NXCD, xcd = wgid % NXCD, off = wgid / NXCD; wgid = (xcd < r ? xcd * (q + 1) : r * (q + 1) + (xcd - r) * q) + off; }
        const int nig = WGM * nN, gid = wgid / nig, fm = gid * WGM, gsz = (nM - fm) < WGM ? (nM - fm) : WGM;
        u.pm = fm + ((wgid % nig) % gsz); u.pn = (wgid % nig) / gsz; return true;
    }
    __device__ __forceinline__ void a_ready(const Unit&) const {}
    __device__ __forceinline__ void done(const Unit&) const {}
};

__device__ __forceinline__ unsigned cvt_pk_bf16(float lo, float hi) { unsigned r; asm volatile("v_cvt_pk_bf16_f32 %0, %1, %2" : "=v"(r) : "v"(lo), "v"(hi)); return r; }
struct EpiStoreBf16 {
    static constexpr bool PERM = true, AFTER_DRAIN = false;
    bf16_t* O; int ldc; int scale_cols; float scale0; int s2lo, s2hi;
    __device__ __forceinline__ void operator()(const f32x4 (&acc)[2][2][4][2], const Unit& u, int wr, int wc, int fr, int fq) const {
        const int row0 = u.pm * BM + wr * 64 + fr, colt = u.pn * BM, col0 = colt + wc * 32 + 8 * fq; const float sc = (colt < scale_cols || (colt >= s2lo && colt < s2hi)) ? scale0 : 1.f;
#pragma unroll
        for (int ai = 0; ai < 2; ++ai)
#pragma unroll
            for (int m = 0; m < 4; ++m) { bf16_t* rowp = O + (size_t)(row0 + ai * HALF + m * 16) * ldc + col0;
#pragma unroll
                for (int bj = 0; bj < 2; ++bj) { const f32x4 v0 = acc[ai][bj][m][0] * sc, v1 = acc[ai][bj][m][1] * sc;
                    u32x4 w; w.x = cvt_pk_bf16(v0[0], v0[1]); w.y = cvt_pk_bf16(v0[2], v0[3]); w.z = cvt_pk_bf16(v1[0], v1[1]); w.w = cvt_pk_bf16(v1[2], v1[3]);
                    *(u32x4*)(rowp + bj * HALF) = w; } }
    }
};
struct EpiStoreF32 {
    static constexpr bool PERM = true, AFTER_DRAIN = false;
    float* O; int ldc;
    __device__ __forceinline__ void operator()(const f32x4 (&acc)[2][2][4][2], const Unit& u, int wr, int wc, int fr, int fq) const {
        const int row0 = u.pm * BM + wr * 64 + fr, col0 = u.pn * BM + wc * 32 + 8 * fq;
#pragma unroll
        for (int ai = 0; ai < 2; ++ai)
#pragma unroll
            for (int m = 0; m < 4; ++m) { float* rowp = O + (size_t)(row0 + ai * HALF + m * 16) * ldc + col0;
#pragma unroll
                for (int bj = 0; bj < 2; ++bj) { *(f32x4*)(rowp + bj * HALF) = acc[ai][bj][m][0]; *(f32x4*)(rowp + bj * HALF + 4) = acc[ai][bj][m][1]; } }
    }
};
struct EpiSwiglu {
    static constexpr bool PERM = true, AFTER_DRAIN = false;
    bf16_t* act; const float* b1;
    __device__ __forceinline__ void operator()(const f32x4 (&acc)[2][2][4][2], const Unit& u, int wr, int wc, int fr, int fq) const {
        const int e = u.pn >> 3, pnl = u.pn & 7, row0 = u.pm * BM + wr * 64 + fr, hc0 = pnl * BM + wc * 32 + 8 * fq;
        f32x4 bv[2][2];
#pragma unroll
        for (int bj = 0; bj < 2; ++bj)
#pragma unroll
            for (int n = 0; n < 2; ++n) bv[bj][n] = *(const f32x4*)(b1 + e * 2048 + hc0 + bj * HALF + 4 * n);
#pragma unroll
        for (int ai = 0; ai < 2; ++ai)
#pragma unroll
            for (int m = 0; m < 4; ++m) { bf16_t* rowp = act + (size_t)(row0 + ai * HALF + m * 16) * 1024 + (hc0 >> 1);
#pragma unroll
                for (int bj = 0; bj < 2; ++bj) { const f32x4 v0 = acc[ai][bj][m][0] + bv[bj][0], v1 = acc[ai][bj][m][1] + bv[bj][1];
                    float r[4];
                    const float gg[4] = {v0[0], v0[2], v1[0], v1[2]}, ll[4] = {v0[1], v0[3], v1[1], v1[3]};
#pragma unroll
                    for (int p = 0; p < 4; ++p) { float g = gg[p], l = ll[p];
                        g = fminf(g, 7.f); l = fminf(fmaxf(l, -7.f), 7.f);
                        r[p] = g * __builtin_amdgcn_rcpf(1.f + __expf(-1.702f * g)) * (l + 1.f); }
                    uint2 w; w.x = cvt_pk_bf16(r[0], r[1]); w.y = cvt_pk_bf16(r[2], r[3]);
                    *(uint2*)(rowp + bj * (HALF / 2)) = w; } }
    }
};
struct EpiY {
    static constexpr bool PERM = true, AFTER_DRAIN = false;
    bf16_t* y; const float* b2;
    __device__ __forceinline__ void operator()(const f32x4 (&acc)[2][2][4][2], const Unit& u, int wr, int wc, int fr, int fq) const {
        const int e = u.pn >> 2, pnl = u.pn & 3, row0 = u.pm * BM + wr * 64 + fr, col0 = pnl * BM + wc * 32 + 8 * fq;
        f32x4 bv[2][2];
#pragma unroll
        for (int bj = 0; bj < 2; ++bj)
#pragma unroll
            for (int n = 0; n < 2; ++n) bv[bj][n] = *(const f32x4*)(b2 + e * 1024 + col0 + bj * HALF + 4 * n);
#pragma unroll
        for (int ai = 0; ai < 2; ++ai)
#pragma unroll
            for (int m = 0; m < 4; ++m) { bf16_t* rowp = y + (size_t)(row0 + ai * HALF + m * 16) * 1024 + col0;
#pragma unroll
                for (int bj = 0; bj < 2; ++bj) { const f32x4 v0 = acc[ai][bj][m][0] + bv[bj][0], v1 = acc[ai][bj][m][1] + bv[bj][1];
                    u32x4 w; w.x = cvt_pk_bf16(v0[0], v0[1]); w.y = cvt_pk_bf16(v0[2], v0[3]); w.z = cvt_pk_bf16(v1[0], v1[1]); w.w = cvt_pk_bf16(v1[2], v1[3]);
                    *(u32x4*)(rowp + bj * HALF) = w; } }
    }
};
template <int NN> struct MoeOrder {
    int nunit, G, c; const PG8_LAS int* texp;
    __device__ __forceinline__ bool next(int i, Unit& u) const {
        const int L = i * G + c; if (L >= nunit) return false;
        const int pm = L / NN, pnl = L % NN; u.pm = pm; u.pn = __builtin_amdgcn_readfirstlane(texp[pm]) * NN + pnl; return true;
    }
    __device__ __forceinline__ void a_ready(const Unit&) const {}
    __device__ __forceinline__ void done(const Unit&) const {}
};
template <class Epi, class Sched, bool ALIGN_EPI = false, bool SP2 = false>
__device__ __forceinline__ void gemm_phase(PG8_LAS unsigned char* lds, const Gemm g, const Sched& S, const Epi& E) {
    int tid_ = threadIdx.x; asm volatile("" : "+v"(tid_));
    const int tid = tid_, wid = __builtin_amdgcn_readfirstlane(tid >> 6), lane = tid & 63, wr = wid >> 2, wc = wid & 3, fr = lane & 15, fq = lane >> 4;
    const int K = g.K, nt = K / BK;
    unsigned voffA[2], voffB[2];
#pragma unroll
    for (int i = 0; i < 2; ++i) { int R, C; stage_rc(tid * 16 + i * 8192, R, C); const int Rb = Epi::PERM ? ((R & ~31) + perm32(R & 31)) : R;
        voffA[i] = (unsigned)(R * K + C) * 2u; voffB[i] = (unsigned)(Rb * K + C) * 2u; }
    const size_t kstep = (size_t)(BK * 2);
    const size_t hstep = (size_t)HALF * K * 2;
    const size_t tstep = 2 * hstep;
    const unsigned ldsw = (unsigned)wid * 1024u;
    const int aoff = lds_byte(wr * 64 + fr, fq * 8), boff = lds_byte(wc * 32 + fr, fq * 8);
#define PG8_SA(b, h) (((b) * 2 + (h)) * HTB)
#define PG8_SB(b, h) ((4 + (b) * 2 + (h)) * HTB)
#define PG8_STAGE(bufoff, gbase, voff) do { _Pragma("unroll") for (int _i = 0; _i < 2; ++_i) \
        __builtin_amdgcn_global_load_lds((const unsigned*)((const char*)(gbase) + (voff)[_i]), (PG8_LAS unsigned*)(lds + (bufoff) + ldsw + _i * 8192), 16, 0, 0); } while (0)
#define PG8_LDA(dst, b, h) do { _Pragma("unroll") for (int m = 0; m < 4; ++m) _Pragma("unroll") for (int k = 0; k < 2; ++k) dst[m][k] = *(const PG8_LAS bf16x8*)(lds + PG8_SA(b, h) + aoff + m * 2048 + k * 1024); } while (0)
#define PG8_LDB(dst, b, h) do { _Pragma("unroll") for (int n = 0; n < 2; ++n) _Pragma("unroll") for (int k = 0; k < 2; ++k) dst[n][k] = *(const PG8_LAS bf16x8*)(lds + PG8_SB(b, h) + boff + n * 2048 + k * 1024); } while (0)
#define PG8_MMA(ai, bj, At, Bt) do { __builtin_amdgcn_s_setprio(1); _Pragma("unroll") for (int m = 0; m < 4; ++m) _Pragma("unroll") for (int n = 0; n < 2; ++n) _Pragma("unroll") for (int k = 0; k < 2; ++k) \
        acc[ai][bj][m][n] = __builtin_amdgcn_mfma_f32_16x16x32_bf16(Bt[n][k], At[m][k], acc[ai][bj][m][n], 0, 0, 0); __builtin_amdgcn_s_setprio(0); } while (0)
#define PG8_WAIT_V(n) asm volatile("s_waitcnt vmcnt(" #n ")" ::: "memory")
#define PG8_WAIT_L(n) asm volatile("s_waitcnt lgkmcnt(" #n ")" ::: "memory")
#define PG8_BAR __builtin_amdgcn_s_barrier()
#define PG8_SCHED __builtin_amdgcn_sched_barrier(0)
    Unit cur, nxt; int ui = 0;
    if (!S.next(0, cur)) return;
    f32x4 acc[2][2][4][2];
#pragma unroll
    for (int a = 0; a < 2; ++a)
#pragma unroll
        for (int b = 0; b < 2; ++b)
#pragma unroll
            for (int m = 0; m < 4; ++m)
#pragma unroll
                for (int n = 0; n < 2; ++n) acc[a][b][m][n] = (f32x4){0.f, 0.f, 0.f, 0.f};
    bf16x8 At[4][2], B0[2][2], B1[2][2];
    const char* cA = (const char*)g.A + (size_t)cur.pm * tstep; const char* cB = (const char*)g.Bt + (size_t)cur.pn * tstep;
    S.a_ready(cur);
    if constexpr (SP2) {
        PG8_STAGE(PG8_SB(0, 0), cB, voffB); PG8_STAGE(PG8_SB(0, 1), cB + hstep, voffB); PG8_STAGE(PG8_SA(0, 0), cA, voffA); PG8_STAGE(PG8_SA(0, 1), cA + hstep, voffA);
        if (wr == 1) PG8_BAR;
        PG8_WAIT_V(2); PG8_BAR;
        PG8_STAGE(PG8_SB(1, 0), cB + kstep, voffB); PG8_STAGE(PG8_SA(1, 0), cA + kstep, voffA); PG8_STAGE(PG8_SB(1, 1), cB + hstep + kstep, voffB);
        PG8_WAIT_V(6); PG8_BAR;
    } else {
        PG8_STAGE(PG8_SB(0, 0), cB, voffB); PG8_STAGE(PG8_SA(0, 0), cA, voffA); PG8_STAGE(PG8_SB(0, 1), cB + hstep, voffB); PG8_STAGE(PG8_SA(0, 1), cA + hstep, voffA);
        if (wr == 1) PG8_BAR;
        PG8_WAIT_V(4); PG8_BAR;
        PG8_STAGE(PG8_SB(1, 0), cB + kstep, voffB); PG8_STAGE(PG8_SA(1, 0), cA + kstep, voffA); PG8_STAGE(PG8_SB(1, 1), cB + hstep + kstep, voffB);
        PG8_WAIT_V(6); PG8_BAR;
    }
    for (;;) {
        const bool has_next = S.next(ui + 1, nxt);
        const char* nA = has_next ? (const char*)g.A + (size_t)nxt.pm * tstep : cA; const char* nB = has_next ? (const char*)g.Bt + (size_t)nxt.pn * tstep : cB;
        for (int t = 0; t < nt; t += 2) {
            const bool last = (t == nt - 2);
            const char* a1 = cA + (size_t)(t + 1) * kstep;
            const char* a2 = last ? nA : cA + (size_t)(t + 2) * kstep; const char* b2 = last ? nB : cB + (size_t)(t + 2) * kstep;
            const char* a3 = a2 + kstep; const char* b3 = b2 + kstep;
            if (last && has_next) S.a_ready(nxt);
            if constexpr (SP2) {
            PG8_LDB(B0, 0, 0); PG8_LDB(B1, 0, 1); PG8_SCHED; PG8_LDA(At, 0, 0); PG8_STAGE(PG8_SA(1, 1), a1 + hstep, voffA);
            PG8_WAIT_V(8); PG8_WAIT_L(0); PG8_BAR; PG8_MMA(0, 0, At, B0); PG8_MMA(0, 1, At, B1); PG8_BAR; PG8_SCHED;
            PG8_LDA(At, 0, 1); PG8_STAGE(PG8_SB(0, 0), b2, voffB); PG8_STAGE(PG8_SB(0, 1), b2 + hstep, voffB); PG8_STAGE(PG8_SA(0, 0), a2, voffA);
            PG8_WAIT_V(8); PG8_WAIT_L(0); PG8_BAR; PG8_MMA(1, 0, At, B0); PG8_MMA(1, 1, At, B1); PG8_BAR; PG8_SCHED;
            PG8_LDB(B0, 1, 0); PG8_LDB(B1, 1, 1); PG8_SCHED; PG8_LDA(At, 1, 0); PG8_STAGE(PG8_SA(0, 1), a2 + hstep, voffA);
            PG8_WAIT_V(8); PG8_WAIT_L(0); PG8_BAR; PG8_MMA(0, 0, At, B0); PG8_MMA(0, 1, At, B1); PG8_BAR; PG8_SCHED;
            PG8_LDA(At, 1, 1); PG8_STAGE(PG8_SB(1, 0), b3, voffB); PG8_STAGE(PG8_SB(1, 1), b3 + hstep, voffB); PG8_STAGE(PG8_SA(1, 0), a3, voffA);
            PG8_WAIT_V(8); PG8_WAIT_L(0); PG8_BAR; PG8_MMA(1, 0, At, B0); PG8_MMA(1, 1, At, B1); PG8_BAR; PG8_SCHED;
            } else {
            PG8_LDB(B0, 0, 0); PG8_SCHED; PG8_LDA(At, 0, 0); PG8_STAGE(PG8_SA(1, 1), a1 + hstep, voffA);
            PG8_WAIT_L(8); PG8_BAR; PG8_WAIT_L(0); PG8_MMA(0, 0, At, B0); PG8_BAR; PG8_SCHED;
            PG8_LDB(B1, 0, 1); PG8_STAGE(PG8_SB(0, 0), b2, voffB);
            PG8_BAR; PG8_WAIT_L(0); PG8_MMA(0, 1, At, B1); PG8_BAR;
            PG8_LDA(At, 0, 1); PG8_STAGE(PG8_SA(0, 0), a2, voffA);
            PG8_BAR; PG8_WAIT_L(0); PG8_MMA(1, 0, At, B0); PG8_BAR; PG8_SCHED;
            PG8_STAGE(PG8_SB(0, 1), b2 + hstep, voffB);
            PG8_WAIT_V(6); PG8_BAR; PG8_MMA(1, 1, At, B1); PG8_BAR;
            PG8_LDB(B0, 1, 0); PG8_SCHED; PG8_LDA(At, 1, 0); PG8_STAGE(PG8_SA(0, 1), a2 + hstep, voffA);
            PG8_WAIT_L(8); PG8_BAR; PG8_WAIT_L(0); PG8_MMA(0, 0, At, B0); PG8_BAR; PG8_SCHED;
            PG8_LDB(B1, 1, 1); PG8_STAGE(PG8_SB(1, 0), b3, voffB);
            PG8_BAR; PG8_WAIT_L(0); PG8_MMA(0, 1, At, B1); PG8_BAR;
            PG8_LDA(At, 1, 1); PG8_STAGE(PG8_SA(1, 0), a3, voffA);
            PG8_BAR; PG8_WAIT_L(0); PG8_MMA(1, 0, At, B0); PG8_BAR; PG8_SCHED;
            PG8_STAGE(PG8_SB(1, 1), b3 + hstep, voffB);
            PG8_WAIT_V(6); PG8_BAR; PG8_MMA(1, 1, At, B1); PG8_BAR;
            }
        }
        if constexpr (ALIGN_EPI) { if (wr == 0) PG8_BAR; }
        if constexpr (!Epi::AFTER_DRAIN) { E(acc, cur, wr, wc, fr, fq); S.done(cur); }
        if (!has_next) break;
#pragma unroll
        for (int a = 0; a < 2; ++a)
#pragma unroll
            for (int b = 0; b < 2; ++b)
#pragma unroll
                for (int m = 0; m < 4; ++m)
#pragma unroll
                    for (int n = 0; n < 2; ++n) acc[a][b][m][n] = (f32x4){0.f, 0.f, 0.f, 0.f};
        cur = nxt; cA = nA; cB = nB; ++ui;
        if constexpr (ALIGN_EPI) { if (wr == 1) PG8_BAR; }
    }
    PG8_WAIT_V(0);
    if constexpr (!ALIGN_EPI) { if (wr == 0) PG8_BAR; }
    PG8_BAR;
    if constexpr (Epi::AFTER_DRAIN) { E.fused(acc, cur, wr, wc, fr, fq, lds, wid, lane); S.done(cur); }
#undef PG8_SA
#undef PG8_SB
#undef PG8_STAGE
#undef PG8_LDA
#undef PG8_LDB
#undef PG8_MMA
#undef PG8_WAIT_V
#undef PG8_WAIT_L
#undef PG8_BAR
#undef PG8_SCHED
}
}
#include <hip/hip_bf16.h>
#include <cmath>
namespace attn_body {
using bf16=__hip_bfloat16;
using bf16x8=__attribute__((ext_vector_type(8)))short;
using s16x4=__attribute__((ext_vector_type(4)))short;
using f32x16=__attribute__((ext_vector_type(16)))float;
using u32x4=__attribute__((ext_vector_type(4)))unsigned;
constexpr int SEQ=8192,D=64,QP=3072,KP=3072,OP=512;
constexpr int NW=8,QBLK=32,QB=QBLK*NW,KVBLK=64,NQB=SEQ/QB;
constexpr int ATTN_UNIT_ROWS=QB;
__device__ __forceinline__ int crow(int r,int hi){return (r&3)+8*(r>>2)+4*hi;}
#define SBAR() __builtin_amdgcn_sched_barrier(0)
__device__ __forceinline__ void cmask(f32x16&p0,f32x16&p1,int jb,int qrel,int hi){
  const float NEG=-INFINITY; int kb=64*jb+4*hi;
  #pragma unroll
  for(int r=0;r<16;++r){int kv=kb+(r&3)+8*(r>>2); if(kv>qrel)p0[r]=NEG; if(kv+32>qrel)p1[r]=NEG;}
}

constexpr int NSLOT=3, SLOTB=8192;
constexpr int LDS_K=0, LDS_V=NSLOT*SLOTB, LDS_WS=2*NSLOT*SLOTB, LDS_OST=LDS_WS+NW*64*4, LDS_TB=LDS_OST+NW*4096+4096, LDS_BYTES=LDS_TB+4096;
constexpr float C2=0.125f*1.4426950408889634f;
__device__ __forceinline__ void glds16(const void*gsrc,unsigned lds_dst){unsigned keep;
  asm volatile("s_mov_b32 %0, m0\n\ts_mov_b32 m0, %2\n\ts_nop 0\n\tglobal_load_lds_dwordx4 %1, off\n\ts_mov_b32 m0, %0":"=&s"(keep):"v"(gsrc),"s"(lds_dst):"memory");}
__device__ __forceinline__ float max3f(float a,float b,float c){float r;asm("v_max3_f32 %0, %1, %2, %3":"=v"(r):"v"(a),"v"(b),"v"(c));return r;}
__device__ __forceinline__ float max2f(float a,float b){float r;asm("v_max_f32_e32 %0, %1, %2":"=v"(r):"v"(a),"v"(b));return r;}
__device__ __forceinline__ float fadd_s(float a,float b){float r;asm("v_add_f32_e32 %0, %1, %2":"=v"(r):"v"(a),"v"(b));return r;}
__device__ __forceinline__ float fsub_s(float a,float b){float r;asm("v_sub_f32_e32 %0, %1, %2":"=v"(r):"v"(a),"v"(b));return r;}
typedef float f32x2_t __attribute__((ext_vector_type(2))); typedef __bf16 bf16x2_t __attribute__((ext_vector_type(2)));
__device__ __forceinline__ unsigned cvtpk_s(float lo,float hi){f32x2_t v={lo,hi};bf16x2_t b=__builtin_convertvector(v,bf16x2_t);return __builtin_bit_cast(unsigned,b);}
#define WAIT_BAR(N) asm volatile("s_waitcnt vmcnt(" #N ") lgkmcnt(0)\n\ts_barrier":::"memory")

__device__ __forceinline__ void qkt(f32x16&p0,f32x16&p1,const char*Kslot,const bf16x8*qr,const f32x16&negm,int r32,int hi){
  const char*kb=Kslot+hi*1024+r32*16;
  #pragma unroll
  for(int d0=0;d0<4;++d0){
    const bf16x8 b0=*reinterpret_cast<const bf16x8*>(kb+d0*2048);
    const bf16x8 b1=*reinterpret_cast<const bf16x8*>(kb+d0*2048+512);
    if(d0==0){p0=__builtin_amdgcn_mfma_f32_32x32x16_bf16(b0,qr[0],negm,0,0,0);p1=__builtin_amdgcn_mfma_f32_32x32x16_bf16(b1,qr[0],negm,0,0,0);}
    else{p0=__builtin_amdgcn_mfma_f32_32x32x16_bf16(b0,qr[d0],p0,0,0,0);p1=__builtin_amdgcn_mfma_f32_32x32x16_bf16(b1,qr[d0],p1,0,0,0);}}
}
typedef __attribute__((address_space(3))) const char* lds_cptr;
typedef short v4i16_t __attribute__((ext_vector_type(4)));
__device__ __forceinline__ void kload8(bf16x8*kf,lds_cptr kp){
  kf[0]=*(const __attribute__((address_space(3))) bf16x8*)(kp);      kf[1]=*(const __attribute__((address_space(3))) bf16x8*)(kp+512);
  kf[2]=*(const __attribute__((address_space(3))) bf16x8*)(kp+2048); kf[3]=*(const __attribute__((address_space(3))) bf16x8*)(kp+2560);
  kf[4]=*(const __attribute__((address_space(3))) bf16x8*)(kp+4096); kf[5]=*(const __attribute__((address_space(3))) bf16x8*)(kp+4608);
  kf[6]=*(const __attribute__((address_space(3))) bf16x8*)(kp+6144); kf[7]=*(const __attribute__((address_space(3))) bf16x8*)(kp+6656);
}
__device__ __forceinline__ void kload2(bf16x8*kf,lds_cptr kp,int j){ kf[2*j]=*(const __attribute__((address_space(3))) bf16x8*)(kp+j*2048); kf[2*j+1]=*(const __attribute__((address_space(3))) bf16x8*)(kp+j*2048+512); }
__device__ __forceinline__ s16x4 vtr(lds_cptr p){ return __builtin_bit_cast(s16x4,__builtin_amdgcn_ds_read_tr16_b64_v4i16((__attribute__((address_space(3))) v4i16_t*)p)); }
__device__ __forceinline__ float rowmax(const f32x16&p0,const f32x16&p1){
  float a=max3f(p0[0],p0[1],p1[0]),b=max3f(p0[2],p0[3],p1[1]);a=max3f(a,p1[2],p1[3]);
  #pragma unroll
  for(int r=4;r<16;r+=4){a=max3f(a,p0[r],p0[r+1]);b=max3f(b,p0[r+2],p0[r+3]);a=max3f(a,p1[r],p1[r+1]);b=max3f(b,p1[r+2],p1[r+3]);}
  const float m=max2f(a,b);
  auto rr=__builtin_amdgcn_permlane32_swap(__float_as_uint(m),__float_as_uint(m),false,false);
  return max2f(__uint_as_float(rr[0]),__uint_as_float(rr[1]));
}
__device__ __forceinline__ void pv(f32x16*o,int vb,bf16x8 pa0,bf16x8 pa1,bf16x8 pa2,bf16x8 pa3){
  #pragma unroll
  for(int d0=0;d0<2;++d0){s16x4 lo[4],hi[4];
    #pragma unroll
    for(int ks=0;ks<4;++ks){
      asm volatile("ds_read_b64_tr_b16 %0,%1 offset:%c2":"=&v"(lo[ks]):"v"(vb),"i"(d0*4096+ks*1024):"memory");
      asm volatile("ds_read_b64_tr_b16 %0,%1 offset:%c2":"=&v"(hi[ks]):"v"(vb),"i"(d0*4096+ks*1024+512):"memory");}
    asm volatile("s_waitcnt lgkmcnt(0)":::"memory");SBAR();
    #define PK(k) (bf16x8){lo[k][0],lo[k][1],lo[k][2],lo[k][3],hi[k][0],hi[k][1],hi[k][2],hi[k][3]}
    o[d0]=__builtin_amdgcn_mfma_f32_32x32x16_bf16(pa0,PK(0),o[d0],0,0,0);
    o[d0]=__builtin_amdgcn_mfma_f32_32x32x16_bf16(pa1,PK(1),o[d0],0,0,0);
    o[d0]=__builtin_amdgcn_mfma_f32_32x32x16_bf16(pa2,PK(2),o[d0],0,0,0);
    o[d0]=__builtin_amdgcn_mfma_f32_32x32x16_bf16(pa3,PK(3),o[d0],0,0,0);
    #undef PK
  }
}

#ifndef ATTN_STORE16
#define ATTN_STORE16(p,v) (*(u32x4*)(p)=(v))
#endif
template<int MODE,int OP,int THRL> __device__ __forceinline__ void attn_unit(const bf16*Qu,const bf16*__restrict__ Kh,const bf16*__restrict__ Vh,bf16*Ou,int q0,int t_lo,int NT,float nsl2,char*shm){
  int tid_=threadIdx.x; asm volatile("":"+v"(tid_));
  const int tid=tid_,lane=tid&63,r32=lane&31,hi=lane>>5; const int wid=__builtin_amdgcn_readfirstlane(tid>>6);
  const bf16*Qw=Qu+(long)(wid*QBLK)*QP;
  const unsigned lds0=(unsigned)(uintptr_t)shm;
  float*wsf=(float*)(shm+LDS_WS)+wid*64;
  const bf16*ksrc=Kh+(long)lane*KP+wid*8;
  const bf16*vsrc=Vh+(long)(16*(wid&3)+(lane>>2))*KP+(wid>>2)*32+(lane&3)*8;
  const unsigned kdst=lds0+LDS_K+wid*1024, vdst=lds0+LDS_V+wid*1024;
  #define DMA_K(t,slot) glds16(ksrc+(long)(t)*KVBLK*KP,(unsigned)__builtin_amdgcn_readfirstlane(kdst+(slot)))
  #define DMA_V(t,slot) glds16(vsrc+(long)(t)*KVBLK*KP,(unsigned)__builtin_amdgcn_readfirstlane(vdst+(slot)))
  const int vb0=(int)(lds0+LDS_V)+((lane>>4)&1)*32+(lane&3)*8+(4*hi+((lane&15)>>2))*64;
  const char*Kbase=shm+LDS_K; bf16x8 kf[8];
  const lds_cptr shm3=(lds_cptr)shm; const lds_cptr kp0=shm3+LDS_K+hi*1024+r32*16; const lds_cptr vp0=shm3+LDS_V+((lane>>4)&1)*32+(lane&3)*8+(4*hi+((lane&15)>>2))*64;
  DMA_K(0,0);DMA_V(0,0);DMA_K(1,SLOTB);
  bf16x8 qr[4];
  #pragma unroll
  for(int d0=0;d0<4;++d0)qr[d0]=*reinterpret_cast<const bf16x8*>(&Qw[(long)r32*QP+d0*16+hi*8]);
  float mhat=0.f,l_reg=0.f;f32x16 o[2];o[0]=f32x16{};o[1]=f32x16{};f32x16 negm=f32x16{};asm volatile("":"+v"(negm));
  const float qf=(float)(q0+wid*QBLK+r32-4*hi);
  const int n_r=q0+(wid>>1), n_c=(wid&1)*32+r32, n_rs=min(max(n_r-4,0),120), n_kc=4*hi-min(max(n_c-8,0),48);
  typedef __attribute__((address_space(3))) const float* lds_fptr;
  const lds_fptr n_tb=(lds_fptr)((__attribute__((address_space(3))) const char*)shm+LDS_TB)+(7-n_r)*31+4*hi-n_c+15;
  #define CMASK(P0,P1,t) do{ if(MODE==0){ const float dq_=qf-(float)(64*(t)); _Pragma("unroll") for(int r=0;r<16;++r){ const float cr_=(float)((r&3)+8*(r>>2)); \
      P0[r]=__builtin_fmaf(nsl2,__builtin_fabsf(dq_-cr_),P0[r]); P1[r]=__builtin_fmaf(nsl2,__builtin_fabsf(dq_-(cr_+32.f)),P1[r]); } } \
    else { const int kr_=t_lo+(t); const bool vr_=(kr_>=n_rs)&&(kr_<n_rs+8); const lds_fptr tb_=n_tb+kr_*31; \
      _Pragma("unroll") for(int r=0;r<16;++r){ const int ko_=(r&3)+8*(r>>2); const float b0_=tb_[ko_],b1_=tb_[ko_+32]; \
        const bool ok0_=vr_&&((unsigned)(n_kc+ko_)<16u), ok1_=vr_&&((unsigned)(n_kc+ko_+32)<16u); \
        P0[r]=ok0_?P0[r]+b0_:-INFINITY; P1[r]=ok1_?P1[r]+b1_:-INFINITY; } } }while(0)
  bool resc=false;
  #define START(P0,P1) do{ const float rm=rowmax(P0,P1); resc=false; \
    { const float dl=(rm>-1e30f)?rm:0.f; mhat=fadd_s(mhat,dl); \
      _Pragma("unroll") for(int r=0;r<16;++r){P0[r]=fsub_s(P0[r],dl);P1[r]=fsub_s(P1[r],dl);} \
      _Pragma("unroll") for(int r=0;r<16;++r)negm[r]=-mhat; asm volatile("":"+v"(negm)); } \
    _Pragma("unroll") for(int r=0;r<16;++r)P0[r]=__builtin_amdgcn_exp2f(P0[r]); }while(0)
  #define RESC() do{ if(resc){ asm volatile("s_waitcnt lgkmcnt(0)":::"memory"); \
      _Pragma("unroll") for(int d_=0;d_<2;++d_) _Pragma("unroll") for(int r=0;r<16;++r)o[d_][r]*=wsf[crow(r,hi)]; } }while(0)
  f32x16 pA0,pA1,pB0,pB1;
  int sl_prev=0,sl_cur=0,sl_next=SLOTB;
  #define ROT() do{sl_prev=sl_cur;sl_cur=sl_next;sl_next=(sl_next==(NSLOT-1)*SLOTB)?0:sl_next+SLOTB;}while(0)
  DMA_K(2,2*SLOTB);
  WAIT_BAR(3);
  qkt(pA0,pA1,Kbase,qr,negm,r32,hi);asm volatile("s_nop 15\n\ts_nop 7":"+v"(pA0),"+v"(pA1));CMASK(pA0,pA1,0);
  START(pA0,pA1);
  _Pragma("unroll") for(int r=0;r<16;++r)pA1[r]=__builtin_amdgcn_exp2f(pA1[r]);
  WAIT_BAR(0);
  DMA_K(3,0);DMA_V(1,SLOTB);
  ROT();
  kload8(kf,kp0+sl_cur);
  WAIT_BAR(2);
  s16x4 vlo[8],vhi[8]; u32x4 pw0,pw1,pw2,pw3;
  #define PKW(P,B) cvtpk_s(P[B],P[B+1])
  #define PAF(k) __builtin_bit_cast(bf16x8,pw##k)
  #define VFR(i) (bf16x8){vlo[i][0],vlo[i][1],vlo[i][2],vlo[i][3],vhi[i][0],vhi[i][1],vhi[i][2],vhi[i][3]}
  #define PIN(x) asm volatile("":"+v"(x))
  #define MX3(a,b,c) __builtin_fmaxf(__builtin_fmaxf((a),(b)),(c))
  #define GAPA(MF,A0,A1,A2,A3,W0,W1,PW) do{ MF; sacc+=A0; sacc+=A1; sacc+=A2; sacc+=A3; PIN(sacc); W0; W1; PIN(PW); SBAR(); }while(0)
  #define EX(v) __builtin_amdgcn_exp2f(v)
  #define GAPB(MF,X,B) do{ MF; X[B]=EX(X[B]); X[B+1]=EX(X[B+1]); X[B+2]=EX(X[B+2]); X[B+3]=EX(X[B+3]); PIN(X); SBAR(); }while(0)
  #define VRD(i) do{ vlo[i]=vtr(vp_+(((i)>>2)*4096+((i)&3)*1024)); vhi[i]=vtr(vp_+(((i)>>2)*4096+((i)&3)*1024+512)); }while(0)
  #define KRD(G,j) do{ if(G){ kload2(kf,kp0+sl_next,j); SBAR(); } }while(0)
  #define STEP(C0,C1,P0,P1,t,GK,GV,GL) do{ SBAR(); \
    const lds_cptr vp_=vp0+sl_prev; \
    VRD(0); SBAR(); float sacc=(P0[0]+P0[1]); \
    GAPA(C0=__builtin_amdgcn_mfma_f32_32x32x16_bf16(kf[0],qr[0],negm,0,0,0), P0[2],P0[3],P0[4],P0[5],     pw0[0]=PKW(P0,0), pw0[1]=PKW(P0,2), pw0); \
    VRD(4); SBAR(); GAPA(C1=__builtin_amdgcn_mfma_f32_32x32x16_bf16(kf[1],qr[0],negm,0,0,0), P0[6],P0[7],P0[8],P0[9],     pw0[2]=PKW(P0,4), pw0[3]=PKW(P0,6), pw0); \
    VRD(1); SBAR(); GAPA(C0=__builtin_amdgcn_mfma_f32_32x32x16_bf16(kf[2],qr[1],C0,0,0,0),   P0[10],P0[11],P0[12],P0[13], pw1[0]=PKW(P0,8), pw1[1]=PKW(P0,10), pw1); \
    VRD(5); SBAR(); GAPA(C1=__builtin_amdgcn_mfma_f32_32x32x16_bf16(kf[3],qr[1],C1,0,0,0),   P0[14],P0[15],P1[0],P1[1],   pw1[2]=PKW(P0,12),pw1[3]=PKW(P0,14), pw1); \
    VRD(2); SBAR(); GAPA(C0=__builtin_amdgcn_mfma_f32_32x32x16_bf16(kf[4],qr[2],C0,0,0,0),   P1[2],P1[3],P1[4],P1[5],     pw2[0]=PKW(P1,0), pw2[1]=PKW(P1,2), pw2); \
    VRD(6); SBAR(); GAPA(C1=__builtin_amdgcn_mfma_f32_32x32x16_bf16(kf[5],qr[2],C1,0,0,0),   P1[6],P1[7],P1[8],P1[9],     pw2[2]=PKW(P1,4), pw2[3]=PKW(P1,6), pw2); \
    VRD(3); SBAR(); GAPA(C0=__builtin_amdgcn_mfma_f32_32x32x16_bf16(kf[6],qr[3],C0,0,0,0),   P1[10],P1[11],P1[12],P1[13], pw3[0]=PKW(P1,8), pw3[1]=PKW(P1,10), pw3); \
    VRD(7); SBAR(); GAPA(C1=__builtin_amdgcn_mfma_f32_32x32x16_bf16(kf[7],qr[3],C1,0,0,0),   P1[14],P1[15],0.f,0.f,       pw3[2]=PKW(P1,12),pw3[3]=PKW(P1,14), pw3); \
    l_reg+=sacc; \
    if(GK){DMA_K((t)+3,sl_cur);} if(GV){DMA_V((t)+1,sl_next);} \
    CMASK(C0,C1,t); \
    { float a=MX3(C0[0],C0[1],C1[0]),b=MX3(C0[2],C0[3],C1[1]); a=MX3(a,C1[2],C1[3]); \
      _Pragma("unroll") for(int r=4;r<16;r+=4){a=MX3(a,C0[r],C0[r+1]);b=MX3(b,C0[r+2],C0[r+3]);a=MX3(a,C1[r],C1[r+1]);b=MX3(b,C1[r+2],C1[r+3]);} \
      float rm=__builtin_fmaxf(a,b); { auto rr=__builtin_amdgcn_permlane32_swap(__float_as_uint(rm),__float_as_uint(rm),false,false); rm=__builtin_fmaxf(__uint_as_float(rr[0]),__uint_as_float(rr[1])); } \
      resc=false; \
      if(__builtin_expect(__any(rm>(float)THRL),0)){ const float dl=__builtin_fmaxf(rm,0.f); mhat+=dl; \
        _Pragma("unroll") for(int r=0;r<16;++r){C0[r]-=dl;C1[r]-=dl;} \
        _Pragma("unroll") for(int r=0;r<16;++r)negm[r]=-mhat; asm volatile("":"+v"(negm)); \
        const float f=__builtin_amdgcn_exp2f(-dl); l_reg*=f; if(hi==0)wsf[r32]=f; resc=true; } } \
    SBAR(); \
    GAPB(o[0]=__builtin_amdgcn_mfma_f32_32x32x16_bf16(PAF(0),VFR(0),o[0],0,0,0), C0,0); \
    GAPB(o[1]=__builtin_amdgcn_mfma_f32_32x32x16_bf16(PAF(0),VFR(4),o[1],0,0,0), C0,4); \
    KRD(GL,0); GAPB(o[0]=__builtin_amdgcn_mfma_f32_32x32x16_bf16(PAF(1),VFR(1),o[0],0,0,0), C0,8); \
    KRD(GL,1); GAPB(o[1]=__builtin_amdgcn_mfma_f32_32x32x16_bf16(PAF(1),VFR(5),o[1],0,0,0), C0,12); \
    KRD(GL,2); GAPB(o[0]=__builtin_amdgcn_mfma_f32_32x32x16_bf16(PAF(2),VFR(2),o[0],0,0,0), C1,0); \
    KRD(GL,3); GAPB(o[1]=__builtin_amdgcn_mfma_f32_32x32x16_bf16(PAF(2),VFR(6),o[1],0,0,0), C1,4); \
    GAPB(o[0]=__builtin_amdgcn_mfma_f32_32x32x16_bf16(PAF(3),VFR(3),o[0],0,0,0), C1,8); \
    GAPB(o[1]=__builtin_amdgcn_mfma_f32_32x32x16_bf16(PAF(3),VFR(7),o[1],0,0,0), C1,12); \
    }while(0)
  int t=1;
  for(;t+5<NT;t+=2){
    STEP(pB0,pB1,pA0,pA1,t,true,true,true);     WAIT_BAR(2); RESC(); ROT();
    STEP(pA0,pA1,pB0,pB1,t+1,true,true,true);   WAIT_BAR(2); RESC(); ROT();
  }
  #define ENDW(tt) do{ if((tt)+3<NT){WAIT_BAR(2);} else if((tt)+2<NT){WAIT_BAR(1);} else {WAIT_BAR(0);} }while(0)
  for(;t+1<NT;t+=2){
    STEP(pB0,pB1,pA0,pA1,t,(t+3<NT),(t+1<NT),(t+1<NT));       ENDW(t);   RESC(); ROT();
    STEP(pA0,pA1,pB0,pB1,t+1,(t+4<NT),(t+2<NT),(t+2<NT));     ENDW(t+1); RESC(); ROT();
  }
  STEP(pB0,pB1,pA0,pA1,NT-1,false,false,false); RESC();
  { float sacc=pB0[0]+pB0[1]; _Pragma("unroll") for(int r=2;r<16;++r)sacc+=pB0[r]; _Pragma("unroll") for(int r=0;r<16;++r)sacc+=pB1[r]; l_reg+=sacc;
    pw0=(u32x4){PKW(pB0,0),PKW(pB0,2),PKW(pB0,4),PKW(pB0,6)};pw1=(u32x4){PKW(pB0,8),PKW(pB0,10),PKW(pB0,12),PKW(pB0,14)};pw2=(u32x4){PKW(pB1,0),PKW(pB1,2),PKW(pB1,4),PKW(pB1,6)};pw3=(u32x4){PKW(pB1,8),PKW(pB1,10),PKW(pB1,12),PKW(pB1,14)};
    SBAR(); pv(o,vb0+sl_cur,PAF(0),PAF(1),PAF(2),PAF(3)); }
  #undef PKW
  #undef PAF
  #undef VFR
  #undef PIN
  #undef MX3
  #undef GAPA
  #undef GAPB
  #undef EX
  #undef VRD
  #undef KRD
  #undef STEP
  #undef ENDW
  {auto rr=__builtin_amdgcn_permlane32_swap(__float_as_uint(l_reg),__float_as_uint(l_reg),false,false);l_reg=__uint_as_float(rr[0])+__uint_as_float(rr[1]);}
  if(hi==0)wsf[32+r32]=l_reg;asm volatile("s_waitcnt lgkmcnt(0)":::"memory");
  float rli[16];
  #pragma unroll
  for(int r=0;r<16;++r)rli[r]=__builtin_amdgcn_rcpf(wsf[32+crow(r,hi)]);
  bf16*Ow=Ou+(long)(wid*QBLK)*OP;
  { bf16*stg=(bf16*)(shm+LDS_OST)+wid*2048;
    #pragma unroll
    for(int r=0;r<16;++r){const int orow=crow(r,hi);
      #pragma unroll
      for(int d0=0;d0<2;++d0)stg[orow*64+d0*32+r32]=__float2bfloat16(o[d0][r]*rli[r]);}
    asm volatile("s_waitcnt lgkmcnt(0)":::"memory");
    #pragma unroll
    for(int i=0;i<4;++i){const int row=i*8+(lane>>3),ch=lane&7; const u32x4 v=*(const u32x4*)(stg+row*64+ch*8); ATTN_STORE16(Ow+(long)row*OP+ch*8,v);} }
  asm volatile("s_waitcnt lgkmcnt(0)\n\ts_barrier":::"memory");
  #undef DMA_K
  #undef DMA_V
  #undef CMASK
  #undef START
  #undef RESC
  #undef ROT
}
constexpr int ATTN_LDS_BYTES=LDS_BYTES;
template<int THRL=8> __device__ __forceinline__ void attn_phase(char*lds,const bf16*proj,bf16*od,int vcu){
  const int bh=vcu>>5,qb=vcu&31,b=bh>>2,h=bh&3; if(bh>=8)return;
  const float nsl2=-__builtin_amdgcn_exp2f(-2.f*(float)(h+1))*1.4426950408889634f;
  const long row0=(long)b*SEQ;
  for(int i=0;i<4;++i){ const int map=i>>1,vh=i&1;
    attn_unit<0,512,THRL>(proj+(row0+qb*QB)*QP+h*128+map*64, proj+row0*KP+512+h*128+map*64, proj+row0*KP+1024+h*128+vh*64,
                    od+((long)map*(2*SEQ)+row0+qb*QB)*512+h*128+vh*64, qb*QB, 0, SEQ/KVBLK, nsl2, lds); }
}
template<int THRL=8> __device__ __forceinline__ void nat_phase(char*lds,const bf16*proj,bf16*concat,const float*rpb,int vcu,int G){
  const int tid=threadIdx.x;
  for(int id=vcu*2;id<512;id+=2*G) for(int j=0;j<2;++j){
    const int u=id+j,h=u&7,rb=u>>3,b=rb>>5,r0=(rb&31)*4;
    const int lo=min(max(r0-4,0),120), hi_=min(max(r0-1,0),120)+7; int nt=hi_-lo+1; nt+=nt&1;
    const long row0=(long)b*SEQ;
    __attribute__((address_space(3))) float* tb=(__attribute__((address_space(3))) float*)((__attribute__((address_space(3))) char*)lds+LDS_TB);
    if(tid<15*31) tb[tid]=rpb[h*15*31+tid]*1.4426950408889634f;
    attn_unit<1,1024,THRL>(proj+(row0+r0*64)*QP+1536+h*64, proj+(row0+lo*64)*KP+2048+h*64, proj+(row0+lo*64)*KP+2560+h*64,
                    concat+(row0+r0*64)*1024+512+h*64, r0, lo, nt, 0.f, lds); }
}
#undef SBAR
#undef WAIT_BAR
}
#define XB_TMO      128
#define XB_XCNT(j)  (256  + 64 * (j))
#define XB_XSUB(j)  (1280 + 64 * (j))
#define XB_XGEN(j)  (2304 + 64 * (j))
#define XB_TOP      3328
#define XB_TOPGEN   3392
#define XCD_BAR_WORDS 3456
#define XB_SPIN_CAP (1u << 18)

__device__ __forceinline__ unsigned xb_ld(unsigned* p)              { return __hip_atomic_load(p, __ATOMIC_RELAXED, __HIP_MEMORY_SCOPE_AGENT); }
__device__ __forceinline__ unsigned xb_add(unsigned* p, unsigned v) { return __hip_atomic_fetch_add(p, v, __ATOMIC_RELAXED, __HIP_MEMORY_SCOPE_AGENT); }
__device__ __forceinline__ unsigned xb_xcc_id() { return (unsigned)__builtin_amdgcn_s_getreg((3 << 11) | 20) & 0xFu; }
#define XB_SPIN(cond, bar) do { unsigned _sp = 0; while (cond) { __builtin_amdgcn_s_sleep(1); \
    if ((++_sp & 255u) == 0u) { if (xb_ld(&(bar)[XB_TMO])) break; if (_sp > XB_SPIN_CAP) { atomicAdd(&(bar)[XB_TMO], 1u); break; } } } } while (0)

struct XcdBarrier {
    unsigned* bar; unsigned x;
    volatile LAS unsigned* st;
};

__device__ __forceinline__ XcdBarrier xcd_barrier_post(unsigned* bar, volatile LAS unsigned* st) {
    XcdBarrier b; b.bar = bar; b.x = xb_xcc_id(); b.st = st;
    if (threadIdx.x == 0) (void)xb_add(&bar[XB_XCNT(b.x)], 1u);
    return b;
}
__device__ __forceinline__ void xcd_barrier_complete(unsigned* bar, unsigned x, unsigned& nloc, unsigned& nx) {
    const unsigned G = gridDim.x * gridDim.y * gridDim.z;
    unsigned sum, cnt, mine, sp = 0u;
    for (;;) {
        sum = 0u; cnt = 0u; mine = 0u;
#pragma unroll
        for (unsigned j = 0; j < 16; ++j) { const unsigned c = xb_ld(&bar[XB_XCNT(j)]); sum += c; cnt += (c > 0u) ? 1u : 0u; mine = (j == x) ? c : mine; }
        if (sum == G) break;
        __builtin_amdgcn_s_sleep(1);
        if ((++sp & 255u) == 0u) { if (xb_ld(&bar[XB_TMO])) break; if (sp > XB_SPIN_CAP) { atomicAdd(&bar[XB_TMO], 1u); break; } }
    }
    nloc = mine > 0u ? mine : 1u; nx = cnt > 0u ? cnt : 1u;
}

__device__ __forceinline__ void xcd_barrier(const XcdBarrier& b) {
    asm volatile("s_waitcnt vmcnt(0)" ::: "memory");
    __syncthreads();
    if (threadIdx.x == 0) {
        unsigned* bar = b.bar;
        __builtin_amdgcn_s_waitcnt(0);
        unsigned nloc = b.st[0], nx = b.st[1];
        if (nloc == 0u) { xcd_barrier_complete(bar, b.x, nloc, nx); b.st[0] = nloc; b.st[1] = nx; }
        const unsigned old = xb_add(&bar[XB_XSUB(b.x)], 1u);
        const unsigned gen = old / nloc;
        if (old + 1u == (gen + 1u) * nloc) {
            __builtin_amdgcn_fence(__ATOMIC_RELEASE, "agent");
            asm volatile("s_waitcnt vmcnt(0)" ::: "memory");
            const unsigned og = xb_add(&bar[XB_TOP], 1u);
            const unsigned tg = og / nx;
            if (og + 1u == (tg + 1u) * nx) xb_add(&bar[XB_TOPGEN], 1u);
            else XB_SPIN(xb_ld(&bar[XB_TOPGEN]) == tg, bar);
            __builtin_amdgcn_fence(__ATOMIC_ACQUIRE, "agent");
            xb_add(&bar[XB_XGEN(b.x)], 1u);
            asm volatile("s_waitcnt vmcnt(0)" ::: "memory");
        } else {
            XB_SPIN(xb_ld(&bar[XB_XGEN(b.x)]) == gen, bar);
            __builtin_amdgcn_fence(__ATOMIC_ACQUIRE, "agent");
            asm volatile("s_waitcnt vmcnt(0)" ::: "memory");
        }
    }
    __syncthreads();
}
__device__ __forceinline__ float wave_sum(float v) {
#pragma unroll
    for (int o = 1; o < 64; o <<= 1) v += __shfl_xor(v, o);
    return v;
}
__device__ __forceinline__ void p0_transpose_item(const float* W, int K, int N, bf16* WT, int row_off, LAS float* scr, int item, int lane) {
    const int nblk = N / 32, kb = item / nblk, nb = item % nblk, k0 = 64 * kb, n0 = 32 * nb;
#pragma unroll 8
    for (int i = 0; i < 32; ++i) { const int kk = 2 * i + (lane >> 5); scr[kk * 33 + (lane & 31)] = W[(size_t)(k0 + kk) * N + n0 + (lane & 31)]; }
    LDS_WAIT(); asm volatile("" ::: "memory");
    const int c = lane & 7;
#pragma unroll
    for (int j = 0; j < 4; ++j) { const int n = (lane >> 3) + 8 * j; const LAS float* s = scr + (8 * c) * 33 + n;
        v4u o; o.x = pk2(s[0 * 33], s[1 * 33]); o.y = pk2(s[2 * 33], s[3 * 33]); o.z = pk2(s[4 * 33], s[5 * 33]); o.w = pk2(s[6 * 33], s[7 * 33]);
        *(GAS v4u*)(WT + (size_t)(row_off + n0 + n) * K + k0 + 8 * c) = o; }
    LDS_WAIT(); asm volatile("" ::: "memory");
}
struct Params { const float* in[22]; float* out; unsigned char* ws; };

__device__ __forceinline__ float mod_val(const float* __restrict__ modp, const float* __restrict__ b_ada, int b, int j) {
    return b_ada[j] + ((modp[(0 * 2 + b) * 6144 + j] + modp[(1 * 2 + b) * 6144 + j]) + (modp[(2 * 2 + b) * 6144 + j] + modp[(3 * 2 + b) * 6144 + j]));
}

__device__ __forceinline__ int opaque_v(int i) { asm volatile("" : "+v"(i)); return i; }
__device__ __forceinline__ int opaque_i(int i) { asm volatile("" : "+s"(i)); return i; }
__device__ __forceinline__ unsigned char* launder_ws(unsigned char* p) { asm volatile("" : "+s"(p)); return p; }
__global__ void __launch_bounds__(NTHR, 2) mk_fwd(Params P) {
    extern __shared__ __attribute__((aligned(16))) unsigned char lds_raw[];
    LAS unsigned char* lds = (LAS unsigned char*)lds_raw;
    const int tid0 = threadIdx.x, wave = __builtin_amdgcn_readfirstlane(tid0 >> 6);
#define PH_TID const int tid = opaque_v(tid0), lane = tid & 63; (void)lane
    const int G = gridDim.x, bx = blockIdx.x, vcu = (G % 8 == 0) ? (bx % 8) * (G / 8) + bx / 8 : bx;
    const int gw = vcu * NWAVES + wave, NGW = G * NWAVES;
    unsigned char* const ws0 = P.ws;
#define WSP(name, type, off) type* name = (type*)(launder_ws(ws0) + (off))
#define INP(name, i) const float* name = P.in[opaque_i(i)]
    LAS int* tab = (LAS int*)(lds + TAB_OFF);

    for (int u = tid0; u < (LDS_BYTES - LDSCTL_OFF) / 4; u += NTHR) ((LAS unsigned*)(lds + LDSCTL_OFF))[u] = 0u;
    __syncthreads();
    XcdBarrier bar = xcd_barrier_post((unsigned*)((gu32*)(ws0 + WS_CTL) + CW_BAR), (volatile LAS unsigned*)(lds + MISC_OFF) + 8);

    if (bx < 48) {
        PH_TID;
        INP(cvec, 1); INP(w_ada, 2); WSP(modp, float, WS_MODP);
        LAS float* sl = (LAS float*)lds;
        for (int i = tid; i < 2048; i += NTHR) { const float c0 = cvec[i]; sl[i] = c0 / (1.f + __expf(-c0)); }
        __syncthreads();
        for (int it = bx; it < 48; it += G) {
            const int j = (it % 12) * 512 + tid, kq = it / 12; float a0 = 0.f, a1 = 0.f;
#pragma unroll 8
            for (int k = kq * 256; k < kq * 256 + 256; ++k) { const float w = w_ada[(size_t)k * 6144 + j]; a0 += sl[k] * w; a1 += sl[1024 + k] * w; }
            modp[(kq * 2 + 0) * 6144 + j] = a0; modp[(kq * 2 + 1) * 6144 + j] = a1;
        }
        __syncthreads();
    }
    for (int rep_ = 0; rep_ <= DUP_P0; ++rep_) {
        LAS float* scr = (LAS float*)(lds + RING_OFF + wave * 16384);
        PH_TID;
        INP(w_in, 6); INP(w_out, 7); INP(w1, 18); INP(w2, 20); WSP(win_t, bf16, WS_WIN); WSP(wout_t, bf16, WS_WOUT); WSP(w1_t, bf16, WS_W1T); WSP(w2_t, bf16, WS_W2T);
        constexpr int I_IN = 16 * 96, I_OUT = 16 * 32, I_W1 = 16 * 64, I_W2 = 16 * 32;
        constexpr int NITEMS = I_IN + I_OUT + NE * (I_W1 + I_W2);
        for (int it = gw; it < NITEMS; it += NGW) {
            int r = it;
            if (r < I_IN) { p0_transpose_item(w_in, D, NPROJ, win_t, 0, scr, r, lane); continue; } r -= I_IN;
            if (r < I_OUT) { p0_transpose_item(w_out, D, D, wout_t, 0, scr, r, lane); continue; } r -= I_OUT;
            if (r < NE * I_W1) { const int e = r / I_W1; p0_transpose_item(w1 + (size_t)e * D * 2048, D, 2048, w1_t, e * 2048, scr, r % I_W1, lane); continue; } r -= NE * I_W1;
            { const int e = r / I_W2; p0_transpose_item(w2 + (size_t)e * FF * D, FF, D, w2_t, e * 1024, scr, r % I_W2, lane); }
        }
    }
    xcd_barrier(bar);

    {
        LAS float* mv = (LAS float*)lds;
        PH_TID;
        INP(x, 0); INP(b_ada, 3); INP(g_pre_mix, 4); WSP(modp, float, WS_MODP); WSP(xn, bf16, WS_XN);
        for (int i = tid; i < 4096; i += NTHR) mv[i] = mod_val(modp, b_ada, i >> 11, i & 2047);
        __syncthreads();
        for (int row = gw; row < M; row += NGW) {
            const int b = row / SEQ; const float* xr = x + (size_t)row * D; const LAS float* sh = mv + b * 2048; const LAS float* sc = sh + 1024;
            f32x4 v[4]; float ss = 0.f;
#pragma unroll
            for (int i = 0; i < 4; ++i) { v[i] = *(const f32x4*)(xr + i * 256 + lane * 4); ss += v[i].x * v[i].x + v[i].y * v[i].y + v[i].z * v[i].z + v[i].w * v[i].w; }
            const float rstd = rsqrtf(wave_sum(ss) * (1.f / D) + RMS_EPS);
#pragma unroll
            for (int i = 0; i < 4; ++i) { const int c0 = i * 256 + lane * 4; float o[4];
#pragma unroll
                for (int e = 0; e < 4; ++e) o[e] = v[i][e] * rstd * g_pre_mix[c0 + e] * (1.f + sc[c0 + e]) + sh[c0 + e];
                uint2 w; w.x = pk2(o[0], o[1]); w.y = pk2(o[2], o[3]); *(uint2*)(xn + (size_t)row * D + c0) = w; }
        }
        __syncthreads();
    }
    xcd_barrier(bar);

    {
        WSP(xn, bf16, WS_XN); WSP(win_t, bf16, WS_WIN); WSP(proj, bf16, WS_PROJ);
        pg8::Gemm g{xn, win_t, M, NPROJ, D}; pg8::StaticOrder S; S.init(M, NPROJ, G, bx);
        pg8::EpiStoreBf16 E{proj, NPROJ, 512, attn_body::C2, 1536, 2048};
        pg8::gemm_phase<pg8::EpiStoreBf16, pg8::StaticOrder, true, true>(lds + RING_OFF, g, S, E);
    }
    xcd_barrier(bar);

    for (int rep_ = 0; rep_ <= DUP_ATT; ++rep_) {
        WSP(proj, bf16, WS_PROJ); WSP(od, bf16, WS_ODIFF);
        attn_body::attn_phase<8>((char*)lds_raw, (const attn_body::bf16*)proj, (attn_body::bf16*)od, vcu);
    }
    for (int rep_ = 0; rep_ <= DUP_NAT; ++rep_) {
        INP(rpb, 13); WSP(proj, bf16, WS_PROJ); WSP(concat, bf16, WS_CONCAT);
        attn_body::nat_phase<8>((char*)lds_raw, (const attn_body::bf16*)proj, (attn_body::bf16*)concat, rpb, vcu, G);
    }
    xcd_barrier(bar);

    {
        PH_TID;
        INP(lq1, 8); INP(lk1, 9); INP(lq2, 10); INP(lk2, 11); INP(g_sub, 12); WSP(od, bf16, WS_ODIFF); WSP(concat, bf16, WS_CONCAT);
        float s1 = 0.f, s2 = 0.f;
        for (int i = 0; i < 64; ++i) { s1 += lq1[i] * lk1[i]; s2 += lq2[i] * lk2[i]; }
        const float lam_init = 0.2f, lam = __expf(s1) - __expf(s2) + lam_init;
        for (int row = gw; row < M; row += NGW) {
            const int c0 = lane * 8;
            const v4u a = *(const v4u*)(od + (size_t)row * 512 + c0), bq = *(const v4u*)(od + ((size_t)M + row) * 512 + c0);
            float v[8]; float ss = 0.f;
#pragma unroll
            for (int e = 0; e < 4; ++e) { v[2 * e] = __uint_as_float(a[e] << 16) - lam * __uint_as_float(bq[e] << 16); v[2 * e + 1] = __uint_as_float(a[e] & 0xffff0000u) - lam * __uint_as_float(bq[e] & 0xffff0000u); }
#pragma unroll
            for (int e = 0; e < 8; ++e) ss += v[e] * v[e];
            ss += __shfl_xor(ss, 1); ss += __shfl_xor(ss, 2); ss += __shfl_xor(ss, 4); ss += __shfl_xor(ss, 8);
            const float rstd = rsqrtf(ss * (1.f / 128.f) + RMS_EPS); v4u w;
#pragma unroll
            for (int e = 0; e < 4; ++e) w[e] = pk2(v[2 * e] * rstd * g_sub[(c0 + 2 * e) & 127] * (1.f - lam_init), v[2 * e + 1] * rstd * g_sub[(c0 + 2 * e + 1) & 127] * (1.f - lam_init));
            *(v4u*)(concat + (size_t)row * D + c0) = w;
        }
    }
    xcd_barrier(bar);

    {
        WSP(concat, bf16, WS_CONCAT); WSP(wout_t, bf16, WS_WOUT); WSP(mix, float, WS_MIX);
        pg8::Gemm g{concat, wout_t, M, D, D}; pg8::StaticOrder S; S.init(M, D, G, bx);
        pg8::EpiStoreF32 E{mix, D};
        pg8::gemm_phase<pg8::EpiStoreF32, pg8::StaticOrder, true, true>(lds + RING_OFF, g, S, E);
    }
    xcd_barrier(bar);

    {
        LAS float* mv = (LAS float*)lds;
        PH_TID;
        INP(x, 0); INP(b_ada, 3); INP(g_post_mix, 5); INP(g_pre_ffn, 14); INP(w_router, 16); INP(b_router, 17);
        WSP(modp, float, WS_MODP); WSP(mix, float, WS_MIX); WSP(x1, float, WS_X1); WSP(h2, bf16, WS_H2); WSP(topi, int, WS_TOPI); WSP(gate, float, WS_GATE); WSP(hist, int, WS_HIST);
        LAS int* ltop = (LAS int*)(lds + 32768);
        for (int i = tid; i < 6144; i += NTHR) { const int b = i / 3072, r = i % 3072; mv[i] = mod_val(modp, b_ada, b, 2048 + r); }
        __syncthreads();
        for (int ch = bx; ch < NCHUNK; ch += G) {
            for (int i8 = 0; i8 < 8; ++i8) {
                const int row = ch * 64 + wave * 8 + i8, b = row / SEQ;
                const LAS float* gt1 = mv + b * 3072; const LAS float* sh2 = gt1 + 1024; const LAS float* sc2 = gt1 + 2048;
                f32x4 mvv[4], xv[4]; float ss = 0.f;
#pragma unroll
                for (int i = 0; i < 4; ++i) { mvv[i] = *(const f32x4*)(mix + (size_t)row * D + i * 256 + lane * 4); xv[i] = *(const f32x4*)(x + (size_t)row * D + i * 256 + lane * 4);
                    ss += mvv[i].x * mvv[i].x + mvv[i].y * mvv[i].y + mvv[i].z * mvv[i].z + mvv[i].w * mvv[i].w; }
                float rstd = rsqrtf(wave_sum(ss) * (1.f / D) + RMS_EPS); ss = 0.f;
#pragma unroll
                for (int i = 0; i < 4; ++i) { const int c0 = i * 256 + lane * 4;
#pragma unroll
                    for (int e = 0; e < 4; ++e) { xv[i][e] = xv[i][e] + gt1[c0 + e] * (mvv[i][e] * rstd * g_post_mix[c0 + e]); ss += xv[i][e] * xv[i][e]; }
                    *(f32x4*)(x1 + (size_t)row * D + c0) = xv[i]; }
                rstd = rsqrtf(wave_sum(ss) * (1.f / D) + RMS_EPS);
                float lg[32];
#pragma unroll
                for (int e = 0; e < 32; ++e) lg[e] = 0.f;
#pragma unroll
                for (int i = 0; i < 4; ++i) { const int c0 = i * 256 + lane * 4; float hv[4];
#pragma unroll
                    for (int j = 0; j < 4; ++j) hv[j] = xv[i][j] * rstd * g_pre_ffn[c0 + j] * (1.f + sc2[c0 + j]) + sh2[c0 + j];
                    uint2 w; w.x = pk2(hv[0], hv[1]); w.y = pk2(hv[2], hv[3]); *(uint2*)(h2 + (size_t)row * D + c0) = w;
#pragma unroll
                    for (int j = 0; j < 4; ++j) { const f32x4* wr = (const f32x4*)(w_router + (size_t)(c0 + j) * 32);
#pragma unroll
                        for (int e4 = 0; e4 < 8; ++e4) { const f32x4 wv = wr[e4]; lg[e4 * 4] += hv[j] * wv.x; lg[e4 * 4 + 1] += hv[j] * wv.y; lg[e4 * 4 + 2] += hv[j] * wv.z; lg[e4 * 4 + 3] += hv[j] * wv.w; } } }
#pragma unroll
                for (int e = 0; e < 32; ++e) lg[e] = wave_sum(lg[e]) + b_router[e];
                unsigned taken = 0u; float tv[4]; int ti[4];
#pragma unroll
                for (int p = 0; p < 4; ++p) { float best = -INFINITY; int bi = 0;
#pragma unroll
                    for (int e = 0; e < 32; ++e) { const bool ok = !((taken >> e) & 1u) && (lg[e] > best); best = ok ? lg[e] : best; bi = ok ? e : bi; }
                    taken |= 1u << bi; tv[p] = best; ti[p] = bi; }
                if (lane == 0) { const float e1 = __expf(tv[1] - tv[0]), e2 = __expf(tv[2] - tv[0]), e3 = __expf(tv[3] - tv[0]); const float rs = 1.f / (1.f + e1 + e2 + e3);
                    *(int4*)(topi + row * 4) = make_int4(ti[0], ti[1], ti[2], ti[3]); *(f32x4*)(gate + row * 4) = (f32x4){rs, e1 * rs, e2 * rs, e3 * rs};
                    const int lr = (wave * 8 + i8) * 4; ltop[lr] = ti[0]; ltop[lr + 1] = ti[1]; ltop[lr + 2] = ti[2]; ltop[lr + 3] = ti[3]; }
            }
            __syncthreads();
            if (tid < 32) { int cnt = 0; for (int i = 0; i < 256; ++i) cnt += (ltop[i] == tid) ? 1 : 0; hist[ch * 32 + tid] = cnt; }
            __syncthreads();
        }
    }
    xcd_barrier(bar);

    {
        LAS int* le = (LAS int*)(lds + 4096); LAS int* ld = (LAS int*)(lds + 8192);
        PH_TID;
        WSP(hist, int, WS_HIST); WSP(topi, int, WS_TOPI); WSP(dest, int, WS_DEST); WSP(h2, bf16, WS_H2); WSP(xbuf, bf16, WS_XBUF); gu32* ctl = (gu32*)(launder_ws(ws0) + WS_CTL);
        for (int ch = bx; ch < NCHUNK; ch += G) {
            if (tid < 32) { int tot = 0, base = 0; for (int c2 = 0; c2 < NCHUNK; ++c2) { const int hv = hist[c2 * 32 + tid]; tot += hv; base += (c2 < ch) ? hv : 0; } tab[32 + tid] = base; tab[tid] = (tot + 255) & ~255; }
            if (tid < 256) le[tid] = topi[ch * 256 + tid];
            __syncthreads();
            if (tid == 0) { int off = 0; for (int e = 0; e < NE; ++e) { const int pad = tab[e]; tab[e] = off;
                    if (ch == 0) for (int tl = 0; tl < pad / 256; ++tl) ctl[CW_TILEEXP + off / 256 + tl] = (unsigned)e;
                    off += pad; }
                if (ch == 0) ctl[CW_TOTAL] = (unsigned)off; }
            __syncthreads();
            if (tid < 256) { const int e = le[tid]; int rank = 0; for (int i = 0; i < tid; ++i) rank += (le[i] == e) ? 1 : 0;
                const int dd = tab[e] + tab[32 + e] + rank; dest[ch * 256 + tid] = dd; ld[tid] = dd; }
            __syncthreads();
            for (int i = 0; i < 32; ++i) { const int a = wave * 32 + i; const int dd = ld[a]; const size_t tok = (size_t)(ch * 256 + a) >> 2;
                const v4u* src = (const v4u*)(h2 + tok * D); v4u* dst = (v4u*)(xbuf + (size_t)dd * D);
                const v4u a0 = src[lane], a1 = src[64 + lane]; dst[lane] = a0; dst[64 + lane] = a1; }
            __syncthreads();
        }
    }
    xcd_barrier(bar);

    {
        PH_TID;
        gu32* ctl = (gu32*)(launder_ws(ws0) + WS_CTL);
        for (int i = tid; i < MAXTILES; i += NTHR) tab[64 + i] = (int)ctl[CW_TILEEXP + i];
        if (tid == 0) tab[352] = (int)ctl[CW_TOTAL];
        __syncthreads();
        const int ntile = __builtin_amdgcn_readfirstlane(tab[352]) >> 8;
        for (int rep_ = 0; rep_ <= DUP_G1; ++rep_) {
            INP(b1, 19); WSP(xbuf, bf16, WS_XBUF); WSP(w1_t, bf16, WS_W1T); WSP(act, bf16, WS_ACT);
            pg8::Gemm g{xbuf, w1_t, CAP, 2048, D}; pg8::MoeOrder<8> S{ntile * 8, G, vcu, (const LAS int*)(tab + 64)};
            pg8::EpiSwiglu E{act, b1};
            pg8::gemm_phase<pg8::EpiSwiglu, pg8::MoeOrder<8>, true, true>(lds + RING_OFF, g, S, E);
        }
        xcd_barrier(bar);
        for (int rep_ = 0; rep_ <= DUP_G2; ++rep_) {
            INP(b2, 21); WSP(act, bf16, WS_ACT); WSP(w2_t, bf16, WS_W2T); WSP(ybuf, bf16, WS_YBUF);
            pg8::Gemm g{act, w2_t, CAP, 1024, FF}; pg8::MoeOrder<4> S{ntile * 4, G, vcu, (const LAS int*)(tab + 64)};
            pg8::EpiY E{ybuf, b2};
            pg8::gemm_phase<pg8::EpiY, pg8::MoeOrder<4>, true, true>(lds + RING_OFF, g, S, E);
        }
    }
    xcd_barrier(bar);

    {
        LAS float* mv = (LAS float*)lds;
        PH_TID;
        INP(b_ada, 3); INP(g_post_ffn, 15); WSP(modp, float, WS_MODP); WSP(x1, float, WS_X1); WSP(ybuf, bf16, WS_YBUF); WSP(dest, int, WS_DEST); WSP(gate, float, WS_GATE); float* out = P.out;
        for (int i = tid; i < 2048; i += NTHR) mv[i] = mod_val(modp, b_ada, i >> 10, 5120 + (i & 1023));
        __syncthreads();
        for (int row = gw; row < M; row += NGW) {
            const int b = row / SEQ; const LAS float* gt2 = mv + b * 1024;
            float f[16]; float ss = 0.f;
#pragma unroll
            for (int i = 0; i < 16; ++i) f[i] = 0.f;
            const int4 dd = *(const int4*)(dest + row * 4); const f32x4 gg = *(const f32x4*)(gate + row * 4);
            const int dda[4] = {dd.x, dd.y, dd.z, dd.w};
#pragma unroll
            for (int p = 0; p < 4; ++p) { const float gp = gg[p]; const bf16* yr = ybuf + (size_t)dda[p] * D;
#pragma unroll
                for (int i = 0; i < 4; ++i) { const uint2 w = *(const uint2*)(yr + i * 256 + lane * 4);
                    f[i * 4] += gp * __uint_as_float(w.x << 16); f[i * 4 + 1] += gp * __uint_as_float(w.x & 0xffff0000u); f[i * 4 + 2] += gp * __uint_as_float(w.y << 16); f[i * 4 + 3] += gp * __uint_as_float(w.y & 0xffff0000u); } }
#pragma unroll
            for (int i = 0; i < 16; ++i) ss += f[i] * f[i];
            const float rstd = rsqrtf(wave_sum(ss) * (1.f / D) + RMS_EPS);
#pragma unroll
            for (int i = 0; i < 4; ++i) { const int c0 = i * 256 + lane * 4; const f32x4 xv = *(const f32x4*)(x1 + (size_t)row * D + c0); f32x4 ov;
#pragma unroll
                for (int e = 0; e < 4; ++e) ov[e] = xv[e] + gt2[c0 + e] * (f[i * 4 + e] * rstd * g_post_ffn[c0 + e]);
                *(f32x4*)(out + (size_t)row * D + c0) = ov; }
        }
    }
}

extern "C" void kernel_launch(void* const* d_in, const int* in_sizes, int n_in, void* d_out, int out_size, void* d_ws, size_t ws_size, hipStream_t stream) {
    static int grid = 0;
    if (grid == 0) {
        if (n_in != 22 || ws_size < WS_END) { fprintf(stderr, "kernel_launch: unexpected n_in %d / ws %zu\n", n_in, ws_size); grid = -1; return; }
        int dev = 0, cus = 0, per_cu = 0;
        if (hipGetDevice(&dev) != hipSuccess || hipDeviceGetAttribute(&cus, hipDeviceAttributeMultiprocessorCount, dev) != hipSuccess) { grid = -1; return; }
        if (hipFuncSetAttribute((const void*)mk_fwd, hipFuncAttributeMaxDynamicSharedMemorySize, LDS_BYTES) != hipSuccess) { fprintf(stderr, "kernel_launch: hipFuncSetAttribute failed\n"); grid = -1; return; }
        if (hipOccupancyMaxActiveBlocksPerMultiprocessor(&per_cu, (const void*)mk_fwd, NTHR, LDS_BYTES) != hipSuccess || per_cu < 1) { fprintf(stderr, "kernel_launch: occupancy query says %d\n", per_cu); }
        (void)hipGetLastError();
        grid = cus;
    }
    if (grid < 0) return;
    if (hipMemsetAsync((char*)d_ws + WS_CTL, 0, 1 * MiB, stream) != hipSuccess) return;
    Params p{};
    for (int i = 0; i < 22; ++i) p.in[i] = (const float*)d_in[i];
    p.out = (float*)d_out; p.ws = (unsigned char*)d_ws;
    hipLaunchKernelGGL(mk_fwd, dim3(grid), dim3(NTHR), LDS_BYTES, stream, p);
}
```

```cpp
#include <hip/hip_runtime.h>
#include <stdint.h>
#include <stdio.h>

#define GAS __attribute__((address_space(1)))
#define LAS __attribute__((address_space(3)))
typedef unsigned short bf16;
typedef unsigned v4u __attribute__((ext_vector_type(4)));
typedef float f32x4 __attribute__((ext_vector_type(4)));
typedef GAS unsigned gu32;
#define LDS_WAIT() asm volatile("s_waitcnt lgkmcnt(0)" ::: "memory")
#define VM_WAIT() asm volatile("s_waitcnt vmcnt(0)" ::: "memory")

#define DUP_P0 0
#define DUP_ATT 0
#define DUP_NAT 0
#define DUP_G1 0
#define DUP_G2 0
#define DUP_P6 0
#define DUP_P7 0
#define DUP_P10 0
constexpr int NB = 2, SEQ = 8192, D = 1024, M = NB * SEQ;
constexpr int NPROJ = 3072, NE = 32, TOPK = 4, FF = 1024;
constexpr int NASSIGN = M * TOPK;
constexpr int CAP = NASSIGN + NE * 256;
constexpr int MAXTILES = CAP / 256;
constexpr int NCHUNK = M / 64;
constexpr float RMS_EPS = 1e-6f;
constexpr int NWAVES = 8, NTHR = 512;

constexpr size_t MiB = 1u << 20;
constexpr size_t WS_CTL = 0;
constexpr size_t WS_MODP = 1 * MiB;
constexpr size_t WS_MOD = 1 * MiB + 512 * 1024;
constexpr size_t WS_HIST = 2 * MiB;
constexpr size_t WS_TOPI = 3 * MiB;
constexpr size_t WS_GATE = 3 * MiB + 512 * 1024;
constexpr size_t WS_DEST = 4 * MiB;
constexpr size_t WS_WIN = 6 * MiB;
constexpr size_t WS_WOUT = 12 * MiB;
constexpr size_t WS_XN = 16 * MiB;
constexpr size_t WS_PROJ = 48 * MiB;
constexpr size_t WS_ODIFF = 144 * MiB;
constexpr size_t WS_XBUF = 48 * MiB;
constexpr size_t WS_CONCAT = 208 * MiB;
constexpr size_t WS_MIX = 240 * MiB;
constexpr size_t WS_X1 = 304 * MiB;
constexpr size_t WS_H2 = 368 * MiB;
constexpr size_t WS_ACT = 400 * MiB;
constexpr size_t WS_YBUF = 544 * MiB;
constexpr size_t WS_W1T = 688 * MiB;
constexpr size_t WS_W2T = 816 * MiB;
constexpr size_t WS_END = 880 * MiB;
static_assert(WS_XBUF + (size_t)CAP * D * 2 <= WS_CONCAT, "XBUF overlay");
constexpr int CW_TOTAL = 64;
constexpr int CW_TILEEXP = 128;
constexpr int CW_NRM = 512;
constexpr int CW_ATTQ = 1024;
constexpr int CW_BAR = 4096;

constexpr int RING_OFF = 0, RING_BYTES = 131072;
constexpr int LDSCTL_OFF = RING_BYTES, MISC_OFF = LDSCTL_OFF + 320, TAB_OFF = LDSCTL_OFF + 1024;
constexpr int LDS_BYTES = 147456;

__device__ __forceinline__ float bf2f(bf16 v) { return __uint_as_float(((unsigned)v) << 16); }
__device__ __forceinline__ unsigned f2bf(float f) { unsigned u = __builtin_bit_cast(unsigned, f); return (u + 0x7fffu + ((u >> 16) & 1u)) >> 16; }
__device__ __forceinline__ unsigned pk2(float lo, float hi) { return f2bf(lo) | (f2bf(hi) << 16); }
namespace pg8 {
#define PG8_LAS __attribute__((address_space(3)))
typedef unsigned short bf16_t;
typedef short bf16x8 __attribute__((ext_vector_type(8)));
typedef float f32x4 __attribute__((ext_vector_type(4)));
typedef unsigned u32x4 __attribute__((ext_vector_type(4)));
constexpr int BM = 256, BK = 64, HALF = 128, HTB = HALF * BK * 2  , STAGE_BYTES = 8 * HTB, NXCD = 8, WGM = 8;

__host__ __device__ __forceinline__ int lds_byte(int r, int c) { const int st = (r >> 4) * 2 + (c >> 5), rr = r & 15, cc = c & 31, ob = rr * 64 + cc * 2; return st * 1024 + (ob ^ (((ob >> 9) & 1) << 5)); }
__host__ __device__ __forceinline__ void stage_rc(int b, int& R, int& C) { const int st = b / 1024, sb = b % 1024, swz = sb ^ (((sb >> 9) & 1) << 5); R = (st >> 1) * 16 + swz / 64; C = (st & 1) * 32 + (swz % 64) / 2; }
__host__ __device__ __forceinline__ int perm32(int rho) { const int n = rho >> 4, i = rho & 15; return 8 * (i >> 2) + 4 * n + (i & 3); }

struct Unit { int pm, pn; };
struct Gemm { const bf16_t* A; const bf16_t* Bt; int M, N, K; };

struct StaticOrder {
    int nM, nN, nwg, G, c;
    __host__ __device__ void init(int M, int N, int G_, int c_) { nM = M / BM; nN = N / BM; nwg = nM * nN; G = G_; c = c_; }
    __host__ __device__ bool next(int i, Unit& u) const {
        const long L = (long)i * G + c; if (L >= nwg) return false;
        int wgid = (int)L; { const int q = nwg / NXCD, r = nwg % NXCD, xcd = wgid % NXCD, off = wgid / NXCD; wgid = (xcd < r ? xcd * (q + 1) : r * (q + 1) + (xcd - r) * q) + off; }
        const int nig = WGM * nN, gid = wgid / nig, fm = gid * WGM, gsz = (nM - fm) < WGM ? (nM - fm) : WGM;
        u.pm = fm + ((wgid % nig) % gsz); u.pn = (wgid % nig) / gsz; return true;
    }
    __device__ __forceinline__ void a_ready(const Unit&) const {}
    __device__ __forceinline__ void done(const Unit&) const {}
};

__device__ __forceinline__ unsigned cvt_pk_bf16(float lo, float hi) { unsigned r; asm volatile("v_cvt_pk_bf16_f32 %0, %1, %2" : "=v"(r) : "v"(lo), "v"(hi)); return r; }
struct EpiStoreBf16 {
    static constexpr bool PERM = true, AFTER_DRAIN = false;
    bf16_t* O; int ldc; int scale_cols; float scale0; int s2lo, s2hi; unsigned* nrm;
    __device__ __forceinline__ void operator()(const f32x4 (&acc)[2][2][4][2], const Unit& u, int wr, int wc, int fr, int fq) const {
        const int row0 = u.pm * BM + wr * 64 + fr, colt = u.pn * BM, col0 = colt + wc * 32 + 8 * fq; const float sc = (colt < scale_cols || (colt >= s2lo && colt < s2hi)) ? scale0 : 1.f;
        float mx[2] = {0.f, 0.f};
#pragma unroll
        for (int ai = 0; ai < 2; ++ai)
#pragma unroll
            for (int m = 0; m < 4; ++m) { bf16_t* rowp = O + (size_t)(row0 + ai * HALF + m * 16) * ldc + col0;
#pragma unroll
                for (int bj = 0; bj < 2; ++bj) { const f32x4 v0 = acc[ai][bj][m][0] * sc, v1 = acc[ai][bj][m][1] * sc;
                    u32x4 w; w.x = cvt_pk_bf16(v0[0], v0[1]); w.y = cvt_pk_bf16(v0[2], v0[3]); w.z = cvt_pk_bf16(v1[0], v1[1]); w.w = cvt_pk_bf16(v1[2], v1[3]);
                    *(u32x4*)(rowp + bj * HALF) = w;
                    if (colt < 1024) { float s = 0.f;
#pragma unroll
                        for (int j = 0; j < 4; ++j) { const float lo = __uint_as_float(w[j] << 16), hi = __uint_as_float(w[j] & 0xffff0000u); s += lo * lo + hi * hi; }
                        s += __shfl_xor(s, 16); s += __shfl_xor(s, 32); mx[bj] = fmaxf(mx[bj], s); } } }
        if (colt < 1024) {
#pragma unroll
            for (int bj = 0; bj < 2; ++bj) { float v = mx[bj]; v = fmaxf(v, __shfl_xor(v, 1)); v = fmaxf(v, __shfl_xor(v, 2)); v = fmaxf(v, __shfl_xor(v, 4)); v = fmaxf(v, __shfl_xor(v, 8));
                if (fr == 0 && fq == 0) { const int g = (colt + bj * HALF + wc * 32) >> 6, b = u.pm >> 5; atomicMax(nrm + ((b * 16 + g) * 2 + (wc & 1)), __float_as_uint(v)); } }
        }
    }
};
struct EpiStoreF32 {
    static constexpr bool PERM = true, AFTER_DRAIN = false;
    float* O; int ldc;
    __device__ __forceinline__ void operator()(const f32x4 (&acc)[2][2][4][2], const Unit& u, int wr, int wc, int fr, int fq) const {
        const int row0 = u.pm * BM + wr * 64 + fr, col0 = u.pn * BM + wc * 32 + 8 * fq;
#pragma unroll
        for (int ai = 0; ai < 2; ++ai)
#pragma unroll
            for (int m = 0; m < 4; ++m) { float* rowp = O + (size_t)(row0 + ai * HALF + m * 16) * ldc + col0;
#pragma unroll
                for (int bj = 0; bj < 2; ++bj) { *(f32x4*)(rowp + bj * HALF) = acc[ai][bj][m][0]; *(f32x4*)(rowp + bj * HALF + 4) = acc[ai][bj][m][1]; } }
    }
};
struct EpiSwiglu {
    static constexpr bool PERM = true, AFTER_DRAIN = false;
    bf16_t* act; const float* b1;
    __device__ __forceinline__ void operator()(const f32x4 (&acc)[2][2][4][2], const Unit& u, int wr, int wc, int fr, int fq) const {
        const int e = u.pn >> 3, pnl = u.pn & 7, row0 = u.pm * BM + wr * 64 + fr, hc0 = pnl * BM + wc * 32 + 8 * fq;
        f32x4 bv[2][2];
#pragma unroll
        for (int bj = 0; bj < 2; ++bj)
#pragma unroll
            for (int n = 0; n < 2; ++n) bv[bj][n] = *(const f32x4*)(b1 + e * 2048 + hc0 + bj * HALF + 4 * n);
#pragma unroll
        for (int ai = 0; ai < 2; ++ai)
#pragma unroll
            for (int m = 0; m < 4; ++m) { bf16_t* rowp = act + (size_t)(row0 + ai * HALF + m * 16) * 1024 + (hc0 >> 1);
#pragma unroll
                for (int bj = 0; bj < 2; ++bj) { const f32x4 v0 = acc[ai][bj][m][0] + bv[bj][0], v1 = acc[ai][bj][m][1] + bv[bj][1];
                    float r[4];
                    const float gg[4] = {v0[0], v0[2], v1[0], v1[2]}, ll[4] = {v0[1], v0[3], v1[1], v1[3]};
#pragma unroll
                    for (int p = 0; p < 4; ++p) { float g = gg[p], l = ll[p];
                        g = fminf(g, 7.f); l = fminf(fmaxf(l, -7.f), 7.f);
                        r[p] = g * __builtin_amdgcn_rcpf(1.f + __expf(-1.702f * g)) * (l + 1.f); }
                    uint2 w; w.x = cvt_pk_bf16(r[0], r[1]); w.y = cvt_pk_bf16(r[2], r[3]);
                    *(uint2*)(rowp + bj * (HALF / 2)) = w; } }
    }
};
struct EpiY {
    static constexpr bool PERM = true, AFTER_DRAIN = false;
    bf16_t* y; const float* b2;
    __device__ __forceinline__ void operator()(const f32x4 (&acc)[2][2][4][2], const Unit& u, int wr, int wc, int fr, int fq) const {
        const int e = u.pn >> 2, pnl = u.pn & 3, row0 = u.pm * BM + wr * 64 + fr, col0 = pnl * BM + wc * 32 + 8 * fq;
        f32x4 bv[2][2];
#pragma unroll
        for (int bj = 0; bj < 2; ++bj)
#pragma unroll
            for (int n = 0; n < 2; ++n) bv[bj][n] = *(const f32x4*)(b2 + e * 1024 + col0 + bj * HALF + 4 * n);
#pragma unroll
        for (int ai = 0; ai < 2; ++ai)
#pragma unroll
            for (int m = 0; m < 4; ++m) { bf16_t* rowp = y + (size_t)(row0 + ai * HALF + m * 16) * 1024 + col0;
#pragma unroll
                for (int bj = 0; bj < 2; ++bj) { const f32x4 v0 = acc[ai][bj][m][0] + bv[bj][0], v1 = acc[ai][bj][m][1] + bv[bj][1];
                    u32x4 w; w.x = cvt_pk_bf16(v0[0], v0[1]); w.y = cvt_pk_bf16(v0[2], v0[3]); w.z = cvt_pk_bf16(v1[0], v1[1]); w.w = cvt_pk_bf16(v1[2], v1[3]);
                    *(u32x4*)(rowp + bj * HALF) = w; } }
    }
};
template <int NN> struct MoeOrder {
    int nunit, G, c; const PG8_LAS int* texp;
    __device__ __forceinline__ bool next(int i, Unit& u) const {
        const int L = i * G + c; if (L >= nunit) return false;
        const int pm = L / NN, pnl = L % NN; u.pm = pm; u.pn = __builtin_amdgcn_readfirstlane(texp[pm]) * NN + pnl; return true;
    }
    __device__ __forceinline__ void a_ready(const Unit&) const {}
    __device__ __forceinline__ void done(const Unit&) const {}
};
template <class Epi, class Sched, bool ALIGN_EPI = false, bool SP2 = false>
__device__ __forceinline__ void gemm_phase(PG8_LAS unsigned char* lds, const Gemm g, const Sched& S, const Epi& E) {
    int tid_ = threadIdx.x; asm volatile("" : "+v"(tid_));
    const int tid = tid_, wid = __builtin_amdgcn_readfirstlane(tid >> 6), lane = tid & 63, wr = wid >> 2, wc = wid & 3, fr = lane & 15, fq = lane >> 4;
    const int K = g.K, nt = K / BK;
    unsigned voffA[2], voffB[2];
#pragma unroll
    for (int i = 0; i < 2; ++i) { int R, C; stage_rc(tid * 16 + i * 8192, R, C); const int Rb = Epi::PERM ? ((R & ~31) + perm32(R & 31)) : R;
        voffA[i] = (unsigned)(R * K + C) * 2u; voffB[i] = (unsigned)(Rb * K + C) * 2u; }
    const size_t kstep = (size_t)(BK * 2);
    const size_t hstep = (size_t)HALF * K * 2;
    const size_t tstep = 2 * hstep;
    const unsigned ldsw = (unsigned)wid * 1024u;
    const int aoff = lds_byte(wr * 64 + fr, fq * 8), boff = lds_byte(wc * 32 + fr, fq * 8);
#define PG8_SA(b, h) (((b) * 2 + (h)) * HTB)
#define PG8_SB(b, h) ((4 + (b) * 2 + (h)) * HTB)
#define PG8_STAGE(bufoff, gbase, voff) do { _Pragma("unroll") for (int _i = 0; _i < 2; ++_i) \
        __builtin_amdgcn_global_load_lds((const unsigned*)((const char*)(gbase) + (voff)[_i]), (PG8_LAS unsigned*)(lds + (bufoff) + ldsw + _i * 8192), 16, 0, 0); } while (0)
#define PG8_LDA(dst, b, h) do { _Pragma("unroll") for (int m = 0; m < 4; ++m) _Pragma("unroll") for (int k = 0; k < 2; ++k) dst[m][k] = *(const PG8_LAS bf16x8*)(lds + PG8_SA(b, h) + aoff + m * 2048 + k * 1024); } while (0)
#define PG8_LDB(dst, b, h) do { _Pragma("unroll") for (int n = 0; n < 2; ++n) _Pragma("unroll") for (int k = 0; k < 2; ++k) dst[n][k] = *(const PG8_LAS bf16x8*)(lds + PG8_SB(b, h) + boff + n * 2048 + k * 1024); } while (0)
#define PG8_MMA(ai, bj, At, Bt) do { __builtin_amdgcn_s_setprio(1); _Pragma("unroll") for (int m = 0; m < 4; ++m) _Pragma("unroll") for (int n = 0; n < 2; ++n) _Pragma("unroll") for (int k = 0; k < 2; ++k) \
        acc[ai][bj][m][n] = __builtin_amdgcn_mfma_f32_16x16x32_bf16(Bt[n][k], At[m][k], acc[ai][bj][m][n], 0, 0, 0); __builtin_amdgcn_s_setprio(0); } while (0)
#define PG8_WAIT_V(n) asm volatile("s_waitcnt vmcnt(" #n ")" ::: "memory")
#define PG8_WAIT_L(n) asm volatile("s_waitcnt lgkmcnt(" #n ")" ::: "memory")
#define PG8_BAR __builtin_amdgcn_s_barrier()
#define PG8_SCHED __builtin_amdgcn_sched_barrier(0)
    Unit cur, nxt; int ui = 0;
    if (!S.next(0, cur)) return;
    f32x4 acc[2][2][4][2];
#pragma unroll
    for (int a = 0; a < 2; ++a)
#pragma unroll
        for (int b = 0; b < 2; ++b)
#pragma unroll
            for (int m = 0; m < 4; ++m)
#pragma unroll
                for (int n = 0; n < 2; ++n) acc[a][b][m][n] = (f32x4){0.f, 0.f, 0.f, 0.f};
    bf16x8 At[4][2], B0[2][2], B1[2][2];
    const char* cA = (const char*)g.A + (size_t)cur.pm * tstep; const char* cB = (const char*)g.Bt + (size_t)cur.pn * tstep;
    S.a_ready(cur);
    if constexpr (SP2) {
        PG8_STAGE(PG8_SB(0, 0), cB, voffB); PG8_STAGE(PG8_SB(0, 1), cB + hstep, voffB); PG8_STAGE(PG8_SA(0, 0), cA, voffA); PG8_STAGE(PG8_SA(0, 1), cA + hstep, voffA);
        if (wr == 1) PG8_BAR;
        PG8_WAIT_V(2); PG8_BAR;
        PG8_STAGE(PG8_SB(1, 0), cB + kstep, voffB); PG8_STAGE(PG8_SA(1, 0), cA + kstep, voffA); PG8_STAGE(PG8_SB(1, 1), cB + hstep + kstep, voffB);
        PG8_WAIT_V(6); PG8_BAR;
    } else {
        PG8_STAGE(PG8_SB(0, 0), cB, voffB); PG8_STAGE(PG8_SA(0, 0), cA, voffA); PG8_STAGE(PG8_SB(0, 1), cB + hstep, voffB); PG8_STAGE(PG8_SA(0, 1), cA + hstep, voffA);
        if (wr == 1) PG8_BAR;
        PG8_WAIT_V(4); PG8_BAR;
        PG8_STAGE(PG8_SB(1, 0), cB + kstep, voffB); PG8_STAGE(PG8_SA(1, 0), cA + kstep, voffA); PG8_STAGE(PG8_SB(1, 1), cB + hstep + kstep, voffB);
        PG8_WAIT_V(6); PG8_BAR;
    }
    for (;;) {
        const bool has_next = S.next(ui + 1, nxt);
        const char* nA = has_next ? (const char*)g.A + (size_t)nxt.pm * tstep : cA; const char* nB = has_next ? (const char*)g.Bt + (size_t)nxt.pn * tstep : cB;
        for (int t = 0; t < nt; t += 2) {
            const bool last = (t == nt - 2);
            const char* a1 = cA + (size_t)(t + 1) * kstep;
            const char* a2 = last ? nA : cA + (size_t)(t + 2) * kstep; const char* b2 = last ? nB : cB + (size_t)(t + 2) * kstep;
            const char* a3 = a2 + kstep; const char* b3 = b2 + kstep;
            if (last && has_next) S.a_ready(nxt);
            if constexpr (SP2) {
            PG8_LDB(B0, 0, 0); PG8_LDB(B1, 0, 1); PG8_SCHED; PG8_LDA(At, 0, 0); PG8_STAGE(PG8_SA(1, 1), a1 + hstep, voffA);
            PG8_WAIT_V(8); PG8_WAIT_L(0); PG8_BAR; PG8_MMA(0, 0, At, B0); PG8_MMA(0, 1, At, B1); PG8_BAR; PG8_SCHED;
            PG8_LDA(At, 0, 1); PG8_STAGE(PG8_SB(0, 0), b2, voffB); PG8_STAGE(PG8_SB(0, 1), b2 + hstep, voffB); PG8_STAGE(PG8_SA(0, 0), a2, voffA);
            PG8_WAIT_V(8); PG8_WAIT_L(0); PG8_BAR; PG8_MMA(1, 0, At, B0); PG8_MMA(1, 1, At, B1); PG8_BAR; PG8_SCHED;
            PG8_LDB(B0, 1, 0); PG8_LDB(B1, 1, 1); PG8_SCHED; PG8_LDA(At, 1, 0); PG8_STAGE(PG8_SA(0, 1), a2 + hstep, voffA);
            PG8_WAIT_V(8); PG8_WAIT_L(0); PG8_BAR; PG8_MMA(0, 0, At, B0); PG8_MMA(0, 1, At, B1); PG8_BAR; PG8_SCHED;
            PG8_LDA(At, 1, 1); PG8_STAGE(PG8_SB(1, 0), b3, voffB); PG8_STAGE(PG8_SB(1, 1), b3 + hstep, voffB); PG8_STAGE(PG8_SA(1, 0), a3, voffA);
            PG8_WAIT_V(8); PG8_WAIT_L(0); PG8_BAR; PG8_MMA(1, 0, At, B0); PG8_MMA(1, 1, At, B1); PG8_BAR; PG8_SCHED;
            } else {
            PG8_LDB(B0, 0, 0); PG8_SCHED; PG8_LDA(At, 0, 0); PG8_STAGE(PG8_SA(1, 1), a1 + hstep, voffA);
            PG8_WAIT_L(8); PG8_BAR; PG8_WAIT_L(0); PG8_MMA(0, 0, At, B0); PG8_BAR; PG8_SCHED;
            PG8_LDB(B1, 0, 1); PG8_STAGE(PG8_SB(0, 0), b2, voffB);
            PG8_BAR; PG8_WAIT_L(0); PG8_MMA(0, 1, At, B1); PG8_BAR;
            PG8_LDA(At, 0, 1); PG8_STAGE(PG8_SA(0, 0), a2, voffA);
            PG8_BAR; PG8_WAIT_L(0); PG8_MMA(1, 0, At, B0); PG8_BAR; PG8_SCHED;
            PG8_STAGE(PG8_SB(0, 1), b2 + hstep, voffB);
            PG8_WAIT_V(6); PG8_BAR; PG8_MMA(1, 1, At, B1); PG8_BAR;
            PG8_LDB(B0, 1, 0); PG8_SCHED; PG8_LDA(At, 1, 0); PG8_STAGE(PG8_SA(0, 1), a2 + hstep, voffA);
            PG8_WAIT_L(8); PG8_BAR; PG8_WAIT_L(0); PG8_MMA(0, 0, At, B0); PG8_BAR; PG8_SCHED;
            PG8_LDB(B1, 1, 1); PG8_STAGE(PG8_SB(1, 0), b3, voffB);
            PG8_BAR; PG8_WAIT_L(0); PG8_MMA(0, 1, At, B1); PG8_BAR;
            PG8_LDA(At, 1, 1); PG8_STAGE(PG8_SA(1, 0), a3, voffA);
            PG8_BAR; PG8_WAIT_L(0); PG8_MMA(1, 0, At, B0); PG8_BAR; PG8_SCHED;
            PG8_STAGE(PG8_SB(1, 1), b3 + hstep, voffB);
            PG8_WAIT_V(6); PG8_BAR; PG8_MMA(1, 1, At, B1); PG8_BAR;
            }
        }
        if constexpr (ALIGN_EPI) { if (wr == 0) PG8_BAR; }
        if constexpr (!Epi::AFTER_DRAIN) { E(acc, cur, wr, wc, fr, fq); S.done(cur); }
        if (!has_next) break;
#pragma unroll
        for (int a = 0; a < 2; ++a)
#pragma unroll
            for (int b = 0; b < 2; ++b)
#pragma unroll
                for (int m = 0; m < 4; ++m)
#pragma unroll
                    for (int n = 0; n < 2; ++n) acc[a][b][m][n] = (f32x4){0.f, 0.f, 0.f, 0.f};
        cur = nxt; cA = nA; cB = nB; ++ui;
        if constexpr (ALIGN_EPI) { if (wr == 1) PG8_BAR; }
    }
    PG8_WAIT_V(0);
    if constexpr (!ALIGN_EPI) { if (wr == 0) PG8_BAR; }
    PG8_BAR;
    if constexpr (Epi::AFTER_DRAIN) { E.fused(acc, cur, wr, wc, fr, fq, lds, wid, lane); S.done(cur); }
#undef PG8_SA
#undef PG8_SB
#undef PG8_STAGE
#undef PG8_LDA
#undef PG8_LDB
#undef PG8_MMA
#undef PG8_WAIT_V
#undef PG8_WAIT_L
#undef PG8_BAR
#undef PG8_SCHED
}
}
#include <hip/hip_bf16.h>
#include <cmath>
namespace attn_body {
using bf16=__hip_bfloat16;
using bf16x8=__attribute__((ext_vector_type(8)))short;
using s16x4=__attribute__((ext_vector_type(4)))short;
using f32x16=__attribute__((ext_vector_type(16)))float;
using u32x4=__attribute__((ext_vector_type(4)))unsigned;
constexpr int SEQ=8192,D=64,QP=3072,KP=3072,OP=512;
constexpr int NW=8,QBLK=32,QB=QBLK*NW,KVBLK=64,NQB=SEQ/QB;
constexpr int ATTN_UNIT_ROWS=QB;
__device__ __forceinline__ int crow(int r,int hi){return (r&3)+8*(r>>2)+4*hi;}
#define SBAR() __builtin_amdgcn_sched_barrier(0)
__device__ __forceinline__ void cmask(f32x16&p0,f32x16&p1,int jb,int qrel,int hi){
  const float NEG=-INFINITY; int kb=64*jb+4*hi;
  #pragma unroll
  for(int r=0;r<16;++r){int kv=kb+(r&3)+8*(r>>2); if(kv>qrel)p0[r]=NEG; if(kv+32>qrel)p1[r]=NEG;}
}

constexpr int NSLOT=3, SLOTB=8192;
constexpr int LDS_K=0, LDS_V=NSLOT*SLOTB, LDS_WS=2*NSLOT*SLOTB, LDS_OST=LDS_WS+NW*64*4, LDS_TB=LDS_OST+NW*4096+4096, LDS_BYTES=LDS_TB+4096;
constexpr float C2=0.125f*1.4426950408889634f;
__device__ __forceinline__ void glds16(const void*gsrc,unsigned lds_dst){unsigned keep;
  asm volatile("s_mov_b32 %0, m0\n\ts_mov_b32 m0, %2\n\ts_nop 0\n\tglobal_load_lds_dwordx4 %1, off\n\ts_mov_b32 m0, %0":"=&s"(keep):"v"(gsrc),"s"(lds_dst):"memory");}
__device__ __forceinline__ float max3f(float a,float b,float c){float r;asm("v_max3_f32 %0, %1, %2, %3":"=v"(r):"v"(a),"v"(b),"v"(c));return r;}
__device__ __forceinline__ float max2f(float a,float b){float r;asm("v_max_f32_e32 %0, %1, %2":"=v"(r):"v"(a),"v"(b));return r;}
__device__ __forceinline__ float fadd_s(float a,float b){float r;asm("v_add_f32_e32 %0, %1, %2":"=v"(r):"v"(a),"v"(b));return r;}
__device__ __forceinline__ float fsub_s(float a,float b){float r;asm("v_sub_f32_e32 %0, %1, %2":"=v"(r):"v"(a),"v"(b));return r;}
typedef float f32x2_t __attribute__((ext_vector_type(2))); typedef __bf16 bf16x2_t __attribute__((ext_vector_type(2)));
__device__ __forceinline__ unsigned cvtpk_s(float lo,float hi){f32x2_t v={lo,hi};bf16x2_t b=__builtin_convertvector(v,bf16x2_t);return __builtin_bit_cast(unsigned,b);}
#define WAIT_BAR(N) asm volatile("s_waitcnt vmcnt(" #N ") lgkmcnt(0)\n\ts_barrier":::"memory")

__device__ __forceinline__ void qkt(f32x16&p0,f32x16&p1,const char*Kslot,const bf16x8*qr,const f32x16&negm,int r32,int hi){
  const char*kb=Kslot+hi*1024+r32*16;
  #pragma unroll
  for(int d0=0;d0<4;++d0){
    const bf16x8 b0=*reinterpret_cast<const bf16x8*>(kb+d0*2048);
    const bf16x8 b1=*reinterpret_cast<const bf16x8*>(kb+d0*2048+512);
    if(d0==0){p0=__builtin_amdgcn_mfma_f32_32x32x16_bf16(b0,qr[0],negm,0,0,0);p1=__builtin_amdgcn_mfma_f32_32x32x16_bf16(b1,qr[0],negm,0,0,0);}
    else{p0=__builtin_amdgcn_mfma_f32_32x32x16_bf16(b0,qr[d0],p0,0,0,0);p1=__builtin_amdgcn_mfma_f32_32x32x16_bf16(b1,qr[d0],p1,0,0,0);}}
}
typedef __attribute__((address_space(3))) const char* lds_cptr;
typedef short v4i16_t __attribute__((ext_vector_type(4)));
__device__ __forceinline__ void kload8(bf16x8*kf,lds_cptr kp){
  kf[0]=*(const __attribute__((address_space(3))) bf16x8*)(kp);      kf[1]=*(const __attribute__((address_space(3))) bf16x8*)(kp+512);
  kf[2]=*(const __attribute__((address_space(3))) bf16x8*)(kp+2048); kf[3]=*(const __attribute__((address_space(3))) bf16x8*)(kp+2560);
  kf[4]=*(const __attribute__((address_space(3))) bf16x8*)(kp+4096); kf[5]=*(const __attribute__((address_space(3))) bf16x8*)(kp+4608);
  kf[6]=*(const __attribute__((address_space(3))) bf16x8*)(kp+6144); kf[7]=*(const __attribute__((address_space(3))) bf16x8*)(kp+6656);
}
__device__ __forceinline__ void kload2(bf16x8*kf,lds_cptr kp,int j){ kf[2*j]=*(const __attribute__((address_space(3))) bf16x8*)(kp+j*2048); kf[2*j+1]=*(const __attribute__((address_space(3))) bf16x8*)(kp+j*2048+512); }
__device__ __forceinline__ s16x4 vtr(lds_cptr p){ return __builtin_bit_cast(s16x4,__builtin_amdgcn_ds_read_tr16_b64_v4i16((__attribute__((address_space(3))) v4i16_t*)p)); }
__device__ __forceinline__ float rowmax(const f32x16&p0,const f32x16&p1){
  float a=max3f(p0[0],p0[1],p1[0]),b=max3f(p0[2],p0[3],p1[1]);a=max3f(a,p1[2],p1[3]);
  #pragma unroll
  for(int r=4;r<16;r+=4){a=max3f(a,p0[r],p0[r+1]);b=max3f(b,p0[r+2],p0[r+3]);a=max3f(a,p1[r],p1[r+1]);b=max3f(b,p1[r+2],p1[r+3]);}
  const float m=max2f(a,b);
  auto rr=__builtin_amdgcn_permlane32_swap(__float_as_uint(m),__float_as_uint(m),false,false);
  return max2f(__uint_as_float(rr[0]),__uint_as_float(rr[1]));
}
__device__ __forceinline__ void pv(f32x16*o,int vb,bf16x8 pa0,bf16x8 pa1,bf16x8 pa2,bf16x8 pa3){
  #pragma unroll
  for(int d0=0;d0<2;++d0){s16x4 lo[4],hi[4];
    #pragma unroll
    for(int ks=0;ks<4;++ks){
      asm volatile("ds_read_b64_tr_b16 %0,%1 offset:%c2":"=&v"(lo[ks]):"v"(vb),"i"(d0*4096+ks*1024):"memory");
      asm volatile("ds_read_b64_tr_b16 %0,%1 offset:%c2":"=&v"(hi[ks]):"v"(vb),"i"(d0*4096+ks*1024+512):"memory");}
    asm volatile("s_waitcnt lgkmcnt(0)":::"memory");SBAR();
    #define PK(k) (bf16x8){lo[k][0],lo[k][1],lo[k][2],lo[k][3],hi[k][0],hi[k][1],hi[k][2],hi[k][3]}
    o[d0]=__builtin_amdgcn_mfma_f32_32x32x16_bf16(pa0,PK(0),o[d0],0,0,0);
    o[d0]=__builtin_amdgcn_mfma_f32_32x32x16_bf16(pa1,PK(1),o[d0],0,0,0);
    o[d0]=__builtin_amdgcn_mfma_f32_32x32x16_bf16(pa2,PK(2),o[d0],0,0,0);
    o[d0]=__builtin_amdgcn_mfma_f32_32x32x16_bf16(pa3,PK(3),o[d0],0,0,0);
    #undef PK
  }
}

#ifndef ATTN_STORE16
#define ATTN_STORE16(p,v) (*(u32x4*)(p)=(v))
#endif
template<int MODE,int OP,int THRL> __device__ __forceinline__ void attn_unit(const bf16*Qu,const bf16*__restrict__ Kh,const bf16*__restrict__ Vh,bf16*Ou,int q0,int t_lo,int NT,float nsl2,char*shm){
  int tid_=threadIdx.x; asm volatile("":"+v"(tid_));
  const int tid=tid_,lane=tid&63,r32=lane&31,hi=lane>>5; const int wid=__builtin_amdgcn_readfirstlane(tid>>6);
  const bf16*Qw=Qu+(long)(wid*QBLK)*QP;
  const unsigned lds0=(unsigned)(uintptr_t)shm;
  float*wsf=(float*)(shm+LDS_WS)+wid*64;
  const bf16*ksrc=Kh+(long)lane*KP+wid*8;
  const bf16*vsrc=Vh+(long)(16*(wid&3)+(lane>>2))*KP+(wid>>2)*32+(lane&3)*8;
  const unsigned kdst=lds0+LDS_K+wid*1024, vdst=lds0+LDS_V+wid*1024;
  #define DMA_K(t,slot) glds16(ksrc+(long)(t)*KVBLK*KP,(unsigned)__builtin_amdgcn_readfirstlane(kdst+(slot)))
  #define DMA_V(t,slot) glds16(vsrc+(long)(t)*KVBLK*KP,(unsigned)__builtin_amdgcn_readfirstlane(vdst+(slot)))
  const int vb0=(int)(lds0+LDS_V)+((lane>>4)&1)*32+(lane&3)*8+(4*hi+((lane&15)>>2))*64;
  const char*Kbase=shm+LDS_K; bf16x8 kf[8];
  const lds_cptr shm3=(lds_cptr)shm; const lds_cptr kp0=shm3+LDS_K+hi*1024+r32*16; const lds_cptr vp0=shm3+LDS_V+((lane>>4)&1)*32+(lane&3)*8+(4*hi+((lane&15)>>2))*64;
  DMA_K(0,0);DMA_V(0,0);DMA_K(1,SLOTB);
  bf16x8 qr[4];
  #pragma unroll
  for(int d0=0;d0<4;++d0)qr[d0]=*reinterpret_cast<const bf16x8*>(&Qw[(long)r32*QP+d0*16+hi*8]);
  float mhat=0.f,l_reg=0.f;f32x16 o[2];o[0]=f32x16{};o[1]=f32x16{};f32x16 negm=f32x16{};asm volatile("":"+v"(negm));
  const float qf=(float)(q0+wid*QBLK+r32-4*hi);
  const int n_r=q0+(wid>>1), n_c=(wid&1)*32+r32, n_rs=min(max(n_r-4,0),120), n_kc=4*hi-min(max(n_c-8,0),48);
  typedef __attribute__((address_space(3))) const float* lds_fptr;
  const lds_fptr n_tb=(lds_fptr)((__attribute__((address_space(3))) const char*)shm+LDS_TB)+(7-n_r)*31+4*hi-n_c+15;
  #define CMASK(P0,P1,t) do{ if(MODE==0){ const float dq_=qf-(float)(64*(t)); _Pragma("unroll") for(int r=0;r<16;++r){ const float cr_=(float)((r&3)+8*(r>>2)); \
      P0[r]=__builtin_fmaf(nsl2,__builtin_fabsf(dq_-cr_),P0[r]); P1[r]=__builtin_fmaf(nsl2,__builtin_fabsf(dq_-(cr_+32.f)),P1[r]); } } \
    else { const int kr_=t_lo+(t); const bool vr_=(kr_>=n_rs)&&(kr_<n_rs+8); const lds_fptr tb_=n_tb+kr_*31; \
      _Pragma("unroll") for(int r=0;r<16;++r){ const int ko_=(r&3)+8*(r>>2); const float b0_=tb_[ko_],b1_=tb_[ko_+32]; \
        const bool ok0_=vr_&&((unsigned)(n_kc+ko_)<16u), ok1_=vr_&&((unsigned)(n_kc+ko_+32)<16u); \
        P0[r]=ok0_?P0[r]+b0_:-INFINITY; P1[r]=ok1_?P1[r]+b1_:-INFINITY; } } }while(0)
  bool resc=false;
  #define START(P0,P1) do{ const float rm=rowmax(P0,P1); resc=false; \
    { const float dl=(rm>-1e30f)?rm:0.f; mhat=fadd_s(mhat,dl); \
      _Pragma("unroll") for(int r=0;r<16;++r){P0[r]=fsub_s(P0[r],dl);P1[r]=fsub_s(P1[r],dl);} \
      _Pragma("unroll") for(int r=0;r<16;++r)negm[r]=-mhat; asm volatile("":"+v"(negm)); } \
    _Pragma("unroll") for(int r=0;r<16;++r)P0[r]=__builtin_amdgcn_exp2f(P0[r]); }while(0)
  #define RESC() do{ if(resc){ asm volatile("s_waitcnt lgkmcnt(0)":::"memory"); \
      _Pragma("unroll") for(int d_=0;d_<2;++d_) _Pragma("unroll") for(int r=0;r<16;++r)o[d_][r]*=wsf[crow(r,hi)]; } }while(0)
  f32x16 pA0,pA1,pB0,pB1;
  int sl_prev=0,sl_cur=0,sl_next=SLOTB;
  #define ROT() do{sl_prev=sl_cur;sl_cur=sl_next;sl_next=(sl_next==(NSLOT-1)*SLOTB)?0:sl_next+SLOTB;}while(0)
  DMA_K(2,2*SLOTB);
  WAIT_BAR(3);
  qkt(pA0,pA1,Kbase,qr,negm,r32,hi);asm volatile("s_nop 15\n\ts_nop 7":"+v"(pA0),"+v"(pA1));CMASK(pA0,pA1,0);
  START(pA0,pA1);
  _Pragma("unroll") for(int r=0;r<16;++r)pA1[r]=__builtin_amdgcn_exp2f(pA1[r]);
  WAIT_BAR(0);
  DMA_K(3,0);DMA_V(1,SLOTB);
  ROT();
  kload8(kf,kp0+sl_cur);
  WAIT_BAR(2);
  s16x4 vlo[8],vhi[8]; u32x4 pw0,pw1,pw2,pw3;
  #define PKW(P,B) cvtpk_s(P[B],P[B+1])
  #define PAF(k) __builtin_bit_cast(bf16x8,pw##k)
  #define VFR(i) (bf16x8){vlo[i][0],vlo[i][1],vlo[i][2],vlo[i][3],vhi[i][0],vhi[i][1],vhi[i][2],vhi[i][3]}
  #define PIN(x) asm volatile("":"+v"(x))
  #define MX3(a,b,c) __builtin_fmaxf(__builtin_fmaxf((a),(b)),(c))
  #define GAPA(MF,A0,A1,A2,A3,W0,W1,PW) do{ MF; sacc+=A0; sacc+=A1; sacc+=A2; sacc+=A3; PIN(sacc); W0; W1; PIN(PW); SBAR(); }while(0)
  #define EX(v) __builtin_amdgcn_exp2f(v)
  #define GAPB(MF,X,B) do{ MF; X[B]=EX(X[B]); X[B+1]=EX(X[B+1]); X[B+2]=EX(X[B+2]); X[B+3]=EX(X[B+3]); PIN(X); SBAR(); }while(0)
  #define VRD(i) do{ vlo[i]=vtr(vp_+(((i)>>2)*4096+((i)&3)*1024)); vhi[i]=vtr(vp_+(((i)>>2)*4096+((i)&3)*1024+512)); }while(0)
  #define KRD(G,j) do{ if(G){ kload2(kf,kp0+sl_next,j); SBAR(); } }while(0)
  #define STEP(C0,C1,P0,P1,t,GK,GV,GL) do{ SBAR(); \
    const lds_cptr vp_=vp0+sl_prev; \
    VRD(0); SBAR(); float sacc=(P0[0]+P0[1]); \
    GAPA(C0=__builtin_amdgcn_mfma_f32_32x32x16_bf16(kf[0],qr[0],negm,0,0,0), P0[2],P0[3],P0[4],P0[5],     pw0[0]=PKW(P0,0), pw0[1]=PKW(P0,2), pw0); \
    VRD(4); SBAR(); GAPA(C1=__builtin_amdgcn_mfma_f32_32x32x16_bf16(kf[1],qr[0],negm,0,0,0), P0[6],P0[7],P0[8],P0[9],     pw0[2]=PKW(P0,4), pw0[3]=PKW(P0,6), pw0); \
    VRD(1); SBAR(); GAPA(C0=__builtin_amdgcn_mfma_f32_32x32x16_bf16(kf[2],qr[1],C0,0,0,0),   P0[10],P0[11],P0[12],P0[13], pw1[0]=PKW(P0,8), pw1[1]=PKW(P0,10), pw1); \
    VRD(5); SBAR(); GAPA(C1=__builtin_amdgcn_mfma_f32_32x32x16_bf16(kf[3],qr[1],C1,0,0,0),   P0[14],P0[15],P1[0],P1[1],   pw1[2]=PKW(P0,12),pw1[3]=PKW(P0,14), pw1); \
    VRD(2); SBAR(); GAPA(C0=__builtin_amdgcn_mfma_f32_32x32x16_bf16(kf[4],qr[2],C0,0,0,0),   P1[2],P1[3],P1[4],P1[5],     pw2[0]=PKW(P1,0), pw2[1]=PKW(P1,2), pw2); \
    VRD(6); SBAR(); GAPA(C1=__builtin_amdgcn_mfma_f32_32x32x16_bf16(kf[5],qr[2],C1,0,0,0),   P1[6],P1[7],P1[8],P1[9],     pw2[2]=PKW(P1,4), pw2[3]=PKW(P1,6), pw2); \
    VRD(3); SBAR(); GAPA(C0=__builtin_amdgcn_mfma_f32_32x32x16_bf16(kf[6],qr[3],C0,0,0,0),   P1[10],P1[11],P1[12],P1[13], pw3[0]=PKW(P1,8), pw3[1]=PKW(P1,10), pw3); \
    VRD(7); SBAR(); GAPA(C1=__builtin_amdgcn_mfma_f32_32x32x16_bf16(kf[7],qr[3],C1,0,0,0),   P1[14],P1[15],0.f,0.f,       pw3[2]=PKW(P1,12),pw3[3]=PKW(P1,14), pw3); \
    l_reg+=sacc; \
    if(GK){DMA_K((t)+3,sl_cur);} if(GV){DMA_V((t)+1,sl_next);} \
    CMASK(C0,C1,t); \
    { float a=MX3(C0[0],C0[1],C1[0]),b=MX3(C0[2],C0[3],C1[1]); a=MX3(a,C1[2],C1[3]); \
      _Pragma("unroll") for(int r=4;r<16;r+=4){a=MX3(a,C0[r],C0[r+1]);b=MX3(b,C0[r+2],C0[r+3]);a=MX3(a,C1[r],C1[r+1]);b=MX3(b,C1[r+2],C1[r+3]);} \
      float rm=__builtin_fmaxf(a,b); { auto rr=__builtin_amdgcn_permlane32_swap(__float_as_uint(rm),__float_as_uint(rm),false,false); rm=__builtin_fmaxf(__uint_as_float(rr[0]),__uint_as_float(rr[1])); } \
      resc=false; \
      if(__builtin_expect(__any(rm>(float)THRL),0)){ const float dl=__builtin_fmaxf(rm,0.f); mhat+=dl; \
        _Pragma("unroll") for(int r=0;r<16;++r){C0[r]-=dl;C1[r]-=dl;} \
        _Pragma("unroll") for(int r=0;r<16;++r)negm[r]=-mhat; asm volatile("":"+v"(negm)); \
        const float f=__builtin_amdgcn_exp2f(-dl); l_reg*=f; if(hi==0)wsf[r32]=f; resc=true; } } \
    SBAR(); \
    GAPB(o[0]=__builtin_amdgcn_mfma_f32_32x32x16_bf16(PAF(0),VFR(0),o[0],0,0,0), C0,0); \
    GAPB(o[1]=__builtin_amdgcn_mfma_f32_32x32x16_bf16(PAF(0),VFR(4),o[1],0,0,0), C0,4); \
    KRD(GL,0); GAPB(o[0]=__builtin_amdgcn_mfma_f32_32x32x16_bf16(PAF(1),VFR(1),o[0],0,0,0), C0,8); \
    KRD(GL,1); GAPB(o[1]=__builtin_amdgcn_mfma_f32_32x32x16_bf16(PAF(1),VFR(5),o[1],0,0,0), C0,12); \
    KRD(GL,2); GAPB(o[0]=__builtin_amdgcn_mfma_f32_32x32x16_bf16(PAF(2),VFR(2),o[0],0,0,0), C1,0); \
    KRD(GL,3); GAPB(o[1]=__builtin_amdgcn_mfma_f32_32x32x16_bf16(PAF(2),VFR(6),o[1],0,0,0), C1,4); \
    GAPB(o[0]=__builtin_amdgcn_mfma_f32_32x32x16_bf16(PAF(3),VFR(3),o[0],0,0,0), C1,8); \
    GAPB(o[1]=__builtin_amdgcn_mfma_f32_32x32x16_bf16(PAF(3),VFR(7),o[1],0,0,0), C1,12); \
    }while(0)
  int t=1;
  for(;t+5<NT;t+=2){
    STEP(pB0,pB1,pA0,pA1,t,true,true,true);     WAIT_BAR(2); RESC(); ROT();
    STEP(pA0,pA1,pB0,pB1,t+1,true,true,true);   WAIT_BAR(2); RESC(); ROT();
  }
  #define ENDW(tt) do{ if((tt)+3<NT){WAIT_BAR(2);} else if((tt)+2<NT){WAIT_BAR(1);} else {WAIT_BAR(0);} }while(0)
  for(;t+1<NT;t+=2){
    STEP(pB0,pB1,pA0,pA1,t,(t+3<NT),(t+1<NT),(t+1<NT));       ENDW(t);   RESC(); ROT();
    STEP(pA0,pA1,pB0,pB1,t+1,(t+4<NT),(t+2<NT),(t+2<NT));     ENDW(t+1); RESC(); ROT();
  }
  STEP(pB0,pB1,pA0,pA1,NT-1,false,false,false); RESC();
  { float sacc=pB0[0]+pB0[1]; _Pragma("unroll") for(int r=2;r<16;++r)sacc+=pB0[r]; _Pragma("unroll") for(int r=0;r<16;++r)sacc+=pB1[r]; l_reg+=sacc;
    pw0=(u32x4){PKW(pB0,0),PKW(pB0,2),PKW(pB0,4),PKW(pB0,6)};pw1=(u32x4){PKW(pB0,8),PKW(pB0,10),PKW(pB0,12),PKW(pB0,14)};pw2=(u32x4){PKW(pB1,0),PKW(pB1,2),PKW(pB1,4),PKW(pB1,6)};pw3=(u32x4){PKW(pB1,8),PKW(pB1,10),PKW(pB1,12),PKW(pB1,14)};
    SBAR(); pv(o,vb0+sl_cur,PAF(0),PAF(1),PAF(2),PAF(3)); }
  #undef PKW
  #undef PAF
  #undef VFR
  #undef PIN
  #undef MX3
  #undef GAPA
  #undef GAPB
  #undef EX
  #undef VRD
  #undef KRD
  #undef STEP
  #undef ENDW
  {auto rr=__builtin_amdgcn_permlane32_swap(__float_as_uint(l_reg),__float_as_uint(l_reg),false,false);l_reg=__uint_as_float(rr[0])+__uint_as_float(rr[1]);}
  if(hi==0)wsf[32+r32]=l_reg;asm volatile("s_waitcnt lgkmcnt(0)":::"memory");
  float rli[16];
  #pragma unroll
  for(int r=0;r<16;++r)rli[r]=__builtin_amdgcn_rcpf(wsf[32+crow(r,hi)]);
  bf16*Ow=Ou+(long)(wid*QBLK)*OP;
  { bf16*stg=(bf16*)(shm+LDS_OST)+wid*2048;
    #pragma unroll
    for(int r=0;r<16;++r){const int orow=crow(r,hi);
      #pragma unroll
      for(int d0=0;d0<2;++d0)stg[orow*64+d0*32+r32]=__float2bfloat16(o[d0][r]*rli[r]);}
    asm volatile("s_waitcnt lgkmcnt(0)":::"memory");
    #pragma unroll
    for(int i=0;i<4;++i){const int row=i*8+(lane>>3),ch=lane&7; const u32x4 v=*(const u32x4*)(stg+row*64+ch*8); ATTN_STORE16(Ow+(long)row*OP+ch*8,v);} }
  asm volatile("s_waitcnt lgkmcnt(0)\n\ts_barrier":::"memory");
  #undef DMA_K
  #undef DMA_V
  #undef CMASK
  #undef START
  #undef RESC
  #undef ROT
}
constexpr int ATTN_LDS_BYTES=LDS_BYTES;
constexpr int LDS_QW=LDS_BYTES;
template<int THRL=8> __device__ __forceinline__ void attn_phase(char*lds,const bf16*proj,bf16*od,unsigned*qctr,const unsigned*nrm){
  const int tid=threadIdx.x;
  volatile __attribute__((address_space(3))) unsigned* qw=(volatile __attribute__((address_space(3))) unsigned*)((__attribute__((address_space(3))) char*)lds+LDS_QW);
  unsigned mine=0; if(tid==0) mine=__hip_atomic_fetch_add(qctr,1u,__ATOMIC_RELAXED,__HIP_MEMORY_SCOPE_AGENT);
  for(;;){
    if(tid==0) qw[0]=mine;
    __syncthreads();
    const int u=(int)__builtin_amdgcn_readfirstlane(qw[0]);
    if(u>=1024) break;
    if(tid==0) mine=__hip_atomic_fetch_add(qctr,1u,__ATOMIC_RELAXED,__HIP_MEMORY_SCOPE_AGENT);
    const int h=3-(u>>8), r=u&255, pass=r>>6, map=pass>>1, vh=pass&1, b=(r>>5)&1, qb=r&31;
    const float sl2=__builtin_amdgcn_exp2f(-2.f*(float)(h+1))*1.4426950408889634f;
    const unsigned* nq=nrm+((b*16+2*h+map)*2), *nk=nrm+((b*16+8+2*h+map)*2);
    const float qn=__builtin_sqrtf(__uint_as_float(nq[0])+__uint_as_float(nq[1])), kn=__builtin_sqrtf(__uint_as_float(nk[0])+__uint_as_float(nk[1]));
    const float R=(2.f*qn*kn+48.f)/sl2; const int q0=qb*QB;
    int t_lo=(int)__builtin_fmaxf(__builtin_floorf(((float)q0-R)*(1.f/64.f)),0.f), t_hi=(int)__builtin_fminf(__builtin_floorf(((float)(q0+QB-1)+R)*(1.f/64.f)),(float)(SEQ/KVBLK-1));
    if(((t_hi-t_lo+1)&1)!=0){ if(t_lo>0)--t_lo; else ++t_hi; }
    const int nt=t_hi-t_lo+1; const long row0=(long)b*SEQ, krow=row0+(long)t_lo*KVBLK;
    attn_unit<0,512,THRL>(proj+(row0+q0)*QP+h*128+map*64, proj+krow*KP+512+h*128+map*64, proj+krow*KP+1024+h*128+vh*64,
                    od+((long)map*(2*SEQ)+row0+q0)*512+h*128+vh*64, q0-t_lo*KVBLK, 0, nt, -sl2, lds);
  }
}
template<int THRL=8> __device__ __forceinline__ void nat_phase(char*lds,const bf16*proj,bf16*concat,const float*rpb,int vcu,int G){
  const int tid=threadIdx.x;
  for(int id=vcu*2;id<512;id+=2*G) for(int j=0;j<2;++j){
    const int u=id+j,h=u&7,rb=u>>3,b=rb>>5,r0=(rb&31)*4;
    const int lo=min(max(r0-4,0),120), hi_=min(max(r0-1,0),120)+7; int nt=hi_-lo+1; nt+=nt&1;
    const long row0=(long)b*SEQ;
    __attribute__((address_space(3))) float* tb=(__attribute__((address_space(3))) float*)((__attribute__((address_space(3))) char*)lds+LDS_TB);
    if(tid<15*31) tb[tid]=rpb[h*15*31+tid]*1.4426950408889634f;
    attn_unit<1,1024,THRL>(proj+(row0+r0*64)*QP+1536+h*64, proj+(row0+lo*64)*KP+2048+h*64, proj+(row0+lo*64)*KP+2560+h*64,
                    concat+(row0+r0*64)*1024+512+h*64, r0, lo, nt, 0.f, lds); }
}
#undef SBAR
#undef WAIT_BAR
}
#define XB_TMO      128
#define XB_XCNT(j)  (256  + 64 * (j))
#define XB_XSUB(j)  (1280 + 64 * (j))
#define XB_XGEN(j)  (2304 + 64 * (j))
#define XB_TOP      3328
#define XB_TOPGEN   3392
#define XCD_BAR_WORDS 3456
#define XB_SPIN_CAP (1u << 18)

__device__ __forceinline__ unsigned xb_ld(unsigned* p)              { return __hip_atomic_load(p, __ATOMIC_RELAXED, __HIP_MEMORY_SCOPE_AGENT); }
__device__ __forceinline__ unsigned xb_add(unsigned* p, unsigned v) { return __hip_atomic_fetch_add(p, v, __ATOMIC_RELAXED, __HIP_MEMORY_SCOPE_AGENT); }
__device__ __forceinline__ unsigned xb_xcc_id() { return (unsigned)__builtin_amdgcn_s_getreg((3 << 11) | 20) & 0xFu; }
#define XB_SPIN(cond, bar) do { unsigned _sp = 0; while (cond) { __builtin_amdgcn_s_sleep(1); \
    if ((++_sp & 255u) == 0u) { if (xb_ld(&(bar)[XB_TMO])) break; if (_sp > XB_SPIN_CAP) { atomicAdd(&(bar)[XB_TMO], 1u); break; } } } } while (0)

struct XcdBarrier {
    unsigned* bar; unsigned x;
    volatile LAS unsigned* st;
};

__device__ __forceinline__ XcdBarrier xcd_barrier_post(unsigned* bar, volatile LAS unsigned* st) {
    XcdBarrier b; b.bar = bar; b.x = xb_xcc_id(); b.st = st;
    if (threadIdx.x == 0) (void)xb_add(&bar[XB_XCNT(b.x)], 1u);
    return b;
}
__device__ __forceinline__ void xcd_barrier_complete(unsigned* bar, unsigned x, unsigned& nloc, unsigned& nx) {
    const unsigned G = gridDim.x * gridDim.y * gridDim.z;
    unsigned sum, cnt, mine, sp = 0u;
    for (;;) {
        sum = 0u; cnt = 0u; mine = 0u;
#pragma unroll
        for (unsigned j = 0; j < 16; ++j) { const unsigned c = xb_ld(&bar[XB_XCNT(j)]); sum += c; cnt += (c > 0u) ? 1u : 0u; mine = (j == x) ? c : mine; }
        if (sum == G) break;
        __builtin_amdgcn_s_sleep(1);
        if ((++sp & 255u) == 0u) { if (xb_ld(&bar[XB_TMO])) break; if (sp > XB_SPIN_CAP) { atomicAdd(&bar[XB_TMO], 1u); break; } }
    }
    nloc = mine > 0u ? mine : 1u; nx = cnt > 0u ? cnt : 1u;
}

__device__ __forceinline__ void xcd_barrier(const XcdBarrier& b) {
    asm volatile("s_waitcnt vmcnt(0)" ::: "memory");
    __syncthreads();
    if (threadIdx.x == 0) {
        unsigned* bar = b.bar;
        __builtin_amdgcn_s_waitcnt(0);
        unsigned nloc = b.st[0], nx = b.st[1];
        if (nloc == 0u) { xcd_barrier_complete(bar, b.x, nloc, nx); b.st[0] = nloc; b.st[1] = nx; }
        const unsigned old = xb_add(&bar[XB_XSUB(b.x)], 1u);
        const unsigned gen = old / nloc;
        if (old + 1u == (gen + 1u) * nloc) {
            __builtin_amdgcn_fence(__ATOMIC_RELEASE, "agent");
            asm volatile("s_waitcnt vmcnt(0)" ::: "memory");
            const unsigned og = xb_add(&bar[XB_TOP], 1u);
            const unsigned tg = og / nx;
            if (og + 1u == (tg + 1u) * nx) xb_add(&bar[XB_TOPGEN], 1u);
            else XB_SPIN(xb_ld(&bar[XB_TOPGEN]) == tg, bar);
            __builtin_amdgcn_fence(__ATOMIC_ACQUIRE, "agent");
            xb_add(&bar[XB_XGEN(b.x)], 1u);
            asm volatile("s_waitcnt vmcnt(0)" ::: "memory");
        } else {
            XB_SPIN(xb_ld(&bar[XB_XGEN(b.x)]) == gen, bar);
            __builtin_amdgcn_fence(__ATOMIC_ACQUIRE, "agent");
            asm volatile("s_waitcnt vmcnt(0)" ::: "memory");
        }
    }
    __syncthreads();
}
__device__ __forceinline__ float wave_sum(float v) {
#pragma unroll
    for (int o = 1; o < 64; o <<= 1) v += __shfl_xor(v, o);
    return v;
}
__device__ __forceinline__ void p0_transpose_item(const float* W, int K, int N, bf16* WT, int row_off, LAS float* scr, int item, int lane) {
    const int nblk = N / 32, kb = item / nblk, nb = item % nblk, k0 = 64 * kb, n0 = 32 * nb;
#pragma unroll 8
    for (int i = 0; i < 32; ++i) { const int kk = 2 * i + (lane >> 5); scr[kk * 33 + (lane & 31)] = W[(size_t)(k0 + kk) * N + n0 + (lane & 31)]; }
    LDS_WAIT(); asm volatile("" ::: "memory");
    const int c = lane & 7;
#pragma unroll
    for (int j = 0; j < 4; ++j) { const int n = (lane >> 3) + 8 * j; const LAS float* s = scr + (8 * c) * 33 + n;
        v4u o; o.x = pk2(s[0 * 33], s[1 * 33]); o.y = pk2(s[2 * 33], s[3 * 33]); o.z = pk2(s[4 * 33], s[5 * 33]); o.w = pk2(s[6 * 33], s[7 * 33]);
        *(GAS v4u*)(WT + (size_t)(row_off + n0 + n) * K + k0 + 8 * c) = o; }
    LDS_WAIT(); asm volatile("" ::: "memory");
}
struct Params { const float* in[22]; float* out; unsigned char* ws; };

__device__ __forceinline__ float mod_val(const float* __restrict__ modp, const float* __restrict__ b_ada, int b, int j) {
    return b_ada[j] + ((modp[(0 * 2 + b) * 6144 + j] + modp[(1 * 2 + b) * 6144 + j]) + (modp[(2 * 2 + b) * 6144 + j] + modp[(3 * 2 + b) * 6144 + j]));
}

__device__ __forceinline__ int opaque_v(int i) { asm volatile("" : "+v"(i)); return i; }
__device__ __forceinline__ int opaque_i(int i) { asm volatile("" : "+s"(i)); return i; }
__device__ __forceinline__ unsigned char* launder_ws(unsigned char* p) { asm volatile("" : "+s"(p)); return p; }
__global__ void __launch_bounds__(NTHR, 2) mk_fwd(Params P) {
    extern __shared__ __attribute__((aligned(16))) unsigned char lds_raw[];
    LAS unsigned char* lds = (LAS unsigned char*)lds_raw;
    const int tid0 = threadIdx.x, wave = __builtin_amdgcn_readfirstlane(tid0 >> 6);
#define PH_TID const int tid = opaque_v(tid0), lane = tid & 63; (void)lane
    const int G = gridDim.x, bx = blockIdx.x, vcu = (G % 8 == 0) ? (bx % 8) * (G / 8) + bx / 8 : bx;
    const int gw = vcu * NWAVES + wave, NGW = G * NWAVES;
    unsigned char* const ws0 = P.ws;
#define WSP(name, type, off) type* name = (type*)(launder_ws(ws0) + (off))
#define INP(name, i) const float* name = P.in[opaque_i(i)]
    LAS int* tab = (LAS int*)(lds + TAB_OFF);

    for (int u = tid0; u < (LDS_BYTES - LDSCTL_OFF) / 4; u += NTHR) ((LAS unsigned*)(lds + LDSCTL_OFF))[u] = 0u;
    __syncthreads();
    XcdBarrier bar = xcd_barrier_post((unsigned*)((gu32*)(ws0 + WS_CTL) + CW_BAR), (volatile LAS unsigned*)(lds + MISC_OFF) + 8);

    if (bx < 48) {
        PH_TID;
        INP(cvec, 1); INP(w_ada, 2); WSP(modp, float, WS_MODP);
        LAS float* sl = (LAS float*)lds;
        for (int i = tid; i < 2048; i += NTHR) { const float c0 = cvec[i]; sl[i] = c0 / (1.f + __expf(-c0)); }
        __syncthreads();
        for (int it = bx; it < 48; it += G) {
            const int j = (it % 12) * 512 + tid, kq = it / 12; float a0 = 0.f, a1 = 0.f;
#pragma unroll 8
            for (int k = kq * 256; k < kq * 256 + 256; ++k) { const float w = w_ada[(size_t)k * 6144 + j]; a0 += sl[k] * w; a1 += sl[1024 + k] * w; }
            modp[(kq * 2 + 0) * 6144 + j] = a0; modp[(kq * 2 + 1) * 6144 + j] = a1;
        }
        __syncthreads();
    }
    for (int rep_ = 0; rep_ <= DUP_P0; ++rep_) {
        LAS float* scr = (LAS float*)(lds + RING_OFF + wave * 16384);
        PH_TID;
        INP(w_in, 6); INP(w_out, 7); INP(w1, 18); INP(w2, 20); WSP(win_t, bf16, WS_WIN); WSP(wout_t, bf16, WS_WOUT); WSP(w1_t, bf16, WS_W1T); WSP(w2_t, bf16, WS_W2T);
        constexpr int I_IN = 16 * 96, I_OUT = 16 * 32, I_W1 = 16 * 64, I_W2 = 16 * 32;
        constexpr int NITEMS = I_IN + I_OUT + NE * (I_W1 + I_W2);
        for (int it = gw; it < NITEMS; it += NGW) {
            int r = it;
            if (r < I_IN) { p0_transpose_item(w_in, D, NPROJ, win_t, 0, scr, r, lane); continue; } r -= I_IN;
            if (r < I_OUT) { p0_transpose_item(w_out, D, D, wout_t, 0, scr, r, lane); continue; } r -= I_OUT;
            if (r < NE * I_W1) { const int e = r / I_W1; p0_transpose_item(w1 + (size_t)e * D * 2048, D, 2048, w1_t, e * 2048, scr, r % I_W1, lane); continue; } r -= NE * I_W1;
            { const int e = r / I_W2; p0_transpose_item(w2 + (size_t)e * FF * D, FF, D, w2_t, e * 1024, scr, r % I_W2, lane); }
        }
    }
    xcd_barrier(bar);

    {
        LAS float* mv = (LAS float*)lds;
        PH_TID;
        INP(x, 0); INP(b_ada, 3); INP(g_pre_mix, 4); WSP(modp, float, WS_MODP); WSP(xn, bf16, WS_XN);
        for (int i = tid; i < 4096; i += NTHR) mv[i] = mod_val(modp, b_ada, i >> 11, i & 2047);
        { WSP(modd, float, WS_MOD); for (int i = vcu * NTHR + tid; i < 2 * 6144; i += G * NTHR) modd[i] = mod_val(modp, b_ada, i / 6144, i % 6144); }
        __syncthreads();
        for (int row = gw; row < M; row += NGW) {
            const int b = row / SEQ; const float* xr = x + (size_t)row * D; const LAS float* sh = mv + b * 2048; const LAS float* sc = sh + 1024;
            f32x4 v[4]; float ss = 0.f;
#pragma unroll
            for (int i = 0; i < 4; ++i) { v[i] = *(const f32x4*)(xr + i * 256 + lane * 4); ss += v[i].x * v[i].x + v[i].y * v[i].y + v[i].z * v[i].z + v[i].w * v[i].w; }
            const float rstd = rsqrtf(wave_sum(ss) * (1.f / D) + RMS_EPS);
#pragma unroll
            for (int i = 0; i < 4; ++i) { const int c0 = i * 256 + lane * 4; float o[4];
#pragma unroll
                for (int e = 0; e < 4; ++e) o[e] = v[i][e] * rstd * g_pre_mix[c0 + e] * (1.f + sc[c0 + e]) + sh[c0 + e];
                uint2 w; w.x = pk2(o[0], o[1]); w.y = pk2(o[2], o[3]); *(uint2*)(xn + (size_t)row * D + c0) = w; }
        }
        __syncthreads();
    }
    xcd_barrier(bar);

    {
        WSP(xn, bf16, WS_XN); WSP(win_t, bf16, WS_WIN); WSP(proj, bf16, WS_PROJ);
        pg8::Gemm g{xn, win_t, M, NPROJ, D}; pg8::StaticOrder S; S.init(M, NPROJ, G, bx);
        pg8::EpiStoreBf16 E{proj, NPROJ, 512, attn_body::C2, 1536, 2048, (unsigned*)((gu32*)(launder_ws(ws0) + WS_CTL) + CW_NRM)};
        pg8::gemm_phase<pg8::EpiStoreBf16, pg8::StaticOrder, true, true>(lds + RING_OFF, g, S, E);
    }
    xcd_barrier(bar);

    for (int rep_ = 0; rep_ <= DUP_ATT; ++rep_) {
        WSP(proj, bf16, WS_PROJ); WSP(od, bf16, WS_ODIFF);
        gu32* ctl = (gu32*)(launder_ws(ws0) + WS_CTL);
        attn_body::attn_phase<8>((char*)lds_raw, (const attn_body::bf16*)proj, (attn_body::bf16*)od, (unsigned*)(ctl + CW_ATTQ) + 64 * rep_, (const unsigned*)(ctl + CW_NRM));
    }
    for (int rep_ = 0; rep_ <= DUP_NAT; ++rep_) {
        INP(rpb, 13); WSP(proj, bf16, WS_PROJ); WSP(concat, bf16, WS_CONCAT);
        attn_body::nat_phase<8>((char*)lds_raw, (const attn_body::bf16*)proj, (attn_body::bf16*)concat, rpb, vcu, G);
    }
    xcd_barrier(bar);

    {
        PH_TID;
        INP(lq1, 8); INP(lk1, 9); INP(lq2, 10); INP(lk2, 11); INP(g_sub, 12); WSP(od, bf16, WS_ODIFF); WSP(concat, bf16, WS_CONCAT);
        float s1 = 0.f, s2 = 0.f;
        for (int i = 0; i < 64; ++i) { s1 += lq1[i] * lk1[i]; s2 += lq2[i] * lk2[i]; }
        const float lam_init = 0.2f, lam = __expf(s1) - __expf(s2) + lam_init;
        for (int row = gw; row < M; row += NGW) {
            const int c0 = lane * 8;
            const v4u a = *(const v4u*)(od + (size_t)row * 512 + c0), bq = *(const v4u*)(od + ((size_t)M + row) * 512 + c0);
            float v[8]; float ss = 0.f;
#pragma unroll
            for (int e = 0; e < 4; ++e) { v[2 * e] = __uint_as_float(a[e] << 16) - lam * __uint_as_float(bq[e] << 16); v[2 * e + 1] = __uint_as_float(a[e] & 0xffff0000u) - lam * __uint_as_float(bq[e] & 0xffff0000u); }
#pragma unroll
            for (int e = 0; e < 8; ++e) ss += v[e] * v[e];
            ss += __shfl_xor(ss, 1); ss += __shfl_xor(ss, 2); ss += __shfl_xor(ss, 4); ss += __shfl_xor(ss, 8);
            const float rstd = rsqrtf(ss * (1.f / 128.f) + RMS_EPS); v4u w;
#pragma unroll
            for (int e = 0; e < 4; ++e) w[e] = pk2(v[2 * e] * rstd * g_sub[(c0 + 2 * e) & 127] * (1.f - lam_init), v[2 * e + 1] * rstd * g_sub[(c0 + 2 * e + 1) & 127] * (1.f - lam_init));
            *(v4u*)(concat + (size_t)row * D + c0) = w;
        }
    }
    xcd_barrier(bar);

    {
        WSP(concat, bf16, WS_CONCAT); WSP(wout_t, bf16, WS_WOUT); WSP(mix, float, WS_MIX);
        pg8::Gemm g{concat, wout_t, M, D, D}; pg8::StaticOrder S; S.init(M, D, G, bx);
        pg8::EpiStoreF32 E{mix, D};
        pg8::gemm_phase<pg8::EpiStoreF32, pg8::StaticOrder, true, true>(lds + RING_OFF, g, S, E);
    }
    xcd_barrier(bar);

    for (int rep_ = 0; rep_ <= DUP_P6; ++rep_) {
        PH_TID;
        INP(x, 0); INP(g_post_mix, 5); INP(g_pre_ffn, 14); INP(w_router, 16); INP(b_router, 17);
        WSP(modd, float, WS_MOD); WSP(mix, float, WS_MIX); WSP(x1, float, WS_X1); WSP(h2, bf16, WS_H2); WSP(topi, int, WS_TOPI); WSP(gate, float, WS_GATE); WSP(hist, int, WS_HIST);
        LAS float* wt = (LAS float*)lds;
        LAS int* ltop = (LAS int*)(lds + LDSCTL_OFF + 4096);
        for (int i = tid; i < 8192; i += NTHR) { const f32x4 w = *(const f32x4*)(w_router + (size_t)i * 4); const int k = i >> 3, e0 = (i & 7) * 4;
            wt[(e0 + 0) * 1024 + k] = w.x; wt[(e0 + 1) * 1024 + k] = w.y; wt[(e0 + 2) * 1024 + k] = w.z; wt[(e0 + 3) * 1024 + k] = w.w; }
        __syncthreads();
        const int my_e = (lane >> 1) & 31; const float my_b = b_router[my_e];
        for (int ch = bx; ch < NCHUNK; ch += G) {
            for (int i8 = 0; i8 < 8; ++i8) {
                const int row = ch * 64 + wave * 8 + i8, b = row / SEQ;
                const float* gt1 = modd + b * 6144 + 2048; const float* sh2 = gt1 + 1024; const float* sc2 = gt1 + 2048;
                f32x4 mvv[4], xv[4]; float ss = 0.f;
#pragma unroll
                for (int i = 0; i < 4; ++i) { mvv[i] = *(const f32x4*)(mix + (size_t)row * D + i * 256 + lane * 4); xv[i] = *(const f32x4*)(x + (size_t)row * D + i * 256 + lane * 4);
                    ss += mvv[i].x * mvv[i].x + mvv[i].y * mvv[i].y + mvv[i].z * mvv[i].z + mvv[i].w * mvv[i].w; }
                float rstd = rsqrtf(wave_sum(ss) * (1.f / D) + RMS_EPS); ss = 0.f;
#pragma unroll
                for (int i = 0; i < 4; ++i) { const int c0 = i * 256 + lane * 4; const f32x4 gg = *(const f32x4*)(gt1 + c0), gp = *(const f32x4*)(g_post_mix + c0);
#pragma unroll
                    for (int e = 0; e < 4; ++e) { xv[i][e] = xv[i][e] + gg[e] * (mvv[i][e] * rstd * gp[e]); ss += xv[i][e] * xv[i][e]; }
                    *(f32x4*)(x1 + (size_t)row * D + c0) = xv[i]; }
                rstd = rsqrtf(wave_sum(ss) * (1.f / D) + RMS_EPS);
                float lg[32];
#pragma unroll
                for (int e = 0; e < 32; ++e) lg[e] = 0.f;
#pragma unroll
                for (int i = 0; i < 4; ++i) { const int c0 = i * 256 + lane * 4; const f32x4 gf = *(const f32x4*)(g_pre_ffn + c0), s2 = *(const f32x4*)(sc2 + c0), h2s = *(const f32x4*)(sh2 + c0); float hv[4];
#pragma unroll
                    for (int j = 0; j < 4; ++j) hv[j] = xv[i][j] * rstd * gf[j] * (1.f + s2[j]) + h2s[j];
                    uint2 w; w.x = pk2(hv[0], hv[1]); w.y = pk2(hv[2], hv[3]); *(uint2*)(h2 + (size_t)row * D + c0) = w;
#pragma unroll
                    for (int e = 0; e < 32; ++e) { const f32x4 wv = *(const LAS f32x4*)(wt + e * 1024 + c0); lg[e] += (hv[0] * wv.x + hv[1] * wv.y) + (hv[2] * wv.z + hv[3] * wv.w); } }
                { const bool b5 = lane & 32, b4 = lane & 16, b3 = lane & 8, b2 = lane & 4, b1 = lane & 2;
#pragma unroll
                  for (int e = 0; e < 16; ++e) { const float keep = b5 ? lg[e + 16] : lg[e], send = b5 ? lg[e] : lg[e + 16]; lg[e] = keep + __shfl_xor(send, 32); }
#pragma unroll
                  for (int e = 0; e < 8; ++e) { const float keep = b4 ? lg[e + 8] : lg[e], send = b4 ? lg[e] : lg[e + 8]; lg[e] = keep + __shfl_xor(send, 16); }
#pragma unroll
                  for (int e = 0; e < 4; ++e) { const float keep = b3 ? lg[e + 4] : lg[e], send = b3 ? lg[e] : lg[e + 4]; lg[e] = keep + __shfl_xor(send, 8); }
#pragma unroll
                  for (int e = 0; e < 2; ++e) { const float keep = b2 ? lg[e + 2] : lg[e], send = b2 ? lg[e] : lg[e + 2]; lg[e] = keep + __shfl_xor(send, 4); }
                  { const float keep = b1 ? lg[1] : lg[0], send = b1 ? lg[0] : lg[1]; lg[0] = keep + __shfl_xor(send, 2); }
                  lg[0] += __shfl_xor(lg[0], 1); }
                float cur = lg[0] + my_b; float tv[4]; int ti[4];
#pragma unroll
                for (int p = 0; p < 4; ++p) { float bv = cur; int bi = my_e;
#pragma unroll
                    for (int o = 1; o < 64; o <<= 1) { const float ov = __shfl_xor(bv, o); const int oi = __shfl_xor(bi, o); const bool take = (ov > bv) || (ov == bv && oi < bi); bv = take ? ov : bv; bi = take ? oi : bi; }
                    tv[p] = bv; ti[p] = bi; cur = (my_e == bi) ? -INFINITY : cur; }
                if (lane == 0) { const float e1 = __expf(tv[1] - tv[0]), e2 = __expf(tv[2] - tv[0]), e3 = __expf(tv[3] - tv[0]); const float rs = 1.f / (1.f + e1 + e2 + e3);
                    *(int4*)(topi + row * 4) = make_int4(ti[0], ti[1], ti[2], ti[3]); *(f32x4*)(gate + row * 4) = (f32x4){rs, e1 * rs, e2 * rs, e3 * rs};
                    const int lr = (wave * 8 + i8) * 4; ltop[lr] = ti[0]; ltop[lr + 1] = ti[1]; ltop[lr + 2] = ti[2]; ltop[lr + 3] = ti[3]; }
            }
            __syncthreads();
            if (tid < 32) { int cnt = 0; for (int i = 0; i < 256; ++i) cnt += (ltop[i] == tid) ? 1 : 0; hist[ch * 32 + tid] = cnt; }
            __syncthreads();
        }
    }
    xcd_barrier(bar);

    for (int rep_ = 0; rep_ <= DUP_P7; ++rep_) {
        LAS int* le = (LAS int*)(lds + 4096); LAS int* ld = (LAS int*)(lds + 8192);
        PH_TID;
        WSP(hist, int, WS_HIST); WSP(topi, int, WS_TOPI); WSP(dest, int, WS_DEST); WSP(h2, bf16, WS_H2); WSP(xbuf, bf16, WS_XBUF); gu32* ctl = (gu32*)(launder_ws(ws0) + WS_CTL);
        for (int ch = bx; ch < NCHUNK; ch += G) {
            if (tid < 32) { int tot = 0, base = 0; for (int c2 = 0; c2 < NCHUNK; ++c2) { const int hv = hist[c2 * 32 + tid]; tot += hv; base += (c2 < ch) ? hv : 0; } tab[32 + tid] = base; tab[tid] = (tot + 255) & ~255; }
            if (tid < 256) le[tid] = topi[ch * 256 + tid];
            __syncthreads();
            if (tid == 0) { int off = 0; for (int e = 0; e < NE; ++e) { const int pad = tab[e]; tab[e] = off;
                    if (ch == 0) for (int tl = 0; tl < pad / 256; ++tl) ctl[CW_TILEEXP + off / 256 + tl] = (unsigned)e;
                    off += pad; }
                if (ch == 0) ctl[CW_TOTAL] = (unsigned)off; }
            __syncthreads();
            if (tid < 256) { const int e = le[tid]; int rank = 0; for (int i = 0; i < tid; ++i) rank += (le[i] == e) ? 1 : 0;
                const int dd = tab[e] + tab[32 + e] + rank; dest[ch * 256 + tid] = dd; ld[tid] = dd; }
            __syncthreads();
            for (int i = 0; i < 32; ++i) { const int a = wave * 32 + i; const int dd = ld[a]; const size_t tok = (size_t)(ch * 256 + a) >> 2;
                const v4u* src = (const v4u*)(h2 + tok * D); v4u* dst = (v4u*)(xbuf + (size_t)dd * D);
                const v4u a0 = src[lane], a1 = src[64 + lane]; dst[lane] = a0; dst[64 + lane] = a1; }
            __syncthreads();
        }
    }
    xcd_barrier(bar);

    {
        PH_TID;
        gu32* ctl = (gu32*)(launder_ws(ws0) + WS_CTL);
        for (int i = tid; i < MAXTILES; i += NTHR) tab[64 + i] = (int)ctl[CW_TILEEXP + i];
        if (tid == 0) tab[352] = (int)ctl[CW_TOTAL];
        __syncthreads();
        const int ntile = __builtin_amdgcn_readfirstlane(tab[352]) >> 8;
        for (int rep_ = 0; rep_ <= DUP_G1; ++rep_) {
            INP(b1, 19); WSP(xbuf, bf16, WS_XBUF); WSP(w1_t, bf16, WS_W1T); WSP(act, bf16, WS_ACT);
            pg8::Gemm g{xbuf, w1_t, CAP, 2048, D}; pg8::MoeOrder<8> S{ntile * 8, G, vcu, (const LAS int*)(tab + 64)};
            pg8::EpiSwiglu E{act, b1};
            pg8::gemm_phase<pg8::EpiSwiglu, pg8::MoeOrder<8>, true, true>(lds + RING_OFF, g, S, E);
        }
        xcd_barrier(bar);
        for (int rep_ = 0; rep_ <= DUP_G2; ++rep_) {
            INP(b2, 21); WSP(act, bf16, WS_ACT); WSP(w2_t, bf16, WS_W2T); WSP(ybuf, bf16, WS_YBUF);
            pg8::Gemm g{act, w2_t, CAP, 1024, FF}; pg8::MoeOrder<4> S{ntile * 4, G, vcu, (const LAS int*)(tab + 64)};
            pg8::EpiY E{ybuf, b2};
            pg8::gemm_phase<pg8::EpiY, pg8::MoeOrder<4>, true, true>(lds + RING_OFF, g, S, E);
        }
    }
    xcd_barrier(bar);

    for (int rep_ = 0; rep_ <= DUP_P10; ++rep_) {
        PH_TID;
        INP(g_post_ffn, 15); WSP(modd, float, WS_MOD); WSP(x1, float, WS_X1); WSP(ybuf, bf16, WS_YBUF); WSP(dest, int, WS_DEST); WSP(gate, float, WS_GATE); float* out = P.out;
        for (int row = gw; row < M; row += NGW) {
            const int b = row / SEQ; const float* gt2 = modd + b * 6144 + 5120;
            float f[16]; float ss = 0.f;
#pragma unroll
            for (int i = 0; i < 16; ++i) f[i] = 0.f;
            const int4 dd = *(const int4*)(dest + row * 4); const f32x4 gg = *(const f32x4*)(gate + row * 4);
            const int dda[4] = {dd.x, dd.y, dd.z, dd.w};
#pragma unroll
            for (int p = 0; p < 4; ++p) { const float gp = gg[p]; const bf16* yr = ybuf + (size_t)dda[p] * D;
#pragma unroll
                for (int i = 0; i < 4; ++i) { const uint2 w = *(const uint2*)(yr + i * 256 + lane * 4);
                    f[i * 4] += gp * __uint_as_float(w.x << 16); f[i * 4 + 1] += gp * __uint_as_float(w.x & 0xffff0000u); f[i * 4 + 2] += gp * __uint_as_float(w.y << 16); f[i * 4 + 3] += gp * __uint_as_float(w.y & 0xffff0000u); } }
#pragma unroll
            for (int i = 0; i < 16; ++i) ss += f[i] * f[i];
            const float rstd = rsqrtf(wave_sum(ss) * (1.f / D) + RMS_EPS);
#pragma unroll
            for (int i = 0; i < 4; ++i) { const int c0 = i * 256 + lane * 4; const f32x4 xv = *(const f32x4*)(x1 + (size_t)row * D + c0); f32x4 ov;
#pragma unroll
                for (int e = 0; e < 4; ++e) ov[e] = xv[e] + gt2[c0 + e] * (f[i * 4 + e] * rstd * g_post_ffn[c0 + e]);
                *(f32x4*)(out + (size_t)row * D + c0) = ov; }
        }
    }
}

extern "C" void kernel_launch(void* const* d_in, const int* in_sizes, int n_in, void* d_out, int out_size, void* d_ws, size_t ws_size, hipStream_t stream) {
    static int grid = 0;
    if (grid == 0) {
        if (n_in != 22 || ws_size < WS_END) { fprintf(stderr, "kernel_launch: unexpected n_in %d / ws %zu\n", n_in, ws_size); grid = -1; return; }
        int dev = 0, cus = 0, per_cu = 0;
        if (hipGetDevice(&dev) != hipSuccess || hipDeviceGetAttribute(&cus, hipDeviceAttributeMultiprocessorCount, dev) != hipSuccess) { grid = -1; return; }
        if (hipFuncSetAttribute((const void*)mk_fwd, hipFuncAttributeMaxDynamicSharedMemorySize, LDS_BYTES) != hipSuccess) { fprintf(stderr, "kernel_launch: hipFuncSetAttribute failed\n"); grid = -1; return; }
        if (hipOccupancyMaxActiveBlocksPerMultiprocessor(&per_cu, (const void*)mk_fwd, NTHR, LDS_BYTES) != hipSuccess || per_cu < 1) { fprintf(stderr, "kernel_launch: occupancy query says %d\n", per_cu); }
        (void)hipGetLastError();
        grid = cus;
    }
    if (grid < 0) return;
    if (hipMemsetAsync((char*)d_ws + WS_CTL, 0, 1 * MiB, stream) != hipSuccess) return;
    Params p{};
    for (int i = 0; i < 22; ++i) p.in[i] = (const float*)d_in[i];
    p.out = (float*)d_out; p.ws = (unsigned char*)d_ws;
    hipLaunchKernelGGL(mk_fwd, dim3(grid), dim3(NTHR), LDS_BYTES, stream, p);
}
```

```cpp
#include <hip/hip_runtime.h>
#include <stdint.h>
#include <stdio.h>

#define GAS __attribute__((address_space(1)))
#define LAS __attribute__((address_space(3)))
typedef unsigned short bf16;
typedef unsigned v4u __attribute__((ext_vector_type(4)));
typedef float f32x4 __attribute__((ext_vector_type(4)));
typedef GAS unsigned gu32;
#define LDS_WAIT() asm volatile("s_waitcnt lgkmcnt(0)" ::: "memory")
#define VM_WAIT() asm volatile("s_waitcnt vmcnt(0)" ::: "memory")

#define DUP_P0 0
#define DUP_ATT 0
#define DUP_NAT 0
#define DUP_G1 0
#define DUP_G2 0
#define DUP_P2 0
#define DUP_P5 0
#define DUP_P1 0
#define DUP_P4 0
#define DUP_BAR 0
#define DUP_P6 0
#define DUP_P7 0
#define DUP_P10 0
constexpr int NB = 2, SEQ = 8192, D = 1024, M = NB * SEQ;
constexpr int NPROJ = 3072, NE = 32, TOPK = 4, FF = 1024;
constexpr int NASSIGN = M * TOPK;
constexpr int CAP = NASSIGN + NE * 256;
constexpr int MAXTILES = CAP / 256;
constexpr int NCHUNK = M / 64;
constexpr float RMS_EPS = 1e-6f;
constexpr int NWAVES = 8, NTHR = 512;

constexpr size_t MiB = 1u << 20;
constexpr size_t WS_CTL = 0;
constexpr size_t WS_MODP = 1 * MiB;
constexpr size_t WS_MOD = 1 * MiB + 512 * 1024;
constexpr size_t WS_HIST = 2 * MiB;
constexpr size_t WS_TOPI = 3 * MiB;
constexpr size_t WS_GATE = 3 * MiB + 512 * 1024;
constexpr size_t WS_DEST = 4 * MiB;
constexpr size_t WS_WIN = 6 * MiB;
constexpr size_t WS_WOUT = 12 * MiB;
constexpr size_t WS_XN = 16 * MiB;
constexpr size_t WS_PROJ = 48 * MiB;
constexpr size_t WS_ODIFF = 144 * MiB;
constexpr size_t WS_XBUF = 48 * MiB;
constexpr size_t WS_CONCAT = 208 * MiB;
constexpr size_t WS_MIX = 240 * MiB;
constexpr size_t WS_X1 = 304 * MiB;
constexpr size_t WS_H2 = 368 * MiB;
constexpr size_t WS_ACT = 400 * MiB;
constexpr size_t WS_YBUF = 544 * MiB;
constexpr size_t WS_W1T = 688 * MiB;
constexpr size_t WS_W2T = 816 * MiB;
constexpr size_t WS_KIMG = 880 * MiB;
constexpr size_t WS_VIMG = 896 * MiB;
constexpr size_t WS_END = 912 * MiB;
static_assert(WS_XBUF + (size_t)CAP * D * 2 <= WS_CONCAT, "XBUF overlay");
constexpr int CW_TOTAL = 64;
constexpr int CW_TILEEXP = 128;
constexpr int CW_NRM = 512;
constexpr int CW_ATTQ = 1024;
constexpr int CW_BAR = 4096;

constexpr int RING_OFF = 0, RING_BYTES = 131072;
constexpr int LDSCTL_OFF = RING_BYTES, MISC_OFF = LDSCTL_OFF + 320, TAB_OFF = LDSCTL_OFF + 1024;
constexpr int LDS_BYTES = 147456;

__device__ __forceinline__ float bf2f(bf16 v) { return __uint_as_float(((unsigned)v) << 16); }
__device__ __forceinline__ unsigned f2bf(float f) { unsigned u = __builtin_bit_cast(unsigned, f); return (u + 0x7fffu + ((u >> 16) & 1u)) >> 16; }
__device__ __forceinline__ unsigned pk2(float lo, float hi) { return f2bf(lo) | (f2bf(hi) << 16); }
namespace pg8 {
#define PG8_LAS __attribute__((address_space(3)))
typedef unsigned short bf16_t;
typedef short bf16x8 __attribute__((ext_vector_type(8)));
typedef float f32x4 __attribute__((ext_vector_type(4)));
typedef unsigned u32x4 __attribute__((ext_vector_type(4)));
constexpr int BM = 256, BK = 64, HALF = 128, HTB = HALF * BK * 2  , STAGE_BYTES = 8 * HTB, NXCD = 8, WGM = 8;

__host__ __device__ __forceinline__ int lds_byte(int r, int c) { const int st = (r >> 4) * 2 + (c >> 5), rr = r & 15, cc = c & 31, ob = rr * 64 + cc * 2; return st * 1024 + (ob ^ (((ob >> 9) & 1) << 5)); }
__host__ __device__ __forceinline__ void stage_rc(int b, int& R, int& C) { const int st = b / 1024, sb = b % 1024, swz = sb ^ (((sb >> 9) & 1) << 5); R = (st >> 1) * 16 + swz / 64; C = (st & 1) * 32 + (swz % 64) / 2; }
__host__ __device__ __forceinline__ int perm32(int rho) { const int n = rho >> 4, i = rho & 15; return 8 * (i >> 2) + 4 * n + (i & 3); }

struct Unit { int pm, pn; };
struct Gemm { const bf16_t* A; const bf16_t* Bt; int M, N, K; };

struct StaticOrder {
    int nM, nN, nwg, G, c;
    __host__ __device__ void init(int M, int N, int G_, int c_) { nM = M / BM; nN = N / BM; nwg = nM * nN; G = G_; c = c_; }
    __host__ __device__ bool next(int i, Unit& u) const {
        const long L = (long)i * G + c; if (L >= nwg) return false;
        int wgid = (int)L; { const int q = nwg / NXCD, r = nwg % NXCD, xcd = wgid % NXCD, off = wgid / NXCD; wgid = (xcd < r ? xcd * (q + 1) : r * (q + 1) + (xcd - r) * q) + off; }
        const int nig = WGM * nN, gid = wgid / nig, fm = gid * WGM, gsz = (nM - fm) < WGM ? (nM - fm) : WGM;
        u.pm = fm + ((wgid % nig) % gsz); u.pn = (wgid % nig) / gsz; return true;
    }
    __device__ __forceinline__ void a_ready(const Unit&) const {}
    __device__ __forceinline__ void done(const Unit&) const {}
};

__device__ __forceinline__ unsigned cvt_pk_bf16(float lo, float hi) { unsigned r; asm volatile("v_cvt_pk_bf16_f32 %0, %1, %2" : "=v"(r) : "v"(lo), "v"(hi)); return r; }
struct EpiStoreBf16 {
    static constexpr bool PERM = true, AFTER_DRAIN = false;
    bf16_t* O; int ldc; int scale_cols; float scale0; int s2lo, s2hi; unsigned* nrm; bf16_t* kimg; bf16_t* vimg;
    __device__ __forceinline__ void operator()(const f32x4 (&acc)[2][2][4][2], const Unit& u, int wr, int wc, int fr, int fq) const {
        const int row0 = u.pm * BM + wr * 64 + fr, colt = u.pn * BM, col0 = colt + wc * 32 + 8 * fq; const float sc = (colt < scale_cols || (colt >= s2lo && colt < s2hi)) ? scale0 : 1.f;
        const bool isk = (colt >= 512 && colt < 1024), isv = (colt >= 1024 && colt < 1536);
        float mx[2] = {0.f, 0.f};
#pragma unroll
        for (int ai = 0; ai < 2; ++ai)
#pragma unroll
            for (int m = 0; m < 4; ++m) { const int row = row0 + ai * HALF + m * 16; bf16_t* rowp = O + (size_t)row * ldc + col0;
                const int b = row >> 13, tile = (row & 8191) >> 6, rr = row & 63;
#pragma unroll
                for (int bj = 0; bj < 2; ++bj) { const f32x4 v0 = acc[ai][bj][m][0] * sc, v1 = acc[ai][bj][m][1] * sc;
                    u32x4 w; w.x = cvt_pk_bf16(v0[0], v0[1]); w.y = cvt_pk_bf16(v0[2], v0[3]); w.z = cvt_pk_bf16(v1[0], v1[1]); w.w = cvt_pk_bf16(v1[2], v1[3]);
                    if (isk) { const int c = col0 + bj * HALF - 512, hm = c >> 6, chunk = (c & 63) >> 3;
                        *(u32x4*)(kimg + ((size_t)((b * 8 + hm) * 128 + tile) * 4096 + chunk * 512 + rr * 8)) = w; }
                    else if (isv) { const int c = col0 + bj * HALF - 1024, h = c >> 7, e = c & 127;
                        *(u32x4*)(vimg + ((size_t)((b * 4 + h) * 128 + tile) * 8192 + (e >> 5) * 2048 + rr * 32 + (e & 31))) = w; }
                    else *(u32x4*)(rowp + bj * HALF) = w;
                    if (colt < 1024) { float s = 0.f;
#pragma unroll
                        for (int j = 0; j < 4; ++j) { const float lo = __uint_as_float(w[j] << 16), hi = __uint_as_float(w[j] & 0xffff0000u); s += lo * lo + hi * hi; }
                        s += __shfl_xor(s, 16); s += __shfl_xor(s, 32); mx[bj] = fmaxf(mx[bj], s); } } }
        if (colt < 1024) {
#pragma unroll
            for (int bj = 0; bj < 2; ++bj) { float v = mx[bj]; v = fmaxf(v, __shfl_xor(v, 1)); v = fmaxf(v, __shfl_xor(v, 2)); v = fmaxf(v, __shfl_xor(v, 4)); v = fmaxf(v, __shfl_xor(v, 8));
                if (fr == 0 && fq == 0) { const int g = (colt + bj * HALF + wc * 32) >> 6, b = u.pm >> 5; atomicMax(nrm + ((b * 16 + g) * 2 + (wc & 1)), __float_as_uint(v)); } }
        }
    }
};
struct EpiStoreF32 {
    static constexpr bool PERM = true, AFTER_DRAIN = false;
    float* O; int ldc;
    __device__ __forceinline__ void operator()(const f32x4 (&acc)[2][2][4][2], const Unit& u, int wr, int wc, int fr, int fq) const {
        const int row0 = u.pm * BM + wr * 64 + fr, col0 = u.pn * BM + wc * 32 + 8 * fq;
#pragma unroll
        for (int ai = 0; ai < 2; ++ai)
#pragma unroll
            for (int m = 0; m < 4; ++m) { float* rowp = O + (size_t)(row0 + ai * HALF + m * 16) * ldc + col0;
#pragma unroll
                for (int bj = 0; bj < 2; ++bj) { *(f32x4*)(rowp + bj * HALF) = acc[ai][bj][m][0]; *(f32x4*)(rowp + bj * HALF + 4) = acc[ai][bj][m][1]; } }
    }
};
struct EpiSwiglu {
    static constexpr bool PERM = true, AFTER_DRAIN = false;
    unsigned char* act; const float* b1;
    __device__ __forceinline__ void operator()(const f32x4 (&acc)[2][2][4][2], const Unit& u, int wr, int wc, int fr, int fq) const {
        const int e = u.pn >> 3, pnl = u.pn & 7, row0 = u.pm * BM + wr * 64 + fr, hc0 = pnl * BM + wc * 32 + 8 * fq;
        f32x4 bv[2][2];
#pragma unroll
        for (int bj = 0; bj < 2; ++bj)
#pragma unroll
            for (int n = 0; n < 2; ++n) bv[bj][n] = *(const f32x4*)(b1 + e * 2048 + hc0 + bj * HALF + 4 * n);
#pragma unroll
        for (int ai = 0; ai < 2; ++ai)
#pragma unroll
            for (int m = 0; m < 4; ++m) { unsigned char* rowp = act + (size_t)(row0 + ai * HALF + m * 16) * 1024 + (hc0 >> 1);
#pragma unroll
                for (int bj = 0; bj < 2; ++bj) { const f32x4 v0 = acc[ai][bj][m][0] + bv[bj][0], v1 = acc[ai][bj][m][1] + bv[bj][1];
                    float r[4];
                    const float gg[4] = {v0[0], v0[2], v1[0], v1[2]}, ll[4] = {v0[1], v0[3], v1[1], v1[3]};
#pragma unroll
                    for (int p = 0; p < 4; ++p) { float g = gg[p], l = ll[p];
                        g = fminf(g, 7.f); l = fminf(fmaxf(l, -7.f), 7.f);
                        r[p] = g * __builtin_amdgcn_rcpf(1.f + __expf(-1.702f * g)) * (l + 1.f); }
                    int w = 0; w = __builtin_amdgcn_cvt_pk_fp8_f32(r[0], r[1], w, false); w = __builtin_amdgcn_cvt_pk_fp8_f32(r[2], r[3], w, true);
                    *(int*)(rowp + bj * (HALF / 2)) = w; } }
    }
};
struct EpiY {
    static constexpr bool PERM = true, AFTER_DRAIN = false;
    bf16_t* y; const float* b2;
    __device__ __forceinline__ void operator()(const f32x4 (&acc)[2][2][4][2], const Unit& u, int wr, int wc, int fr, int fq) const {
        const int e = u.pn >> 2, pnl = u.pn & 3, row0 = u.pm * BM + wr * 64 + fr, col0 = pnl * BM + wc * 32 + 8 * fq;
        f32x4 bv[2][2];
#pragma unroll
        for (int bj = 0; bj < 2; ++bj)
#pragma unroll
            for (int n = 0; n < 2; ++n) bv[bj][n] = *(const f32x4*)(b2 + e * 1024 + col0 + bj * HALF + 4 * n);
#pragma unroll
        for (int ai = 0; ai < 2; ++ai)
#pragma unroll
            for (int m = 0; m < 4; ++m) { bf16_t* rowp = y + (size_t)(row0 + ai * HALF + m * 16) * 1024 + col0;
#pragma unroll
                for (int bj = 0; bj < 2; ++bj) { const f32x4 v0 = acc[ai][bj][m][0] + bv[bj][0], v1 = acc[ai][bj][m][1] + bv[bj][1];
                    u32x4 w; w.x = cvt_pk_bf16(v0[0], v0[1]); w.y = cvt_pk_bf16(v0[2], v0[3]); w.z = cvt_pk_bf16(v1[0], v1[1]); w.w = cvt_pk_bf16(v1[2], v1[3]);
                    *(u32x4*)(rowp + bj * HALF) = w; } }
    }
};
template <int NN> struct MoeOrder {
    int nunit, G, c; const PG8_LAS int* texp;
    __device__ __forceinline__ bool next(int i, Unit& u) const {
        const int L = i * G + c; if (L >= nunit) return false;
        const int pm = L / NN, pnl = L % NN; u.pm = pm; u.pn = __builtin_amdgcn_readfirstlane(texp[pm]) * NN + pnl; return true;
    }
    __device__ __forceinline__ void a_ready(const Unit&) const {}
    __device__ __forceinline__ void done(const Unit&) const {}
};
typedef int i32x4_t __attribute__((ext_vector_type(4))); typedef int i32x8_t __attribute__((ext_vector_type(8)));
__device__ __forceinline__ void pg8_glds16(const void* sbase, unsigned voff, unsigned lds_dst) { unsigned keep;
    asm volatile("s_mov_b32 %0, m0\n\ts_mov_b32 m0, %3\n\ts_nop 0\n\tglobal_load_lds_dwordx4 %1, %2\n\ts_mov_b32 m0, %0" : "=&s"(keep) : "v"(voff), "s"(sbase), "s"(lds_dst) : "memory"); }
template <class Epi, class Sched, bool ALIGN_EPI = false, bool SP2 = false, bool FP8 = false>
__device__ __forceinline__ void gemm_phase(PG8_LAS unsigned char* lds, const Gemm g, const Sched& S, const Epi& E) {
    int tid_ = threadIdx.x; asm volatile("" : "+v"(tid_));
    const int tid = tid_, wid = __builtin_amdgcn_readfirstlane(tid >> 6), lane = tid & 63, wr = wid >> 2, wc = wid & 3, fr = lane & 15, fq = lane >> 4;
    const int K = g.K, KB = FP8 ? K : 2 * K, nt = KB / (BK * 2);
    unsigned voffA[2], voffB[2];
#pragma unroll
    for (int i = 0; i < 2; ++i) { int R, C; stage_rc(tid * 16 + i * 8192, R, C); const int Rb = Epi::PERM ? ((R & ~31) + perm32(R & 31)) : R;
        voffA[i] = (unsigned)(R * KB + C * 2); voffB[i] = (unsigned)(Rb * KB + C * 2); }
    const size_t kstep = (size_t)(BK * 2);
    const size_t hstep = (size_t)HALF * KB;
    const size_t tstep = 2 * hstep;
    const unsigned ldsb = (unsigned)(uintptr_t)lds;
    const unsigned ldsw = (unsigned)wid * 1024u; const unsigned ldsbw = (unsigned)__builtin_amdgcn_readfirstlane(ldsb + ldsw);
    const int aoff = lds_byte(wr * 64 + fr, fq * 8), boff = lds_byte(wc * 32 + fr, fq * 8);
#define PG8_CAT(x, y) __builtin_shufflevector(__builtin_bit_cast(i32x4_t, x), __builtin_bit_cast(i32x4_t, y), 0, 1, 2, 3, 4, 5, 6, 7)
#define PG8_SA(b, h) (((b) * 2 + (h)) * HTB)
#define PG8_SB(b, h) ((4 + (b) * 2 + (h)) * HTB)
#define PG8_STAGE(bufoff, gbase, voff) do { _Pragma("unroll") for (int _i = 0; _i < 2; ++_i) \
        pg8_glds16((const void*)(gbase), (voff)[_i], ldsbw + (unsigned)((bufoff) + _i * 8192)); } while (0)
#define PG8_LDA(dst, b, h) do { if constexpr (FP8) { _Pragma("unroll") for (int m = 0; m < 4; ++m) dst##8[m] = PG8_CAT(*(const PG8_LAS bf16x8*)(lds + PG8_SA(b, h) + aoff + m * 2048), *(const PG8_LAS bf16x8*)(lds + PG8_SA(b, h) + aoff + m * 2048 + 1024)); } \
    else { _Pragma("unroll") for (int m = 0; m < 4; ++m) _Pragma("unroll") for (int k = 0; k < 2; ++k) dst[m][k] = *(const PG8_LAS bf16x8*)(lds + PG8_SA(b, h) + aoff + m * 2048 + k * 1024); } } while (0)
#define PG8_LDB(dst, b, h) do { if constexpr (FP8) { _Pragma("unroll") for (int n = 0; n < 2; ++n) dst##8[n] = PG8_CAT(*(const PG8_LAS bf16x8*)(lds + PG8_SB(b, h) + boff + n * 2048), *(const PG8_LAS bf16x8*)(lds + PG8_SB(b, h) + boff + n * 2048 + 1024)); } \
    else { _Pragma("unroll") for (int n = 0; n < 2; ++n) _Pragma("unroll") for (int k = 0; k < 2; ++k) dst[n][k] = *(const PG8_LAS bf16x8*)(lds + PG8_SB(b, h) + boff + n * 2048 + k * 1024); } } while (0)
#define PG8_MMA(ai, bj, At, Bt) do { __builtin_amdgcn_s_setprio(1); if constexpr (FP8) { _Pragma("unroll") for (int m = 0; m < 4; ++m) _Pragma("unroll") for (int n = 0; n < 2; ++n) \
        acc[ai][bj][m][n] = __builtin_amdgcn_mfma_scale_f32_16x16x128_f8f6f4(Bt##8[n], At##8[m], acc[ai][bj][m][n], 0, 0, 0, 0x7c7c7c7c, 0, 0x7c7c7c7c); } \
    else { _Pragma("unroll") for (int m = 0; m < 4; ++m) _Pragma("unroll") for (int n = 0; n < 2; ++n) _Pragma("unroll") for (int k = 0; k < 2; ++k) \
        acc[ai][bj][m][n] = __builtin_amdgcn_mfma_f32_16x16x32_bf16(Bt[n][k], At[m][k], acc[ai][bj][m][n], 0, 0, 0); } __builtin_amdgcn_s_setprio(0); } while (0)
#define PG8_WAIT_V(n) asm volatile("s_waitcnt vmcnt(" #n ")" ::: "memory")
#define PG8_WAIT_L(n) asm volatile("s_waitcnt lgkmcnt(" #n ")" ::: "memory")
#define PG8_BAR __builtin_amdgcn_s_barrier()
#define PG8_SCHED __builtin_amdgcn_sched_barrier(0)
    Unit cur, nxt; int ui = 0;
    if (!S.next(0, cur)) return;
    f32x4 acc[2][2][4][2];
#pragma unroll
    for (int a = 0; a < 2; ++a)
#pragma unroll
        for (int b = 0; b < 2; ++b)
#pragma unroll
            for (int m = 0; m < 4; ++m)
#pragma unroll
                for (int n = 0; n < 2; ++n) acc[a][b][m][n] = (f32x4){0.f, 0.f, 0.f, 0.f};
    bf16x8 At[4][2], B0[2][2], B1[2][2]; i32x8_t At8[4], B08[2], B18[2];
    const char* cA = (const char*)g.A + (size_t)cur.pm * tstep; const char* cB = (const char*)g.Bt + (size_t)cur.pn * tstep;
    S.a_ready(cur);
    if constexpr (SP2) {
        PG8_STAGE(PG8_SB(0, 0), cB, voffB); PG8_STAGE(PG8_SB(0, 1), cB + hstep, voffB); PG8_STAGE(PG8_SA(0, 0), cA, voffA); PG8_STAGE(PG8_SA(0, 1), cA + hstep, voffA);
        if (wr == 1) PG8_BAR;
        PG8_WAIT_V(2); PG8_BAR;
        PG8_STAGE(PG8_SB(1, 0), cB + kstep, voffB); PG8_STAGE(PG8_SA(1, 0), cA + kstep, voffA); PG8_STAGE(PG8_SB(1, 1), cB + hstep + kstep, voffB);
        PG8_WAIT_V(6); PG8_BAR;
    } else {
        PG8_STAGE(PG8_SB(0, 0), cB, voffB); PG8_STAGE(PG8_SA(0, 0), cA, voffA); PG8_STAGE(PG8_SB(0, 1), cB + hstep, voffB); PG8_STAGE(PG8_SA(0, 1), cA + hstep, voffA);
        if (wr == 1) PG8_BAR;
        PG8_WAIT_V(4); PG8_BAR;
        PG8_STAGE(PG8_SB(1, 0), cB + kstep, voffB); PG8_STAGE(PG8_SA(1, 0), cA + kstep, voffA); PG8_STAGE(PG8_SB(1, 1), cB + hstep + kstep, voffB);
        PG8_WAIT_V(6); PG8_BAR;
    }
    for (;;) {
        const bool has_next = S.next(ui + 1, nxt);
        const char* nA = has_next ? (const char*)g.A + (size_t)nxt.pm * tstep : cA; const char* nB = has_next ? (const char*)g.Bt + (size_t)nxt.pn * tstep : cB;
#pragma clang loop unroll(disable)
        for (int t = 0; t < nt; t += 2) {
            const bool last = (t == nt - 2);
            const char* a1 = cA + (size_t)(t + 1) * kstep;
            const char* a2 = last ? nA : cA + (size_t)(t + 2) * kstep; const char* b2 = last ? nB : cB + (size_t)(t + 2) * kstep;
            const char* a3 = a2 + kstep; const char* b3 = b2 + kstep;
            if (last && has_next) S.a_ready(nxt);
            if constexpr (SP2) {
            PG8_LDB(B0, 0, 0); PG8_LDB(B1, 0, 1); PG8_SCHED; PG8_LDA(At, 0, 0); PG8_STAGE(PG8_SA(1, 1), a1 + hstep, voffA);
            PG8_WAIT_V(8); PG8_WAIT_L(0); PG8_BAR; PG8_MMA(0, 0, At, B0); PG8_MMA(0, 1, At, B1); PG8_BAR; PG8_SCHED;
            PG8_LDA(At, 0, 1); PG8_STAGE(PG8_SB(0, 0), b2, voffB); PG8_STAGE(PG8_SB(0, 1), b2 + hstep, voffB); PG8_STAGE(PG8_SA(0, 0), a2, voffA);
            PG8_WAIT_V(8); PG8_WAIT_L(0); PG8_BAR; PG8_MMA(1, 0, At, B0); PG8_MMA(1, 1, At, B1); PG8_BAR; PG8_SCHED;
            PG8_LDB(B0, 1, 0); PG8_LDB(B1, 1, 1); PG8_SCHED; PG8_LDA(At, 1, 0); PG8_STAGE(PG8_SA(0, 1), a2 + hstep, voffA);
            PG8_WAIT_V(8); PG8_WAIT_L(0); PG8_BAR; PG8_MMA(0, 0, At, B0); PG8_MMA(0, 1, At, B1); PG8_BAR; PG8_SCHED;
            PG8_LDA(At, 1, 1); PG8_STAGE(PG8_SB(1, 0), b3, voffB); PG8_STAGE(PG8_SB(1, 1), b3 + hstep, voffB); PG8_STAGE(PG8_SA(1, 0), a3, voffA);
            PG8_WAIT_V(8); PG8_WAIT_L(0); PG8_BAR; PG8_MMA(1, 0, At, B0); PG8_MMA(1, 1, At, B1); PG8_BAR; PG8_SCHED;
            } else {
            PG8_LDB(B0, 0, 0); PG8_SCHED; PG8_LDA(At, 0, 0); PG8_STAGE(PG8_SA(1, 1), a1 + hstep, voffA);
            PG8_WAIT_L(8); PG8_BAR; PG8_WAIT_L(0); PG8_MMA(0, 0, At, B0); PG8_BAR; PG8_SCHED;
            PG8_LDB(B1, 0, 1); PG8_STAGE(PG8_SB(0, 0), b2, voffB);
            PG8_BAR; PG8_WAIT_L(0); PG8_MMA(0, 1, At, B1); PG8_BAR;
            PG8_LDA(At, 0, 1); PG8_STAGE(PG8_SA(0, 0), a2, voffA);
            PG8_BAR; PG8_WAIT_L(0); PG8_MMA(1, 0, At, B0); PG8_BAR; PG8_SCHED;
            PG8_STAGE(PG8_SB(0, 1), b2 + hstep, voffB);
            PG8_WAIT_V(6); PG8_BAR; PG8_MMA(1, 1, At, B1); PG8_BAR;
            PG8_LDB(B0, 1, 0); PG8_SCHED; PG8_LDA(At, 1, 0); PG8_STAGE(PG8_SA(0, 1), a2 + hstep, voffA);
            PG8_WAIT_L(8); PG8_BAR; PG8_WAIT_L(0); PG8_MMA(0, 0, At, B0); PG8_BAR; PG8_SCHED;
            PG8_LDB(B1, 1, 1); PG8_STAGE(PG8_SB(1, 0), b3, voffB);
            PG8_BAR; PG8_WAIT_L(0); PG8_MMA(0, 1, At, B1); PG8_BAR;
            PG8_LDA(At, 1, 1); PG8_STAGE(PG8_SA(1, 0), a3, voffA);
            PG8_BAR; PG8_WAIT_L(0); PG8_MMA(1, 0, At, B0); PG8_BAR; PG8_SCHED;
            PG8_STAGE(PG8_SB(1, 1), b3 + hstep, voffB);
            PG8_WAIT_V(6); PG8_BAR; PG8_MMA(1, 1, At, B1); PG8_BAR;
            }
        }
        if constexpr (ALIGN_EPI) { if (wr == 0) PG8_BAR; }
        if constexpr (!Epi::AFTER_DRAIN) { int t2_ = threadIdx.x; asm volatile("" : "+v"(t2_)); const int l2_ = t2_ & 63;
            E(acc, cur, wr, wc, l2_ & 15, l2_ >> 4); S.done(cur); }
        if (!has_next) break;
#pragma unroll
        for (int a = 0; a < 2; ++a)
#pragma unroll
            for (int b = 0; b < 2; ++b)
#pragma unroll
                for (int m = 0; m < 4; ++m)
#pragma unroll
                    for (int n = 0; n < 2; ++n) acc[a][b][m][n] = (f32x4){0.f, 0.f, 0.f, 0.f};
        cur = nxt; cA = nA; cB = nB; ++ui;
        if constexpr (ALIGN_EPI) { if (wr == 1) PG8_BAR; }
    }
    PG8_WAIT_V(0);
    if constexpr (!ALIGN_EPI) { if (wr == 0) PG8_BAR; }
    PG8_BAR;
    if constexpr (Epi::AFTER_DRAIN) { E.fused(acc, cur, wr, wc, fr, fq, lds, wid, lane); S.done(cur); }
#undef PG8_SA
#undef PG8_SB
#undef PG8_STAGE
#undef PG8_LDA
#undef PG8_LDB
#undef PG8_MMA
#undef PG8_CAT
#undef PG8_WAIT_V
#undef PG8_WAIT_L
#undef PG8_BAR
#undef PG8_SCHED
}
}
#include <hip/hip_bf16.h>
#include <cmath>
namespace attn_body {
using bf16=__hip_bfloat16;
using bf16x8=__attribute__((ext_vector_type(8)))short;
using s16x4=__attribute__((ext_vector_type(4)))short;
using f32x16=__attribute__((ext_vector_type(16)))float;
using u32x4=__attribute__((ext_vector_type(4)))unsigned;
constexpr int SEQ=8192,D=64,QP=3072,KP=3072,OP=512;
constexpr int NW=8,QBLK=32,QB=QBLK*NW,KVBLK=64,NQB=SEQ/QB;
constexpr int ATTN_UNIT_ROWS=QB;
__device__ __forceinline__ int crow(int r,int hi){return (r&3)+8*(r>>2)+4*hi;}
#define SBAR() __builtin_amdgcn_sched_barrier(0)
__device__ __forceinline__ void cmask(f32x16&p0,f32x16&p1,int jb,int qrel,int hi){
  const float NEG=-INFINITY; int kb=64*jb+4*hi;
  #pragma unroll
  for(int r=0;r<16;++r){int kv=kb+(r&3)+8*(r>>2); if(kv>qrel)p0[r]=NEG; if(kv+32>qrel)p1[r]=NEG;}
}

constexpr int NSLOT=3, SLOTB=8192;
constexpr int LDS_K=0, LDS_V=NSLOT*SLOTB, LDS_WS=2*NSLOT*SLOTB, LDS_OST=LDS_WS+NW*64*4, LDS_TB=LDS_OST+NW*4096+4096, LDS_BYTES=LDS_TB+4096;
constexpr float C2=0.125f*1.4426950408889634f;
__device__ __forceinline__ void glds16(const void*gsrc,unsigned lds_dst){unsigned keep;
  asm volatile("s_mov_b32 %0, m0\n\ts_mov_b32 m0, %2\n\ts_nop 0\n\tglobal_load_lds_dwordx4 %1, off\n\ts_mov_b32 m0, %0":"=&s"(keep):"v"(gsrc),"s"(lds_dst):"memory");}
__device__ __forceinline__ float max3f(float a,float b,float c){float r;asm("v_max3_f32 %0, %1, %2, %3":"=v"(r):"v"(a),"v"(b),"v"(c));return r;}
__device__ __forceinline__ float max2f(float a,float b){float r;asm("v_max_f32_e32 %0, %1, %2":"=v"(r):"v"(a),"v"(b));return r;}
__device__ __forceinline__ float fadd_s(float a,float b){float r;asm("v_add_f32_e32 %0, %1, %2":"=v"(r):"v"(a),"v"(b));return r;}
__device__ __forceinline__ float fsub_s(float a,float b){float r;asm("v_sub_f32_e32 %0, %1, %2":"=v"(r):"v"(a),"v"(b));return r;}
typedef float f32x2_t __attribute__((ext_vector_type(2))); typedef __bf16 bf16x2_t __attribute__((ext_vector_type(2)));
__device__ __forceinline__ unsigned cvtpk_s(float lo,float hi){f32x2_t v={lo,hi};bf16x2_t b=__builtin_convertvector(v,bf16x2_t);return __builtin_bit_cast(unsigned,b);}
#define WAIT_BAR(N) asm volatile("s_waitcnt vmcnt(" #N ") lgkmcnt(0)\n\ts_barrier":::"memory")

__device__ __forceinline__ void qkt(f32x16&p0,f32x16&p1,const char*Kslot,const bf16x8*qr,const f32x16&negm,int r32,int hi){
  const char*kb=Kslot+hi*1024+r32*16;
  #pragma unroll
  for(int d0=0;d0<4;++d0){
    const bf16x8 b0=*reinterpret_cast<const bf16x8*>(kb+d0*2048);
    const bf16x8 b1=*reinterpret_cast<const bf16x8*>(kb+d0*2048+512);
    if(d0==0){p0=__builtin_amdgcn_mfma_f32_32x32x16_bf16(b0,qr[0],negm,0,0,0);p1=__builtin_amdgcn_mfma_f32_32x32x16_bf16(b1,qr[0],negm,0,0,0);}
    else{p0=__builtin_amdgcn_mfma_f32_32x32x16_bf16(b0,qr[d0],p0,0,0,0);p1=__builtin_amdgcn_mfma_f32_32x32x16_bf16(b1,qr[d0],p1,0,0,0);}}
}
typedef __attribute__((address_space(3))) const char* lds_cptr;
typedef short v4i16_t __attribute__((ext_vector_type(4)));
__device__ __forceinline__ void kload8(bf16x8*kf,lds_cptr kp){
  kf[0]=*(const __attribute__((address_space(3))) bf16x8*)(kp);      kf[1]=*(const __attribute__((address_space(3))) bf16x8*)(kp+512);
  kf[2]=*(const __attribute__((address_space(3))) bf16x8*)(kp+2048); kf[3]=*(const __attribute__((address_space(3))) bf16x8*)(kp+2560);
  kf[4]=*(const __attribute__((address_space(3))) bf16x8*)(kp+4096); kf[5]=*(const __attribute__((address_space(3))) bf16x8*)(kp+4608);
  kf[6]=*(const __attribute__((address_space(3))) bf16x8*)(kp+6144); kf[7]=*(const __attribute__((address_space(3))) bf16x8*)(kp+6656);
}
__device__ __forceinline__ void kload2(bf16x8*kf,lds_cptr kp,int j){ kf[2*j]=*(const __attribute__((address_space(3))) bf16x8*)(kp+j*2048); kf[2*j+1]=*(const __attribute__((address_space(3))) bf16x8*)(kp+j*2048+512); }
__device__ __forceinline__ s16x4 vtr(lds_cptr p){ return __builtin_bit_cast(s16x4,__builtin_amdgcn_ds_read_tr16_b64_v4i16((__attribute__((address_space(3))) v4i16_t*)p)); }
__device__ __forceinline__ float rowmax(const f32x16&p0,const f32x16&p1){
  float a=max3f(p0[0],p0[1],p1[0]),b=max3f(p0[2],p0[3],p1[1]);a=max3f(a,p1[2],p1[3]);
  #pragma unroll
  for(int r=4;r<16;r+=4){a=max3f(a,p0[r],p0[r+1]);b=max3f(b,p0[r+2],p0[r+3]);a=max3f(a,p1[r],p1[r+1]);b=max3f(b,p1[r+2],p1[r+3]);}
  const float m=max2f(a,b);
  auto rr=__builtin_amdgcn_permlane32_swap(__float_as_uint(m),__float_as_uint(m),false,false);
  return max2f(__uint_as_float(rr[0]),__uint_as_float(rr[1]));
}
__device__ __forceinline__ void pv(f32x16*o,int vb,bf16x8 pa0,bf16x8 pa1,bf16x8 pa2,bf16x8 pa3){
  #pragma unroll
  for(int d0=0;d0<2;++d0){s16x4 lo[4],hi[4];
    #pragma unroll
    for(int ks=0;ks<4;++ks){
      asm volatile("ds_read_b64_tr_b16 %0,%1 offset:%c2":"=&v"(lo[ks]):"v"(vb),"i"(d0*4096+ks*1024):"memory");
      asm volatile("ds_read_b64_tr_b16 %0,%1 offset:%c2":"=&v"(hi[ks]):"v"(vb),"i"(d0*4096+ks*1024+512):"memory");}
    asm volatile("s_waitcnt lgkmcnt(0)":::"memory");SBAR();
    #define PK(k) (bf16x8){lo[k][0],lo[k][1],lo[k][2],lo[k][3],hi[k][0],hi[k][1],hi[k][2],hi[k][3]}
    o[d0]=__builtin_amdgcn_mfma_f32_32x32x16_bf16(pa0,PK(0),o[d0],0,0,0);
    o[d0]=__builtin_amdgcn_mfma_f32_32x32x16_bf16(pa1,PK(1),o[d0],0,0,0);
    o[d0]=__builtin_amdgcn_mfma_f32_32x32x16_bf16(pa2,PK(2),o[d0],0,0,0);
    o[d0]=__builtin_amdgcn_mfma_f32_32x32x16_bf16(pa3,PK(3),o[d0],0,0,0);
    #undef PK
  }
}

#ifndef ATTN_STORE16
#define ATTN_STORE16(p,v) (*(u32x4*)(p)=(v))
#endif
template<int MODE,int OP,int THRL> __device__ __forceinline__ void attn_unit(const bf16*Qu,const bf16*__restrict__ Kh,const bf16*__restrict__ Vh,bf16*Ou,int q0,int t_lo,int NT,float nsl2,char*shm){
  int tid_=threadIdx.x; asm volatile("":"+v"(tid_));
  const int tid=tid_,lane=tid&63,r32=lane&31,hi=lane>>5; const int wid=__builtin_amdgcn_readfirstlane(tid>>6);
  const bf16*Qw=Qu+(long)(wid*QBLK)*QP;
  const unsigned lds0=(unsigned)(uintptr_t)shm;
  float*wsf=(float*)(shm+LDS_WS)+wid*64;
  const bf16*ksrc=Kh+(long)lane*KP+wid*8;
  const bf16*vsrc=Vh+(long)(16*(wid&3)+(lane>>2))*KP+(wid>>2)*32+(lane&3)*8;
  const unsigned kdst=lds0+LDS_K+wid*1024, vdst=lds0+LDS_V+wid*1024;
  #define DMA_K(t,slot) glds16(ksrc+(long)(t)*KVBLK*KP,(unsigned)__builtin_amdgcn_readfirstlane(kdst+(slot)))
  #define DMA_V(t,slot) glds16(vsrc+(long)(t)*KVBLK*KP,(unsigned)__builtin_amdgcn_readfirstlane(vdst+(slot)))
  const int vb0=(int)(lds0+LDS_V)+((lane>>4)&1)*32+(lane&3)*8+(4*hi+((lane&15)>>2))*64;
  const char*Kbase=shm+LDS_K; bf16x8 kf[8];
  const lds_cptr shm3=(lds_cptr)shm; const lds_cptr kp0=shm3+LDS_K+hi*1024+r32*16; const lds_cptr vp0=shm3+LDS_V+((lane>>4)&1)*32+(lane&3)*8+(4*hi+((lane&15)>>2))*64;
  DMA_K(0,0);DMA_V(0,0);DMA_K(1,SLOTB);
  bf16x8 qr[4];
  #pragma unroll
  for(int d0=0;d0<4;++d0)qr[d0]=*reinterpret_cast<const bf16x8*>(&Qw[(long)r32*QP+d0*16+hi*8]);
  float mhat=0.f,l_reg=0.f;f32x16 o[2];o[0]=f32x16{};o[1]=f32x16{};f32x16 negm=f32x16{};asm volatile("":"+v"(negm));
  const float qf=(float)(q0+wid*QBLK+r32-4*hi);
  const int n_r=q0+(wid>>1), n_c=(wid&1)*32+r32, n_rs=min(max(n_r-4,0),120), n_kc=4*hi-min(max(n_c-8,0),48);
  typedef __attribute__((address_space(3))) const float* lds_fptr;
  const lds_fptr n_tb=(lds_fptr)((__attribute__((address_space(3))) const char*)shm+LDS_TB)+(7-n_r)*31+4*hi-n_c+15;
  #define CMASK(P0,P1,t) do{ if(MODE==0){ const float dq_=qf-(float)(64*(t)); _Pragma("unroll") for(int r=0;r<16;++r){ const float cr_=(float)((r&3)+8*(r>>2)); \
      P0[r]=__builtin_fmaf(nsl2,__builtin_fabsf(dq_-cr_),P0[r]); P1[r]=__builtin_fmaf(nsl2,__builtin_fabsf(dq_-(cr_+32.f)),P1[r]); } } \
    else { const int kr_=t_lo+(t); const bool vr_=(kr_>=n_rs)&&(kr_<n_rs+8); const lds_fptr tb_=n_tb+kr_*31; \
      _Pragma("unroll") for(int r=0;r<16;++r){ const int ko_=(r&3)+8*(r>>2); const float b0_=tb_[ko_],b1_=tb_[ko_+32]; \
        const bool ok0_=vr_&&((unsigned)(n_kc+ko_)<16u), ok1_=vr_&&((unsigned)(n_kc+ko_+32)<16u); \
        P0[r]=ok0_?P0[r]+b0_:-INFINITY; P1[r]=ok1_?P1[r]+b1_:-INFINITY; } } }while(0)
  bool resc=false;
  #define START(P0,P1) do{ const float rm=rowmax(P0,P1); resc=false; \
    { const float dl=(rm>-1e30f)?rm:0.f; mhat=fadd_s(mhat,dl); \
      _Pragma("unroll") for(int r=0;r<16;++r){P0[r]=fsub_s(P0[r],dl);P1[r]=fsub_s(P1[r],dl);} \
      _Pragma("unroll") for(int r=0;r<16;++r)negm[r]=-mhat; asm volatile("":"+v"(negm)); } \
    _Pragma("unroll") for(int r=0;r<16;++r)P0[r]=__builtin_amdgcn_exp2f(P0[r]); }while(0)
  #define RESC() do{ if(resc){ asm volatile("s_waitcnt lgkmcnt(0)":::"memory"); \
      _Pragma("unroll") for(int d_=0;d_<2;++d_) _Pragma("unroll") for(int r=0;r<16;++r)o[d_][r]*=wsf[crow(r,hi)]; } }while(0)
  f32x16 pA0,pA1,pB0,pB1;
  int sl_prev=0,sl_cur=0,sl_next=SLOTB;
  #define ROT() do{sl_prev=sl_cur;sl_cur=sl_next;sl_next=(sl_next==(NSLOT-1)*SLOTB)?0:sl_next+SLOTB;}while(0)
  DMA_K(2,2*SLOTB);
  WAIT_BAR(3);
  qkt(pA0,pA1,Kbase,qr,negm,r32,hi);asm volatile("s_nop 15\n\ts_nop 7":"+v"(pA0),"+v"(pA1));CMASK(pA0,pA1,0);
  START(pA0,pA1);
  _Pragma("unroll") for(int r=0;r<16;++r)pA1[r]=__builtin_amdgcn_exp2f(pA1[r]);
  WAIT_BAR(0);
  DMA_K(3,0);DMA_V(1,SLOTB);
  ROT();
  kload8(kf,kp0+sl_cur);
  WAIT_BAR(2);
  s16x4 vlo[8],vhi[8]; u32x4 pw0,pw1,pw2,pw3;
  #define PKW(P,B) cvtpk_s(P[B],P[B+1])
  #define PAF(k) __builtin_bit_cast(bf16x8,pw##k)
  #define VFR(i) (bf16x8){vlo[i][0],vlo[i][1],vlo[i][2],vlo[i][3],vhi[i][0],vhi[i][1],vhi[i][2],vhi[i][3]}
  #define PIN(x) asm volatile("":"+v"(x))
  #define MX3(a,b,c) __builtin_fmaxf(__builtin_fmaxf((a),(b)),(c))
  #define GAPA(MF,A0,A1,A2,A3,W0,W1,PW) do{ MF; sacc+=A0; sacc+=A1; sacc+=A2; sacc+=A3; PIN(sacc); W0; W1; PIN(PW); SBAR(); }while(0)
  #define EX(v) __builtin_amdgcn_exp2f(v)
  #define GAPB(MF,X,B) do{ MF; X[B]=EX(X[B]); X[B+1]=EX(X[B+1]); X[B+2]=EX(X[B+2]); X[B+3]=EX(X[B+3]); PIN(X); SBAR(); }while(0)
  #define VRD(i) do{ vlo[i]=vtr(vp_+(((i)>>2)*4096+((i)&3)*1024)); vhi[i]=vtr(vp_+(((i)>>2)*4096+((i)&3)*1024+512)); }while(0)
  #define KRD(G,j) do{ if(G){ kload2(kf,kp0+sl_next,j); SBAR(); } }while(0)
  #define STEP(C0,C1,P0,P1,t,GK,GV,GL) do{ SBAR(); \
    const lds_cptr vp_=vp0+sl_prev; \
    VRD(0); SBAR(); float sacc=(P0[0]+P0[1]); \
    GAPA(C0=__builtin_amdgcn_mfma_f32_32x32x16_bf16(kf[0],qr[0],negm,0,0,0), P0[2],P0[3],P0[4],P0[5],     pw0[0]=PKW(P0,0), pw0[1]=PKW(P0,2), pw0); \
    VRD(4); SBAR(); GAPA(C1=__builtin_amdgcn_mfma_f32_32x32x16_bf16(kf[1],qr[0],negm,0,0,0), P0[6],P0[7],P0[8],P0[9],     pw0[2]=PKW(P0,4), pw0[3]=PKW(P0,6), pw0); \
    VRD(1); SBAR(); GAPA(C0=__builtin_amdgcn_mfma_f32_32x32x16_bf16(kf[2],qr[1],C0,0,0,0),   P0[10],P0[11],P0[12],P0[13], pw1[0]=PKW(P0,8), pw1[1]=PKW(P0,10), pw1); \
    VRD(5); SBAR(); GAPA(C1=__builtin_amdgcn_mfma_f32_32x32x16_bf16(kf[3],qr[1],C1,0,0,0),   P0[14],P0[15],P1[0],P1[1],   pw1[2]=PKW(P0,12),pw1[3]=PKW(P0,14), pw1); \
    VRD(2); SBAR(); GAPA(C0=__builtin_amdgcn_mfma_f32_32x32x16_bf16(kf[4],qr[2],C0,0,0,0),   P1[2],P1[3],P1[4],P1[5],     pw2[0]=PKW(P1,0), pw2[1]=PKW(P1,2), pw2); \
    VRD(6); SBAR(); GAPA(C1=__builtin_amdgcn_mfma_f32_32x32x16_bf16(kf[5],qr[2],C1,0,0,0),   P1[6],P1[7],P1[8],P1[9],     pw2[2]=PKW(P1,4), pw2[3]=PKW(P1,6), pw2); \
    VRD(3); SBAR(); GAPA(C0=__builtin_amdgcn_mfma_f32_32x32x16_bf16(kf[6],qr[3],C0,0,0,0),   P1[10],P1[11],P1[12],P1[13], pw3[0]=PKW(P1,8), pw3[1]=PKW(P1,10), pw3); \
    VRD(7); SBAR(); GAPA(C1=__builtin_amdgcn_mfma_f32_32x32x16_bf16(kf[7],qr[3],C1,0,0,0),   P1[14],P1[15],0.f,0.f,       pw3[2]=PKW(P1,12),pw3[3]=PKW(P1,14), pw3); \
    l_reg+=sacc; \
    if(GK){DMA_K((t)+3,sl_cur);} if(GV){DMA_V((t)+1,sl_next);} \
    CMASK(C0,C1,t); \
    { float a=MX3(C0[0],C0[1],C1[0]),b=MX3(C0[2],C0[3],C1[1]); a=MX3(a,C1[2],C1[3]); \
      _Pragma("unroll") for(int r=4;r<16;r+=4){a=MX3(a,C0[r],C0[r+1]);b=MX3(b,C0[r+2],C0[r+3]);a=MX3(a,C1[r],C1[r+1]);b=MX3(b,C1[r+2],C1[r+3]);} \
      float rm=__builtin_fmaxf(a,b); { auto rr=__builtin_amdgcn_permlane32_swap(__float_as_uint(rm),__float_as_uint(rm),false,false); rm=__builtin_fmaxf(__uint_as_float(rr[0]),__uint_as_float(rr[1])); } \
      resc=false; \
      if(__builtin_expect(__any(rm>(float)THRL),0)){ const float dl=__builtin_fmaxf(rm,0.f); mhat+=dl; \
        _Pragma("unroll") for(int r=0;r<16;++r){C0[r]-=dl;C1[r]-=dl;} \
        _Pragma("unroll") for(int r=0;r<16;++r)negm[r]=-mhat; asm volatile("":"+v"(negm)); \
        const float f=__builtin_amdgcn_exp2f(-dl); l_reg*=f; if(hi==0)wsf[r32]=f; resc=true; } } \
    SBAR(); \
    GAPB(o[0]=__builtin_amdgcn_mfma_f32_32x32x16_bf16(PAF(0),VFR(0),o[0],0,0,0), C0,0); \
    GAPB(o[1]=__builtin_amdgcn_mfma_f32_32x32x16_bf16(PAF(0),VFR(4),o[1],0,0,0), C0,4); \
    KRD(GL,0); GAPB(o[0]=__builtin_amdgcn_mfma_f32_32x32x16_bf16(PAF(1),VFR(1),o[0],0,0,0), C0,8); \
    KRD(GL,1); GAPB(o[1]=__builtin_amdgcn_mfma_f32_32x32x16_bf16(PAF(1),VFR(5),o[1],0,0,0), C0,12); \
    KRD(GL,2); GAPB(o[0]=__builtin_amdgcn_mfma_f32_32x32x16_bf16(PAF(2),VFR(2),o[0],0,0,0), C1,0); \
    KRD(GL,3); GAPB(o[1]=__builtin_amdgcn_mfma_f32_32x32x16_bf16(PAF(2),VFR(6),o[1],0,0,0), C1,4); \
    GAPB(o[0]=__builtin_amdgcn_mfma_f32_32x32x16_bf16(PAF(3),VFR(3),o[0],0,0,0), C1,8); \
    GAPB(o[1]=__builtin_amdgcn_mfma_f32_32x32x16_bf16(PAF(3),VFR(7),o[1],0,0,0), C1,12); \
    }while(0)
  int t=1;
  for(;t+5<NT;t+=2){
    STEP(pB0,pB1,pA0,pA1,t,true,true,true);     WAIT_BAR(2); RESC(); ROT();
    STEP(pA0,pA1,pB0,pB1,t+1,true,true,true);   WAIT_BAR(2); RESC(); ROT();
  }
  #define ENDW(tt) do{ if((tt)+3<NT){WAIT_BAR(2);} else if((tt)+2<NT){WAIT_BAR(1);} else {WAIT_BAR(0);} }while(0)
  for(;t+1<NT;t+=2){
    STEP(pB0,pB1,pA0,pA1,t,(t+3<NT),(t+1<NT),(t+1<NT));       ENDW(t);   RESC(); ROT();
    STEP(pA0,pA1,pB0,pB1,t+1,(t+4<NT),(t+2<NT),(t+2<NT));     ENDW(t+1); RESC(); ROT();
  }
  STEP(pB0,pB1,pA0,pA1,NT-1,false,false,false); RESC();
  { float sacc=pB0[0]+pB0[1]; _Pragma("unroll") for(int r=2;r<16;++r)sacc+=pB0[r]; _Pragma("unroll") for(int r=0;r<16;++r)sacc+=pB1[r]; l_reg+=sacc;
    pw0=(u32x4){PKW(pB0,0),PKW(pB0,2),PKW(pB0,4),PKW(pB0,6)};pw1=(u32x4){PKW(pB0,8),PKW(pB0,10),PKW(pB0,12),PKW(pB0,14)};pw2=(u32x4){PKW(pB1,0),PKW(pB1,2),PKW(pB1,4),PKW(pB1,6)};pw3=(u32x4){PKW(pB1,8),PKW(pB1,10),PKW(pB1,12),PKW(pB1,14)};
    SBAR(); pv(o,vb0+sl_cur,PAF(0),PAF(1),PAF(2),PAF(3)); }
  #undef PKW
  #undef PAF
  #undef VFR
  #undef PIN
  #undef MX3
  #undef GAPA
  #undef GAPB
  #undef EX
  #undef VRD
  #undef KRD
  #undef STEP
  #undef ENDW
  {auto rr=__builtin_amdgcn_permlane32_swap(__float_as_uint(l_reg),__float_as_uint(l_reg),false,false);l_reg=__uint_as_float(rr[0])+__uint_as_float(rr[1]);}
  if(hi==0)wsf[32+r32]=l_reg;asm volatile("s_waitcnt lgkmcnt(0)":::"memory");
  float rli[16];
  #pragma unroll
  for(int r=0;r<16;++r)rli[r]=__builtin_amdgcn_rcpf(wsf[32+crow(r,hi)]);
  bf16*Ow=Ou+(long)(wid*QBLK)*OP;
  { bf16*stg=(bf16*)(shm+LDS_OST)+wid*2048;
    #pragma unroll
    for(int r=0;r<16;++r){const int orow=crow(r,hi);
      #pragma unroll
      for(int d0=0;d0<2;++d0)stg[orow*64+d0*32+r32]=__float2bfloat16(o[d0][r]*rli[r]);}
    asm volatile("s_waitcnt lgkmcnt(0)":::"memory");
    #pragma unroll
    for(int i=0;i<4;++i){const int row=i*8+(lane>>3),ch=lane&7; const u32x4 v=*(const u32x4*)(stg+row*64+ch*8); ATTN_STORE16(Ow+(long)row*OP+ch*8,v);} }
  asm volatile("s_waitcnt lgkmcnt(0)\n\ts_barrier":::"memory");
  #undef DMA_K
  #undef DMA_V
  #undef CMASK
  #undef START
  #undef RESC
  #undef ROT
}
constexpr int W_K=0, W_V=NSLOT*SLOTB, W_WS=W_V+NSLOT*2*SLOTB, W_OST=W_WS+NW*64*4, W_BYTES=W_OST+NW*4096;
template<int THRL> __device__ __forceinline__ void attn_unit128(const bf16*Qu,const bf16*__restrict__ Kh,const bf16*__restrict__ Vh,bf16*Ou,int q0,int NT,float nsl2,char*shm){
  constexpr int OP=512;
  int tid_=threadIdx.x; asm volatile("":"+v"(tid_));
  const int tid=tid_,lane=tid&63,r32=lane&31,hi=lane>>5; const int wid=__builtin_amdgcn_readfirstlane(tid>>6);
  const bf16*Qw=Qu+(long)(wid*QBLK)*QP;
  const unsigned lds0=(unsigned)(uintptr_t)shm;
  float*wsf=(float*)(shm+W_WS)+wid*64;
  const bf16*ksrc=Kh+wid*512+lane*8;
  const bf16*vsrc=Vh+wid*512+lane*8;
  const unsigned kdst=lds0+W_K+wid*1024, vdst=lds0+W_V+wid*1024;
  #define DMA_K(t,slot) glds16(ksrc+(long)(t)*4096,(unsigned)__builtin_amdgcn_readfirstlane(kdst+(slot)))
  #define DMA_V(t,slot) do{ glds16(vsrc+(long)(t)*8192,(unsigned)__builtin_amdgcn_readfirstlane(vdst+2*(slot))); glds16(vsrc+(long)(t)*8192+4096,(unsigned)__builtin_amdgcn_readfirstlane(vdst+2*(slot)+8192)); }while(0)
  const int vb0=(int)(lds0+W_V)+((lane>>4)&1)*32+(lane&3)*8+(4*hi+((lane&15)>>2))*64;
  bf16x8 kf[8];
  const lds_cptr shm3=(lds_cptr)shm; const lds_cptr kp0=shm3+W_K+hi*1024+r32*16; const lds_cptr vp0=shm3+W_V+((lane>>4)&1)*32+(lane&3)*8+(4*hi+((lane&15)>>2))*64;
  DMA_K(0,0);DMA_V(0,0);DMA_K(1,SLOTB);
  bf16x8 qr[4];
  #pragma unroll
  for(int d0=0;d0<4;++d0)qr[d0]=*reinterpret_cast<const bf16x8*>(&Qw[(long)r32*QP+d0*16+hi*8]);
  float mhat=0.f,l_reg=0.f;f32x16 o[4];o[0]=f32x16{};o[1]=f32x16{};o[2]=f32x16{};o[3]=f32x16{};
  const float qf=(float)(q0+wid*QBLK+r32-4*hi);
  const int td=(q0>>6)+(wid>>1);
  #define CINIT(C0,C1,t) do{ const int tt_=(t); const float dq_=qf-(float)(64*tt_); \
    if(tt_==td){ _Pragma("unroll") for(int r=0;r<16;++r){ const float cr_=(float)((r&3)+8*(r>>2)); \
        C0[r]=__builtin_fmaf(nsl2,__builtin_fabsf(dq_-cr_),-mhat); C1[r]=__builtin_fmaf(nsl2,__builtin_fabsf(dq_-(cr_+32.f)),-mhat); } } \
    else { const float k_=(tt_<td)?-nsl2:nsl2; const float b_=__builtin_fmaf(-k_,dq_,-mhat); \
      _Pragma("unroll") for(int r=0;r<16;++r){ const float cr_=(float)((r&3)+8*(r>>2)); C0[r]=__builtin_fmaf(k_,cr_,b_); C1[r]=__builtin_fmaf(k_,cr_+32.f,b_); } } }while(0)
  bool resc=false;
  #define START(P0,P1) do{ const float rm=rowmax(P0,P1); resc=false; \
    { const float dl=rm; mhat=fadd_s(mhat,dl); \
      _Pragma("unroll") for(int r=0;r<16;++r){P0[r]=fsub_s(P0[r],dl);P1[r]=fsub_s(P1[r],dl);} } \
    _Pragma("unroll") for(int r=0;r<16;++r)P0[r]=__builtin_amdgcn_exp2f(P0[r]); }while(0)
  #define RESC() do{ if(resc){ asm volatile("s_waitcnt lgkmcnt(0)":::"memory"); \
      _Pragma("unroll") for(int d_=0;d_<4;++d_) _Pragma("unroll") for(int r=0;r<16;++r)o[d_][r]*=wsf[crow(r,hi)]; } }while(0)
  f32x16 pA0,pA1,pB0,pB1;
  int sl_prev=0,sl_cur=0,sl_next=SLOTB;
  #define ROT() do{sl_prev=sl_cur;sl_cur=sl_next;sl_next=(sl_next==(NSLOT-1)*SLOTB)?0:sl_next+SLOTB;}while(0)
  DMA_K(2,2*SLOTB);
  WAIT_BAR(4);
  CINIT(pA0,pA1,0);
  { const lds_cptr kb=kp0;
    #pragma unroll
    for(int d0=0;d0<4;++d0){ const bf16x8 b0=*(const __attribute__((address_space(3))) bf16x8*)(kb+d0*2048), b1=*(const __attribute__((address_space(3))) bf16x8*)(kb+d0*2048+512);
      pA0=__builtin_amdgcn_mfma_f32_32x32x16_bf16(b0,qr[d0],pA0,0,0,0); pA1=__builtin_amdgcn_mfma_f32_32x32x16_bf16(b1,qr[d0],pA1,0,0,0); } }
  asm volatile("s_nop 15\n\ts_nop 7":"+v"(pA0),"+v"(pA1));
  START(pA0,pA1);
  _Pragma("unroll") for(int r=0;r<16;++r)pA1[r]=__builtin_amdgcn_exp2f(pA1[r]);
  WAIT_BAR(0);
  DMA_K(3,0);DMA_V(1,SLOTB);
  ROT();
  kload8(kf,kp0+sl_cur);
  WAIT_BAR(3);
  s16x4 vlo[8],vhi[8]; u32x4 pw0,pw1,pw2,pw3;
  #define PKW(P,B) cvtpk_s(P[B],P[B+1])
  #define PAF(k) __builtin_bit_cast(bf16x8,pw##k)
  #define VFR(i) (bf16x8){vlo[i][0],vlo[i][1],vlo[i][2],vlo[i][3],vhi[i][0],vhi[i][1],vhi[i][2],vhi[i][3]}
  #define PIN(x) asm volatile("":"+v"(x))
  #define MX3(a,b,c) __builtin_fmaxf(__builtin_fmaxf((a),(b)),(c))
  #define GAPA(MF,A0,A1,A2,A3,W0,W1,PW) do{ MF; sacc+=A0; sacc+=A1; sacc+=A2; sacc+=A3; PIN(sacc); W0; W1; PIN(PW); SBAR(); }while(0)
  #define EX(v) __builtin_amdgcn_exp2f(v)
  #define GAPB(MF,X,B) do{ MF; X[B]=EX(X[B]); X[B+1]=EX(X[B+1]); PIN(X); SBAR(); }while(0)
  #define VRD(i) do{ vlo[i]=vtr(vp_+(((i)>>2)*4096+((i)&3)*1024)); vhi[i]=vtr(vp_+(((i)>>2)*4096+((i)&3)*1024+512)); }while(0)
  #define VRD2(i) do{ vlo[i]=vtr(vp_+(8192+((i)>>2)*4096+((i)&3)*1024)); vhi[i]=vtr(vp_+(8192+((i)>>2)*4096+((i)&3)*1024+512)); SBAR(); }while(0)
  #define KRD(G,j) do{ if(G){ kload2(kf,kp0+sl_next,j); SBAR(); } }while(0)
  #define STEP(C0,C1,P0,P1,t,GK,GV,GL) do{ SBAR(); \
    const lds_cptr vp_=vp0+2*sl_prev; \
    CINIT(C0,C1,t); SBAR(); \
    VRD(0); SBAR(); float sacc=(P0[0]+P0[1]); \
    GAPA(C0=__builtin_amdgcn_mfma_f32_32x32x16_bf16(kf[0],qr[0],C0,0,0,0), P0[2],P0[3],P0[4],P0[5],     pw0[0]=PKW(P0,0), pw0[1]=PKW(P0,2), pw0); \
    VRD(4); SBAR(); GAPA(C1=__builtin_amdgcn_mfma_f32_32x32x16_bf16(kf[1],qr[0],C1,0,0,0), P0[6],P0[7],P0[8],P0[9],     pw0[2]=PKW(P0,4), pw0[3]=PKW(P0,6), pw0); \
    VRD(1); SBAR(); GAPA(C0=__builtin_amdgcn_mfma_f32_32x32x16_bf16(kf[2],qr[1],C0,0,0,0),   P0[10],P0[11],P0[12],P0[13], pw1[0]=PKW(P0,8), pw1[1]=PKW(P0,10), pw1); \
    VRD(5); SBAR(); GAPA(C1=__builtin_amdgcn_mfma_f32_32x32x16_bf16(kf[3],qr[1],C1,0,0,0),   P0[14],P0[15],P1[0],P1[1],   pw1[2]=PKW(P0,12),pw1[3]=PKW(P0,14), pw1); \
    VRD(2); SBAR(); GAPA(C0=__builtin_amdgcn_mfma_f32_32x32x16_bf16(kf[4],qr[2],C0,0,0,0),   P1[2],P1[3],P1[4],P1[5],     pw2[0]=PKW(P1,0), pw2[1]=PKW(P1,2), pw2); \
    VRD(6); SBAR(); GAPA(C1=__builtin_amdgcn_mfma_f32_32x32x16_bf16(kf[5],qr[2],C1,0,0,0),   P1[6],P1[7],P1[8],P1[9],     pw2[2]=PKW(P1,4), pw2[3]=PKW(P1,6), pw2); \
    VRD(3); SBAR(); GAPA(C0=__builtin_amdgcn_mfma_f32_32x32x16_bf16(kf[6],qr[3],C0,0,0,0),   P1[10],P1[11],P1[12],P1[13], pw3[0]=PKW(P1,8), pw3[1]=PKW(P1,10), pw3); \
    VRD(7); SBAR(); GAPA(C1=__builtin_amdgcn_mfma_f32_32x32x16_bf16(kf[7],qr[3],C1,0,0,0),   P1[14],P1[15],0.f,0.f,       pw3[2]=PKW(P1,12),pw3[3]=PKW(P1,14), pw3); \
    l_reg+=sacc; \
    if(GK){DMA_K((t)+3,sl_cur);} if(GV){DMA_V((t)+1,sl_next);} \
    { float a=MX3(C0[0],C0[1],C1[0]),b=MX3(C0[2],C0[3],C1[1]); a=MX3(a,C1[2],C1[3]); \
      _Pragma("unroll") for(int r=4;r<16;r+=4){a=MX3(a,C0[r],C0[r+1]);b=MX3(b,C0[r+2],C0[r+3]);a=MX3(a,C1[r],C1[r+1]);b=MX3(b,C1[r+2],C1[r+3]);} \
      float rm=__builtin_fmaxf(a,b); { auto rr=__builtin_amdgcn_permlane32_swap(__float_as_uint(rm),__float_as_uint(rm),false,false); rm=__builtin_fmaxf(__uint_as_float(rr[0]),__uint_as_float(rr[1])); } \
      resc=false; \
      if(__builtin_expect(__any(rm>(float)THRL),0)){ const float dl=__builtin_fmaxf(rm,0.f); mhat+=dl; \
        _Pragma("unroll") for(int r=0;r<16;++r){C0[r]-=dl;C1[r]-=dl;} \
        const float f=__builtin_amdgcn_exp2f(-dl); l_reg*=f; if(hi==0)wsf[r32]=f; resc=true; } } \
    SBAR(); \
    GAPB(o[0]=__builtin_amdgcn_mfma_f32_32x32x16_bf16(PAF(0),VFR(0),o[0],0,0,0), C0,0); \
    GAPB(o[1]=__builtin_amdgcn_mfma_f32_32x32x16_bf16(PAF(0),VFR(4),o[1],0,0,0), C0,2);  VRD2(0); \
    GAPB(o[0]=__builtin_amdgcn_mfma_f32_32x32x16_bf16(PAF(1),VFR(1),o[0],0,0,0), C0,4);  VRD2(4); \
    GAPB(o[1]=__builtin_amdgcn_mfma_f32_32x32x16_bf16(PAF(1),VFR(5),o[1],0,0,0), C0,6);  VRD2(1); \
    GAPB(o[0]=__builtin_amdgcn_mfma_f32_32x32x16_bf16(PAF(2),VFR(2),o[0],0,0,0), C0,8);  VRD2(5); \
    GAPB(o[1]=__builtin_amdgcn_mfma_f32_32x32x16_bf16(PAF(2),VFR(6),o[1],0,0,0), C0,10); VRD2(2); \
    GAPB(o[0]=__builtin_amdgcn_mfma_f32_32x32x16_bf16(PAF(3),VFR(3),o[0],0,0,0), C0,12); VRD2(6); \
    GAPB(o[1]=__builtin_amdgcn_mfma_f32_32x32x16_bf16(PAF(3),VFR(7),o[1],0,0,0), C0,14); VRD2(3); VRD2(7); \
    GAPB(o[2]=__builtin_amdgcn_mfma_f32_32x32x16_bf16(PAF(0),VFR(0),o[2],0,0,0), C1,0); \
    GAPB(o[3]=__builtin_amdgcn_mfma_f32_32x32x16_bf16(PAF(0),VFR(4),o[3],0,0,0), C1,2); \
    KRD(GL,0); GAPB(o[2]=__builtin_amdgcn_mfma_f32_32x32x16_bf16(PAF(1),VFR(1),o[2],0,0,0), C1,4); \
    KRD(GL,1); GAPB(o[3]=__builtin_amdgcn_mfma_f32_32x32x16_bf16(PAF(1),VFR(5),o[3],0,0,0), C1,6); \
    KRD(GL,2); GAPB(o[2]=__builtin_amdgcn_mfma_f32_32x32x16_bf16(PAF(2),VFR(2),o[2],0,0,0), C1,8); \
    KRD(GL,3); GAPB(o[3]=__builtin_amdgcn_mfma_f32_32x32x16_bf16(PAF(2),VFR(6),o[3],0,0,0), C1,10); \
    GAPB(o[2]=__builtin_amdgcn_mfma_f32_32x32x16_bf16(PAF(3),VFR(3),o[2],0,0,0), C1,12); \
    GAPB(o[3]=__builtin_amdgcn_mfma_f32_32x32x16_bf16(PAF(3),VFR(7),o[3],0,0,0), C1,14); \
    }while(0)
  int t=1;
  for(;t+5<NT;t+=2){
    STEP(pB0,pB1,pA0,pA1,t,true,true,true);     WAIT_BAR(3); RESC(); ROT();
    STEP(pA0,pA1,pB0,pB1,t+1,true,true,true);   WAIT_BAR(3); RESC(); ROT();
  }
  #define ENDW(tt) do{ if((tt)+3<NT){WAIT_BAR(3);} else if((tt)+2<NT){WAIT_BAR(2);} else {WAIT_BAR(0);} }while(0)
  for(;t+1<NT;t+=2){
    STEP(pB0,pB1,pA0,pA1,t,(t+3<NT),(t+1<NT),(t+1<NT));       ENDW(t);   RESC(); ROT();
    STEP(pA0,pA1,pB0,pB1,t+1,(t+4<NT),(t+2<NT),(t+2<NT));     ENDW(t+1); RESC(); ROT();
  }
  STEP(pB0,pB1,pA0,pA1,NT-1,false,false,false); RESC();
  { float sacc=pB0[0]+pB0[1]; _Pragma("unroll") for(int r=2;r<16;++r)sacc+=pB0[r]; _Pragma("unroll") for(int r=0;r<16;++r)sacc+=pB1[r]; l_reg+=sacc;
    pw0=(u32x4){PKW(pB0,0),PKW(pB0,2),PKW(pB0,4),PKW(pB0,6)};pw1=(u32x4){PKW(pB0,8),PKW(pB0,10),PKW(pB0,12),PKW(pB0,14)};pw2=(u32x4){PKW(pB1,0),PKW(pB1,2),PKW(pB1,4),PKW(pB1,6)};pw3=(u32x4){PKW(pB1,8),PKW(pB1,10),PKW(pB1,12),PKW(pB1,14)};
    SBAR(); pv(o,vb0+2*sl_cur,PAF(0),PAF(1),PAF(2),PAF(3)); pv(o+2,vb0+2*sl_cur+8192,PAF(0),PAF(1),PAF(2),PAF(3)); }
  #undef PKW
  #undef PAF
  #undef VFR
  #undef PIN
  #undef MX3
  #undef GAPA
  #undef GAPB
  #undef EX
  #undef VRD
  #undef VRD2
  #undef KRD
  #undef STEP
  #undef ENDW
  {auto rr=__builtin_amdgcn_permlane32_swap(__float_as_uint(l_reg),__float_as_uint(l_reg),false,false);l_reg=__uint_as_float(rr[0])+__uint_as_float(rr[1]);}
  if(hi==0)wsf[32+r32]=l_reg;asm volatile("s_waitcnt lgkmcnt(0)":::"memory");
  float rli[16];
  #pragma unroll
  for(int r=0;r<16;++r)rli[r]=__builtin_amdgcn_rcpf(wsf[32+crow(r,hi)]);
  bf16*Ow=Ou+(long)(wid*QBLK)*OP;
  { bf16*stg=(bf16*)(shm+W_OST)+wid*2048;
    #pragma unroll
    for(int hf=0;hf<2;++hf){
      #pragma unroll
      for(int r=0;r<16;++r){const int orow=crow(r,hi);
        #pragma unroll
        for(int d0=0;d0<2;++d0)stg[orow*64+d0*32+r32]=__float2bfloat16(o[hf*2+d0][r]*rli[r]);}
      asm volatile("s_waitcnt lgkmcnt(0)":::"memory");
      #pragma unroll
      for(int i=0;i<4;++i){const int row=i*8+(lane>>3),ch=lane&7; const u32x4 v=*(const u32x4*)(stg+row*64+ch*8); ATTN_STORE16(Ow+(long)row*OP+hf*64+ch*8,v);}
      asm volatile("s_waitcnt lgkmcnt(0)":::"memory"); } }
  asm volatile("s_waitcnt lgkmcnt(0)\n\ts_barrier":::"memory");
  #undef DMA_K
  #undef DMA_V
  #undef CINIT
  #undef START
  #undef RESC
  #undef ROT
}
constexpr int ATTN_LDS_BYTES=LDS_BYTES;
constexpr int LDS_QW=W_BYTES;
template<int THRL=8> __device__ __forceinline__ void attn_phase(char*lds,const bf16*proj,const bf16*kimg,const bf16*vimg,bf16*od,unsigned*qctr,const unsigned*nrm){
  const int tid=threadIdx.x;
  volatile __attribute__((address_space(3))) unsigned* qw=(volatile __attribute__((address_space(3))) unsigned*)((__attribute__((address_space(3))) char*)lds+LDS_QW);
  unsigned mine=0; if(tid==0) mine=__hip_atomic_fetch_add(qctr,1u,__ATOMIC_RELAXED,__HIP_MEMORY_SCOPE_AGENT);
  for(;;){
    if(tid==0) qw[0]=mine;
    __syncthreads();
    const int u=(int)__builtin_amdgcn_readfirstlane(qw[0]);
    if(u>=512) break;
    if(tid==0) mine=__hip_atomic_fetch_add(qctr,1u,__ATOMIC_RELAXED,__HIP_MEMORY_SCOPE_AGENT);
    const int h=3-(u>>7), r=u&127, map=r>>6, b=(r>>5)&1, qb=r&31;
    const float sl2=__builtin_amdgcn_exp2f(-2.f*(float)(h+1))*1.4426950408889634f;
    const unsigned* nq=nrm+((b*16+2*h+map)*2), *nk=nrm+((b*16+8+2*h+map)*2);
    const float qn=__builtin_sqrtf(__uint_as_float(nq[0])+__uint_as_float(nq[1])), kn=__builtin_sqrtf(__uint_as_float(nk[0])+__uint_as_float(nk[1]));
    const float R=(2.f*qn*kn+48.f)/sl2; const int q0=qb*QB;
    int t_lo=(int)__builtin_fmaxf(__builtin_floorf(((float)q0-R)*(1.f/64.f)),0.f), t_hi=(int)__builtin_fminf(__builtin_floorf(((float)(q0+QB-1)+R)*(1.f/64.f)),(float)(SEQ/KVBLK-1));
    if(((t_hi-t_lo+1)&1)!=0){ if(t_lo>0)--t_lo; else ++t_hi; }
    const int nt=t_hi-t_lo+1; const long row0=(long)b*SEQ;
    attn_unit128<THRL>(proj+(row0+q0)*QP+h*128+map*64, kimg+((long)((b*4+h)*2+map)*128+t_lo)*4096, vimg+((long)(b*4+h)*128+t_lo)*8192,
                    od+((long)map*(2*SEQ)+row0+q0)*512+h*128, q0-t_lo*KVBLK, nt, -sl2, lds);
  }
}
template<int THRL=8> __device__ __forceinline__ void nat_phase(char*lds,const bf16*proj,bf16*concat,const float*rpb,int vcu,int G){
  const int tid=threadIdx.x;
  for(int id=vcu*2;id<512;id+=2*G) for(int j=0;j<2;++j){
    const int u=id+j,h=u&7,rb=u>>3,b=rb>>5,r0=(rb&31)*4;
    const int lo=min(max(r0-4,0),120), hi_=min(max(r0-1,0),120)+7; int nt=hi_-lo+1; nt+=nt&1;
    const long row0=(long)b*SEQ;
    __attribute__((address_space(3))) float* tb=(__attribute__((address_space(3))) float*)((__attribute__((address_space(3))) char*)lds+LDS_TB);
    if(tid<15*31) tb[tid]=rpb[h*15*31+tid]*1.4426950408889634f;
    attn_unit<1,1024,THRL>(proj+(row0+r0*64)*QP+1536+h*64, proj+(row0+lo*64)*KP+2048+h*64, proj+(row0+lo*64)*KP+2560+h*64,
                    concat+(row0+r0*64)*1024+512+h*64, r0, lo, nt, 0.f, lds); }
}
#undef SBAR
#undef WAIT_BAR
}
#define XB_TMO      128
#define XB_XCNT(j)  (256  + 64 * (j))
#define XB_XSUB(j)  (1280 + 64 * (j))
#define XB_XGEN(j)  (2304 + 64 * (j))
#define XB_TOP      3328
#define XB_TOPGEN   3392
#define XCD_BAR_WORDS 3456
#define XB_SPIN_CAP (1u << 18)

__device__ __forceinline__ unsigned xb_ld(unsigned* p)              { return __hip_atomic_load(p, __ATOMIC_RELAXED, __HIP_MEMORY_SCOPE_AGENT); }
__device__ __forceinline__ unsigned xb_add(unsigned* p, unsigned v) { return __hip_atomic_fetch_add(p, v, __ATOMIC_RELAXED, __HIP_MEMORY_SCOPE_AGENT); }
__device__ __forceinline__ unsigned xb_xcc_id() { return (unsigned)__builtin_amdgcn_s_getreg((3 << 11) | 20) & 0xFu; }
#define XB_SPIN(cond, bar) do { unsigned _sp = 0; while (cond) { __builtin_amdgcn_s_sleep(1); \
    if ((++_sp & 255u) == 0u) { if (xb_ld(&(bar)[XB_TMO])) break; if (_sp > XB_SPIN_CAP) { atomicAdd(&(bar)[XB_TMO], 1u); break; } } } } while (0)

struct XcdBarrier {
    unsigned* bar; unsigned x;
    volatile LAS unsigned* st;
};

__device__ __forceinline__ XcdBarrier xcd_barrier_post(unsigned* bar, volatile LAS unsigned* st) {
    XcdBarrier b; b.bar = bar; b.x = xb_xcc_id(); b.st = st;
    if (threadIdx.x == 0) (void)xb_add(&bar[XB_XCNT(b.x)], 1u);
    return b;
}
__device__ __forceinline__ void xcd_barrier_complete(unsigned* bar, unsigned x, unsigned& nloc, unsigned& nx) {
    const unsigned G = gridDim.x * gridDim.y * gridDim.z;
    unsigned sum, cnt, mine, sp = 0u;
    for (;;) {
        sum = 0u; cnt = 0u; mine = 0u;
#pragma unroll
        for (unsigned j = 0; j < 16; ++j) { const unsigned c = xb_ld(&bar[XB_XCNT(j)]); sum += c; cnt += (c > 0u) ? 1u : 0u; mine = (j == x) ? c : mine; }
        if (sum == G) break;
        __builtin_amdgcn_s_sleep(1);
        if ((++sp & 255u) == 0u) { if (xb_ld(&bar[XB_TMO])) break; if (sp > XB_SPIN_CAP) { atomicAdd(&bar[XB_TMO], 1u); break; } }
    }
    nloc = mine > 0u ? mine : 1u; nx = cnt > 0u ? cnt : 1u;
}

__device__ __forceinline__ void xcd_barrier(const XcdBarrier& b) {
    asm volatile("s_waitcnt vmcnt(0)" ::: "memory");
    __syncthreads();
    if (threadIdx.x == 0) {
        unsigned* bar = b.bar;
        __builtin_amdgcn_s_waitcnt(0);
        unsigned nloc = b.st[0], nx = b.st[1];
        if (nloc == 0u) { xcd_barrier_complete(bar, b.x, nloc, nx); b.st[0] = nloc; b.st[1] = nx; }
        const unsigned old = xb_add(&bar[XB_XSUB(b.x)], 1u);
        const unsigned gen = old / nloc;
        if (old + 1u == (gen + 1u) * nloc) {
            __builtin_amdgcn_fence(__ATOMIC_RELEASE, "agent");
            asm volatile("s_waitcnt vmcnt(0)" ::: "memory");
            const unsigned og = xb_add(&bar[XB_TOP], 1u);
            const unsigned tg = og / nx;
            if (og + 1u == (tg + 1u) * nx) xb_add(&bar[XB_TOPGEN], 1u);
            else XB_SPIN(xb_ld(&bar[XB_TOPGEN]) == tg, bar);
            __builtin_amdgcn_fence(__ATOMIC_ACQUIRE, "agent");
            xb_add(&bar[XB_XGEN(b.x)], 1u);
            asm volatile("s_waitcnt vmcnt(0)" ::: "memory");
        } else {
            XB_SPIN(xb_ld(&bar[XB_XGEN(b.x)]) == gen, bar);
            __builtin_amdgcn_fence(__ATOMIC_ACQUIRE, "agent");
            asm volatile("s_waitcnt vmcnt(0)" ::: "memory");
        }
    }
    __syncthreads();
}
__device__ __forceinline__ float wave_sum(float v) {
#pragma unroll
    for (int o = 1; o < 64; o <<= 1) v += __shfl_xor(v, o);
    return v;
}
__device__ __forceinline__ void p0_transpose_item(const float* W, int K, int N, bf16* WT, int row_off, LAS float* scr, int item, int lane) {
    const int nblk = N / 32, kb = item / nblk, nb = item % nblk, k0 = 64 * kb, n0 = 32 * nb;
#pragma unroll 8
    for (int i = 0; i < 32; ++i) { const int kk = 2 * i + (lane >> 5); scr[kk * 33 + (lane & 31)] = W[(size_t)(k0 + kk) * N + n0 + (lane & 31)]; }
    LDS_WAIT(); asm volatile("" ::: "memory");
    const int c = lane & 7;
#pragma unroll
    for (int j = 0; j < 4; ++j) { const int n = (lane >> 3) + 8 * j; const LAS float* s = scr + (8 * c) * 33 + n;
        v4u o; o.x = pk2(s[0 * 33], s[1 * 33]); o.y = pk2(s[2 * 33], s[3 * 33]); o.z = pk2(s[4 * 33], s[5 * 33]); o.w = pk2(s[6 * 33], s[7 * 33]);
        *(GAS v4u*)(WT + (size_t)(row_off + n0 + n) * K + k0 + 8 * c) = o; }
    LDS_WAIT(); asm volatile("" ::: "memory");
}
__device__ __forceinline__ unsigned pk4_fp8(float a, float b, float c, float d) {
    int w = 0; w = __builtin_amdgcn_cvt_pk_fp8_f32(__builtin_amdgcn_fmed3f(a, -448.f, 448.f), __builtin_amdgcn_fmed3f(b, -448.f, 448.f), w, false);
    w = __builtin_amdgcn_cvt_pk_fp8_f32(__builtin_amdgcn_fmed3f(c, -448.f, 448.f), __builtin_amdgcn_fmed3f(d, -448.f, 448.f), w, true); return (unsigned)w;
}
__device__ __forceinline__ void p0_transpose_item_f8(const float* W, int K, int N, unsigned char* WT, int row_off, LAS float* scr, int item, int lane, float SC) {
    const int nblk = N / 32, kb = item / nblk, nb = item % nblk, k0 = 64 * kb, n0 = 32 * nb;
#pragma unroll 8
    for (int i = 0; i < 32; ++i) { const int kk = 2 * i + (lane >> 5); scr[kk * 33 + (lane & 31)] = W[(size_t)(k0 + kk) * N + n0 + (lane & 31)]; }
    LDS_WAIT(); asm volatile("" ::: "memory");
    const int c = lane & 3;
#pragma unroll
    for (int j = 0; j < 2; ++j) { const int n = (lane >> 2) + 16 * j; const LAS float* s = scr + (16 * c) * 33 + n;
        v4u o; o.x = pk4_fp8(s[0 * 33] * SC, s[1 * 33] * SC, s[2 * 33] * SC, s[3 * 33] * SC); o.y = pk4_fp8(s[4 * 33] * SC, s[5 * 33] * SC, s[6 * 33] * SC, s[7 * 33] * SC);
        o.z = pk4_fp8(s[8 * 33] * SC, s[9 * 33] * SC, s[10 * 33] * SC, s[11 * 33] * SC); o.w = pk4_fp8(s[12 * 33] * SC, s[13 * 33] * SC, s[14 * 33] * SC, s[15 * 33] * SC);
        *(GAS v4u*)(WT + (size_t)(row_off + n0 + n) * K + k0 + 16 * c) = o; }
    LDS_WAIT(); asm volatile("" ::: "memory");
}
struct Params { const float* in[22]; float* out; unsigned char* ws; };

__device__ __forceinline__ float mod_val(const float* __restrict__ modp, const float* __restrict__ b_ada, int b, int j) {
    return b_ada[j] + ((modp[(0 * 2 + b) * 6144 + j] + modp[(1 * 2 + b) * 6144 + j]) + (modp[(2 * 2 + b) * 6144 + j] + modp[(3 * 2 + b) * 6144 + j]));
}

__device__ __forceinline__ int opaque_v(int i) { asm volatile("" : "+v"(i)); return i; }
__device__ __forceinline__ int opaque_i(int i) { asm volatile("" : "+s"(i)); return i; }
__device__ __forceinline__ unsigned char* launder_ws(unsigned char* p) { asm volatile("" : "+s"(p)); return p; }
__global__ void __launch_bounds__(NTHR, 2) mk_fwd(Params P) {
    extern __shared__ __attribute__((aligned(16))) unsigned char lds_raw[];
    LAS unsigned char* lds = (LAS unsigned char*)lds_raw;
    const int tid0 = threadIdx.x;
#define PH_TID const int tid = opaque_v(tid0), lane = tid & 63, wave = __builtin_amdgcn_readfirstlane(tid >> 6); const int bx = opaque_i((int)blockIdx.x), G = (int)gridDim.x, \
        vcu = (G % 8 == 0) ? (bx % 8) * (G / 8) + bx / 8 : bx, gw = vcu * NWAVES + wave, NGW = G * NWAVES; (void)lane; (void)gw; (void)NGW; (void)vcu; (void)bx
    unsigned char* const ws0 = P.ws;
#define WSP(name, type, off) type* name = (type*)(launder_ws(ws0) + (off))
#define INP(name, i) const float* name = P.in[opaque_i(i)]
    LAS int* tab = (LAS int*)(lds + TAB_OFF);

    for (int u = tid0; u < (LDS_BYTES - LDSCTL_OFF) / 4; u += NTHR) ((LAS unsigned*)(lds + LDSCTL_OFF))[u] = 0u;
    __syncthreads();
    XcdBarrier bar = xcd_barrier_post((unsigned*)((gu32*)(ws0 + WS_CTL) + CW_BAR), (volatile LAS unsigned*)(lds + MISC_OFF) + 8);

    if ((int)blockIdx.x < 192) {
        PH_TID;
        INP(cvec, 1); INP(w_ada, 2); WSP(modp, float, WS_MODP);
        LAS float* sl = (LAS float*)lds; LAS float* red = sl + 512;
        for (int it = bx; it < 192; it += G) {
            const int cc = it % 48, kq = it / 48, cl = tid & 127, ks = tid >> 7;
            { const float c0 = cvec[(tid >> 8) * 1024 + kq * 256 + (tid & 255)]; sl[tid] = c0 / (1.f + __expf(-c0)); }
            __syncthreads();
            float a0 = 0.f, a1 = 0.f; const float* wp = w_ada + (size_t)(kq * 256 + ks * 64) * 6144 + cc * 128 + cl;
#pragma unroll 8
            for (int kk = 0; kk < 64; ++kk) { const float w = wp[(size_t)kk * 6144]; a0 += sl[ks * 64 + kk] * w; a1 += sl[256 + ks * 64 + kk] * w; }
            red[(ks * 2 + 0) * 128 + cl] = a0; red[(ks * 2 + 1) * 128 + cl] = a1;
            __syncthreads();
            if (tid < 256) { const int b = tid >> 7; const float v = (red[(0 * 2 + b) * 128 + cl] + red[(1 * 2 + b) * 128 + cl]) + (red[(2 * 2 + b) * 128 + cl] + red[(3 * 2 + b) * 128 + cl]);
                modp[(kq * 2 + b) * 6144 + cc * 128 + cl] = v; }
            __syncthreads();
        }
    }
    for (int rep_ = 0; rep_ <= DUP_P0; ++rep_) {
        PH_TID;
        LAS float* scr = (LAS float*)(lds + RING_OFF + wave * 16384);
        INP(w_in, 6); INP(w_out, 7); INP(w1, 18); INP(w2, 20); WSP(win_t, bf16, WS_WIN); WSP(wout_t, bf16, WS_WOUT); WSP(w1_t, bf16, WS_W1T); WSP(w2_t, bf16, WS_W2T);
        constexpr int I_IN = 16 * 96, I_OUT = 16 * 32, I_W1 = 16 * 64, I_W2 = 16 * 32;
        constexpr int NITEMS = I_IN + I_OUT + NE * (I_W1 + I_W2);
        for (int it = gw; it < NITEMS; it += NGW) {
            int r = it;
            if (r < I_IN) { p0_transpose_item(w_in, D, NPROJ, win_t, 0, scr, r, lane); continue; } r -= I_IN;
            if (r < I_OUT) { p0_transpose_item(w_out, D, D, wout_t, 0, scr, r, lane); continue; } r -= I_OUT;
            if (r < NE * I_W1) { const int e = r / I_W1; p0_transpose_item_f8(w1 + (size_t)e * D * 2048, D, 2048, (unsigned char*)w1_t, e * 2048, scr, r % I_W1, lane, 64.f); continue; } r -= NE * I_W1;
            { const int e = r / I_W2; p0_transpose_item_f8(w2 + (size_t)e * FF * D, FF, D, (unsigned char*)w2_t, e * 1024, scr, r % I_W2, lane, 64.f); }
        }
    }
    xcd_barrier(bar);

    for (int xb_ = 0; xb_ < DUP_BAR; ++xb_) xcd_barrier(bar);
    for (int rep_ = 0; rep_ <= DUP_P1; ++rep_) {
        LAS float* mv = (LAS float*)lds;
        PH_TID;
        INP(x, 0); INP(b_ada, 3); INP(g_pre_mix, 4); WSP(modp, float, WS_MODP); WSP(xn, bf16, WS_XN);
        for (int i = tid; i < 4096; i += NTHR) mv[i] = mod_val(modp, b_ada, i >> 11, i & 2047);
        { WSP(modd, float, WS_MOD); for (int i = vcu * NTHR + tid; i < 2 * 6144; i += G * NTHR) modd[i] = mod_val(modp, b_ada, i / 6144, i % 6144); }
        __syncthreads();
        for (int row = gw; row < M; row += NGW) {
            const int b = row / SEQ; const float* xr = x + (size_t)row * D; const LAS float* sh = mv + b * 2048; const LAS float* sc = sh + 1024;
            f32x4 v[4]; float ss = 0.f;
#pragma unroll
            for (int i = 0; i < 4; ++i) { v[i] = *(const f32x4*)(xr + i * 256 + lane * 4); ss += v[i].x * v[i].x + v[i].y * v[i].y + v[i].z * v[i].z + v[i].w * v[i].w; }
            const float rstd = rsqrtf(wave_sum(ss) * (1.f / D) + RMS_EPS);
#pragma unroll
            for (int i = 0; i < 4; ++i) { const int c0 = i * 256 + lane * 4; float o[4];
#pragma unroll
                for (int e = 0; e < 4; ++e) o[e] = v[i][e] * rstd * g_pre_mix[c0 + e] * (1.f + sc[c0 + e]) + sh[c0 + e];
                uint2 w; w.x = pk2(o[0], o[1]); w.y = pk2(o[2], o[3]); *(uint2*)(xn + (size_t)row * D + c0) = w; }
        }
        __syncthreads();
    }
    xcd_barrier(bar);

    for (int rep_ = 0; rep_ <= DUP_P2; ++rep_) {
        PH_TID; WSP(xn, bf16, WS_XN); WSP(win_t, bf16, WS_WIN); WSP(proj, bf16, WS_PROJ);
        pg8::Gemm g{xn, win_t, M, NPROJ, D}; pg8::StaticOrder S; S.init(M, NPROJ, G, bx);
        WSP(kimg, bf16, WS_KIMG); WSP(vimg, bf16, WS_VIMG);
        pg8::EpiStoreBf16 E{proj, NPROJ, 512, attn_body::C2, 1536, 2048, (unsigned*)((gu32*)(launder_ws(ws0) + WS_CTL) + CW_NRM), kimg, vimg};
        pg8::gemm_phase<pg8::EpiStoreBf16, pg8::StaticOrder, true, true>(lds + RING_OFF, g, S, E);
    }
    xcd_barrier(bar);

    for (int rep_ = 0; rep_ <= DUP_ATT; ++rep_) {
        PH_TID; WSP(proj, bf16, WS_PROJ); WSP(od, bf16, WS_ODIFF);
        gu32* ctl = (gu32*)(launder_ws(ws0) + WS_CTL);
        WSP(kimg, bf16, WS_KIMG); WSP(vimg, bf16, WS_VIMG);
        attn_body::attn_phase<8>((char*)lds_raw, (const attn_body::bf16*)proj, (const attn_body::bf16*)kimg, (const attn_body::bf16*)vimg, (attn_body::bf16*)od, (unsigned*)(ctl + CW_ATTQ) + 64 * rep_, (const unsigned*)(ctl + CW_NRM));
    }
    for (int rep_ = 0; rep_ <= DUP_NAT; ++rep_) {
        PH_TID; INP(rpb, 13); WSP(proj, bf16, WS_PROJ); WSP(concat, bf16, WS_CONCAT);
        attn_body::nat_phase<8>((char*)lds_raw, (const attn_body::bf16*)proj, (attn_body::bf16*)concat, rpb, vcu, G);
    }
    xcd_barrier(bar);

    for (int rep_ = 0; rep_ <= DUP_P4; ++rep_) {
        PH_TID;
        INP(lq1, 8); INP(lk1, 9); INP(lq2, 10); INP(lk2, 11); INP(g_sub, 12); WSP(od, bf16, WS_ODIFF); WSP(concat, bf16, WS_CONCAT);
        float s1 = 0.f, s2 = 0.f;
        for (int i = 0; i < 64; ++i) { s1 += lq1[i] * lk1[i]; s2 += lq2[i] * lk2[i]; }
        const float lam_init = 0.2f, lam = __expf(s1) - __expf(s2) + lam_init;
        for (int row = gw; row < M; row += NGW) {
            const int c0 = lane * 8;
            const v4u a = *(const v4u*)(od + (size_t)row * 512 + c0), bq = *(const v4u*)(od + ((size_t)M + row) * 512 + c0);
            float v[8]; float ss = 0.f;
#pragma unroll
            for (int e = 0; e < 4; ++e) { v[2 * e] = __uint_as_float(a[e] << 16) - lam * __uint_as_float(bq[e] << 16); v[2 * e + 1] = __uint_as_float(a[e] & 0xffff0000u) - lam * __uint_as_float(bq[e] & 0xffff0000u); }
#pragma unroll
            for (int e = 0; e < 8; ++e) ss += v[e] * v[e];
            ss += __shfl_xor(ss, 1); ss += __shfl_xor(ss, 2); ss += __shfl_xor(ss, 4); ss += __shfl_xor(ss, 8);
            const float rstd = rsqrtf(ss * (1.f / 128.f) + RMS_EPS); v4u w;
#pragma unroll
            for (int e = 0; e < 4; ++e) w[e] = pk2(v[2 * e] * rstd * g_sub[(c0 + 2 * e) & 127] * (1.f - lam_init), v[2 * e + 1] * rstd * g_sub[(c0 + 2 * e + 1) & 127] * (1.f - lam_init));
            *(v4u*)(concat + (size_t)row * D + c0) = w;
        }
    }
    xcd_barrier(bar);

    for (int rep_ = 0; rep_ <= DUP_P5; ++rep_) {
        PH_TID; WSP(concat, bf16, WS_CONCAT); WSP(wout_t, bf16, WS_WOUT); WSP(mix, float, WS_MIX);
        pg8::Gemm g{concat, wout_t, M, D, D}; pg8::StaticOrder S; S.init(M, D, G, bx);
        pg8::EpiStoreF32 E{mix, D};
        pg8::gemm_phase<pg8::EpiStoreF32, pg8::StaticOrder, true, true>(lds + RING_OFF, g, S, E);
    }
    xcd_barrier(bar);

    for (int rep_ = 0; rep_ <= DUP_P6; ++rep_) {
        PH_TID;
        INP(x, 0); INP(g_post_mix, 5); INP(g_pre_ffn, 14); INP(w_router, 16); INP(b_router, 17);
        WSP(modd, float, WS_MOD); WSP(mix, float, WS_MIX); WSP(x1, float, WS_X1); WSP(h2, bf16, WS_H2); WSP(topi, int, WS_TOPI); WSP(gate, float, WS_GATE); WSP(hist, int, WS_HIST);
        LAS float* wt = (LAS float*)lds;
        LAS int* ltop = (LAS int*)(lds + LDSCTL_OFF + 4096);
        for (int i = tid; i < 8192; i += NTHR) { const f32x4 w = *(const f32x4*)(w_router + (size_t)i * 4); const int k = i >> 3, e0 = (i & 7) * 4;
            wt[(e0 + 0) * 1024 + k] = w.x; wt[(e0 + 1) * 1024 + k] = w.y; wt[(e0 + 2) * 1024 + k] = w.z; wt[(e0 + 3) * 1024 + k] = w.w; }
        __syncthreads();
        const int my_e = (lane >> 1) & 31; const float my_b = b_router[my_e];
        for (int ch = bx; ch < NCHUNK; ch += G) {
            for (int i8 = 0; i8 < 8; ++i8) {
                const int row = ch * 64 + wave * 8 + i8, b = row / SEQ;
                const float* gt1 = modd + b * 6144 + 2048; const float* sh2 = gt1 + 1024; const float* sc2 = gt1 + 2048;
                f32x4 mvv[4], xv[4]; float ss = 0.f;
#pragma unroll
                for (int i = 0; i < 4; ++i) { mvv[i] = *(const f32x4*)(mix + (size_t)row * D + i * 256 + lane * 4); xv[i] = *(const f32x4*)(x + (size_t)row * D + i * 256 + lane * 4);
                    ss += mvv[i].x * mvv[i].x + mvv[i].y * mvv[i].y + mvv[i].z * mvv[i].z + mvv[i].w * mvv[i].w; }
                float rstd = rsqrtf(wave_sum(ss) * (1.f / D) + RMS_EPS); ss = 0.f;
#pragma unroll
                for (int i = 0; i < 4; ++i) { const int c0 = i * 256 + lane * 4; const f32x4 gg = *(const f32x4*)(gt1 + c0), gp = *(const f32x4*)(g_post_mix + c0);
#pragma unroll
                    for (int e = 0; e < 4; ++e) { xv[i][e] = xv[i][e] + gg[e] * (mvv[i][e] * rstd * gp[e]); ss += xv[i][e] * xv[i][e]; }
                    *(f32x4*)(x1 + (size_t)row * D + c0) = xv[i]; }
                rstd = rsqrtf(wave_sum(ss) * (1.f / D) + RMS_EPS);
                float lg[32];
#pragma unroll
                for (int e = 0; e < 32; ++e) lg[e] = 0.f;
#pragma unroll
                for (int i = 0; i < 4; ++i) { const int c0 = i * 256 + lane * 4; const f32x4 gf = *(const f32x4*)(g_pre_ffn + c0), s2 = *(const f32x4*)(sc2 + c0), h2s = *(const f32x4*)(sh2 + c0); float hv[4];
#pragma unroll
                    for (int j = 0; j < 4; ++j) hv[j] = xv[i][j] * rstd * gf[j] * (1.f + s2[j]) + h2s[j];
                    *(unsigned*)((unsigned char*)h2 + (size_t)row * D + c0) = pk4_fp8(hv[0], hv[1], hv[2], hv[3]);
#pragma unroll
                    for (int e = 0; e < 32; ++e) { const f32x4 wv = *(const LAS f32x4*)(wt + e * 1024 + c0); lg[e] += (hv[0] * wv.x + hv[1] * wv.y) + (hv[2] * wv.z + hv[3] * wv.w); } }
                { const bool b5 = lane & 32, b4 = lane & 16, b3 = lane & 8, b2 = lane & 4, b1 = lane & 2;
#pragma unroll
                  for (int e = 0; e < 16; ++e) { const float keep = b5 ? lg[e + 16] : lg[e], send = b5 ? lg[e] : lg[e + 16]; lg[e] = keep + __shfl_xor(send, 32); }
#pragma unroll
                  for (int e = 0; e < 8; ++e) { const float keep = b4 ? lg[e + 8] : lg[e], send = b4 ? lg[e] : lg[e + 8]; lg[e] = keep + __shfl_xor(send, 16); }
#pragma unroll
                  for (int e = 0; e < 4; ++e) { const float keep = b3 ? lg[e + 4] : lg[e], send = b3 ? lg[e] : lg[e + 4]; lg[e] = keep + __shfl_xor(send, 8); }
#pragma unroll
                  for (int e = 0; e < 2; ++e) { const float keep = b2 ? lg[e + 2] : lg[e], send = b2 ? lg[e] : lg[e + 2]; lg[e] = keep + __shfl_xor(send, 4); }
                  { const float keep = b1 ? lg[1] : lg[0], send = b1 ? lg[0] : lg[1]; lg[0] = keep + __shfl_xor(send, 2); }
                  lg[0] += __shfl_xor(lg[0], 1); }
                float cur = lg[0] + my_b; float tv[4]; int ti[4];
#pragma unroll
                for (int p = 0; p < 4; ++p) { float bv = cur; int bi = my_e;
#pragma unroll
                    for (int o = 1; o < 64; o <<= 1) { const float ov = __shfl_xor(bv, o); const int oi = __shfl_xor(bi, o); const bool take = (ov > bv) || (ov == bv && oi < bi); bv = take ? ov : bv; bi = take ? oi : bi; }
                    tv[p] = bv; ti[p] = bi; cur = (my_e == bi) ? -INFINITY : cur; }
                if (lane == 0) { const float e1 = __expf(tv[1] - tv[0]), e2 = __expf(tv[2] - tv[0]), e3 = __expf(tv[3] - tv[0]); const float rs = 1.f / (1.f + e1 + e2 + e3);
                    *(int4*)(topi + row * 4) = make_int4(ti[0], ti[1], ti[2], ti[3]); *(f32x4*)(gate + row * 4) = (f32x4){rs, e1 * rs, e2 * rs, e3 * rs};
                    const int lr = (wave * 8 + i8) * 4; ltop[lr] = ti[0]; ltop[lr + 1] = ti[1]; ltop[lr + 2] = ti[2]; ltop[lr + 3] = ti[3]; }
            }
            __syncthreads();
            if (tid < 32) { int cnt = 0; for (int i = 0; i < 256; ++i) cnt += (ltop[i] == tid) ? 1 : 0; hist[ch * 32 + tid] = cnt; }
            __syncthreads();
        }
    }
    xcd_barrier(bar);

    for (int rep_ = 0; rep_ <= DUP_P7; ++rep_) {
        LAS int* le = (LAS int*)(lds + 4096); LAS int* ld = (LAS int*)(lds + 8192);
        PH_TID;
        WSP(hist, int, WS_HIST); WSP(topi, int, WS_TOPI); WSP(dest, int, WS_DEST); WSP(h2, bf16, WS_H2); WSP(xbuf, bf16, WS_XBUF); gu32* ctl = (gu32*)(launder_ws(ws0) + WS_CTL);
        for (int ch = bx; ch < NCHUNK; ch += G) {
            if (tid < 32) { int tot = 0, base = 0; for (int c2 = 0; c2 < NCHUNK; ++c2) { const int hv = hist[c2 * 32 + tid]; tot += hv; base += (c2 < ch) ? hv : 0; } tab[32 + tid] = base; tab[tid] = (tot + 255) & ~255; }
            if (tid < 256) le[tid] = topi[ch * 256 + tid];
            __syncthreads();
            if (tid == 0) { int off = 0; for (int e = 0; e < NE; ++e) { const int pad = tab[e]; tab[e] = off;
                    if (ch == 0) for (int tl = 0; tl < pad / 256; ++tl) ctl[CW_TILEEXP + off / 256 + tl] = (unsigned)e;
                    off += pad; }
                if (ch == 0) ctl[CW_TOTAL] = (unsigned)off; }
            __syncthreads();
            if (tid < 256) { const int e = le[tid]; int rank = 0; for (int i = 0; i < tid; ++i) rank += (le[i] == e) ? 1 : 0;
                const int dd = tab[e] + tab[32 + e] + rank; dest[ch * 256 + tid] = dd; ld[tid] = dd; }
            __syncthreads();
            for (int i = 0; i < 32; ++i) { const int a = wave * 32 + i; const int dd = ld[a]; const size_t tok = (size_t)(ch * 256 + a) >> 2;
                const v4u* src = (const v4u*)((const unsigned char*)h2 + tok * D); v4u* dst = (v4u*)((unsigned char*)xbuf + (size_t)dd * D);
                dst[lane] = src[lane]; }
            __syncthreads();
        }
    }
    xcd_barrier(bar);

    {
        PH_TID;
        gu32* ctl = (gu32*)(launder_ws(ws0) + WS_CTL);
        for (int i = tid; i < MAXTILES; i += NTHR) tab[64 + i] = (int)ctl[CW_TILEEXP + i];
        if (tid == 0) tab[352] = (int)ctl[CW_TOTAL];
        __syncthreads();
        const int ntile = __builtin_amdgcn_readfirstlane(tab[352]) >> 8;
        for (int rep_ = 0; rep_ <= DUP_G1; ++rep_) {
            INP(b1, 19); WSP(xbuf, bf16, WS_XBUF); WSP(w1_t, bf16, WS_W1T); WSP(act, bf16, WS_ACT);
            pg8::Gemm g{xbuf, w1_t, CAP, 2048, D}; pg8::MoeOrder<8> S{ntile * 8, G, vcu, (const LAS int*)(tab + 64)};
            pg8::EpiSwiglu E{(unsigned char*)act, b1};
            pg8::gemm_phase<pg8::EpiSwiglu, pg8::MoeOrder<8>, true, true, true>(lds + RING_OFF, g, S, E);
        }
        xcd_barrier(bar);
        for (int rep_ = 0; rep_ <= DUP_G2; ++rep_) {
            INP(b2, 21); WSP(act, bf16, WS_ACT); WSP(w2_t, bf16, WS_W2T); WSP(ybuf, bf16, WS_YBUF);
            pg8::Gemm g{act, w2_t, CAP, 1024, FF}; pg8::MoeOrder<4> S{ntile * 4, G, vcu, (const LAS int*)(tab + 64)};
            pg8::EpiY E{ybuf, b2};
            pg8::gemm_phase<pg8::EpiY, pg8::MoeOrder<4>, true, true, true>(lds + RING_OFF, g, S, E);
        }
    }
    xcd_barrier(bar);

    for (int rep_ = 0; rep_ <= DUP_P10; ++rep_) {
        PH_TID;
        INP(g_post_ffn, 15); WSP(modd, float, WS_MOD); WSP(x1, float, WS_X1); WSP(ybuf, bf16, WS_YBUF); WSP(dest, int, WS_DEST); WSP(gate, float, WS_GATE); float* out = P.out;
        for (int row = gw; row < M; row += NGW) {
            const int b = row / SEQ; const float* gt2 = modd + b * 6144 + 5120;
            float f[16]; float ss = 0.f;
#pragma unroll
            for (int i = 0; i < 16; ++i) f[i] = 0.f;
            const int4 dd = *(const int4*)(dest + row * 4); const f32x4 gg = *(const f32x4*)(gate + row * 4);
            const int dda[4] = {dd.x, dd.y, dd.z, dd.w};
#pragma unroll
            for (int p = 0; p < 4; ++p) { const float gp = gg[p]; const bf16* yr = ybuf + (size_t)dda[p] * D;
#pragma unroll
                for (int i = 0; i < 4; ++i) { const uint2 w = *(const uint2*)(yr + i * 256 + lane * 4);
                    f[i * 4] += gp * __uint_as_float(w.x << 16); f[i * 4 + 1] += gp * __uint_as_float(w.x & 0xffff0000u); f[i * 4 + 2] += gp * __uint_as_float(w.y << 16); f[i * 4 + 3] += gp * __uint_as_float(w.y & 0xffff0000u); } }
#pragma unroll
            for (int i = 0; i < 16; ++i) ss += f[i] * f[i];
            const float rstd = rsqrtf(wave_sum(ss) * (1.f / D) + RMS_EPS);
#pragma unroll
            for (int i = 0; i < 4; ++i) { const int c0 = i * 256 + lane * 4; const f32x4 xv = *(const f32x4*)(x1 + (size_t)row * D + c0); f32x4 ov;
#pragma unroll
                for (int e = 0; e < 4; ++e) ov[e] = xv[e] + gt2[c0 + e] * (f[i * 4 + e] * rstd * g_post_ffn[c0 + e]);
                *(f32x4*)(out + (size_t)row * D + c0) = ov; }
        }
    }
}

extern "C" void kernel_launch(void* const* d_in, const int* in_sizes, int n_in, void* d_out, int out_size, void* d_ws, size_t ws_size, hipStream_t stream) {
    static int grid = 0;
    if (grid == 0) {
        if (n_in != 22 || ws_size < WS_END) { fprintf(stderr, "kernel_launch: unexpected n_in %d / ws %zu\n", n_in, ws_size); grid = -1; return; }
        int dev = 0, cus = 0, per_cu = 0;
        if (hipGetDevice(&dev) != hipSuccess || hipDeviceGetAttribute(&cus, hipDeviceAttributeMultiprocessorCount, dev) != hipSuccess) { grid = -1; return; }
        if (hipFuncSetAttribute((const void*)mk_fwd, hipFuncAttributeMaxDynamicSharedMemorySize, LDS_BYTES) != hipSuccess) { fprintf(stderr, "kernel_launch: hipFuncSetAttribute failed\n"); grid = -1; return; }
        if (hipOccupancyMaxActiveBlocksPerMultiprocessor(&per_cu, (const void*)mk_fwd, NTHR, LDS_BYTES) != hipSuccess || per_cu < 1) { fprintf(stderr, "kernel_launch: occupancy query says %d\n", per_cu); }
        (void)hipGetLastError();
        grid = cus;
    }
    if (grid < 0) return;
    if (hipMemsetAsync((char*)d_ws + WS_CTL, 0, 1 * MiB, stream) != hipSuccess) return;
    Params p{};
    for (int i = 0; i < 22; ++i) p.in[i] = (const float*)d_in[i];
    p.out = (float*)d_out; p.ws = (unsigned char*)d_ws;
    hipLaunchKernelGGL(mk_fwd, dim3(grid), dim3(NTHR), LDS_BYTES, stream, p);
}
```

```cpp
#include <hip/hip_runtime.h>
#include <stdint.h>
#include <stdio.h>

#define GAS __attribute__((address_space(1)))
#define LAS __attribute__((address_space(3)))
typedef unsigned short bf16;
typedef unsigned v4u __attribute__((ext_vector_type(4)));
typedef float f32x4 __attribute__((ext_vector_type(4)));
typedef GAS unsigned gu32;
#define LDS_WAIT() asm volatile("s_waitcnt lgkmcnt(0)" ::: "memory")
#define VM_WAIT() asm volatile("s_waitcnt vmcnt(0)" ::: "memory")

#define DUP_P0 0
#define DUP_ATT 0
#define DUP_NAT 0
#define DUP_G1 0
#define DUP_G2 0
#define DUP_P2 0
#define DUP_P5 0
#define DUP_P1 0
#define DUP_P4 0
#define DUP_BAR 0
#define DUP_P6 0
#define DUP_P7 0
#define DUP_P10 0
constexpr int NB = 2, SEQ = 8192, D = 1024, M = NB * SEQ;
constexpr int NPROJ = 3072, NE = 32, TOPK = 4, FF = 1024;
constexpr int NASSIGN = M * TOPK;
constexpr int CAP = NASSIGN + NE * 256;
constexpr int MAXTILES = CAP / 256;
constexpr int NCHUNK = M / 64;
constexpr float RMS_EPS = 1e-6f;
constexpr int NWAVES = 8, NTHR = 512;

constexpr size_t MiB = 1u << 20;
constexpr size_t WS_CTL = 0;
constexpr size_t WS_MODP = 1 * MiB;
constexpr size_t WS_MOD = 1 * MiB + 512 * 1024;
constexpr size_t WS_HIST = 2 * MiB;
constexpr size_t WS_TOPI = 3 * MiB;
constexpr size_t WS_GATE = 3 * MiB + 512 * 1024;
constexpr size_t WS_DEST = 4 * MiB;
constexpr size_t WS_WIN = 6 * MiB;
constexpr size_t WS_WOUT = 12 * MiB;
constexpr size_t WS_XN = 16 * MiB;
constexpr size_t WS_PROJ = 48 * MiB;
constexpr size_t WS_ODIFF = 144 * MiB;
constexpr size_t WS_XBUF = 48 * MiB;
constexpr size_t WS_CONCAT = 208 * MiB;
constexpr size_t WS_MIX = 240 * MiB;
constexpr size_t WS_X1 = 304 * MiB;
constexpr size_t WS_H2 = 368 * MiB;
constexpr size_t WS_ACT = 400 * MiB;
constexpr size_t WS_YBUF = 544 * MiB;
constexpr size_t WS_W1T = 688 * MiB;
constexpr size_t WS_W2T = 816 * MiB;
constexpr size_t WS_KIMG = 880 * MiB;
constexpr size_t WS_VIMG = 896 * MiB;
constexpr size_t WS_END = 912 * MiB;
static_assert(WS_XBUF + (size_t)CAP * D * 2 <= WS_CONCAT, "XBUF overlay");
constexpr int CW_TOTAL = 64;
constexpr int CW_TILEEXP = 128;
constexpr int CW_NRM = 512;
constexpr int CW_ATTQ = 1024;
constexpr int CW_CONVQ = 2048;
constexpr int CW_BAR = 4096;

constexpr int RING_OFF = 0, RING_BYTES = 131072;
constexpr int LDSCTL_OFF = RING_BYTES, MISC_OFF = LDSCTL_OFF + 320, TAB_OFF = LDSCTL_OFF + 1024;
constexpr int LDS_BYTES = 147456;

__device__ __forceinline__ float bf2f(bf16 v) { return __uint_as_float(((unsigned)v) << 16); }
__device__ __forceinline__ unsigned f2bf(float f) { unsigned u = __builtin_bit_cast(unsigned, f); return (u + 0x7fffu + ((u >> 16) & 1u)) >> 16; }
__device__ __forceinline__ unsigned pk2(float lo, float hi) { return f2bf(lo) | (f2bf(hi) << 16); }
namespace pg8 {
#define PG8_LAS __attribute__((address_space(3)))
typedef unsigned short bf16_t;
typedef short bf16x8 __attribute__((ext_vector_type(8)));
typedef float f32x4 __attribute__((ext_vector_type(4)));
typedef unsigned u32x4 __attribute__((ext_vector_type(4)));
constexpr int BM = 256, BK = 64, HALF = 128, HTB = HALF * BK * 2  , STAGE_BYTES = 8 * HTB, NXCD = 8, WGM = 8;

__host__ __device__ __forceinline__ int lds_byte(int r, int c) { const int st = (r >> 4) * 2 + (c >> 5), rr = r & 15, cc = c & 31, ob = rr * 64 + cc * 2; return st * 1024 + (ob ^ (((ob >> 9) & 1) << 5)); }
__host__ __device__ __forceinline__ void stage_rc(int b, int& R, int& C) { const int st = b / 1024, sb = b % 1024, swz = sb ^ (((sb >> 9) & 1) << 5); R = (st >> 1) * 16 + swz / 64; C = (st & 1) * 32 + (swz % 64) / 2; }
__host__ __device__ __forceinline__ int perm32(int rho) { const int n = rho >> 4, i = rho & 15; return 8 * (i >> 2) + 4 * n + (i & 3); }

struct Unit { int pm, pn; };
struct Gemm { const bf16_t* A; const bf16_t* Bt; int M, N, K; };

struct StaticOrder {
    int nM, nN, nwg, G, c;
    __host__ __device__ void init(int M, int N, int G_, int c_) { nM = M / BM; nN = N / BM; nwg = nM * nN; G = G_; c = c_; }
    __host__ __device__ bool next(int i, Unit& u) const {
        const long L = (long)i * G + c; if (L >= nwg) return false;
        int wgid = (int)L; { const int q = nwg / NXCD, r = nwg % NXCD, xcd = wgid % NXCD, off = wgid / NXCD; wgid = (xcd < r ? xcd * (q + 1) : r * (q + 1) + (xcd - r) * q) + off; }
        const int nig = WGM * nN, gid = wgid / nig, fm = gid * WGM, gsz = (nM - fm) < WGM ? (nM - fm) : WGM;
        u.pm = fm + ((wgid % nig) % gsz); u.pn = (wgid % nig) / gsz; return true;
    }
    __device__ __forceinline__ void a_ready(const Unit&) const {}
    __device__ __forceinline__ void done(const Unit&) const {}
};

__device__ __forceinline__ unsigned cvt_pk_bf16(float lo, float hi) { unsigned r; asm volatile("v_cvt_pk_bf16_f32 %0, %1, %2" : "=v"(r) : "v"(lo), "v"(hi)); return r; }
struct EpiStoreBf16 {
    static constexpr bool PERM = true, AFTER_DRAIN = false;
    bf16_t* O; int ldc; int scale_cols; float scale0; int s2lo, s2hi; unsigned* nrm; bf16_t* kimg; bf16_t* vimg;
    __device__ __forceinline__ void operator()(const f32x4 (&acc)[2][2][4][2], const Unit& u, int wr, int wc, int fr, int fq) const {
        const int row0 = u.pm * BM + wr * 64 + fr, colt = u.pn * BM, col0 = colt + wc * 32 + 8 * fq; const float sc = (colt < scale_cols || (colt >= s2lo && colt < s2hi)) ? scale0 : 1.f;
        const bool isk = (colt >= 512 && colt < 1024), isv = (colt >= 1024 && colt < 1536);
        float mx[2] = {0.f, 0.f};
#pragma unroll
        for (int ai = 0; ai < 2; ++ai)
#pragma unroll
            for (int m = 0; m < 4; ++m) { const int row = row0 + ai * HALF + m * 16; bf16_t* rowp = O + (size_t)row * ldc + col0;
                const int b = row >> 13, tile = (row & 8191) >> 6, rr = row & 63;
#pragma unroll
                for (int bj = 0; bj < 2; ++bj) { const f32x4 v0 = acc[ai][bj][m][0] * sc, v1 = acc[ai][bj][m][1] * sc;
                    u32x4 w; w.x = cvt_pk_bf16(v0[0], v0[1]); w.y = cvt_pk_bf16(v0[2], v0[3]); w.z = cvt_pk_bf16(v1[0], v1[1]); w.w = cvt_pk_bf16(v1[2], v1[3]);
                    if (isk) { const int c = col0 + bj * HALF - 512, hm = c >> 6, chunk = (c & 63) >> 3;
                        *(u32x4*)(kimg + ((size_t)((b * 8 + hm) * 128 + tile) * 4096 + chunk * 512 + rr * 8)) = w; }
                    else if (isv) { const int c = col0 + bj * HALF - 1024, h = c >> 7, e = c & 127;
                        *(u32x4*)(vimg + ((size_t)((b * 4 + h) * 128 + tile) * 8192 + (e >> 5) * 2048 + rr * 32 + (e & 31))) = w; }
                    else *(u32x4*)(rowp + bj * HALF) = w;
                    if (colt < 1024) { float s = 0.f;
#pragma unroll
                        for (int j = 0; j < 4; ++j) { const float lo = __uint_as_float(w[j] << 16), hi = __uint_as_float(w[j] & 0xffff0000u); s += lo * lo + hi * hi; }
                        s += __shfl_xor(s, 16); s += __shfl_xor(s, 32); mx[bj] = fmaxf(mx[bj], s); } } }
        if (colt < 1024) {
#pragma unroll
            for (int bj = 0; bj < 2; ++bj) { float v = mx[bj]; v = fmaxf(v, __shfl_xor(v, 1)); v = fmaxf(v, __shfl_xor(v, 2)); v = fmaxf(v, __shfl_xor(v, 4)); v = fmaxf(v, __shfl_xor(v, 8));
                if (fr == 0 && fq == 0) { const int g = (colt + bj * HALF + wc * 32) >> 6, b = u.pm >> 5; atomicMax(nrm + ((b * 16 + g) * 2 + (wc & 1)), __float_as_uint(v)); } }
        }
    }
};
struct EpiStoreF32 {
    static constexpr bool PERM = true, AFTER_DRAIN = false;
    float* O; int ldc;
    __device__ __forceinline__ void operator()(const f32x4 (&acc)[2][2][4][2], const Unit& u, int wr, int wc, int fr, int fq) const {
        const int row0 = u.pm * BM + wr * 64 + fr, col0 = u.pn * BM + wc * 32 + 8 * fq;
#pragma unroll
        for (int ai = 0; ai < 2; ++ai)
#pragma unroll
            for (int m = 0; m < 4; ++m) { float* rowp = O + (size_t)(row0 + ai * HALF + m * 16) * ldc + col0;
#pragma unroll
                for (int bj = 0; bj < 2; ++bj) { *(f32x4*)(rowp + bj * HALF) = acc[ai][bj][m][0]; *(f32x4*)(rowp + bj * HALF + 4) = acc[ai][bj][m][1]; } }
    }
};
struct EpiSwiglu {
    static constexpr bool PERM = true, AFTER_DRAIN = false;
    unsigned char* act; const float* b1;
    __device__ __forceinline__ void operator()(const f32x4 (&acc)[2][2][4][2], const Unit& u, int wr, int wc, int fr, int fq) const {
        const int e = u.pn >> 3, pnl = u.pn & 7, row0 = u.pm * BM + wr * 64 + fr, hc0 = pnl * BM + wc * 32 + 8 * fq;
        f32x4 bv[2][2];
#pragma unroll
        for (int bj = 0; bj < 2; ++bj)
#pragma unroll
            for (int n = 0; n < 2; ++n) bv[bj][n] = *(const f32x4*)(b1 + e * 2048 + hc0 + bj * HALF + 4 * n);
#pragma unroll
        for (int ai = 0; ai < 2; ++ai)
#pragma unroll
            for (int m = 0; m < 4; ++m) { unsigned char* rowp = act + (size_t)(row0 + ai * HALF + m * 16) * 1024 + (hc0 >> 1);
#pragma unroll
                for (int bj = 0; bj < 2; ++bj) { const f32x4 v0 = acc[ai][bj][m][0] + bv[bj][0], v1 = acc[ai][bj][m][1] + bv[bj][1];
                    float r[4];
                    const float gg[4] = {v0[0], v0[2], v1[0], v1[2]}, ll[4] = {v0[1], v0[3], v1[1], v1[3]};
#pragma unroll
                    for (int p = 0; p < 4; ++p) { float g = gg[p], l = ll[p];
                        g = fminf(g, 7.f); l = fminf(fmaxf(l, -7.f), 7.f);
                        r[p] = g * __builtin_amdgcn_rcpf(1.f + __expf(-1.702f * g)) * (l + 1.f); }
                    int w = 0; w = __builtin_amdgcn_cvt_pk_fp8_f32(r[0], r[1], w, false); w = __builtin_amdgcn_cvt_pk_fp8_f32(r[2], r[3], w, true);
                    *(int*)(rowp + bj * (HALF / 2)) = w; } }
    }
};
struct EpiY {
    static constexpr bool PERM = true, AFTER_DRAIN = false;
    bf16_t* y; const float* b2;
    __device__ __forceinline__ void operator()(const f32x4 (&acc)[2][2][4][2], const Unit& u, int wr, int wc, int fr, int fq) const {
        const int e = u.pn >> 2, pnl = u.pn & 3, row0 = u.pm * BM + wr * 64 + fr, col0 = pnl * BM + wc * 32 + 8 * fq;
        f32x4 bv[2][2];
#pragma unroll
        for (int bj = 0; bj < 2; ++bj)
#pragma unroll
            for (int n = 0; n < 2; ++n) bv[bj][n] = *(const f32x4*)(b2 + e * 1024 + col0 + bj * HALF + 4 * n);
#pragma unroll
        for (int ai = 0; ai < 2; ++ai)
#pragma unroll
            for (int m = 0; m < 4; ++m) { bf16_t* rowp = y + (size_t)(row0 + ai * HALF + m * 16) * 1024 + col0;
#pragma unroll
                for (int bj = 0; bj < 2; ++bj) { const f32x4 v0 = acc[ai][bj][m][0] + bv[bj][0], v1 = acc[ai][bj][m][1] + bv[bj][1];
                    u32x4 w; w.x = cvt_pk_bf16(v0[0], v0[1]); w.y = cvt_pk_bf16(v0[2], v0[3]); w.z = cvt_pk_bf16(v1[0], v1[1]); w.w = cvt_pk_bf16(v1[2], v1[3]);
                    *(u32x4*)(rowp + bj * HALF) = w; } }
    }
};
template <int NN> struct MoeOrder {
    int nunit, G, c; const PG8_LAS int* texp;
    __device__ __forceinline__ bool next(int i, Unit& u) const {
        const int L = i * G + c; if (L >= nunit) return false;
        const int pm = L / NN, pnl = L % NN; u.pm = pm; u.pn = __builtin_amdgcn_readfirstlane(texp[pm]) * NN + pnl; return true;
    }
    __device__ __forceinline__ void a_ready(const Unit&) const {}
    __device__ __forceinline__ void done(const Unit&) const {}
};
typedef int i32x4_t __attribute__((ext_vector_type(4))); typedef int i32x8_t __attribute__((ext_vector_type(8)));
__device__ __forceinline__ void pg8_glds16(const void* sbase, unsigned voff, unsigned lds_dst) { unsigned keep;
    asm volatile("s_mov_b32 %0, m0\n\ts_mov_b32 m0, %3\n\ts_nop 0\n\tglobal_load_lds_dwordx4 %1, %2\n\ts_mov_b32 m0, %0" : "=&s"(keep) : "v"(voff), "s"(sbase), "s"(lds_dst) : "memory"); }
template <class Epi, class Sched, bool ALIGN_EPI = false, bool SP2 = false, bool FP8 = false>
__device__ __forceinline__ void gemm_phase(PG8_LAS unsigned char* lds, const Gemm g, const Sched& S, const Epi& E) {
    int tid_ = threadIdx.x; asm volatile("" : "+v"(tid_));
    const int tid = tid_, wid = __builtin_amdgcn_readfirstlane(tid >> 6), lane = tid & 63, wr = wid >> 2, wc = wid & 3, fr = lane & 15, fq = lane >> 4;
    const int K = g.K, KB = FP8 ? K : 2 * K, nt = KB / (BK * 2);
    unsigned voffA[2], voffB[2];
#pragma unroll
    for (int i = 0; i < 2; ++i) { int R, C; stage_rc(tid * 16 + i * 8192, R, C); const int Rb = Epi::PERM ? ((R & ~31) + perm32(R & 31)) : R;
        voffA[i] = (unsigned)(R * KB + C * 2); voffB[i] = (unsigned)(Rb * KB + C * 2); }
    const size_t kstep = (size_t)(BK * 2);
    const size_t hstep = (size_t)HALF * KB;
    const size_t tstep = 2 * hstep;
    const unsigned ldsb = (unsigned)(uintptr_t)lds;
    const unsigned ldsw = (unsigned)wid * 1024u; const unsigned ldsbw = (unsigned)__builtin_amdgcn_readfirstlane(ldsb + ldsw);
    const int aoff = lds_byte(wr * 64 + fr, fq * 8), boff = lds_byte(wc * 32 + fr, fq * 8);
#define PG8_CAT(x, y) __builtin_shufflevector(__builtin_bit_cast(i32x4_t, x), __builtin_bit_cast(i32x4_t, y), 0, 1, 2, 3, 4, 5, 6, 7)
#define PG8_SA(b, h) (((b) * 2 + (h)) * HTB)
#define PG8_SB(b, h) ((4 + (b) * 2 + (h)) * HTB)
#define PG8_STAGE(bufoff, gbase, voff) do { _Pragma("unroll") for (int _i = 0; _i < 2; ++_i) \
        pg8_glds16((const void*)(gbase), (voff)[_i], ldsbw + (unsigned)((bufoff) + _i * 8192)); } while (0)
#define PG8_LDA(dst, b, h) do { if constexpr (FP8) { _Pragma("unroll") for (int m = 0; m < 4; ++m) dst##8[m] = PG8_CAT(*(const PG8_LAS bf16x8*)(lds + PG8_SA(b, h) + aoff + m * 2048), *(const PG8_LAS bf16x8*)(lds + PG8_SA(b, h) + aoff + m * 2048 + 1024)); } \
    else { _Pragma("unroll") for (int m = 0; m < 4; ++m) _Pragma("unroll") for (int k = 0; k < 2; ++k) dst[m][k] = *(const PG8_LAS bf16x8*)(lds + PG8_SA(b, h) + aoff + m * 2048 + k * 1024); } } while (0)
#define PG8_LDB(dst, b, h) do { if constexpr (FP8) { _Pragma("unroll") for (int n = 0; n < 2; ++n) dst##8[n] = PG8_CAT(*(const PG8_LAS bf16x8*)(lds + PG8_SB(b, h) + boff + n * 2048), *(const PG8_LAS bf16x8*)(lds + PG8_SB(b, h) + boff + n * 2048 + 1024)); } \
    else { _Pragma("unroll") for (int n = 0; n < 2; ++n) _Pragma("unroll") for (int k = 0; k < 2; ++k) dst[n][k] = *(const PG8_LAS bf16x8*)(lds + PG8_SB(b, h) + boff + n * 2048 + k * 1024); } } while (0)
#define PG8_MMA(ai, bj, At, Bt) do { __builtin_amdgcn_s_setprio(1); if constexpr (FP8) { _Pragma("unroll") for (int m = 0; m < 4; ++m) _Pragma("unroll") for (int n = 0; n < 2; ++n) \
        acc[ai][bj][m][n] = __builtin_amdgcn_mfma_scale_f32_16x16x128_f8f6f4(Bt##8[n], At##8[m], acc[ai][bj][m][n], 0, 0, 0, 0x7c7c7c7c, 0, 0x7c7c7c7c); } \
    else { _Pragma("unroll") for (int m = 0; m < 4; ++m) _Pragma("unroll") for (int n = 0; n < 2; ++n) _Pragma("unroll") for (int k = 0; k < 2; ++k) \
        acc[ai][bj][m][n] = __builtin_amdgcn_mfma_f32_16x16x32_bf16(Bt[n][k], At[m][k], acc[ai][bj][m][n], 0, 0, 0); } __builtin_amdgcn_s_setprio(0); } while (0)
#define PG8_WAIT_V(n) asm volatile("s_waitcnt vmcnt(" #n ")" ::: "memory")
#define PG8_WAIT_L(n) asm volatile("s_waitcnt lgkmcnt(" #n ")" ::: "memory")
#define PG8_BAR __builtin_amdgcn_s_barrier()
#define PG8_SCHED __builtin_amdgcn_sched_barrier(0)
    Unit cur, nxt; int ui = 0;
    if (!S.next(0, cur)) return;
    f32x4 acc[2][2][4][2];
#pragma unroll
    for (int a = 0; a < 2; ++a)
#pragma unroll
        for (int b = 0; b < 2; ++b)
#pragma unroll
            for (int m = 0; m < 4; ++m)
#pragma unroll
                for (int n = 0; n < 2; ++n) acc[a][b][m][n] = (f32x4){0.f, 0.f, 0.f, 0.f};
    bf16x8 At[4][2], B0[2][2], B1[2][2]; i32x8_t At8[4], B08[2], B18[2];
    const char* cA = (const char*)g.A + (size_t)cur.pm * tstep; const char* cB = (const char*)g.Bt + (size_t)cur.pn * tstep;
    S.a_ready(cur);
    if constexpr (SP2) {
        PG8_STAGE(PG8_SB(0, 0), cB, voffB); PG8_STAGE(PG8_SB(0, 1), cB + hstep, voffB); PG8_STAGE(PG8_SA(0, 0), cA, voffA); PG8_STAGE(PG8_SA(0, 1), cA + hstep, voffA);
        if (wr == 1) PG8_BAR;
        PG8_WAIT_V(2); PG8_BAR;
        PG8_STAGE(PG8_SB(1, 0), cB + kstep, voffB); PG8_STAGE(PG8_SA(1, 0), cA + kstep, voffA); PG8_STAGE(PG8_SB(1, 1), cB + hstep + kstep, voffB);
        PG8_WAIT_V(6); PG8_BAR;
    } else {
        PG8_STAGE(PG8_SB(0, 0), cB, voffB); PG8_STAGE(PG8_SA(0, 0), cA, voffA); PG8_STAGE(PG8_SB(0, 1), cB + hstep, voffB); PG8_STAGE(PG8_SA(0, 1), cA + hstep, voffA);
        if (wr == 1) PG8_BAR;
        PG8_WAIT_V(4); PG8_BAR;
        PG8_STAGE(PG8_SB(1, 0), cB + kstep, voffB); PG8_STAGE(PG8_SA(1, 0), cA + kstep, voffA); PG8_STAGE(PG8_SB(1, 1), cB + hstep + kstep, voffB);
        PG8_WAIT_V(6); PG8_BAR;
    }
    for (;;) {
        const bool has_next = S.next(ui + 1, nxt);
        const char* nA = has_next ? (const char*)g.A + (size_t)nxt.pm * tstep : cA; const char* nB = has_next ? (const char*)g.Bt + (size_t)nxt.pn * tstep : cB;
#pragma clang loop unroll(disable)
        for (int t = 0; t < nt; t += 2) {
            const bool last = (t == nt - 2);
            const char* a1 = cA + (size_t)(t + 1) * kstep;
            const char* a2 = last ? nA : cA + (size_t)(t + 2) * kstep; const char* b2 = last ? nB : cB + (size_t)(t + 2) * kstep;
            const char* a3 = a2 + kstep; const char* b3 = b2 + kstep;
            if (last && has_next) S.a_ready(nxt);
            if constexpr (SP2) {
            PG8_LDB(B0, 0, 0); PG8_LDB(B1, 0, 1); PG8_SCHED; PG8_LDA(At, 0, 0); PG8_STAGE(PG8_SA(1, 1), a1 + hstep, voffA);
            PG8_WAIT_V(8); PG8_WAIT_L(0); PG8_BAR; PG8_MMA(0, 0, At, B0); PG8_MMA(0, 1, At, B1); PG8_BAR; PG8_SCHED;
            PG8_LDA(At, 0, 1); PG8_STAGE(PG8_SB(0, 0), b2, voffB); PG8_STAGE(PG8_SB(0, 1), b2 + hstep, voffB); PG8_STAGE(PG8_SA(0, 0), a2, voffA);
            PG8_WAIT_V(8); PG8_WAIT_L(0); PG8_BAR; PG8_MMA(1, 0, At, B0); PG8_MMA(1, 1, At, B1); PG8_BAR; PG8_SCHED;
            PG8_LDB(B0, 1, 0); PG8_LDB(B1, 1, 1); PG8_SCHED; PG8_LDA(At, 1, 0); PG8_STAGE(PG8_SA(0, 1), a2 + hstep, voffA);
            PG8_WAIT_V(8); PG8_WAIT_L(0); PG8_BAR; PG8_MMA(0, 0, At, B0); PG8_MMA(0, 1, At, B1); PG8_BAR; PG8_SCHED;
            PG8_LDA(At, 1, 1); PG8_STAGE(PG8_SB(1, 0), b3, voffB); PG8_STAGE(PG8_SB(1, 1), b3 + hstep, voffB); PG8_STAGE(PG8_SA(1, 0), a3, voffA);
            PG8_WAIT_V(8); PG8_WAIT_L(0); PG8_BAR; PG8_MMA(1, 0, At, B0); PG8_MMA(1, 1, At, B1); PG8_BAR; PG8_SCHED;
            } else {
            PG8_LDB(B0, 0, 0); PG8_SCHED; PG8_LDA(At, 0, 0); PG8_STAGE(PG8_SA(1, 1), a1 + hstep, voffA);
            PG8_WAIT_L(8); PG8_BAR; PG8_WAIT_L(0); PG8_MMA(0, 0, At, B0); PG8_BAR; PG8_SCHED;
            PG8_LDB(B1, 0, 1); PG8_STAGE(PG8_SB(0, 0), b2, voffB);
            PG8_BAR; PG8_WAIT_L(0); PG8_MMA(0, 1, At, B1); PG8_BAR;
            PG8_LDA(At, 0, 1); PG8_STAGE(PG8_SA(0, 0), a2, voffA);
            PG8_BAR; PG8_WAIT_L(0); PG8_MMA(1, 0, At, B0); PG8_BAR; PG8_SCHED;
            PG8_STAGE(PG8_SB(0, 1), b2 + hstep, voffB);
            PG8_WAIT_V(6); PG8_BAR; PG8_MMA(1, 1, At, B1); PG8_BAR;
            PG8_LDB(B0, 1, 0); PG8_SCHED; PG8_LDA(At, 1, 0); PG8_STAGE(PG8_SA(0, 1), a2 + hstep, voffA);
            PG8_WAIT_L(8); PG8_BAR; PG8_WAIT_L(0); PG8_MMA(0, 0, At, B0); PG8_BAR; PG8_SCHED;
            PG8_LDB(B1, 1, 1); PG8_STAGE(PG8_SB(1, 0), b3, voffB);
            PG8_BAR; PG8_WAIT_L(0); PG8_MMA(0, 1, At, B1); PG8_BAR;
            PG8_LDA(At, 1, 1); PG8_STAGE(PG8_SA(1, 0), a3, voffA);
            PG8_BAR; PG8_WAIT_L(0); PG8_MMA(1, 0, At, B0); PG8_BAR; PG8_SCHED;
            PG8_STAGE(PG8_SB(1, 1), b3 + hstep, voffB);
            PG8_WAIT_V(6); PG8_BAR; PG8_MMA(1, 1, At, B1); PG8_BAR;
            }
        }
        if constexpr (ALIGN_EPI) { if (wr == 0) PG8_BAR; }
        if constexpr (!Epi::AFTER_DRAIN) { int t2_ = threadIdx.x; asm volatile("" : "+v"(t2_)); const int l2_ = t2_ & 63;
            E(acc, cur, wr, wc, l2_ & 15, l2_ >> 4); S.done(cur); }
        if (!has_next) break;
#pragma unroll
        for (int a = 0; a < 2; ++a)
#pragma unroll
            for (int b = 0; b < 2; ++b)
#pragma unroll
                for (int m = 0; m < 4; ++m)
#pragma unroll
                    for (int n = 0; n < 2; ++n) acc[a][b][m][n] = (f32x4){0.f, 0.f, 0.f, 0.f};
        cur = nxt; cA = nA; cB = nB; ++ui;
        if constexpr (ALIGN_EPI) { if (wr == 1) PG8_BAR; }
    }
    PG8_WAIT_V(0);
    if constexpr (!ALIGN_EPI) { if (wr == 0) PG8_BAR; }
    PG8_BAR;
    if constexpr (Epi::AFTER_DRAIN) { E.fused(acc, cur, wr, wc, fr, fq, lds, wid, lane); S.done(cur); }
#undef PG8_SA
#undef PG8_SB
#undef PG8_STAGE
#undef PG8_LDA
#undef PG8_LDB
#undef PG8_MMA
#undef PG8_CAT
#undef PG8_WAIT_V
#undef PG8_WAIT_L
#undef PG8_BAR
#undef PG8_SCHED
}
}
#include <hip/hip_bf16.h>
#include <cmath>
namespace attn_body {
using bf16=__hip_bfloat16;
using bf16x8=__attribute__((ext_vector_type(8)))short;
using s16x4=__attribute__((ext_vector_type(4)))short;
using f32x16=__attribute__((ext_vector_type(16)))float;
using u32x4=__attribute__((ext_vector_type(4)))unsigned;
constexpr int SEQ=8192,D=64,QP=3072,KP=3072,OP=512;
constexpr int NW=8,QBLK=32,QB=QBLK*NW,KVBLK=64,NQB=SEQ/QB;
constexpr int ATTN_UNIT_ROWS=QB;
__device__ __forceinline__ int crow(int r,int hi){return (r&3)+8*(r>>2)+4*hi;}
#define SBAR() __builtin_amdgcn_sched_barrier(0)
__device__ __forceinline__ void cmask(f32x16&p0,f32x16&p1,int jb,int qrel,int hi){
  const float NEG=-INFINITY; int kb=64*jb+4*hi;
  #pragma unroll
  for(int r=0;r<16;++r){int kv=kb+(r&3)+8*(r>>2); if(kv>qrel)p0[r]=NEG; if(kv+32>qrel)p1[r]=NEG;}
}

constexpr int NSLOT=3, SLOTB=8192;
constexpr int LDS_K=0, LDS_V=NSLOT*SLOTB, LDS_WS=2*NSLOT*SLOTB, LDS_OST=LDS_WS+NW*64*4, LDS_TB=LDS_OST+NW*4096+4096, LDS_BYTES=LDS_TB+4096;
constexpr float C2=0.125f*1.4426950408889634f;
__device__ __forceinline__ void glds16(const void*gsrc,unsigned lds_dst){unsigned keep;
  asm volatile("s_mov_b32 %0, m0\n\ts_mov_b32 m0, %2\n\ts_nop 0\n\tglobal_load_lds_dwordx4 %1, off\n\ts_mov_b32 m0, %0":"=&s"(keep):"v"(gsrc),"s"(lds_dst):"memory");}
__device__ __forceinline__ float max3f(float a,float b,float c){float r;asm("v_max3_f32 %0, %1, %2, %3":"=v"(r):"v"(a),"v"(b),"v"(c));return r;}
__device__ __forceinline__ float max2f(float a,float b){float r;asm("v_max_f32_e32 %0, %1, %2":"=v"(r):"v"(a),"v"(b));return r;}
__device__ __forceinline__ float fadd_s(float a,float b){float r;asm("v_add_f32_e32 %0, %1, %2":"=v"(r):"v"(a),"v"(b));return r;}
__device__ __forceinline__ float fsub_s(float a,float b){float r;asm("v_sub_f32_e32 %0, %1, %2":"=v"(r):"v"(a),"v"(b));return r;}
typedef float f32x2_t __attribute__((ext_vector_type(2))); typedef __bf16 bf16x2_t __attribute__((ext_vector_type(2)));
__device__ __forceinline__ unsigned cvtpk_s(float lo,float hi){f32x2_t v={lo,hi};bf16x2_t b=__builtin_convertvector(v,bf16x2_t);return __builtin_bit_cast(unsigned,b);}
#define WAIT_BAR(N) asm volatile("s_waitcnt vmcnt(" #N ") lgkmcnt(0)\n\ts_barrier":::"memory")

__device__ __forceinline__ void qkt(f32x16&p0,f32x16&p1,const char*Kslot,const bf16x8*qr,const f32x16&negm,int r32,int hi){
  const char*kb=Kslot+hi*1024+r32*16;
  #pragma unroll
  for(int d0=0;d0<4;++d0){
    const bf16x8 b0=*reinterpret_cast<const bf16x8*>(kb+d0*2048);
    const bf16x8 b1=*reinterpret_cast<const bf16x8*>(kb+d0*2048+512);
    if(d0==0){p0=__builtin_amdgcn_mfma_f32_32x32x16_bf16(b0,qr[0],negm,0,0,0);p1=__builtin_amdgcn_mfma_f32_32x32x16_bf16(b1,qr[0],negm,0,0,0);}
    else{p0=__builtin_amdgcn_mfma_f32_32x32x16_bf16(b0,qr[d0],p0,0,0,0);p1=__builtin_amdgcn_mfma_f32_32x32x16_bf16(b1,qr[d0],p1,0,0,0);}}
}
typedef __attribute__((address_space(3))) const char* lds_cptr;
typedef short v4i16_t __attribute__((ext_vector_type(4)));
__device__ __forceinline__ void kload8(bf16x8*kf,lds_cptr kp){
  kf[0]=*(const __attribute__((address_space(3))) bf16x8*)(kp);      kf[1]=*(const __attribute__((address_space(3))) bf16x8*)(kp+512);
  kf[2]=*(const __attribute__((address_space(3))) bf16x8*)(kp+2048); kf[3]=*(const __attribute__((address_space(3))) bf16x8*)(kp+2560);
  kf[4]=*(const __attribute__((address_space(3))) bf16x8*)(kp+4096); kf[5]=*(const __attribute__((address_space(3))) bf16x8*)(kp+4608);
  kf[6]=*(const __attribute__((address_space(3))) bf16x8*)(kp+6144); kf[7]=*(const __attribute__((address_space(3))) bf16x8*)(kp+6656);
}
__device__ __forceinline__ void kload2(bf16x8*kf,lds_cptr kp,int j){ kf[2*j]=*(const __attribute__((address_space(3))) bf16x8*)(kp+j*2048); kf[2*j+1]=*(const __attribute__((address_space(3))) bf16x8*)(kp+j*2048+512); }
__device__ __forceinline__ s16x4 vtr(lds_cptr p){ return __builtin_bit_cast(s16x4,__builtin_amdgcn_ds_read_tr16_b64_v4i16((__attribute__((address_space(3))) v4i16_t*)p)); }
__device__ __forceinline__ float rowmax(const f32x16&p0,const f32x16&p1){
  float a=max3f(p0[0],p0[1],p1[0]),b=max3f(p0[2],p0[3],p1[1]);a=max3f(a,p1[2],p1[3]);
  #pragma unroll
  for(int r=4;r<16;r+=4){a=max3f(a,p0[r],p0[r+1]);b=max3f(b,p0[r+2],p0[r+3]);a=max3f(a,p1[r],p1[r+1]);b=max3f(b,p1[r+2],p1[r+3]);}
  const float m=max2f(a,b);
  auto rr=__builtin_amdgcn_permlane32_swap(__float_as_uint(m),__float_as_uint(m),false,false);
  return max2f(__uint_as_float(rr[0]),__uint_as_float(rr[1]));
}
__device__ __forceinline__ void pv(f32x16*o,int vb,bf16x8 pa0,bf16x8 pa1,bf16x8 pa2,bf16x8 pa3){
  #pragma unroll
  for(int d0=0;d0<2;++d0){s16x4 lo[4],hi[4];
    #pragma unroll
    for(int ks=0;ks<4;++ks){
      asm volatile("ds_read_b64_tr_b16 %0,%1 offset:%c2":"=&v"(lo[ks]):"v"(vb),"i"(d0*4096+ks*1024):"memory");
      asm volatile("ds_read_b64_tr_b16 %0,%1 offset:%c2":"=&v"(hi[ks]):"v"(vb),"i"(d0*4096+ks*1024+512):"memory");}
    asm volatile("s_waitcnt lgkmcnt(0)":::"memory");SBAR();
    #define PK(k) (bf16x8){lo[k][0],lo[k][1],lo[k][2],lo[k][3],hi[k][0],hi[k][1],hi[k][2],hi[k][3]}
    o[d0]=__builtin_amdgcn_mfma_f32_32x32x16_bf16(pa0,PK(0),o[d0],0,0,0);
    o[d0]=__builtin_amdgcn_mfma_f32_32x32x16_bf16(pa1,PK(1),o[d0],0,0,0);
    o[d0]=__builtin_amdgcn_mfma_f32_32x32x16_bf16(pa2,PK(2),o[d0],0,0,0);
    o[d0]=__builtin_amdgcn_mfma_f32_32x32x16_bf16(pa3,PK(3),o[d0],0,0,0);
    #undef PK
  }
}

#ifndef ATTN_STORE16
#define ATTN_STORE16(p,v) (*(u32x4*)(p)=(v))
#endif
template<int MODE,int OP,int THRL> __device__ __forceinline__ void attn_unit(const bf16*Qu,const bf16*__restrict__ Kh,const bf16*__restrict__ Vh,bf16*Ou,int q0,int t_lo,int NT,float nsl2,char*shm){
  int tid_=threadIdx.x; asm volatile("":"+v"(tid_));
  const int tid=tid_,lane=tid&63,r32=lane&31,hi=lane>>5; const int wid=__builtin_amdgcn_readfirstlane(tid>>6);
  const bf16*Qw=Qu+(long)(wid*QBLK)*QP;
  const unsigned lds0=(unsigned)(uintptr_t)shm;
  float*wsf=(float*)(shm+LDS_WS)+wid*64;
  const bf16*ksrc=Kh+(long)lane*KP+wid*8;
  const bf16*vsrc=Vh+(long)(16*(wid&3)+(lane>>2))*KP+(wid>>2)*32+(lane&3)*8;
  const unsigned kdst=lds0+LDS_K+wid*1024, vdst=lds0+LDS_V+wid*1024;
  #define DMA_K(t,slot) glds16(ksrc+(long)(t)*KVBLK*KP,(unsigned)__builtin_amdgcn_readfirstlane(kdst+(slot)))
  #define DMA_V(t,slot) glds16(vsrc+(long)(t)*KVBLK*KP,(unsigned)__builtin_amdgcn_readfirstlane(vdst+(slot)))
  const int vb0=(int)(lds0+LDS_V)+((lane>>4)&1)*32+(lane&3)*8+(4*hi+((lane&15)>>2))*64;
  const char*Kbase=shm+LDS_K; bf16x8 kf[8];
  const lds_cptr shm3=(lds_cptr)shm; const lds_cptr kp0=shm3+LDS_K+hi*1024+r32*16; const lds_cptr vp0=shm3+LDS_V+((lane>>4)&1)*32+(lane&3)*8+(4*hi+((lane&15)>>2))*64;
  DMA_K(0,0);DMA_V(0,0);DMA_K(1,SLOTB);
  bf16x8 qr[4];
  #pragma unroll
  for(int d0=0;d0<4;++d0)qr[d0]=*reinterpret_cast<const bf16x8*>(&Qw[(long)r32*QP+d0*16+hi*8]);
  float mhat=0.f,l_reg=0.f;f32x16 o[2];o[0]=f32x16{};o[1]=f32x16{};f32x16 negm=f32x16{};asm volatile("":"+v"(negm));
  const float qf=(float)(q0+wid*QBLK+r32-4*hi);
  const int n_r=q0+(wid>>1), n_c=(wid&1)*32+r32, n_rs=min(max(n_r-4,0),120), n_kc=4*hi-min(max(n_c-8,0),48);
  typedef __attribute__((address_space(3))) const float* lds_fptr;
  const lds_fptr n_tb=(lds_fptr)((__attribute__((address_space(3))) const char*)shm+LDS_TB)+(7-n_r)*31+4*hi-n_c+15;
  #define CMASK(P0,P1,t) do{ if(MODE==0){ const float dq_=qf-(float)(64*(t)); _Pragma("unroll") for(int r=0;r<16;++r){ const float cr_=(float)((r&3)+8*(r>>2)); \
      P0[r]=__builtin_fmaf(nsl2,__builtin_fabsf(dq_-cr_),P0[r]); P1[r]=__builtin_fmaf(nsl2,__builtin_fabsf(dq_-(cr_+32.f)),P1[r]); } } \
    else { const int kr_=t_lo+(t); const bool vr_=(kr_>=n_rs)&&(kr_<n_rs+8); const lds_fptr tb_=n_tb+kr_*31; \
      _Pragma("unroll") for(int r=0;r<16;++r){ const int ko_=(r&3)+8*(r>>2); const float b0_=tb_[ko_],b1_=tb_[ko_+32]; \
        const bool ok0_=vr_&&((unsigned)(n_kc+ko_)<16u), ok1_=vr_&&((unsigned)(n_kc+ko_+32)<16u); \
        P0[r]=ok0_?P0[r]+b0_:-INFINITY; P1[r]=ok1_?P1[r]+b1_:-INFINITY; } } }while(0)
  bool resc=false;
  #define START(P0,P1) do{ const float rm=rowmax(P0,P1); resc=false; \
    { const float dl=(rm>-1e30f)?rm:0.f; mhat=fadd_s(mhat,dl); \
      _Pragma("unroll") for(int r=0;r<16;++r){P0[r]=fsub_s(P0[r],dl);P1[r]=fsub_s(P1[r],dl);} \
      _Pragma("unroll") for(int r=0;r<16;++r)negm[r]=-mhat; asm volatile("":"+v"(negm)); } \
    _Pragma("unroll") for(int r=0;r<16;++r)P0[r]=__builtin_amdgcn_exp2f(P0[r]); }while(0)
  #define RESC() do{ if(resc){ asm volatile("s_waitcnt lgkmcnt(0)":::"memory"); \
      _Pragma("unroll") for(int d_=0;d_<2;++d_) _Pragma("unroll") for(int r=0;r<16;++r)o[d_][r]*=wsf[crow(r,hi)]; } }while(0)
  f32x16 pA0,pA1,pB0,pB1;
  int sl_prev=0,sl_cur=0,sl_next=SLOTB;
  #define ROT() do{sl_prev=sl_cur;sl_cur=sl_next;sl_next=(sl_next==(NSLOT-1)*SLOTB)?0:sl_next+SLOTB;}while(0)
  DMA_K(2,2*SLOTB);
  WAIT_BAR(3);
  qkt(pA0,pA1,Kbase,qr,negm,r32,hi);asm volatile("s_nop 15\n\ts_nop 7":"+v"(pA0),"+v"(pA1));CMASK(pA0,pA1,0);
  START(pA0,pA1);
  _Pragma("unroll") for(int r=0;r<16;++r)pA1[r]=__builtin_amdgcn_exp2f(pA1[r]);
  WAIT_BAR(0);
  DMA_K(3,0);DMA_V(1,SLOTB);
  ROT();
  kload8(kf,kp0+sl_cur);
  WAIT_BAR(2);
  s16x4 vlo[8],vhi[8]; u32x4 pw0,pw1,pw2,pw3;
  #define PKW(P,B) cvtpk_s(P[B],P[B+1])
  #define PAF(k) __builtin_bit_cast(bf16x8,pw##k)
  #define VFR(i) (bf16x8){vlo[i][0],vlo[i][1],vlo[i][2],vlo[i][3],vhi[i][0],vhi[i][1],vhi[i][2],vhi[i][3]}
  #define PIN(x) asm volatile("":"+v"(x))
  #define MX3(a,b,c) __builtin_fmaxf(__builtin_fmaxf((a),(b)),(c))
  #define GAPA(MF,A0,A1,A2,A3,W0,W1,PW) do{ MF; sacc+=A0; sacc+=A1; sacc+=A2; sacc+=A3; PIN(sacc); W0; W1; PIN(PW); SBAR(); }while(0)
  #define EX(v) __builtin_amdgcn_exp2f(v)
  #define GAPB(MF,X,B) do{ MF; X[B]=EX(X[B]); X[B+1]=EX(X[B+1]); X[B+2]=EX(X[B+2]); X[B+3]=EX(X[B+3]); PIN(X); SBAR(); }while(0)
  #define VRD(i) do{ vlo[i]=vtr(vp_+(((i)>>2)*4096+((i)&3)*1024)); vhi[i]=vtr(vp_+(((i)>>2)*4096+((i)&3)*1024+512)); }while(0)
  #define KRD(G,j) do{ if(G){ kload2(kf,kp0+sl_next,j); SBAR(); } }while(0)
  #define STEP(C0,C1,P0,P1,t,GK,GV,GL) do{ SBAR(); \
    const lds_cptr vp_=vp0+sl_prev; \
    VRD(0); SBAR(); float sacc=(P0[0]+P0[1]); \
    GAPA(C0=__builtin_amdgcn_mfma_f32_32x32x16_bf16(kf[0],qr[0],negm,0,0,0), P0[2],P0[3],P0[4],P0[5],     pw0[0]=PKW(P0,0), pw0[1]=PKW(P0,2), pw0); \
    VRD(4); SBAR(); GAPA(C1=__builtin_amdgcn_mfma_f32_32x32x16_bf16(kf[1],qr[0],negm,0,0,0), P0[6],P0[7],P0[8],P0[9],     pw0[2]=PKW(P0,4), pw0[3]=PKW(P0,6), pw0); \
    VRD(1); SBAR(); GAPA(C0=__builtin_amdgcn_mfma_f32_32x32x16_bf16(kf[2],qr[1],C0,0,0,0),   P0[10],P0[11],P0[12],P0[13], pw1[0]=PKW(P0,8), pw1[1]=PKW(P0,10), pw1); \
    VRD(5); SBAR(); GAPA(C1=__builtin_amdgcn_mfma_f32_32x32x16_bf16(kf[3],qr[1],C1,0,0,0),   P0[14],P0[15],P1[0],P1[1],   pw1[2]=PKW(P0,12),pw1[3]=PKW(P0,14), pw1); \
    VRD(2); SBAR(); GAPA(C0=__builtin_amdgcn_mfma_f32_32x32x16_bf16(kf[4],qr[2],C0,0,0,0),   P1[2],P1[3],P1[4],P1[5],     pw2[0]=PKW(P1,0), pw2[1]=PKW(P1,2), pw2); \
    VRD(6); SBAR(); GAPA(C1=__builtin_amdgcn_mfma_f32_32x32x16_bf16(kf[5],qr[2],C1,0,0,0),   P1[6],P1[7],P1[8],P1[9],     pw2[2]=PKW(P1,4), pw2[3]=PKW(P1,6), pw2); \
    VRD(3); SBAR(); GAPA(C0=__builtin_amdgcn_mfma_f32_32x32x16_bf16(kf[6],qr[3],C0,0,0,0),   P1[10],P1[11],P1[12],P1[13], pw3[0]=PKW(P1,8), pw3[1]=PKW(P1,10), pw3); \
    VRD(7); SBAR(); GAPA(C1=__builtin_amdgcn_mfma_f32_32x32x16_bf16(kf[7],qr[3],C1,0,0,0),   P1[14],P1[15],0.f,0.f,       pw3[2]=PKW(P1,12),pw3[3]=PKW(P1,14), pw3); \
    l_reg+=sacc; \
    if(GK){DMA_K((t)+3,sl_cur);} if(GV){DMA_V((t)+1,sl_next);} \
    CMASK(C0,C1,t); \
    { float a=MX3(C0[0],C0[1],C1[0]),b=MX3(C0[2],C0[3],C1[1]); a=MX3(a,C1[2],C1[3]); \
      _Pragma("unroll") for(int r=4;r<16;r+=4){a=MX3(a,C0[r],C0[r+1]);b=MX3(b,C0[r+2],C0[r+3]);a=MX3(a,C1[r],C1[r+1]);b=MX3(b,C1[r+2],C1[r+3]);} \
      float rm=__builtin_fmaxf(a,b); { auto rr=__builtin_amdgcn_permlane32_swap(__float_as_uint(rm),__float_as_uint(rm),false,false); rm=__builtin_fmaxf(__uint_as_float(rr[0]),__uint_as_float(rr[1])); } \
      resc=false; \
      if(__builtin_expect(__any(rm>(float)THRL),0)){ const float dl=__builtin_fmaxf(rm,0.f); mhat+=dl; \
        _Pragma("unroll") for(int r=0;r<16;++r){C0[r]-=dl;C1[r]-=dl;} \
        _Pragma("unroll") for(int r=0;r<16;++r)negm[r]=-mhat; asm volatile("":"+v"(negm)); \
        const float f=__builtin_amdgcn_exp2f(-dl); l_reg*=f; if(hi==0)wsf[r32]=f; resc=true; } } \
    SBAR(); \
    GAPB(o[0]=__builtin_amdgcn_mfma_f32_32x32x16_bf16(PAF(0),VFR(0),o[0],0,0,0), C0,0); \
    GAPB(o[1]=__builtin_amdgcn_mfma_f32_32x32x16_bf16(PAF(0),VFR(4),o[1],0,0,0), C0,4); \
    KRD(GL,0); GAPB(o[0]=__builtin_amdgcn_mfma_f32_32x32x16_bf16(PAF(1),VFR(1),o[0],0,0,0), C0,8); \
    KRD(GL,1); GAPB(o[1]=__builtin_amdgcn_mfma_f32_32x32x16_bf16(PAF(1),VFR(5),o[1],0,0,0), C0,12); \
    KRD(GL,2); GAPB(o[0]=__builtin_amdgcn_mfma_f32_32x32x16_bf16(PAF(2),VFR(2),o[0],0,0,0), C1,0); \
    KRD(GL,3); GAPB(o[1]=__builtin_amdgcn_mfma_f32_32x32x16_bf16(PAF(2),VFR(6),o[1],0,0,0), C1,4); \
    GAPB(o[0]=__builtin_amdgcn_mfma_f32_32x32x16_bf16(PAF(3),VFR(3),o[0],0,0,0), C1,8); \
    GAPB(o[1]=__builtin_amdgcn_mfma_f32_32x32x16_bf16(PAF(3),VFR(7),o[1],0,0,0), C1,12); \
    }while(0)
  int t=1;
  for(;t+5<NT;t+=2){
    STEP(pB0,pB1,pA0,pA1,t,true,true,true);     WAIT_BAR(2); RESC(); ROT();
    STEP(pA0,pA1,pB0,pB1,t+1,true,true,true);   WAIT_BAR(2); RESC(); ROT();
  }
  #define ENDW(tt) do{ if((tt)+3<NT){WAIT_BAR(2);} else if((tt)+2<NT){WAIT_BAR(1);} else {WAIT_BAR(0);} }while(0)
  for(;t+1<NT;t+=2){
    STEP(pB0,pB1,pA0,pA1,t,(t+3<NT),(t+1<NT),(t+1<NT));       ENDW(t);   RESC(); ROT();
    STEP(pA0,pA1,pB0,pB1,t+1,(t+4<NT),(t+2<NT),(t+2<NT));     ENDW(t+1); RESC(); ROT();
  }
  STEP(pB0,pB1,pA0,pA1,NT-1,false,false,false); RESC();
  { float sacc=pB0[0]+pB0[1]; _Pragma("unroll") for(int r=2;r<16;++r)sacc+=pB0[r]; _Pragma("unroll") for(int r=0;r<16;++r)sacc+=pB1[r]; l_reg+=sacc;
    pw0=(u32x4){PKW(pB0,0),PKW(pB0,2),PKW(pB0,4),PKW(pB0,6)};pw1=(u32x4){PKW(pB0,8),PKW(pB0,10),PKW(pB0,12),PKW(pB0,14)};pw2=(u32x4){PKW(pB1,0),PKW(pB1,2),PKW(pB1,4),PKW(pB1,6)};pw3=(u32x4){PKW(pB1,8),PKW(pB1,10),PKW(pB1,12),PKW(pB1,14)};
    SBAR(); pv(o,vb0+sl_cur,PAF(0),PAF(1),PAF(2),PAF(3)); }
  #undef PKW
  #undef PAF
  #undef VFR
  #undef PIN
  #undef MX3
  #undef GAPA
  #undef GAPB
  #undef EX
  #undef VRD
  #undef KRD
  #undef STEP
  #undef ENDW
  {auto rr=__builtin_amdgcn_permlane32_swap(__float_as_uint(l_reg),__float_as_uint(l_reg),false,false);l_reg=__uint_as_float(rr[0])+__uint_as_float(rr[1]);}
  if(hi==0)wsf[32+r32]=l_reg;asm volatile("s_waitcnt lgkmcnt(0)":::"memory");
  float rli[16];
  #pragma unroll
  for(int r=0;r<16;++r)rli[r]=__builtin_amdgcn_rcpf(wsf[32+crow(r,hi)]);
  bf16*Ow=Ou+(long)(wid*QBLK)*OP;
  { bf16*stg=(bf16*)(shm+LDS_OST)+wid*2048;
    #pragma unroll
    for(int r=0;r<16;++r){const int orow=crow(r,hi);
      #pragma unroll
      for(int d0=0;d0<2;++d0)stg[orow*64+d0*32+r32]=__float2bfloat16(o[d0][r]*rli[r]);}
    asm volatile("s_waitcnt lgkmcnt(0)":::"memory");
    #pragma unroll
    for(int i=0;i<4;++i){const int row=i*8+(lane>>3),ch=lane&7; const u32x4 v=*(const u32x4*)(stg+row*64+ch*8); ATTN_STORE16(Ow+(long)row*OP+ch*8,v);} }
  asm volatile("s_waitcnt lgkmcnt(0)\n\ts_barrier":::"memory");
  #undef DMA_K
  #undef DMA_V
  #undef CMASK
  #undef START
  #undef RESC
  #undef ROT
}
constexpr int W_K=0, W_V=NSLOT*SLOTB, W_WS=W_V+NSLOT*2*SLOTB, W_OST=W_WS+NW*64*4, W_BYTES=W_OST+NW*4096;
template<int THRL> __device__ __forceinline__ void attn_unit128(const bf16*Qu,const bf16*__restrict__ Kh,const bf16*__restrict__ Vh,bf16*Ou,int q0,int NT,float nsl2,char*shm){
  constexpr int OP=512;
  int tid_=threadIdx.x; asm volatile("":"+v"(tid_));
  const int tid=tid_,lane=tid&63,r32=lane&31,hi=lane>>5; const int wid=__builtin_amdgcn_readfirstlane(tid>>6);
  const bf16*Qw=Qu+(long)(wid*QBLK)*QP;
  const unsigned lds0=(unsigned)(uintptr_t)shm;
  float*wsf=(float*)(shm+W_WS)+wid*64;
  const bf16*ksrc=Kh+wid*512+lane*8;
  const bf16*vsrc=Vh+wid*512+lane*8;
  const unsigned kdst=lds0+W_K+wid*1024, vdst=lds0+W_V+wid*1024;
  #define DMA_K(t,slot) glds16(ksrc+(long)(t)*4096,(unsigned)__builtin_amdgcn_readfirstlane(kdst+(slot)))
  #define DMA_V(t,slot) do{ glds16(vsrc+(long)(t)*8192,(unsigned)__builtin_amdgcn_readfirstlane(vdst+2*(slot))); glds16(vsrc+(long)(t)*8192+4096,(unsigned)__builtin_amdgcn_readfirstlane(vdst+2*(slot)+8192)); }while(0)
  const int vb0=(int)(lds0+W_V)+((lane>>4)&1)*32+(lane&3)*8+(4*hi+((lane&15)>>2))*64;
  bf16x8 kf[8];
  const lds_cptr shm3=(lds_cptr)shm; const lds_cptr kp0=shm3+W_K+hi*1024+r32*16; const lds_cptr vp0=shm3+W_V+((lane>>4)&1)*32+(lane&3)*8+(4*hi+((lane&15)>>2))*64;
  DMA_K(0,0);DMA_V(0,0);DMA_K(1,SLOTB);
  bf16x8 qr[4];
  #pragma unroll
  for(int d0=0;d0<4;++d0)qr[d0]=*reinterpret_cast<const bf16x8*>(&Qw[(long)r32*QP+d0*16+hi*8]);
  float mhat=0.f,l_reg=0.f;f32x16 o[4];o[0]=f32x16{};o[1]=f32x16{};o[2]=f32x16{};o[3]=f32x16{};
  const float qf=(float)(q0+wid*QBLK+r32-4*hi);
  const int td=(q0>>6)+(wid>>1);
  #define CINIT(C0,C1,t) do{ const int tt_=(t); const float dq_=qf-(float)(64*tt_); \
    if(tt_==td){ _Pragma("unroll") for(int r=0;r<16;++r){ const float cr_=(float)((r&3)+8*(r>>2)); \
        C0[r]=__builtin_fmaf(nsl2,__builtin_fabsf(dq_-cr_),-mhat); C1[r]=__builtin_fmaf(nsl2,__builtin_fabsf(dq_-(cr_+32.f)),-mhat); } } \
    else { const float k_=(tt_<td)?-nsl2:nsl2; const float b_=__builtin_fmaf(-k_,dq_,-mhat); \
      _Pragma("unroll") for(int r=0;r<16;++r){ const float cr_=(float)((r&3)+8*(r>>2)); C0[r]=__builtin_fmaf(k_,cr_,b_); C1[r]=__builtin_fmaf(k_,cr_+32.f,b_); } } }while(0)
  bool resc=false;
  #define START(P0,P1) do{ const float rm=rowmax(P0,P1); resc=false; \
    { const float dl=rm; mhat=fadd_s(mhat,dl); \
      _Pragma("unroll") for(int r=0;r<16;++r){P0[r]=fsub_s(P0[r],dl);P1[r]=fsub_s(P1[r],dl);} } \
    _Pragma("unroll") for(int r=0;r<16;++r)P0[r]=__builtin_amdgcn_exp2f(P0[r]); }while(0)
  #define RESC() do{ if(resc){ asm volatile("s_waitcnt lgkmcnt(0)":::"memory"); \
      _Pragma("unroll") for(int d_=0;d_<4;++d_) _Pragma("unroll") for(int r=0;r<16;++r)o[d_][r]*=wsf[crow(r,hi)]; } }while(0)
  f32x16 pA0,pA1,pB0,pB1;
  int sl_prev=0,sl_cur=0,sl_next=SLOTB;
  #define ROT() do{sl_prev=sl_cur;sl_cur=sl_next;sl_next=(sl_next==(NSLOT-1)*SLOTB)?0:sl_next+SLOTB;}while(0)
  DMA_K(2,2*SLOTB);
  WAIT_BAR(4);
  CINIT(pA0,pA1,0);
  { const lds_cptr kb=kp0;
    #pragma unroll
    for(int d0=0;d0<4;++d0){ const bf16x8 b0=*(const __attribute__((address_space(3))) bf16x8*)(kb+d0*2048), b1=*(const __attribute__((address_space(3))) bf16x8*)(kb+d0*2048+512);
      pA0=__builtin_amdgcn_mfma_f32_32x32x16_bf16(b0,qr[d0],pA0,0,0,0); pA1=__builtin_amdgcn_mfma_f32_32x32x16_bf16(b1,qr[d0],pA1,0,0,0); } }
  asm volatile("s_nop 15\n\ts_nop 7":"+v"(pA0),"+v"(pA1));
  START(pA0,pA1);
  _Pragma("unroll") for(int r=0;r<16;++r)pA1[r]=__builtin_amdgcn_exp2f(pA1[r]);
  WAIT_BAR(0);
  DMA_K(3,0);DMA_V(1,SLOTB);
  ROT();
  kload8(kf,kp0+sl_cur);
  WAIT_BAR(3);
  s16x4 vlo[8],vhi[8]; u32x4 pw0,pw1,pw2,pw3;
  #define PKW(P,B) cvtpk_s(P[B],P[B+1])
  #define PAF(k) __builtin_bit_cast(bf16x8,pw##k)
  #define VFR(i) (bf16x8){vlo[i][0],vlo[i][1],vlo[i][2],vlo[i][3],vhi[i][0],vhi[i][1],vhi[i][2],vhi[i][3]}
  #define PIN(x) asm volatile("":"+v"(x))
  #define MX3(a,b,c) __builtin_fmaxf(__builtin_fmaxf((a),(b)),(c))
  #define GAPA(MF,A0,A1,A2,A3,W0,W1,PW) do{ MF; sacc+=A0; sacc+=A1; sacc+=A2; sacc+=A3; PIN(sacc); W0; W1; PIN(PW); SBAR(); }while(0)
  #define EX(v) __builtin_amdgcn_exp2f(v)
  #define GAPB(MF,X,B) do{ MF; X[B]=EX(X[B]); X[B+1]=EX(X[B+1]); PIN(X); SBAR(); }while(0)
  #define VRD(i) do{ vlo[i]=vtr(vp_+(((i)>>2)*4096+((i)&3)*1024)); vhi[i]=vtr(vp_+(((i)>>2)*4096+((i)&3)*1024+512)); }while(0)
  #define VRD2(i) do{ vlo[i]=vtr(vp_+(8192+((i)>>2)*4096+((i)&3)*1024)); vhi[i]=vtr(vp_+(8192+((i)>>2)*4096+((i)&3)*1024+512)); SBAR(); }while(0)
  #define KRD(G,j) do{ if(G){ kload2(kf,kp0+sl_next,j); SBAR(); } }while(0)
  #define STEP(C0,C1,P0,P1,t,GK,GV,GL) do{ SBAR(); \
    const lds_cptr vp_=vp0+2*sl_prev; \
    CINIT(C0,C1,t); SBAR(); \
    VRD(0); SBAR(); float sacc=(P0[0]+P0[1]); \
    GAPA(C0=__builtin_amdgcn_mfma_f32_32x32x16_bf16(kf[0],qr[0],C0,0,0,0), P0[2],P0[3],P0[4],P0[5],     pw0[0]=PKW(P0,0), pw0[1]=PKW(P0,2), pw0); \
    VRD(4); SBAR(); GAPA(C1=__builtin_amdgcn_mfma_f32_32x32x16_bf16(kf[1],qr[0],C1,0,0,0), P0[6],P0[7],P0[8],P0[9],     pw0[2]=PKW(P0,4), pw0[3]=PKW(P0,6), pw0); \
    VRD(1); SBAR(); GAPA(C0=__builtin_amdgcn_mfma_f32_32x32x16_bf16(kf[2],qr[1],C0,0,0,0),   P0[10],P0[11],P0[12],P0[13], pw1[0]=PKW(P0,8), pw1[1]=PKW(P0,10), pw1); \
    VRD(5); SBAR(); GAPA(C1=__builtin_amdgcn_mfma_f32_32x32x16_bf16(kf[3],qr[1],C1,0,0,0),   P0[14],P0[15],P1[0],P1[1],   pw1[2]=PKW(P0,12),pw1[3]=PKW(P0,14), pw1); \
    VRD(2); SBAR(); GAPA(C0=__builtin_amdgcn_mfma_f32_32x32x16_bf16(kf[4],qr[2],C0,0,0,0),   P1[2],P1[3],P1[4],P1[5],     pw2[0]=PKW(P1,0), pw2[1]=PKW(P1,2), pw2); \
    VRD(6); SBAR(); GAPA(C1=__builtin_amdgcn_mfma_f32_32x32x16_bf16(kf[5],qr[2],C1,0,0,0),   P1[6],P1[7],P1[8],P1[9],     pw2[2]=PKW(P1,4), pw2[3]=PKW(P1,6), pw2); \
    VRD(3); SBAR(); GAPA(C0=__builtin_amdgcn_mfma_f32_32x32x16_bf16(kf[6],qr[3],C0,0,0,0),   P1[10],P1[11],P1[12],P1[13], pw3[0]=PKW(P1,8), pw3[1]=PKW(P1,10), pw3); \
    VRD(7); SBAR(); GAPA(C1=__builtin_amdgcn_mfma_f32_32x32x16_bf16(kf[7],qr[3],C1,0,0,0),   P1[14],P1[15],0.f,0.f,       pw3[2]=PKW(P1,12),pw3[3]=PKW(P1,14), pw3); \
    l_reg+=sacc; \
    if(GK){DMA_K((t)+3,sl_cur);} if(GV){DMA_V((t)+1,sl_next);} \
    { float a=MX3(C0[0],C0[1],C1[0]),b=MX3(C0[2],C0[3],C1[1]); a=MX3(a,C1[2],C1[3]); \
      _Pragma("unroll") for(int r=4;r<16;r+=4){a=MX3(a,C0[r],C0[r+1]);b=MX3(b,C0[r+2],C0[r+3]);a=MX3(a,C1[r],C1[r+1]);b=MX3(b,C1[r+2],C1[r+3]);} \
      float rm=__builtin_fmaxf(a,b); { auto rr=__builtin_amdgcn_permlane32_swap(__float_as_uint(rm),__float_as_uint(rm),false,false); rm=__builtin_fmaxf(__uint_as_float(rr[0]),__uint_as_float(rr[1])); } \
      resc=false; \
      if(__builtin_expect(__any(rm>(float)THRL),0)){ const float dl=__builtin_fmaxf(rm,0.f); mhat+=dl; \
        _Pragma("unroll") for(int r=0;r<16;++r){C0[r]-=dl;C1[r]-=dl;} \
        const float f=__builtin_amdgcn_exp2f(-dl); l_reg*=f; if(hi==0)wsf[r32]=f; resc=true; } } \
    SBAR(); \
    GAPB(o[0]=__builtin_amdgcn_mfma_f32_32x32x16_bf16(PAF(0),VFR(0),o[0],0,0,0), C0,0); \
    GAPB(o[1]=__builtin_amdgcn_mfma_f32_32x32x16_bf16(PAF(0),VFR(4),o[1],0,0,0), C0,2);  VRD2(0); \
    GAPB(o[0]=__builtin_amdgcn_mfma_f32_32x32x16_bf16(PAF(1),VFR(1),o[0],0,0,0), C0,4);  VRD2(4); \
    GAPB(o[1]=__builtin_amdgcn_mfma_f32_32x32x16_bf16(PAF(1),VFR(5),o[1],0,0,0), C0,6);  VRD2(1); \
    GAPB(o[0]=__builtin_amdgcn_mfma_f32_32x32x16_bf16(PAF(2),VFR(2),o[0],0,0,0), C0,8);  VRD2(5); \
    GAPB(o[1]=__builtin_amdgcn_mfma_f32_32x32x16_bf16(PAF(2),VFR(6),o[1],0,0,0), C0,10); VRD2(2); \
    GAPB(o[0]=__builtin_amdgcn_mfma_f32_32x32x16_bf16(PAF(3),VFR(3),o[0],0,0,0), C0,12); VRD2(6); \
    GAPB(o[1]=__builtin_amdgcn_mfma_f32_32x32x16_bf16(PAF(3),VFR(7),o[1],0,0,0), C0,14); VRD2(3); VRD2(7); \
    GAPB(o[2]=__builtin_amdgcn_mfma_f32_32x32x16_bf16(PAF(0),VFR(0),o[2],0,0,0), C1,0); \
    GAPB(o[3]=__builtin_amdgcn_mfma_f32_32x32x16_bf16(PAF(0),VFR(4),o[3],0,0,0), C1,2); \
    KRD(GL,0); GAPB(o[2]=__builtin_amdgcn_mfma_f32_32x32x16_bf16(PAF(1),VFR(1),o[2],0,0,0), C1,4); \
    KRD(GL,1); GAPB(o[3]=__builtin_amdgcn_mfma_f32_32x32x16_bf16(PAF(1),VFR(5),o[3],0,0,0), C1,6); \
    KRD(GL,2); GAPB(o[2]=__builtin_amdgcn_mfma_f32_32x32x16_bf16(PAF(2),VFR(2),o[2],0,0,0), C1,8); \
    KRD(GL,3); GAPB(o[3]=__builtin_amdgcn_mfma_f32_32x32x16_bf16(PAF(2),VFR(6),o[3],0,0,0), C1,10); \
    GAPB(o[2]=__builtin_amdgcn_mfma_f32_32x32x16_bf16(PAF(3),VFR(3),o[2],0,0,0), C1,12); \
    GAPB(o[3]=__builtin_amdgcn_mfma_f32_32x32x16_bf16(PAF(3),VFR(7),o[3],0,0,0), C1,14); \
    }while(0)
  int t=1;
  for(;t+5<NT;t+=2){
    STEP(pB0,pB1,pA0,pA1,t,true,true,true);     WAIT_BAR(3); RESC(); ROT();
    STEP(pA0,pA1,pB0,pB1,t+1,true,true,true);   WAIT_BAR(3); RESC(); ROT();
  }
  #define ENDW(tt) do{ if((tt)+3<NT){WAIT_BAR(3);} else if((tt)+2<NT){WAIT_BAR(2);} else {WAIT_BAR(0);} }while(0)
  for(;t+1<NT;t+=2){
    STEP(pB0,pB1,pA0,pA1,t,(t+3<NT),(t+1<NT),(t+1<NT));       ENDW(t);   RESC(); ROT();
    STEP(pA0,pA1,pB0,pB1,t+1,(t+4<NT),(t+2<NT),(t+2<NT));     ENDW(t+1); RESC(); ROT();
  }
  STEP(pB0,pB1,pA0,pA1,NT-1,false,false,false); RESC();
  { float sacc=pB0[0]+pB0[1]; _Pragma("unroll") for(int r=2;r<16;++r)sacc+=pB0[r]; _Pragma("unroll") for(int r=0;r<16;++r)sacc+=pB1[r]; l_reg+=sacc;
    pw0=(u32x4){PKW(pB0,0),PKW(pB0,2),PKW(pB0,4),PKW(pB0,6)};pw1=(u32x4){PKW(pB0,8),PKW(pB0,10),PKW(pB0,12),PKW(pB0,14)};pw2=(u32x4){PKW(pB1,0),PKW(pB1,2),PKW(pB1,4),PKW(pB1,6)};pw3=(u32x4){PKW(pB1,8),PKW(pB1,10),PKW(pB1,12),PKW(pB1,14)};
    SBAR(); pv(o,vb0+2*sl_cur,PAF(0),PAF(1),PAF(2),PAF(3)); pv(o+2,vb0+2*sl_cur+8192,PAF(0),PAF(1),PAF(2),PAF(3)); }
  #undef PKW
  #undef PAF
  #undef VFR
  #undef PIN
  #undef MX3
  #undef GAPA
  #undef GAPB
  #undef EX
  #undef VRD
  #undef VRD2
  #undef KRD
  #undef STEP
  #undef ENDW
  {auto rr=__builtin_amdgcn_permlane32_swap(__float_as_uint(l_reg),__float_as_uint(l_reg),false,false);l_reg=__uint_as_float(rr[0])+__uint_as_float(rr[1]);}
  if(hi==0)wsf[32+r32]=l_reg;asm volatile("s_waitcnt lgkmcnt(0)":::"memory");
  float rli[16];
  #pragma unroll
  for(int r=0;r<16;++r)rli[r]=__builtin_amdgcn_rcpf(wsf[32+crow(r,hi)]);
  bf16*Ow=Ou+(long)(wid*QBLK)*OP;
  { bf16*stg=(bf16*)(shm+W_OST)+wid*2048;
    #pragma unroll
    for(int hf=0;hf<2;++hf){
      #pragma unroll
      for(int r=0;r<16;++r){const int orow=crow(r,hi);
        #pragma unroll
        for(int d0=0;d0<2;++d0)stg[orow*64+d0*32+r32]=__float2bfloat16(o[hf*2+d0][r]*rli[r]);}
      asm volatile("s_waitcnt lgkmcnt(0)":::"memory");
      #pragma unroll
      for(int i=0;i<4;++i){const int row=i*8+(lane>>3),ch=lane&7; const u32x4 v=*(const u32x4*)(stg+row*64+ch*8); ATTN_STORE16(Ow+(long)row*OP+hf*64+ch*8,v);}
      asm volatile("s_waitcnt lgkmcnt(0)":::"memory"); } }
  asm volatile("s_waitcnt lgkmcnt(0)\n\ts_barrier":::"memory");
  #undef DMA_K
  #undef DMA_V
  #undef CINIT
  #undef START
  #undef RESC
  #undef ROT
}
constexpr int ATTN_LDS_BYTES=LDS_BYTES;
constexpr int LDS_QW=W_BYTES;
template<int THRL=8> __device__ __forceinline__ void attn_phase(char*lds,const bf16*proj,const bf16*kimg,const bf16*vimg,bf16*od,unsigned*qctr,const unsigned*nrm){
  const int tid=threadIdx.x;
  volatile __attribute__((address_space(3))) unsigned* qw=(volatile __attribute__((address_space(3))) unsigned*)((__attribute__((address_space(3))) char*)lds+LDS_QW);
  unsigned mine=0; if(tid==0) mine=__hip_atomic_fetch_add(qctr,1u,__ATOMIC_RELAXED,__HIP_MEMORY_SCOPE_AGENT);
  for(;;){
    if(tid==0) qw[0]=mine;
    __syncthreads();
    const int u=(int)__builtin_amdgcn_readfirstlane(qw[0]);
    if(u>=512) break;
    if(tid==0) mine=__hip_atomic_fetch_add(qctr,1u,__ATOMIC_RELAXED,__HIP_MEMORY_SCOPE_AGENT);
    const int h=3-(u>>7), r=u&127, map=r>>6, b=(r>>5)&1, qb=r&31;
    const float sl2=__builtin_amdgcn_exp2f(-2.f*(float)(h+1))*1.4426950408889634f;
    const unsigned* nq=nrm+((b*16+2*h+map)*2), *nk=nrm+((b*16+8+2*h+map)*2);
    const float qn=__builtin_sqrtf(__uint_as_float(nq[0])+__uint_as_float(nq[1])), kn=__builtin_sqrtf(__uint_as_float(nk[0])+__uint_as_float(nk[1]));
    const float R=(2.f*qn*kn+48.f)/sl2; const int q0=qb*QB;
    int t_lo=(int)__builtin_fmaxf(__builtin_floorf(((float)q0-R)*(1.f/64.f)),0.f), t_hi=(int)__builtin_fminf(__builtin_floorf(((float)(q0+QB-1)+R)*(1.f/64.f)),(float)(SEQ/KVBLK-1));
    if(((t_hi-t_lo+1)&1)!=0){ if(t_lo>0)--t_lo; else ++t_hi; }
    const int nt=t_hi-t_lo+1; const long row0=(long)b*SEQ;
    attn_unit128<THRL>(proj+(row0+q0)*QP+h*128+map*64, kimg+((long)((b*4+h)*2+map)*128+t_lo)*4096, vimg+((long)(b*4+h)*128+t_lo)*8192,
                    od+((long)map*(2*SEQ)+row0+q0)*512+h*128, q0-t_lo*KVBLK, nt, -sl2, lds);
  }
}
template<int THRL=8> __device__ __forceinline__ void nat_phase(char*lds,const bf16*proj,bf16*concat,const float*rpb,int vcu,int G){
  const int tid=threadIdx.x;
  for(int id=vcu*2;id<512;id+=2*G) for(int j=0;j<2;++j){
    const int u=id+j,h=u&7,rb=u>>3,b=rb>>5,r0=(rb&31)*4;
    const int lo=min(max(r0-4,0),120), hi_=min(max(r0-1,0),120)+7; int nt=hi_-lo+1; nt+=nt&1;
    const long row0=(long)b*SEQ;
    __attribute__((address_space(3))) float* tb=(__attribute__((address_space(3))) float*)((__attribute__((address_space(3))) char*)lds+LDS_TB);
    if(tid<15*31) tb[tid]=rpb[h*15*31+tid]*1.4426950408889634f;
    attn_unit<1,1024,THRL>(proj+(row0+r0*64)*QP+1536+h*64, proj+(row0+lo*64)*KP+2048+h*64, proj+(row0+lo*64)*KP+2560+h*64,
                    concat+(row0+r0*64)*1024+512+h*64, r0, lo, nt, 0.f, lds); }
}
#undef SBAR
#undef WAIT_BAR
}
#define XB_TMO      128
#define XB_XCNT(j)  (256  + 64 * (j))
#define XB_XSUB(j)  (1280 + 64 * (j))
#define XB_XGEN(j)  (2304 + 64 * (j))
#define XB_TOP      3328
#define XB_TOPGEN   3392
#define XCD_BAR_WORDS 3456
#define XB_SPIN_CAP (1u << 18)

__device__ __forceinline__ unsigned xb_ld(unsigned* p)              { return __hip_atomic_load(p, __ATOMIC_RELAXED, __HIP_MEMORY_SCOPE_AGENT); }
__device__ __forceinline__ unsigned xb_add(unsigned* p, unsigned v) { return __hip_atomic_fetch_add(p, v, __ATOMIC_RELAXED, __HIP_MEMORY_SCOPE_AGENT); }
__device__ __forceinline__ unsigned xb_xcc_id() { return (unsigned)__builtin_amdgcn_s_getreg((3 << 11) | 20) & 0xFu; }
#define XB_SPIN(cond, bar) do { unsigned _sp = 0; while (cond) { __builtin_amdgcn_s_sleep(1); \
    if ((++_sp & 255u) == 0u) { if (xb_ld(&(bar)[XB_TMO])) break; if (_sp > XB_SPIN_CAP) { atomicAdd(&(bar)[XB_TMO], 1u); break; } } } } while (0)

struct XcdBarrier {
    unsigned* bar; unsigned x;
    volatile LAS unsigned* st;
};

__device__ __forceinline__ XcdBarrier xcd_barrier_post(unsigned* bar, volatile LAS unsigned* st) {
    XcdBarrier b; b.bar = bar; b.x = xb_xcc_id(); b.st = st;
    if (threadIdx.x == 0) (void)xb_add(&bar[XB_XCNT(b.x)], 1u);
    return b;
}
__device__ __forceinline__ void xcd_barrier_complete(unsigned* bar, unsigned x, unsigned& nloc, unsigned& nx) {
    const unsigned G = gridDim.x * gridDim.y * gridDim.z;
    unsigned sum, cnt, mine, sp = 0u;
    for (;;) {
        sum = 0u; cnt = 0u; mine = 0u;
#pragma unroll
        for (unsigned j = 0; j < 16; ++j) { const unsigned c = xb_ld(&bar[XB_XCNT(j)]); sum += c; cnt += (c > 0u) ? 1u : 0u; mine = (j == x) ? c : mine; }
        if (sum == G) break;
        __builtin_amdgcn_s_sleep(1);
        if ((++sp & 255u) == 0u) { if (xb_ld(&bar[XB_TMO])) break; if (sp > XB_SPIN_CAP) { atomicAdd(&bar[XB_TMO], 1u); break; } }
    }
    nloc = mine > 0u ? mine : 1u; nx = cnt > 0u ? cnt : 1u;
}

__device__ __forceinline__ void xcd_barrier(const XcdBarrier& b) {
    asm volatile("s_waitcnt vmcnt(0)" ::: "memory");
    __syncthreads();
    if (threadIdx.x == 0) {
        unsigned* bar = b.bar;
        __builtin_amdgcn_s_waitcnt(0);
        unsigned nloc = b.st[0], nx = b.st[1];
        if (nloc == 0u) { xcd_barrier_complete(bar, b.x, nloc, nx); b.st[0] = nloc; b.st[1] = nx; }
        const unsigned old = xb_add(&bar[XB_XSUB(b.x)], 1u);
        const unsigned gen = old / nloc;
        if (old + 1u == (gen + 1u) * nloc) {
            __builtin_amdgcn_fence(__ATOMIC_RELEASE, "agent");
            asm volatile("s_waitcnt vmcnt(0)" ::: "memory");
            const unsigned og = xb_add(&bar[XB_TOP], 1u);
            const unsigned tg = og / nx;
            if (og + 1u == (tg + 1u) * nx) xb_add(&bar[XB_TOPGEN], 1u);
            else XB_SPIN(xb_ld(&bar[XB_TOPGEN]) == tg, bar);
            __builtin_amdgcn_fence(__ATOMIC_ACQUIRE, "agent");
            xb_add(&bar[XB_XGEN(b.x)], 1u);
            asm volatile("s_waitcnt vmcnt(0)" ::: "memory");
        } else {
            XB_SPIN(xb_ld(&bar[XB_XGEN(b.x)]) == gen, bar);
            __builtin_amdgcn_fence(__ATOMIC_ACQUIRE, "agent");
            asm volatile("s_waitcnt vmcnt(0)" ::: "memory");
        }
    }
    __syncthreads();
}
__device__ __forceinline__ float wave_sum(float v) {
#pragma unroll
    for (int o = 1; o < 64; o <<= 1) v += __shfl_xor(v, o);
    return v;
}
__device__ __forceinline__ void p0_transpose_item(const float* W, int K, int N, bf16* WT, int row_off, LAS float* scr, int item, int lane) {
    const int nblk = N / 32, kb = item / nblk, nb = item % nblk, k0 = 64 * kb, n0 = 32 * nb;
#pragma unroll 8
    for (int i = 0; i < 32; ++i) { const int kk = 2 * i + (lane >> 5); scr[kk * 33 + (lane & 31)] = W[(size_t)(k0 + kk) * N + n0 + (lane & 31)]; }
    LDS_WAIT(); asm volatile("" ::: "memory");
    const int c = lane & 7;
#pragma unroll
    for (int j = 0; j < 4; ++j) { const int n = (lane >> 3) + 8 * j; const LAS float* s = scr + (8 * c) * 33 + n;
        v4u o; o.x = pk2(s[0 * 33], s[1 * 33]); o.y = pk2(s[2 * 33], s[3 * 33]); o.z = pk2(s[4 * 33], s[5 * 33]); o.w = pk2(s[6 * 33], s[7 * 33]);
        *(GAS v4u*)(WT + (size_t)(row_off + n0 + n) * K + k0 + 8 * c) = o; }
    LDS_WAIT(); asm volatile("" ::: "memory");
}
__device__ __forceinline__ unsigned pk4_fp8(float a, float b, float c, float d) {
    int w = 0; w = __builtin_amdgcn_cvt_pk_fp8_f32(__builtin_amdgcn_fmed3f(a, -448.f, 448.f), __builtin_amdgcn_fmed3f(b, -448.f, 448.f), w, false);
    w = __builtin_amdgcn_cvt_pk_fp8_f32(__builtin_amdgcn_fmed3f(c, -448.f, 448.f), __builtin_amdgcn_fmed3f(d, -448.f, 448.f), w, true); return (unsigned)w;
}
__device__ __forceinline__ void p0_transpose_item_f8(const float* W, int K, int N, unsigned char* WT, int row_off, LAS float* scr, int item, int lane, float SC) {
    const int nblk = N / 32, kb = item / nblk, nb = item % nblk, k0 = 64 * kb, n0 = 32 * nb;
#pragma unroll 8
    for (int i = 0; i < 32; ++i) { const int kk = 2 * i + (lane >> 5); scr[kk * 33 + (lane & 31)] = W[(size_t)(k0 + kk) * N + n0 + (lane & 31)]; }
    LDS_WAIT(); asm volatile("" ::: "memory");
    const int c = lane & 3;
#pragma unroll
    for (int j = 0; j < 2; ++j) { const int n = (lane >> 2) + 16 * j; const LAS float* s = scr + (16 * c) * 33 + n;
        v4u o; o.x = pk4_fp8(s[0 * 33] * SC, s[1 * 33] * SC, s[2 * 33] * SC, s[3 * 33] * SC); o.y = pk4_fp8(s[4 * 33] * SC, s[5 * 33] * SC, s[6 * 33] * SC, s[7 * 33] * SC);
        o.z = pk4_fp8(s[8 * 33] * SC, s[9 * 33] * SC, s[10 * 33] * SC, s[11 * 33] * SC); o.w = pk4_fp8(s[12 * 33] * SC, s[13 * 33] * SC, s[14 * 33] * SC, s[15 * 33] * SC);
        *(GAS v4u*)(WT + (size_t)(row_off + n0 + n) * K + k0 + 16 * c) = o; }
    LDS_WAIT(); asm volatile("" ::: "memory");
}
struct Params { const float* in[22]; float* out; unsigned char* ws; };

__device__ __forceinline__ float mod_val(const float* __restrict__ modp, const float* __restrict__ b_ada, int b, int j) {
    return b_ada[j] + ((modp[(0 * 2 + b) * 6144 + j] + modp[(1 * 2 + b) * 6144 + j]) + (modp[(2 * 2 + b) * 6144 + j] + modp[(3 * 2 + b) * 6144 + j]));
}

__device__ __forceinline__ int opaque_v(int i) { asm volatile("" : "+v"(i)); return i; }
__device__ __forceinline__ int opaque_i(int i) { asm volatile("" : "+s"(i)); return i; }
__device__ __forceinline__ unsigned char* launder_ws(unsigned char* p) { asm volatile("" : "+s"(p)); return p; }
__global__ void __launch_bounds__(NTHR, 2) mk_fwd(Params P) {
    extern __shared__ __attribute__((aligned(16))) unsigned char lds_raw[];
    LAS unsigned char* lds = (LAS unsigned char*)lds_raw;
    const int tid0 = threadIdx.x;
#define PH_TID const int tid = opaque_v(tid0), lane = tid & 63, wave = __builtin_amdgcn_readfirstlane(tid >> 6); const int bx = opaque_i((int)blockIdx.x), G = (int)gridDim.x, \
        vcu = (G % 8 == 0) ? (bx % 8) * (G / 8) + bx / 8 : bx, gw = vcu * NWAVES + wave, NGW = G * NWAVES; (void)lane; (void)gw; (void)NGW; (void)vcu; (void)bx
    unsigned char* const ws0 = P.ws;
#define WSP(name, type, off) type* name = (type*)(launder_ws(ws0) + (off))
#define INP(name, i) const float* name = P.in[opaque_i(i)]
    LAS int* tab = (LAS int*)(lds + TAB_OFF);

    for (int u = tid0; u < (LDS_BYTES - LDSCTL_OFF) / 4; u += NTHR) ((LAS unsigned*)(lds + LDSCTL_OFF))[u] = 0u;
    __syncthreads();
    XcdBarrier bar = xcd_barrier_post((unsigned*)((gu32*)(ws0 + WS_CTL) + CW_BAR), (volatile LAS unsigned*)(lds + MISC_OFF) + 8);

    if ((int)blockIdx.x < 192) {
        PH_TID;
        INP(cvec, 1); INP(w_ada, 2); WSP(modp, float, WS_MODP);
        LAS float* sl = (LAS float*)lds; LAS float* red = sl + 512;
        for (int it = bx; it < 192; it += G) {
            const int cc = it % 48, kq = it / 48, cl = tid & 127, ks = tid >> 7;
            { const float c0 = cvec[(tid >> 8) * 1024 + kq * 256 + (tid & 255)]; sl[tid] = c0 / (1.f + __expf(-c0)); }
            __syncthreads();
            float a0 = 0.f, a1 = 0.f; const float* wp = w_ada + (size_t)(kq * 256 + ks * 64) * 6144 + cc * 128 + cl;
#pragma unroll 8
            for (int kk = 0; kk < 64; ++kk) { const float w = wp[(size_t)kk * 6144]; a0 += sl[ks * 64 + kk] * w; a1 += sl[256 + ks * 64 + kk] * w; }
            red[(ks * 2 + 0) * 128 + cl] = a0; red[(ks * 2 + 1) * 128 + cl] = a1;
            __syncthreads();
            if (tid < 256) { const int b = tid >> 7; const float v = (red[(0 * 2 + b) * 128 + cl] + red[(1 * 2 + b) * 128 + cl]) + (red[(2 * 2 + b) * 128 + cl] + red[(3 * 2 + b) * 128 + cl]);
                modp[(kq * 2 + b) * 6144 + cc * 128 + cl] = v; }
            __syncthreads();
        }
    }
    for (int rep_ = 0; rep_ <= DUP_P0; ++rep_) {
        PH_TID;
        LAS float* scr = (LAS float*)(lds + RING_OFF + wave * 16384);
        INP(w_in, 6); INP(w_out, 7); WSP(win_t, bf16, WS_WIN); WSP(wout_t, bf16, WS_WOUT);
        constexpr int I_IN = 16 * 96, I_OUT = 16 * 32;
        for (int it = gw; it < I_IN + I_OUT; it += NGW) {
            if (it < I_IN) p0_transpose_item(w_in, D, NPROJ, win_t, 0, scr, it, lane); else p0_transpose_item(w_out, D, D, wout_t, 0, scr, it - I_IN, lane);
        }
    }
    xcd_barrier(bar);

    for (int xb_ = 0; xb_ < DUP_BAR; ++xb_) xcd_barrier(bar);
    for (int rep_ = 0; rep_ <= DUP_P1; ++rep_) {
        LAS float* mv = (LAS float*)lds;
        PH_TID;
        INP(x, 0); INP(b_ada, 3); INP(g_pre_mix, 4); WSP(modp, float, WS_MODP); WSP(xn, bf16, WS_XN);
        for (int i = tid; i < 4096; i += NTHR) mv[i] = mod_val(modp, b_ada, i >> 11, i & 2047);
        { WSP(modd, float, WS_MOD); for (int i = vcu * NTHR + tid; i < 2 * 6144; i += G * NTHR) modd[i] = mod_val(modp, b_ada, i / 6144, i % 6144); }
        __syncthreads();
        for (int row = gw; row < M; row += NGW) {
            const int b = row / SEQ; const float* xr = x + (size_t)row * D; const LAS float* sh = mv + b * 2048; const LAS float* sc = sh + 1024;
            f32x4 v[4]; float ss = 0.f;
#pragma unroll
            for (int i = 0; i < 4; ++i) { v[i] = *(const f32x4*)(xr + i * 256 + lane * 4); ss += v[i].x * v[i].x + v[i].y * v[i].y + v[i].z * v[i].z + v[i].w * v[i].w; }
            const float rstd = rsqrtf(wave_sum(ss) * (1.f / D) + RMS_EPS);
#pragma unroll
            for (int i = 0; i < 4; ++i) { const int c0 = i * 256 + lane * 4; float o[4];
#pragma unroll
                for (int e = 0; e < 4; ++e) o[e] = v[i][e] * rstd * g_pre_mix[c0 + e] * (1.f + sc[c0 + e]) + sh[c0 + e];
                uint2 w; w.x = pk2(o[0], o[1]); w.y = pk2(o[2], o[3]); *(uint2*)(xn + (size_t)row * D + c0) = w; }
        }
        __syncthreads();
    }
    xcd_barrier(bar);

    for (int rep_ = 0; rep_ <= DUP_P2; ++rep_) {
        PH_TID; WSP(xn, bf16, WS_XN); WSP(win_t, bf16, WS_WIN); WSP(proj, bf16, WS_PROJ);
        pg8::Gemm g{xn, win_t, M, NPROJ, D}; pg8::StaticOrder S; S.init(M, NPROJ, G, bx);
        WSP(kimg, bf16, WS_KIMG); WSP(vimg, bf16, WS_VIMG);
        pg8::EpiStoreBf16 E{proj, NPROJ, 512, attn_body::C2, 1536, 2048, (unsigned*)((gu32*)(launder_ws(ws0) + WS_CTL) + CW_NRM), kimg, vimg};
        pg8::gemm_phase<pg8::EpiStoreBf16, pg8::StaticOrder, true, true>(lds + RING_OFF, g, S, E);
    }
    xcd_barrier(bar);

#define CONV_DRAIN() do { PH_TID; INP(w1, 18); INP(w2, 20); WSP(w1_t, bf16, WS_W1T); WSP(w2_t, bf16, WS_W2T); gu32* ctlq = (gu32*)(launder_ws(ws0) + WS_CTL); \
        LAS float* scr = (LAS float*)(lds + RING_OFF + wave * 16384); volatile LAS unsigned* cqw = (volatile LAS unsigned*)(lds + LDSCTL_OFF + 8192); \
        constexpr int I_W1 = 16 * 64, I_W2 = 16 * 32, NCHK = NE * (I_W1 + I_W2) / 64; \
        for (;;) { if (tid == 0) cqw[0] = __hip_atomic_fetch_add((unsigned*)(ctlq + CW_CONVQ), 1u, __ATOMIC_RELAXED, __HIP_MEMORY_SCOPE_AGENT); \
            __syncthreads(); const int chk = (int)__builtin_amdgcn_readfirstlane(cqw[0]); __syncthreads(); if (chk >= NCHK) break; \
            for (int i8 = 0; i8 < 8; ++i8) { int r = chk * 64 + i8 * 8 + wave; \
                if (r < NE * I_W1) { const int e = r / I_W1; p0_transpose_item_f8(w1 + (size_t)e * D * 2048, D, 2048, (unsigned char*)w1_t, e * 2048, scr, r % I_W1, lane, 64.f); } \
                else { r -= NE * I_W1; const int e = r / I_W2; p0_transpose_item_f8(w2 + (size_t)e * FF * D, FF, D, (unsigned char*)w2_t, e * 1024, scr, r % I_W2, lane, 64.f); } } } \
        __syncthreads(); } while (0)
    const bool conv_first = ((((int)blockIdx.x) >> 3) & 3) == 3;
    if (conv_first) CONV_DRAIN();
    for (int rep_ = 0; rep_ <= DUP_ATT; ++rep_) {
        PH_TID; WSP(proj, bf16, WS_PROJ); WSP(od, bf16, WS_ODIFF);
        gu32* ctl = (gu32*)(launder_ws(ws0) + WS_CTL);
        WSP(kimg, bf16, WS_KIMG); WSP(vimg, bf16, WS_VIMG);
        attn_body::attn_phase<8>((char*)lds_raw, (const attn_body::bf16*)proj, (const attn_body::bf16*)kimg, (const attn_body::bf16*)vimg, (attn_body::bf16*)od, (unsigned*)(ctl + CW_ATTQ) + 64 * rep_, (const unsigned*)(ctl + CW_NRM));
    }
    if (!conv_first) CONV_DRAIN();
    for (int rep_ = 0; rep_ <= DUP_NAT; ++rep_) {
        PH_TID; INP(rpb, 13); WSP(proj, bf16, WS_PROJ); WSP(concat, bf16, WS_CONCAT);
        attn_body::nat_phase<8>((char*)lds_raw, (const attn_body::bf16*)proj, (attn_body::bf16*)concat, rpb, vcu, G);
    }
    xcd_barrier(bar);

    for (int rep_ = 0; rep_ <= DUP_P4; ++rep_) {
        PH_TID;
        INP(lq1, 8); INP(lk1, 9); INP(lq2, 10); INP(lk2, 11); INP(g_sub, 12); WSP(od, bf16, WS_ODIFF); WSP(concat, bf16, WS_CONCAT);
        float s1 = 0.f, s2 = 0.f;
        for (int i = 0; i < 64; ++i) { s1 += lq1[i] * lk1[i]; s2 += lq2[i] * lk2[i]; }
        const float lam_init = 0.2f, lam = __expf(s1) - __expf(s2) + lam_init;
        for (int row = gw; row < M; row += NGW) {
            const int c0 = lane * 8;
            const v4u a = *(const v4u*)(od + (size_t)row * 512 + c0), bq = *(const v4u*)(od + ((size_t)M + row) * 512 + c0);
            float v[8]; float ss = 0.f;
#pragma unroll
            for (int e = 0; e < 4; ++e) { v[2 * e] = __uint_as_float(a[e] << 16) - lam * __uint_as_float(bq[e] << 16); v[2 * e + 1] = __uint_as_float(a[e] & 0xffff0000u) - lam * __uint_as_float(bq[e] & 0xffff0000u); }
#pragma unroll
            for (int e = 0; e < 8; ++e) ss += v[e] * v[e];
            ss += __shfl_xor(ss, 1); ss += __shfl_xor(ss, 2); ss += __shfl_xor(ss, 4); ss += __shfl_xor(ss, 8);
            const float rstd = rsqrtf(ss * (1.f / 128.f) + RMS_EPS); v4u w;
#pragma unroll
            for (int e = 0; e < 4; ++e) w[e] = pk2(v[2 * e] * rstd * g_sub[(c0 + 2 * e) & 127] * (1.f - lam_init), v[2 * e + 1] * rstd * g_sub[(c0 + 2 * e + 1) & 127] * (1.f - lam_init));
            *(v4u*)(concat + (size_t)row * D + c0) = w;
        }
    }
    xcd_barrier(bar);

    for (int rep_ = 0; rep_ <= DUP_P5; ++rep_) {
        PH_TID; WSP(concat, bf16, WS_CONCAT); WSP(wout_t, bf16, WS_WOUT); WSP(mix, float, WS_MIX);
        pg8::Gemm g{concat, wout_t, M, D, D}; pg8::StaticOrder S; S.init(M, D, G, bx);
        pg8::EpiStoreF32 E{mix, D};
        pg8::gemm_phase<pg8::EpiStoreF32, pg8::StaticOrder, true, true>(lds + RING_OFF, g, S, E);
    }
    xcd_barrier(bar);

    for (int rep_ = 0; rep_ <= DUP_P6; ++rep_) {
        PH_TID;
        INP(x, 0); INP(g_post_mix, 5); INP(g_pre_ffn, 14); INP(w_router, 16); INP(b_router, 17);
        WSP(modd, float, WS_MOD); WSP(mix, float, WS_MIX); WSP(x1, float, WS_X1); WSP(h2, bf16, WS_H2); WSP(topi, int, WS_TOPI); WSP(gate, float, WS_GATE); WSP(hist, int, WS_HIST);
        LAS float* wt = (LAS float*)lds;
        LAS int* ltop = (LAS int*)(lds + LDSCTL_OFF + 4096);
        for (int i = tid; i < 8192; i += NTHR) { const f32x4 w = *(const f32x4*)(w_router + (size_t)i * 4); const int k = i >> 3, e0 = (i & 7) * 4;
            wt[(e0 + 0) * 1024 + k] = w.x; wt[(e0 + 1) * 1024 + k] = w.y; wt[(e0 + 2) * 1024 + k] = w.z; wt[(e0 + 3) * 1024 + k] = w.w; }
        __syncthreads();
        const int my_e = (lane >> 1) & 31; const float my_b = b_router[my_e];
        for (int ch = bx; ch < NCHUNK; ch += G) {
            for (int i8 = 0; i8 < 8; ++i8) {
                const int row = ch * 64 + wave * 8 + i8, b = row / SEQ;
                const float* gt1 = modd + b * 6144 + 2048; const float* sh2 = gt1 + 1024; const float* sc2 = gt1 + 2048;
                f32x4 mvv[4], xv[4]; float ss = 0.f;
#pragma unroll
                for (int i = 0; i < 4; ++i) { mvv[i] = *(const f32x4*)(mix + (size_t)row * D + i * 256 + lane * 4); xv[i] = *(const f32x4*)(x + (size_t)row * D + i * 256 + lane * 4);
                    ss += mvv[i].x * mvv[i].x + mvv[i].y * mvv[i].y + mvv[i].z * mvv[i].z + mvv[i].w * mvv[i].w; }
                float rstd = rsqrtf(wave_sum(ss) * (1.f / D) + RMS_EPS); ss = 0.f;
#pragma unroll
                for (int i = 0; i < 4; ++i) { const int c0 = i * 256 + lane * 4; const f32x4 gg = *(const f32x4*)(gt1 + c0), gp = *(const f32x4*)(g_post_mix + c0);
#pragma unroll
                    for (int e = 0; e < 4; ++e) { xv[i][e] = xv[i][e] + gg[e] * (mvv[i][e] * rstd * gp[e]); ss += xv[i][e] * xv[i][e]; }
                    *(f32x4*)(x1 + (size_t)row * D + c0) = xv[i]; }
                rstd = rsqrtf(wave_sum(ss) * (1.f / D) + RMS_EPS);
                float lg[32];
#pragma unroll
                for (int e = 0; e < 32; ++e) lg[e] = 0.f;
#pragma unroll
                for (int i = 0; i < 4; ++i) { const int c0 = i * 256 + lane * 4; const f32x4 gf = *(const f32x4*)(g_pre_ffn + c0), s2 = *(const f32x4*)(sc2 + c0), h2s = *(const f32x4*)(sh2 + c0); float hv[4];
#pragma unroll
                    for (int j = 0; j < 4; ++j) hv[j] = xv[i][j] * rstd * gf[j] * (1.f + s2[j]) + h2s[j];
                    *(unsigned*)((unsigned char*)h2 + (size_t)row * D + c0) = pk4_fp8(hv[0], hv[1], hv[2], hv[3]);
#pragma unroll
                    for (int e = 0; e < 32; ++e) { const f32x4 wv = *(const LAS f32x4*)(wt + e * 1024 + c0); lg[e] += (hv[0] * wv.x + hv[1] * wv.y) + (hv[2] * wv.z + hv[3] * wv.w); } }
                { const bool b5 = lane & 32, b4 = lane & 16, b3 = lane & 8, b2 = lane & 4, b1 = lane & 2;
#pragma unroll
                  for (int e = 0; e < 16; ++e) { const float keep = b5 ? lg[e + 16] : lg[e], send = b5 ? lg[e] : lg[e + 16]; lg[e] = keep + __shfl_xor(send, 32); }
#pragma unroll
                  for (int e = 0; e < 8; ++e) { const float keep = b4 ? lg[e + 8] : lg[e], send = b4 ? lg[e] : lg[e + 8]; lg[e] = keep + __shfl_xor(send, 16); }
#pragma unroll
                  for (int e = 0; e < 4; ++e) { const float keep = b3 ? lg[e + 4] : lg[e], send = b3 ? lg[e] : lg[e + 4]; lg[e] = keep + __shfl_xor(send, 8); }
#pragma unroll
                  for (int e = 0; e < 2; ++e) { const float keep = b2 ? lg[e + 2] : lg[e], send = b2 ? lg[e] : lg[e + 2]; lg[e] = keep + __shfl_xor(send, 4); }
                  { const float keep = b1 ? lg[1] : lg[0], send = b1 ? lg[0] : lg[1]; lg[0] = keep + __shfl_xor(send, 2); }
                  lg[0] += __shfl_xor(lg[0], 1); }
                float cur = lg[0] + my_b; float tv[4]; int ti[4];
#pragma unroll
                for (int p = 0; p < 4; ++p) { float bv = cur; int bi = my_e;
#pragma unroll
                    for (int o = 1; o < 64; o <<= 1) { const float ov = __shfl_xor(bv, o); const int oi = __shfl_xor(bi, o); const bool take = (ov > bv) || (ov == bv && oi < bi); bv = take ? ov : bv; bi = take ? oi : bi; }
                    tv[p] = bv; ti[p] = bi; cur = (my_e == bi) ? -INFINITY : cur; }
                if (lane == 0) { const float e1 = __expf(tv[1] - tv[0]), e2 = __expf(tv[2] - tv[0]), e3 = __expf(tv[3] - tv[0]); const float rs = 1.f / (1.f + e1 + e2 + e3);
                    *(int4*)(topi + row * 4) = make_int4(ti[0], ti[1], ti[2], ti[3]); *(f32x4*)(gate + row * 4) = (f32x4){rs, e1 * rs, e2 * rs, e3 * rs};
                    const int lr = (wave * 8 + i8) * 4; ltop[lr] = ti[0]; ltop[lr + 1] = ti[1]; ltop[lr + 2] = ti[2]; ltop[lr + 3] = ti[3]; }
            }
            __syncthreads();
            if (tid < 32) { int cnt = 0; for (int i = 0; i < 256; ++i) cnt += (ltop[i] == tid) ? 1 : 0; hist[ch * 32 + tid] = cnt; }
            __syncthreads();
        }
    }
    xcd_barrier(bar);

    for (int rep_ = 0; rep_ <= DUP_P7; ++rep_) {
        LAS int* le = (LAS int*)(lds + 4096); LAS int* ld = (LAS int*)(lds + 8192);
        PH_TID;
        WSP(hist, int, WS_HIST); WSP(topi, int, WS_TOPI); WSP(dest, int, WS_DEST); WSP(h2, bf16, WS_H2); WSP(xbuf, bf16, WS_XBUF); gu32* ctl = (gu32*)(launder_ws(ws0) + WS_CTL);
        for (int ch = bx; ch < NCHUNK; ch += G) {
            if (tid < 32) { int tot = 0, base = 0; for (int c2 = 0; c2 < NCHUNK; ++c2) { const int hv = hist[c2 * 32 + tid]; tot += hv; base += (c2 < ch) ? hv : 0; } tab[32 + tid] = base; tab[tid] = (tot + 255) & ~255; }
            if (tid < 256) le[tid] = topi[ch * 256 + tid];
            __syncthreads();
            if (tid == 0) { int off = 0; for (int e = 0; e < NE; ++e) { const int pad = tab[e]; tab[e] = off;
                    if (ch == 0) for (int tl = 0; tl < pad / 256; ++tl) ctl[CW_TILEEXP + off / 256 + tl] = (unsigned)e;
                    off += pad; }
                if (ch == 0) ctl[CW_TOTAL] = (unsigned)off; }
            __syncthreads();
            if (tid < 256) { const int e = le[tid]; int rank = 0; for (int i = 0; i < tid; ++i) rank += (le[i] == e) ? 1 : 0;
                const int dd = tab[e] + tab[32 + e] + rank; dest[ch * 256 + tid] = dd; ld[tid] = dd; }
            __syncthreads();
            for (int i = 0; i < 32; ++i) { const int a = wave * 32 + i; const int dd = ld[a]; const size_t tok = (size_t)(ch * 256 + a) >> 2;
                const v4u* src = (const v4u*)((const unsigned char*)h2 + tok * D); v4u* dst = (v4u*)((unsigned char*)xbuf + (size_t)dd * D);
                dst[lane] = src[lane]; }
            __syncthreads();
        }
    }
    xcd_barrier(bar);

    {
        PH_TID;
        gu32* ctl = (gu32*)(launder_ws(ws0) + WS_CTL);
        for (int i = tid; i < MAXTILES; i += NTHR) tab[64 + i] = (int)ctl[CW_TILEEXP + i];
        if (tid == 0) tab[352] = (int)ctl[CW_TOTAL];
        __syncthreads();
        const int ntile = __builtin_amdgcn_readfirstlane(tab[352]) >> 8;
        for (int rep_ = 0; rep_ <= DUP_G1; ++rep_) {
            INP(b1, 19); WSP(xbuf, bf16, WS_XBUF); WSP(w1_t, bf16, WS_W1T); WSP(act, bf16, WS_ACT);
            pg8::Gemm g{xbuf, w1_t, CAP, 2048, D}; pg8::MoeOrder<8> S{ntile * 8, G, vcu, (const LAS int*)(tab + 64)};
            pg8::EpiSwiglu E{(unsigned char*)act, b1};
            pg8::gemm_phase<pg8::EpiSwiglu, pg8::MoeOrder<8>, true, true, true>(lds + RING_OFF, g, S, E);
        }
        xcd_barrier(bar);
        for (int rep_ = 0; rep_ <= DUP_G2; ++rep_) {
            INP(b2, 21); WSP(act, bf16, WS_ACT); WSP(w2_t, bf16, WS_W2T); WSP(ybuf, bf16, WS_YBUF);
            pg8::Gemm g{act, w2_t, CAP, 1024, FF}; pg8::MoeOrder<4> S{ntile * 4, G, vcu, (const LAS int*)(tab + 64)};
            pg8::EpiY E{ybuf, b2};
            pg8::gemm_phase<pg8::EpiY, pg8::MoeOrder<4>, true, true, true>(lds + RING_OFF, g, S, E);
        }
    }
    xcd_barrier(bar);

    for (int rep_ = 0; rep_ <= DUP_P10; ++rep_) {
        PH_TID;
        INP(g_post_ffn, 15); WSP(modd, float, WS_MOD); WSP(x1, float, WS_X1); WSP(ybuf, bf16, WS_YBUF); WSP(dest, int, WS_DEST); WSP(gate, float, WS_GATE); float* out = P.out;
        for (int row = gw; row < M; row += NGW) {
            const int b = row / SEQ; const float* gt2 = modd + b * 6144 + 5120;
            float f[16]; float ss = 0.f;
#pragma unroll
            for (int i = 0; i < 16; ++i) f[i] = 0.f;
            const int4 dd = *(const int4*)(dest + row * 4); const f32x4 gg = *(const f32x4*)(gate + row * 4);
            const int dda[4] = {dd.x, dd.y, dd.z, dd.w};
#pragma unroll
            for (int p = 0; p < 4; ++p) { const float gp = gg[p]; const bf16* yr = ybuf + (size_t)dda[p] * D;
#pragma unroll
                for (int i = 0; i < 4; ++i) { const uint2 w = *(const uint2*)(yr + i * 256 + lane * 4);
                    f[i * 4] += gp * __uint_as_float(w.x << 16); f[i * 4 + 1] += gp * __uint_as_float(w.x & 0xffff0000u); f[i * 4 + 2] += gp * __uint_as_float(w.y << 16); f[i * 4 + 3] += gp * __uint_as_float(w.y & 0xffff0000u); } }
#pragma unroll
            for (int i = 0; i < 16; ++i) ss += f[i] * f[i];
            const float rstd = rsqrtf(wave_sum(ss) * (1.f / D) + RMS_EPS);
#pragma unroll
            for (int i = 0; i < 4; ++i) { const int c0 = i * 256 + lane * 4; const f32x4 xv = *(const f32x4*)(x1 + (size_t)row * D + c0); f32x4 ov;
#pragma unroll
                for (int e = 0; e < 4; ++e) ov[e] = xv[e] + gt2[c0 + e] * (f[i * 4 + e] * rstd * g_post_ffn[c0 + e]);
                *(f32x4*)(out + (size_t)row * D + c0) = ov; }
        }
    }
}

extern "C" void kernel_launch(void* const* d_in, const int* in_sizes, int n_in, void* d_out, int out_size, void* d_ws, size_t ws_size, hipStream_t stream) {
    static int grid = 0;
    if (grid == 0) {
        if (n_in != 22 || ws_size < WS_END) { fprintf(stderr, "kernel_launch: unexpected n_in %d / ws %zu\n", n_in, ws_size); grid = -1; return; }
        int dev = 0, cus = 0, per_cu = 0;
        if (hipGetDevice(&dev) != hipSuccess || hipDeviceGetAttribute(&cus, hipDeviceAttributeMultiprocessorCount, dev) != hipSuccess) { grid = -1; return; }
        if (hipFuncSetAttribute((const void*)mk_fwd, hipFuncAttributeMaxDynamicSharedMemorySize, LDS_BYTES) != hipSuccess) { fprintf(stderr, "kernel_launch: hipFuncSetAttribute failed\n"); grid = -1; return; }
        if (hipOccupancyMaxActiveBlocksPerMultiprocessor(&per_cu, (const void*)mk_fwd, NTHR, LDS_BYTES) != hipSuccess || per_cu < 1) { fprintf(stderr, "kernel_launch: occupancy query says %d\n", per_cu); }
        (void)hipGetLastError();
        grid = cus;
    }
    if (grid < 0) return;
    if (hipMemsetAsync((char*)d_ws + WS_CTL, 0, 1 * MiB, stream) != hipSuccess) return;
    Params p{};
    for (int i = 0; i < 22; ++i) p.in[i] = (const float*)d_in[i];
    p.out = (float*)d_out; p.ws = (unsigned char*)d_ws;
    hipLaunchKernelGGL(mk_fwd, dim3(grid), dim3(NTHR), LDS_BYTES, stream, p);
}
```

```cpp
#include <hip/hip_runtime.h>
#include <stdint.h>
#include <stdio.h>

#define GAS __attribute__((address_space(1)))
#define LAS __attribute__((address_space(3)))
typedef unsigned short bf16;
typedef unsigned v4u __attribute__((ext_vector_type(4)));
typedef float f32x4 __attribute__((ext_vector_type(4)));
typedef GAS unsigned gu32;
#define LDS_WAIT() asm volatile("s_waitcnt lgkmcnt(0)" ::: "memory")
#define VM_WAIT() asm volatile("s_waitcnt vmcnt(0)" ::: "memory")

#define DUP_P0 0
#define DUP_ATT 0
#define DUP_NAT 0
#define DUP_G1 0
#define DUP_G2 0
#define DUP_P2 0
#define DUP_P5 0
#define DUP_P1 0
#define DUP_P4 0
#define DUP_BAR 0
#define DUP_P6 0
#define DUP_P7 0
#define DUP_P10 0
constexpr int NB = 2, SEQ = 8192, D = 1024, M = NB * SEQ;
constexpr int NPROJ = 3072, NE = 32, TOPK = 4, FF = 1024;
constexpr int NASSIGN = M * TOPK;
constexpr int CAP = NASSIGN + NE * 256;
constexpr int MAXTILES = CAP / 256;
constexpr int NCHUNK = M / 64;
constexpr float RMS_EPS = 1e-6f;
constexpr int NWAVES = 8, NTHR = 512;

constexpr size_t MiB = 1u << 20;
constexpr size_t WS_CTL = 0;
constexpr size_t WS_MODP = 1 * MiB;
constexpr size_t WS_MOD = 1 * MiB + 512 * 1024;
constexpr size_t WS_HIST = 2 * MiB;
constexpr size_t WS_TOPI = 3 * MiB;
constexpr size_t WS_GATE = 3 * MiB + 512 * 1024;
constexpr size_t WS_DEST = 4 * MiB;
constexpr size_t WS_WIN = 6 * MiB;
constexpr size_t WS_WOUT = 12 * MiB;
constexpr size_t WS_XN = 16 * MiB;
constexpr size_t WS_PROJ = 48 * MiB;
constexpr size_t WS_ODIFF = 144 * MiB;
constexpr size_t WS_XBUF = 48 * MiB;
constexpr size_t WS_CONCAT = 208 * MiB;
constexpr size_t WS_MIX = 240 * MiB;
constexpr size_t WS_X1 = 304 * MiB;
constexpr size_t WS_H2 = 368 * MiB;
constexpr size_t WS_ACT = 400 * MiB;
constexpr size_t WS_YBUF = 544 * MiB;
constexpr size_t WS_W1T = 688 * MiB;
constexpr size_t WS_W2T = 816 * MiB;
constexpr size_t WS_KIMG = 880 * MiB;
constexpr size_t WS_VIMG = 896 * MiB;
constexpr size_t WS_END = 912 * MiB;
static_assert(WS_XBUF + (size_t)CAP * D * 2 <= WS_CONCAT, "XBUF overlay");
constexpr int CW_TOTAL = 64;
constexpr int CW_TILEEXP = 128;
constexpr int CW_NRM = 512;
constexpr int CW_ATTQ = 1024;
constexpr int CW_NATQ = 1536;
constexpr int CW_CONVQ = 2048;
constexpr int CW_BAR = 4096;

constexpr int RING_OFF = 0, RING_BYTES = 131072;
constexpr int LDSCTL_OFF = RING_BYTES, MISC_OFF = LDSCTL_OFF + 320, TAB_OFF = LDSCTL_OFF + 1024;
constexpr int LDS_BYTES = 147456;

__device__ __forceinline__ float bf2f(bf16 v) { return __uint_as_float(((unsigned)v) << 16); }
__device__ __forceinline__ unsigned f2bf(float f) { unsigned u = __builtin_bit_cast(unsigned, f); return (u + 0x7fffu + ((u >> 16) & 1u)) >> 16; }
__device__ __forceinline__ unsigned pk2(float lo, float hi) { return f2bf(lo) | (f2bf(hi) << 16); }
namespace pg8 {
#define PG8_LAS __attribute__((address_space(3)))
typedef unsigned short bf16_t;
typedef short bf16x8 __attribute__((ext_vector_type(8)));
typedef float f32x4 __attribute__((ext_vector_type(4)));
typedef unsigned u32x4 __attribute__((ext_vector_type(4)));
constexpr int BM = 256, BK = 64, HALF = 128, HTB = HALF * BK * 2  , STAGE_BYTES = 8 * HTB, NXCD = 8, WGM = 8;

__host__ __device__ __forceinline__ int lds_byte(int r, int c) { const int st = (r >> 4) * 2 + (c >> 5), rr = r & 15, cc = c & 31, ob = rr * 64 + cc * 2; return st * 1024 + (ob ^ (((ob >> 9) & 1) << 5)); }
__host__ __device__ __forceinline__ void stage_rc(int b, int& R, int& C) { const int st = b / 1024, sb = b % 1024, swz = sb ^ (((sb >> 9) & 1) << 5); R = (st >> 1) * 16 + swz / 64; C = (st & 1) * 32 + (swz % 64) / 2; }
__host__ __device__ __forceinline__ int perm32(int rho) { const int n = rho >> 4, i = rho & 15; return 8 * (i >> 2) + 4 * n + (i & 3); }

struct Unit { int pm, pn; };
struct Gemm { const bf16_t* A; const bf16_t* Bt; int M, N, K; };

struct StaticOrder {
    int nM, nN, nwg, G, c;
    __host__ __device__ void init(int M, int N, int G_, int c_) { nM = M / BM; nN = N / BM; nwg = nM * nN; G = G_; c = c_; }
    __host__ __device__ bool next(int i, Unit& u) const {
        const long L = (long)i * G + c; if (L >= nwg) return false;
        int wgid = (int)L; { const int q = nwg / NXCD, r = nwg % NXCD, xcd = wgid % NXCD, off = wgid / NXCD; wgid = (xcd < r ? xcd * (q + 1) : r * (q + 1) + (xcd - r) * q) + off; }
        const int nig = WGM * nN, gid = wgid / nig, fm = gid * WGM, gsz = (nM - fm) < WGM ? (nM - fm) : WGM;
        u.pm = fm + ((wgid % nig) % gsz); u.pn = (wgid % nig) / gsz; return true;
    }
    __device__ __forceinline__ void a_ready(const Unit&) const {}
    __device__ __forceinline__ void done(const Unit&) const {}
};

__device__ __forceinline__ unsigned cvt_pk_bf16(float lo, float hi) { unsigned r; asm volatile("v_cvt_pk_bf16_f32 %0, %1, %2" : "=v"(r) : "v"(lo), "v"(hi)); return r; }
struct EpiStoreBf16 {
    static constexpr bool PERM = true, AFTER_DRAIN = false;
    bf16_t* O; int ldc; int scale_cols; float scale0; int s2lo, s2hi; unsigned* nrm; bf16_t* kimg; bf16_t* vimg;
    __device__ __forceinline__ void operator()(const f32x4 (&acc)[2][2][4][2], const Unit& u, int wr, int wc, int fr, int fq) const {
        const int row0 = u.pm * BM + wr * 64 + fr, colt = u.pn * BM, col0 = colt + wc * 32 + 8 * fq; const float sc = (colt < scale_cols || (colt >= s2lo && colt < s2hi)) ? scale0 : 1.f;
        const bool isk = (colt >= 512 && colt < 1024), isv = (colt >= 1024 && colt < 1536);
        float mx[2] = {0.f, 0.f};
#pragma unroll
        for (int ai = 0; ai < 2; ++ai)
#pragma unroll
            for (int m = 0; m < 4; ++m) { const int row = row0 + ai * HALF + m * 16; bf16_t* rowp = O + (size_t)row * ldc + col0;
                const int b = row >> 13, tile = (row & 8191) >> 6, rr = row & 63;
#pragma unroll
                for (int bj = 0; bj < 2; ++bj) { const f32x4 v0 = acc[ai][bj][m][0] * sc, v1 = acc[ai][bj][m][1] * sc;
                    u32x4 w; w.x = cvt_pk_bf16(v0[0], v0[1]); w.y = cvt_pk_bf16(v0[2], v0[3]); w.z = cvt_pk_bf16(v1[0], v1[1]); w.w = cvt_pk_bf16(v1[2], v1[3]);
                    if (isk) { const int c = col0 + bj * HALF - 512, hm = c >> 6, chunk = (c & 63) >> 3;
                        *(u32x4*)(kimg + ((size_t)((b * 8 + hm) * 128 + tile) * 4096 + chunk * 512 + rr * 8)) = w; }
                    else if (isv) { const int c = col0 + bj * HALF - 1024, h = c >> 7, e = c & 127;
                        *(u32x4*)(vimg + ((size_t)((b * 4 + h) * 128 + tile) * 8192 + (e >> 5) * 2048 + rr * 32 + (e & 31))) = w; }
                    else *(u32x4*)(rowp + bj * HALF) = w;
                    if (colt < 1024) { float s = 0.f;
#pragma unroll
                        for (int j = 0; j < 4; ++j) { const float lo = __uint_as_float(w[j] << 16), hi = __uint_as_float(w[j] & 0xffff0000u); s += lo * lo + hi * hi; }
                        s += __shfl_xor(s, 16); s += __shfl_xor(s, 32); mx[bj] = fmaxf(mx[bj], s); } } }
        if (colt < 1024) {
#pragma unroll
            for (int bj = 0; bj < 2; ++bj) { float v = mx[bj]; v = fmaxf(v, __shfl_xor(v, 1)); v = fmaxf(v, __shfl_xor(v, 2)); v = fmaxf(v, __shfl_xor(v, 4)); v = fmaxf(v, __shfl_xor(v, 8));
                if (fr == 0 && fq == 0) { const int g = (colt + bj * HALF + wc * 32) >> 6, b = u.pm >> 5; atomicMax(nrm + ((b * 16 + g) * 2 + (wc & 1)), __float_as_uint(v)); } }
        }
    }
};
struct EpiStoreF32 {
    static constexpr bool PERM = true, AFTER_DRAIN = false;
    float* O; int ldc;
    __device__ __forceinline__ void operator()(const f32x4 (&acc)[2][2][4][2], const Unit& u, int wr, int wc, int fr, int fq) const {
        const int row0 = u.pm * BM + wr * 64 + fr, col0 = u.pn * BM + wc * 32 + 8 * fq;
#pragma unroll
        for (int ai = 0; ai < 2; ++ai)
#pragma unroll
            for (int m = 0; m < 4; ++m) { float* rowp = O + (size_t)(row0 + ai * HALF + m * 16) * ldc + col0;
#pragma unroll
                for (int bj = 0; bj < 2; ++bj) { *(f32x4*)(rowp + bj * HALF) = acc[ai][bj][m][0]; *(f32x4*)(rowp + bj * HALF + 4) = acc[ai][bj][m][1]; } }
    }
};
struct EpiSwiglu {
    static constexpr bool PERM = true, AFTER_DRAIN = false;
    unsigned char* act; const float* b1;
    __device__ __forceinline__ void operator()(const f32x4 (&acc)[2][2][4][2], const Unit& u, int wr, int wc, int fr, int fq) const {
        const int e = u.pn >> 3, pnl = u.pn & 7, row0 = u.pm * BM + wr * 64 + fr, hc0 = pnl * BM + wc * 32 + 8 * fq;
        f32x4 bv[2][2];
#pragma unroll
        for (int bj = 0; bj < 2; ++bj)
#pragma unroll
            for (int n = 0; n < 2; ++n) bv[bj][n] = *(const f32x4*)(b1 + e * 2048 + hc0 + bj * HALF + 4 * n);
#pragma unroll
        for (int ai = 0; ai < 2; ++ai)
#pragma unroll
            for (int m = 0; m < 4; ++m) { unsigned char* rowp = act + (size_t)(row0 + ai * HALF + m * 16) * 1024 + (hc0 >> 1);
#pragma unroll
                for (int bj = 0; bj < 2; ++bj) { const f32x4 v0 = acc[ai][bj][m][0] + bv[bj][0], v1 = acc[ai][bj][m][1] + bv[bj][1];
                    float r[4];
                    const float gg[4] = {v0[0], v0[2], v1[0], v1[2]}, ll[4] = {v0[1], v0[3], v1[1], v1[3]};
#pragma unroll
                    for (int p = 0; p < 4; ++p) { float g = gg[p], l = ll[p];
                        g = fminf(g, 7.f); l = fminf(fmaxf(l, -7.f), 7.f);
                        r[p] = g * __builtin_amdgcn_rcpf(1.f + __expf(-1.702f * g)) * (l + 1.f); }
                    int w = 0; w = __builtin_amdgcn_cvt_pk_fp8_f32(r[0], r[1], w, false); w = __builtin_amdgcn_cvt_pk_fp8_f32(r[2], r[3], w, true);
                    *(int*)(rowp + bj * (HALF / 2)) = w; } }
    }
};
struct EpiY {
    static constexpr bool PERM = true, AFTER_DRAIN = false;
    bf16_t* y; const float* b2;
    __device__ __forceinline__ void operator()(const f32x4 (&acc)[2][2][4][2], const Unit& u, int wr, int wc, int fr, int fq) const {
        const int e = u.pn >> 2, pnl = u.pn & 3, row0 = u.pm * BM + wr * 64 + fr, col0 = pnl * BM + wc * 32 + 8 * fq;
        f32x4 bv[2][2];
#pragma unroll
        for (int bj = 0; bj < 2; ++bj)
#pragma unroll
            for (int n = 0; n < 2; ++n) bv[bj][n] = *(const f32x4*)(b2 + e * 1024 + col0 + bj * HALF + 4 * n);
#pragma unroll
        for (int ai = 0; ai < 2; ++ai)
#pragma unroll
            for (int m = 0; m < 4; ++m) { bf16_t* rowp = y + (size_t)(row0 + ai * HALF + m * 16) * 1024 + col0;
#pragma unroll
                for (int bj = 0; bj < 2; ++bj) { const f32x4 v0 = acc[ai][bj][m][0] + bv[bj][0], v1 = acc[ai][bj][m][1] + bv[bj][1];
                    u32x4 w; w.x = cvt_pk_bf16(v0[0], v0[1]); w.y = cvt_pk_bf16(v0[2], v0[3]); w.z = cvt_pk_bf16(v1[0], v1[1]); w.w = cvt_pk_bf16(v1[2], v1[3]);
                    *(u32x4*)(rowp + bj * HALF) = w; } }
    }
};
template <int NN> struct MoeOrder {
    int nunit, G, c; const PG8_LAS int* texp;
    __device__ __forceinline__ bool next(int i, Unit& u) const {
        const int L = i * G + c; if (L >= nunit) return false;
        const int pm = L / NN, pnl = L % NN; u.pm = pm; u.pn = __builtin_amdgcn_readfirstlane(texp[pm]) * NN + pnl; return true;
    }
    __device__ __forceinline__ void a_ready(const Unit&) const {}
    __device__ __forceinline__ void done(const Unit&) const {}
};
typedef int i32x4_t __attribute__((ext_vector_type(4))); typedef int i32x8_t __attribute__((ext_vector_type(8)));
__device__ __forceinline__ void pg8_glds16(const void* sbase, unsigned voff, unsigned lds_dst) { unsigned keep;
    asm volatile("s_mov_b32 %0, m0\n\ts_mov_b32 m0, %3\n\ts_nop 0\n\tglobal_load_lds_dwordx4 %1, %2\n\ts_mov_b32 m0, %0" : "=&s"(keep) : "v"(voff), "s"(sbase), "s"(lds_dst) : "memory"); }
template <class Epi, class Sched, bool ALIGN_EPI = false, bool SP2 = false, bool FP8 = false>
__device__ __forceinline__ void gemm_phase(PG8_LAS unsigned char* lds, const Gemm g, const Sched& S, const Epi& E) {
    int tid_ = threadIdx.x; asm volatile("" : "+v"(tid_));
    const int tid = tid_, wid = __builtin_amdgcn_readfirstlane(tid >> 6), lane = tid & 63, wr = wid >> 2, wc = wid & 3, fr = lane & 15, fq = lane >> 4;
    const int K = g.K, KB = FP8 ? K : 2 * K, nt = KB / (BK * 2);
    unsigned voffA[2], voffB[2];
#pragma unroll
    for (int i = 0; i < 2; ++i) { int R, C; stage_rc(tid * 16 + i * 8192, R, C); const int Rb = Epi::PERM ? ((R & ~31) + perm32(R & 31)) : R;
        voffA[i] = (unsigned)(R * KB + C * 2); voffB[i] = (unsigned)(Rb * KB + C * 2); }
    const size_t kstep = (size_t)(BK * 2);
    const size_t hstep = (size_t)HALF * KB;
    const size_t tstep = 2 * hstep;
    const unsigned ldsb = (unsigned)(uintptr_t)lds;
    const unsigned ldsw = (unsigned)wid * 1024u; const unsigned ldsbw = (unsigned)__builtin_amdgcn_readfirstlane(ldsb + ldsw);
    const int aoff = lds_byte(wr * 64 + fr, fq * 8), boff = lds_byte(wc * 32 + fr, fq * 8);
#define PG8_CAT(x, y) __builtin_shufflevector(__builtin_bit_cast(i32x4_t, x), __builtin_bit_cast(i32x4_t, y), 0, 1, 2, 3, 4, 5, 6, 7)
#define PG8_SA(b, h) (((b) * 2 + (h)) * HTB)
#define PG8_SB(b, h) ((4 + (b) * 2 + (h)) * HTB)
#define PG8_STAGE(bufoff, gbase, voff) do { _Pragma("unroll") for (int _i = 0; _i < 2; ++_i) \
        pg8_glds16((const void*)(gbase), (voff)[_i], ldsbw + (unsigned)((bufoff) + _i * 8192)); } while (0)
#define PG8_LDA(dst, b, h) do { if constexpr (FP8) { _Pragma("unroll") for (int m = 0; m < 4; ++m) dst##8[m] = PG8_CAT(*(const PG8_LAS bf16x8*)(lds + PG8_SA(b, h) + aoff + m * 2048), *(const PG8_LAS bf16x8*)(lds + PG8_SA(b, h) + aoff + m * 2048 + 1024)); } \
    else { _Pragma("unroll") for (int m = 0; m < 4; ++m) _Pragma("unroll") for (int k = 0; k < 2; ++k) dst[m][k] = *(const PG8_LAS bf16x8*)(lds + PG8_SA(b, h) + aoff + m * 2048 + k * 1024); } } while (0)
#define PG8_LDB(dst, b, h) do { if constexpr (FP8) { _Pragma("unroll") for (int n = 0; n < 2; ++n) dst##8[n] = PG8_CAT(*(const PG8_LAS bf16x8*)(lds + PG8_SB(b, h) + boff + n * 2048), *(const PG8_LAS bf16x8*)(lds + PG8_SB(b, h) + boff + n * 2048 + 1024)); } \
    else { _Pragma("unroll") for (int n = 0; n < 2; ++n) _Pragma("unroll") for (int k = 0; k < 2; ++k) dst[n][k] = *(const PG8_LAS bf16x8*)(lds + PG8_SB(b, h) + boff + n * 2048 + k * 1024); } } while (0)
#define PG8_MMA(ai, bj, At, Bt) do { __builtin_amdgcn_s_setprio(1); if constexpr (FP8) { _Pragma("unroll") for (int m = 0; m < 4; ++m) _Pragma("unroll") for (int n = 0; n < 2; ++n) \
        acc[ai][bj][m][n] = __builtin_amdgcn_mfma_scale_f32_16x16x128_f8f6f4(Bt##8[n], At##8[m], acc[ai][bj][m][n], 0, 0, 0, 0x7c7c7c7c, 0, 0x7c7c7c7c); } \
    else { _Pragma("unroll") for (int m = 0; m < 4; ++m) _Pragma("unroll") for (int n = 0; n < 2; ++n) _Pragma("unroll") for (int k = 0; k < 2; ++k) \
        acc[ai][bj][m][n] = __builtin_amdgcn_mfma_f32_16x16x32_bf16(Bt[n][k], At[m][k], acc[ai][bj][m][n], 0, 0, 0); } __builtin_amdgcn_s_setprio(0); } while (0)
#define PG8_WAIT_V(n) asm volatile("s_waitcnt vmcnt(" #n ")" ::: "memory")
#define PG8_WAIT_L(n) asm volatile("s_waitcnt lgkmcnt(" #n ")" ::: "memory")
#define PG8_BAR __builtin_amdgcn_s_barrier()
#define PG8_SCHED __builtin_amdgcn_sched_barrier(0)
    Unit cur, nxt; int ui = 0;
    if (!S.next(0, cur)) return;
    f32x4 acc[2][2][4][2];
#pragma unroll
    for (int a = 0; a < 2; ++a)
#pragma unroll
        for (int b = 0; b < 2; ++b)
#pragma unroll
            for (int m = 0; m < 4; ++m)
#pragma unroll
                for (int n = 0; n < 2; ++n) acc[a][b][m][n] = (f32x4){0.f, 0.f, 0.f, 0.f};
    bf16x8 At[4][2], B0[2][2], B1[2][2]; i32x8_t At8[4], B08[2], B18[2];
    const char* cA = (const char*)g.A + (size_t)cur.pm * tstep; const char* cB = (const char*)g.Bt + (size_t)cur.pn * tstep;
    S.a_ready(cur);
    if constexpr (SP2) {
        PG8_STAGE(PG8_SB(0, 0), cB, voffB); PG8_STAGE(PG8_SB(0, 1), cB + hstep, voffB); PG8_STAGE(PG8_SA(0, 0), cA, voffA); PG8_STAGE(PG8_SA(0, 1), cA + hstep, voffA);
        if (wr == 1) PG8_BAR;
        PG8_WAIT_V(2); PG8_BAR;
        PG8_STAGE(PG8_SB(1, 0), cB + kstep, voffB); PG8_STAGE(PG8_SA(1, 0), cA + kstep, voffA); PG8_STAGE(PG8_SB(1, 1), cB + hstep + kstep, voffB);
        PG8_WAIT_V(6); PG8_BAR;
    } else {
        PG8_STAGE(PG8_SB(0, 0), cB, voffB); PG8_STAGE(PG8_SA(0, 0), cA, voffA); PG8_STAGE(PG8_SB(0, 1), cB + hstep, voffB); PG8_STAGE(PG8_SA(0, 1), cA + hstep, voffA);
        if (wr == 1) PG8_BAR;
        PG8_WAIT_V(4); PG8_BAR;
        PG8_STAGE(PG8_SB(1, 0), cB + kstep, voffB); PG8_STAGE(PG8_SA(1, 0), cA + kstep, voffA); PG8_STAGE(PG8_SB(1, 1), cB + hstep + kstep, voffB);
        PG8_WAIT_V(6); PG8_BAR;
    }
    for (;;) {
        const bool has_next = S.next(ui + 1, nxt);
        const char* nA = has_next ? (const char*)g.A + (size_t)nxt.pm * tstep : cA; const char* nB = has_next ? (const char*)g.Bt + (size_t)nxt.pn * tstep : cB;
#pragma clang loop unroll(disable)
        for (int t = 0; t < nt; t += 2) {
            const bool last = (t == nt - 2);
            const char* a1 = cA + (size_t)(t + 1) * kstep;
            const char* a2 = last ? nA : cA + (size_t)(t + 2) * kstep; const char* b2 = last ? nB : cB + (size_t)(t + 2) * kstep;
            const char* a3 = a2 + kstep; const char* b3 = b2 + kstep;
            if (last && has_next) S.a_ready(nxt);
            if constexpr (SP2) {
            PG8_LDB(B0, 0, 0); PG8_LDB(B1, 0, 1); PG8_SCHED; PG8_LDA(At, 0, 0); PG8_STAGE(PG8_SA(1, 1), a1 + hstep, voffA);
            PG8_WAIT_V(8); PG8_WAIT_L(0); PG8_BAR; PG8_MMA(0, 0, At, B0); PG8_MMA(0, 1, At, B1); PG8_BAR; PG8_SCHED;
            PG8_LDA(At, 0, 1); PG8_STAGE(PG8_SB(0, 0), b2, voffB); PG8_STAGE(PG8_SB(0, 1), b2 + hstep, voffB); PG8_STAGE(PG8_SA(0, 0), a2, voffA);
            PG8_WAIT_V(8); PG8_WAIT_L(0); PG8_BAR; PG8_MMA(1, 0, At, B0); PG8_MMA(1, 1, At, B1); PG8_BAR; PG8_SCHED;
            PG8_LDB(B0, 1, 0); PG8_LDB(B1, 1, 1); PG8_SCHED; PG8_LDA(At, 1, 0); PG8_STAGE(PG8_SA(0, 1), a2 + hstep, voffA);
            PG8_WAIT_V(8); PG8_WAIT_L(0); PG8_BAR; PG8_MMA(0, 0, At, B0); PG8_MMA(0, 1, At, B1); PG8_BAR; PG8_SCHED;
            PG8_LDA(At, 1, 1); PG8_STAGE(PG8_SB(1, 0), b3, voffB); PG8_STAGE(PG8_SB(1, 1), b3 + hstep, voffB); PG8_STAGE(PG8_SA(1, 0), a3, voffA);
            PG8_WAIT_V(8); PG8_WAIT_L(0); PG8_BAR; PG8_MMA(1, 0, At, B0); PG8_MMA(1, 1, At, B1); PG8_BAR; PG8_SCHED;
            } else {
            PG8_LDB(B0, 0, 0); PG8_SCHED; PG8_LDA(At, 0, 0); PG8_STAGE(PG8_SA(1, 1), a1 + hstep, voffA);
            PG8_WAIT_L(8); PG8_BAR; PG8_WAIT_L(0); PG8_MMA(0, 0, At, B0); PG8_BAR; PG8_SCHED;
            PG8_LDB(B1, 0, 1); PG8_STAGE(PG8_SB(0, 0), b2, voffB);
            PG8_BAR; PG8_WAIT_L(0); PG8_MMA(0, 1, At, B1); PG8_BAR;
            PG8_LDA(At, 0, 1); PG8_STAGE(PG8_SA(0, 0), a2, voffA);
            PG8_BAR; PG8_WAIT_L(0); PG8_MMA(1, 0, At, B0); PG8_BAR; PG8_SCHED;
            PG8_STAGE(PG8_SB(0, 1), b2 + hstep, voffB);
            PG8_WAIT_V(6); PG8_BAR; PG8_MMA(1, 1, At, B1); PG8_BAR;
            PG8_LDB(B0, 1, 0); PG8_SCHED; PG8_LDA(At, 1, 0); PG8_STAGE(PG8_SA(0, 1), a2 + hstep, voffA);
            PG8_WAIT_L(8); PG8_BAR; PG8_WAIT_L(0); PG8_MMA(0, 0, At, B0); PG8_BAR; PG8_SCHED;
            PG8_LDB(B1, 1, 1); PG8_STAGE(PG8_SB(1, 0), b3, voffB);
            PG8_BAR; PG8_WAIT_L(0); PG8_MMA(0, 1, At, B1); PG8_BAR;
            PG8_LDA(At, 1, 1); PG8_STAGE(PG8_SA(1, 0), a3, voffA);
            PG8_BAR; PG8_WAIT_L(0); PG8_MMA(1, 0, At, B0); PG8_BAR; PG8_SCHED;
            PG8_STAGE(PG8_SB(1, 1), b3 + hstep, voffB);
            PG8_WAIT_V(6); PG8_BAR; PG8_MMA(1, 1, At, B1); PG8_BAR;
            }
        }
        if constexpr (ALIGN_EPI) { if (wr == 0) PG8_BAR; }
        if constexpr (!Epi::AFTER_DRAIN) { int t2_ = threadIdx.x; asm volatile("" : "+v"(t2_)); const int l2_ = t2_ & 63;
            E(acc, cur, wr, wc, l2_ & 15, l2_ >> 4); S.done(cur); }
        if (!has_next) break;
#pragma unroll
        for (int a = 0; a < 2; ++a)
#pragma unroll
            for (int b = 0; b < 2; ++b)
#pragma unroll
                for (int m = 0; m < 4; ++m)
#pragma unroll
                    for (int n = 0; n < 2; ++n) acc[a][b][m][n] = (f32x4){0.f, 0.f, 0.f, 0.f};
        cur = nxt; cA = nA; cB = nB; ++ui;
        if constexpr (ALIGN_EPI) { if (wr == 1) PG8_BAR; }
    }
    PG8_WAIT_V(0);
    if constexpr (!ALIGN_EPI) { if (wr == 0) PG8_BAR; }
    PG8_BAR;
    if constexpr (Epi::AFTER_DRAIN) { E.fused(acc, cur, wr, wc, fr, fq, lds, wid, lane); S.done(cur); }
#undef PG8_SA
#undef PG8_SB
#undef PG8_STAGE
#undef PG8_LDA
#undef PG8_LDB
#undef PG8_MMA
#undef PG8_CAT
#undef PG8_WAIT_V
#undef PG8_WAIT_L
#undef PG8_BAR
#undef PG8_SCHED
}
}
#include <hip/hip_bf16.h>
#include <cmath>
namespace attn_body {
using bf16=__hip_bfloat16;
using bf16x8=__attribute__((ext_vector_type(8)))short;
using s16x4=__attribute__((ext_vector_type(4)))short;
using f32x16=__attribute__((ext_vector_type(16)))float;
using u32x4=__attribute__((ext_vector_type(4)))unsigned;
constexpr int SEQ=8192,D=64,QP=3072,KP=3072,OP=512;
constexpr int NW=8,QBLK=32,QB=QBLK*NW,KVBLK=64,NQB=SEQ/QB;
constexpr int ATTN_UNIT_ROWS=QB;
__device__ __forceinline__ int crow(int r,int hi){return (r&3)+8*(r>>2)+4*hi;}
#define SBAR() __builtin_amdgcn_sched_barrier(0)
__device__ __forceinline__ void cmask(f32x16&p0,f32x16&p1,int jb,int qrel,int hi){
  const float NEG=-INFINITY; int kb=64*jb+4*hi;
  #pragma unroll
  for(int r=0;r<16;++r){int kv=kb+(r&3)+8*(r>>2); if(kv>qrel)p0[r]=NEG; if(kv+32>qrel)p1[r]=NEG;}
}

constexpr int NSLOT=3, SLOTB=8192;
constexpr int LDS_K=0, LDS_V=NSLOT*SLOTB, LDS_WS=2*NSLOT*SLOTB, LDS_OST=LDS_WS+NW*64*4, LDS_TB=LDS_OST+NW*4096+4096, LDS_BYTES=LDS_TB+4096;
constexpr float C2=0.125f*1.4426950408889634f;
__device__ __forceinline__ void glds16(const void*gsrc,unsigned lds_dst){unsigned keep;
  asm volatile("s_mov_b32 %0, m0\n\ts_mov_b32 m0, %2\n\ts_nop 0\n\tglobal_load_lds_dwordx4 %1, off\n\ts_mov_b32 m0, %0":"=&s"(keep):"v"(gsrc),"s"(lds_dst):"memory");}
__device__ __forceinline__ float max3f(float a,float b,float c){float r;asm("v_max3_f32 %0, %1, %2, %3":"=v"(r):"v"(a),"v"(b),"v"(c));return r;}
__device__ __forceinline__ float max2f(float a,float b){float r;asm("v_max_f32_e32 %0, %1, %2":"=v"(r):"v"(a),"v"(b));return r;}
__device__ __forceinline__ float fadd_s(float a,float b){float r;asm("v_add_f32_e32 %0, %1, %2":"=v"(r):"v"(a),"v"(b));return r;}
__device__ __forceinline__ float fsub_s(float a,float b){float r;asm("v_sub_f32_e32 %0, %1, %2":"=v"(r):"v"(a),"v"(b));return r;}
typedef float f32x2_t __attribute__((ext_vector_type(2))); typedef __bf16 bf16x2_t __attribute__((ext_vector_type(2)));
__device__ __forceinline__ unsigned cvtpk_s(float lo,float hi){f32x2_t v={lo,hi};bf16x2_t b=__builtin_convertvector(v,bf16x2_t);return __builtin_bit_cast(unsigned,b);}
#define WAIT_BAR(N) asm volatile("s_waitcnt vmcnt(" #N ") lgkmcnt(0)\n\ts_barrier":::"memory")

__device__ __forceinline__ void qkt(f32x16&p0,f32x16&p1,const char*Kslot,const bf16x8*qr,const f32x16&negm,int r32,int hi){
  const char*kb=Kslot+hi*1024+r32*16;
  #pragma unroll
  for(int d0=0;d0<4;++d0){
    const bf16x8 b0=*reinterpret_cast<const bf16x8*>(kb+d0*2048);
    const bf16x8 b1=*reinterpret_cast<const bf16x8*>(kb+d0*2048+512);
    if(d0==0){p0=__builtin_amdgcn_mfma_f32_32x32x16_bf16(b0,qr[0],negm,0,0,0);p1=__builtin_amdgcn_mfma_f32_32x32x16_bf16(b1,qr[0],negm,0,0,0);}
    else{p0=__builtin_amdgcn_mfma_f32_32x32x16_bf16(b0,qr[d0],p0,0,0,0);p1=__builtin_amdgcn_mfma_f32_32x32x16_bf16(b1,qr[d0],p1,0,0,0);}}
}
typedef __attribute__((address_space(3))) const char* lds_cptr;
typedef short v4i16_t __attribute__((ext_vector_type(4)));
__device__ __forceinline__ void kload8(bf16x8*kf,lds_cptr kp){
  kf[0]=*(const __attribute__((address_space(3))) bf16x8*)(kp);      kf[1]=*(const __attribute__((address_space(3))) bf16x8*)(kp+512);
  kf[2]=*(const __attribute__((address_space(3))) bf16x8*)(kp+2048); kf[3]=*(const __attribute__((address_space(3))) bf16x8*)(kp+2560);
  kf[4]=*(const __attribute__((address_space(3))) bf16x8*)(kp+4096); kf[5]=*(const __attribute__((address_space(3))) bf16x8*)(kp+4608);
  kf[6]=*(const __attribute__((address_space(3))) bf16x8*)(kp+6144); kf[7]=*(const __attribute__((address_space(3))) bf16x8*)(kp+6656);
}
__device__ __forceinline__ void kload2(bf16x8*kf,lds_cptr kp,int j){ kf[2*j]=*(const __attribute__((address_space(3))) bf16x8*)(kp+j*2048); kf[2*j+1]=*(const __attribute__((address_space(3))) bf16x8*)(kp+j*2048+512); }
__device__ __forceinline__ s16x4 vtr(lds_cptr p){ return __builtin_bit_cast(s16x4,__builtin_amdgcn_ds_read_tr16_b64_v4i16((__attribute__((address_space(3))) v4i16_t*)p)); }
__device__ __forceinline__ float rowmax(const f32x16&p0,const f32x16&p1){
  float a=max3f(p0[0],p0[1],p1[0]),b=max3f(p0[2],p0[3],p1[1]);a=max3f(a,p1[2],p1[3]);
  #pragma unroll
  for(int r=4;r<16;r+=4){a=max3f(a,p0[r],p0[r+1]);b=max3f(b,p0[r+2],p0[r+3]);a=max3f(a,p1[r],p1[r+1]);b=max3f(b,p1[r+2],p1[r+3]);}
  const float m=max2f(a,b);
  auto rr=__builtin_amdgcn_permlane32_swap(__float_as_uint(m),__float_as_uint(m),false,false);
  return max2f(__uint_as_float(rr[0]),__uint_as_float(rr[1]));
}
__device__ __forceinline__ void pv(f32x16*o,int vb,bf16x8 pa0,bf16x8 pa1,bf16x8 pa2,bf16x8 pa3){
  #pragma unroll
  for(int d0=0;d0<2;++d0){s16x4 lo[4],hi[4];
    #pragma unroll
    for(int ks=0;ks<4;++ks){
      asm volatile("ds_read_b64_tr_b16 %0,%1 offset:%c2":"=&v"(lo[ks]):"v"(vb),"i"(d0*4096+ks*1024):"memory");
      asm volatile("ds_read_b64_tr_b16 %0,%1 offset:%c2":"=&v"(hi[ks]):"v"(vb),"i"(d0*4096+ks*1024+512):"memory");}
    asm volatile("s_waitcnt lgkmcnt(0)":::"memory");SBAR();
    #define PK(k) (bf16x8){lo[k][0],lo[k][1],lo[k][2],lo[k][3],hi[k][0],hi[k][1],hi[k][2],hi[k][3]}
    o[d0]=__builtin_amdgcn_mfma_f32_32x32x16_bf16(pa0,PK(0),o[d0],0,0,0);
    o[d0]=__builtin_amdgcn_mfma_f32_32x32x16_bf16(pa1,PK(1),o[d0],0,0,0);
    o[d0]=__builtin_amdgcn_mfma_f32_32x32x16_bf16(pa2,PK(2),o[d0],0,0,0);
    o[d0]=__builtin_amdgcn_mfma_f32_32x32x16_bf16(pa3,PK(3),o[d0],0,0,0);
    #undef PK
  }
}

#ifndef ATTN_STORE16
#define ATTN_STORE16(p,v) (*(u32x4*)(p)=(v))
#endif
template<int MODE,int OP,int THRL> __device__ __forceinline__ void attn_unit(const bf16*Qu,const bf16*__restrict__ Kh,const bf16*__restrict__ Vh,bf16*Ou,int q0,int t_lo,int NT,float nsl2,char*shm){
  int tid_=threadIdx.x; asm volatile("":"+v"(tid_));
  const int tid=tid_,lane=tid&63,r32=lane&31,hi=lane>>5; const int wid=__builtin_amdgcn_readfirstlane(tid>>6);
  const bf16*Qw=Qu+(long)(wid*QBLK)*QP;
  const unsigned lds0=(unsigned)(uintptr_t)shm;
  float*wsf=(float*)(shm+LDS_WS)+wid*64;
  const bf16*ksrc=Kh+(long)lane*KP+wid*8;
  const bf16*vsrc=Vh+(long)(16*(wid&3)+(lane>>2))*KP+(wid>>2)*32+(lane&3)*8;
  const unsigned kdst=lds0+LDS_K+wid*1024, vdst=lds0+LDS_V+wid*1024;
  #define DMA_K(t,slot) glds16(ksrc+(long)(t)*KVBLK*KP,(unsigned)__builtin_amdgcn_readfirstlane(kdst+(slot)))
  #define DMA_V(t,slot) glds16(vsrc+(long)(t)*KVBLK*KP,(unsigned)__builtin_amdgcn_readfirstlane(vdst+(slot)))
  const int vb0=(int)(lds0+LDS_V)+((lane>>4)&1)*32+(lane&3)*8+(4*hi+((lane&15)>>2))*64;
  const char*Kbase=shm+LDS_K; bf16x8 kf[8];
  const lds_cptr shm3=(lds_cptr)shm; const lds_cptr kp0=shm3+LDS_K+hi*1024+r32*16; const lds_cptr vp0=shm3+LDS_V+((lane>>4)&1)*32+(lane&3)*8+(4*hi+((lane&15)>>2))*64;
  DMA_K(0,0);DMA_V(0,0);DMA_K(1,SLOTB);
  bf16x8 qr[4];
  #pragma unroll
  for(int d0=0;d0<4;++d0)qr[d0]=*reinterpret_cast<const bf16x8*>(&Qw[(long)r32*QP+d0*16+hi*8]);
  float mhat=0.f,l_reg=0.f;f32x16 o[2];o[0]=f32x16{};o[1]=f32x16{};f32x16 negm=f32x16{};asm volatile("":"+v"(negm));
  const float qf=(float)(q0+wid*QBLK+r32-4*hi);
  const int n_r=q0+(wid>>1), n_c=(wid&1)*32+r32, n_rs=min(max(n_r-4,0),120), n_kc=4*hi-min(max(n_c-8,0),48);
  typedef __attribute__((address_space(3))) const float* lds_fptr;
  const lds_fptr n_tb=(lds_fptr)((__attribute__((address_space(3))) const char*)shm+LDS_TB)+(7-n_r)*31+4*hi-n_c+15;
  #define CMASK(P0,P1,t) do{ if(MODE==0){ const float dq_=qf-(float)(64*(t)); _Pragma("unroll") for(int r=0;r<16;++r){ const float cr_=(float)((r&3)+8*(r>>2)); \
      P0[r]=__builtin_fmaf(nsl2,__builtin_fabsf(dq_-cr_),P0[r]); P1[r]=__builtin_fmaf(nsl2,__builtin_fabsf(dq_-(cr_+32.f)),P1[r]); } } \
    else { const int kr_=t_lo+(t); const bool vr_=(kr_>=n_rs)&&(kr_<n_rs+8); const lds_fptr tb_=n_tb+kr_*31; \
      _Pragma("unroll") for(int r=0;r<16;++r){ const int ko_=(r&3)+8*(r>>2); const float b0_=tb_[ko_],b1_=tb_[ko_+32]; \
        const bool ok0_=vr_&&((unsigned)(n_kc+ko_)<16u), ok1_=vr_&&((unsigned)(n_kc+ko_+32)<16u); \
        P0[r]=ok0_?P0[r]+b0_:-INFINITY; P1[r]=ok1_?P1[r]+b1_:-INFINITY; } } }while(0)
  bool resc=false;
  #define START(P0,P1) do{ const float rm=rowmax(P0,P1); resc=false; \
    { const float dl=(rm>-1e30f)?rm:0.f; mhat=fadd_s(mhat,dl); \
      _Pragma("unroll") for(int r=0;r<16;++r){P0[r]=fsub_s(P0[r],dl);P1[r]=fsub_s(P1[r],dl);} \
      _Pragma("unroll") for(int r=0;r<16;++r)negm[r]=-mhat; asm volatile("":"+v"(negm)); } \
    _Pragma("unroll") for(int r=0;r<16;++r)P0[r]=__builtin_amdgcn_exp2f(P0[r]); }while(0)
  #define RESC() do{ if(resc){ asm volatile("s_waitcnt lgkmcnt(0)":::"memory"); \
      _Pragma("unroll") for(int d_=0;d_<2;++d_) _Pragma("unroll") for(int r=0;r<16;++r)o[d_][r]*=wsf[crow(r,hi)]; } }while(0)
  f32x16 pA0,pA1,pB0,pB1;
  int sl_prev=0,sl_cur=0,sl_next=SLOTB;
  #define ROT() do{sl_prev=sl_cur;sl_cur=sl_next;sl_next=(sl_next==(NSLOT-1)*SLOTB)?0:sl_next+SLOTB;}while(0)
  DMA_K(2,2*SLOTB);
  WAIT_BAR(3);
  qkt(pA0,pA1,Kbase,qr,negm,r32,hi);asm volatile("s_nop 15\n\ts_nop 7":"+v"(pA0),"+v"(pA1));CMASK(pA0,pA1,0);
  START(pA0,pA1);
  _Pragma("unroll") for(int r=0;r<16;++r)pA1[r]=__builtin_amdgcn_exp2f(pA1[r]);
  WAIT_BAR(0);
  DMA_K(3,0);DMA_V(1,SLOTB);
  ROT();
  kload8(kf,kp0+sl_cur);
  WAIT_BAR(2);
  s16x4 vlo[8],vhi[8]; u32x4 pw0,pw1,pw2,pw3;
  #define PKW(P,B) cvtpk_s(P[B],P[B+1])
  #define PAF(k) __builtin_bit_cast(bf16x8,pw##k)
  #define VFR(i) (bf16x8){vlo[i][0],vlo[i][1],vlo[i][2],vlo[i][3],vhi[i][0],vhi[i][1],vhi[i][2],vhi[i][3]}
  #define PIN(x) asm volatile("":"+v"(x))
  #define MX3(a,b,c) __builtin_fmaxf(__builtin_fmaxf((a),(b)),(c))
  #define GAPA(MF,A0,A1,A2,A3,W0,W1,PW) do{ MF; sacc+=A0; sacc+=A1; sacc+=A2; sacc+=A3; PIN(sacc); W0; W1; PIN(PW); SBAR(); }while(0)
  #define EX(v) __builtin_amdgcn_exp2f(v)
  #define GAPB(MF,X,B) do{ MF; X[B]=EX(X[B]); X[B+1]=EX(X[B+1]); X[B+2]=EX(X[B+2]); X[B+3]=EX(X[B+3]); PIN(X); SBAR(); }while(0)
  #define VRD(i) do{ vlo[i]=vtr(vp_+(((i)>>2)*4096+((i)&3)*1024)); vhi[i]=vtr(vp_+(((i)>>2)*4096+((i)&3)*1024+512)); }while(0)
  #define KRD(G,j) do{ if(G){ kload2(kf,kp0+sl_next,j); SBAR(); } }while(0)
  #define STEP(C0,C1,P0,P1,t,GK,GV,GL) do{ SBAR(); \
    const lds_cptr vp_=vp0+sl_prev; \
    VRD(0); SBAR(); float sacc=(P0[0]+P0[1]); \
    GAPA(C0=__builtin_amdgcn_mfma_f32_32x32x16_bf16(kf[0],qr[0],negm,0,0,0), P0[2],P0[3],P0[4],P0[5],     pw0[0]=PKW(P0,0), pw0[1]=PKW(P0,2), pw0); \
    VRD(4); SBAR(); GAPA(C1=__builtin_amdgcn_mfma_f32_32x32x16_bf16(kf[1],qr[0],negm,0,0,0), P0[6],P0[7],P0[8],P0[9],     pw0[2]=PKW(P0,4), pw0[3]=PKW(P0,6), pw0); \
    VRD(1); SBAR(); GAPA(C0=__builtin_amdgcn_mfma_f32_32x32x16_bf16(kf[2],qr[1],C0,0,0,0),   P0[10],P0[11],P0[12],P0[13], pw1[0]=PKW(P0,8), pw1[1]=PKW(P0,10), pw1); \
    VRD(5); SBAR(); GAPA(C1=__builtin_amdgcn_mfma_f32_32x32x16_bf16(kf[3],qr[1],C1,0,0,0),   P0[14],P0[15],P1[0],P1[1],   pw1[2]=PKW(P0,12),pw1[3]=PKW(P0,14), pw1); \
    VRD(2); SBAR(); GAPA(C0=__builtin_amdgcn_mfma_f32_32x32x16_bf16(kf[4],qr[2],C0,0,0,0),   P1[2],P1[3],P1[4],P1[5],     pw2[0]=PKW(P1,0), pw2[1]=PKW(P1,2), pw2); \
    VRD(6); SBAR(); GAPA(C1=__builtin_amdgcn_mfma_f32_32x32x16_bf16(kf[5],qr[2],C1,0,0,0),   P1[6],P1[7],P1[8],P1[9],     pw2[2]=PKW(P1,4), pw2[3]=PKW(P1,6), pw2); \
    VRD(3); SBAR(); GAPA(C0=__builtin_amdgcn_mfma_f32_32x32x16_bf16(kf[6],qr[3],C0,0,0,0),   P1[10],P1[11],P1[12],P1[13], pw3[0]=PKW(P1,8), pw3[1]=PKW(P1,10), pw3); \
    VRD(7); SBAR(); GAPA(C1=__builtin_amdgcn_mfma_f32_32x32x16_bf16(kf[7],qr[3],C1,0,0,0),   P1[14],P1[15],0.f,0.f,       pw3[2]=PKW(P1,12),pw3[3]=PKW(P1,14), pw3); \
    l_reg+=sacc; \
    if(GK){DMA_K((t)+3,sl_cur);} if(GV){DMA_V((t)+1,sl_next);} \
    CMASK(C0,C1,t); \
    { float a=MX3(C0[0],C0[1],C1[0]),b=MX3(C0[2],C0[3],C1[1]); a=MX3(a,C1[2],C1[3]); \
      _Pragma("unroll") for(int r=4;r<16;r+=4){a=MX3(a,C0[r],C0[r+1]);b=MX3(b,C0[r+2],C0[r+3]);a=MX3(a,C1[r],C1[r+1]);b=MX3(b,C1[r+2],C1[r+3]);} \
      float rm=__builtin_fmaxf(a,b); { auto rr=__builtin_amdgcn_permlane32_swap(__float_as_uint(rm),__float_as_uint(rm),false,false); rm=__builtin_fmaxf(__uint_as_float(rr[0]),__uint_as_float(rr[1])); } \
      resc=false; \
      if(__builtin_expect(__any(rm>(float)THRL),0)){ const float dl=__builtin_fmaxf(rm,0.f); mhat+=dl; \
        _Pragma("unroll") for(int r=0;r<16;++r){C0[r]-=dl;C1[r]-=dl;} \
        _Pragma("unroll") for(int r=0;r<16;++r)negm[r]=-mhat; asm volatile("":"+v"(negm)); \
        const float f=__builtin_amdgcn_exp2f(-dl); l_reg*=f; if(hi==0)wsf[r32]=f; resc=true; } } \
    SBAR(); \
    GAPB(o[0]=__builtin_amdgcn_mfma_f32_32x32x16_bf16(PAF(0),VFR(0),o[0],0,0,0), C0,0); \
    GAPB(o[1]=__builtin_amdgcn_mfma_f32_32x32x16_bf16(PAF(0),VFR(4),o[1],0,0,0), C0,4); \
    KRD(GL,0); GAPB(o[0]=__builtin_amdgcn_mfma_f32_32x32x16_bf16(PAF(1),VFR(1),o[0],0,0,0), C0,8); \
    KRD(GL,1); GAPB(o[1]=__builtin_amdgcn_mfma_f32_32x32x16_bf16(PAF(1),VFR(5),o[1],0,0,0), C0,12); \
    KRD(GL,2); GAPB(o[0]=__builtin_amdgcn_mfma_f32_32x32x16_bf16(PAF(2),VFR(2),o[0],0,0,0), C1,0); \
    KRD(GL,3); GAPB(o[1]=__builtin_amdgcn_mfma_f32_32x32x16_bf16(PAF(2),VFR(6),o[1],0,0,0), C1,4); \
    GAPB(o[0]=__builtin_amdgcn_mfma_f32_32x32x16_bf16(PAF(3),VFR(3),o[0],0,0,0), C1,8); \
    GAPB(o[1]=__builtin_amdgcn_mfma_f32_32x32x16_bf16(PAF(3),VFR(7),o[1],0,0,0), C1,12); \
    }while(0)
  int t=1;
  for(;t+5<NT;t+=2){
    STEP(pB0,pB1,pA0,pA1,t,true,true,true);     WAIT_BAR(2); RESC(); ROT();
    STEP(pA0,pA1,pB0,pB1,t+1,true,true,true);   WAIT_BAR(2); RESC(); ROT();
  }
  #define ENDW(tt) do{ if((tt)+3<NT){WAIT_BAR(2);} else if((tt)+2<NT){WAIT_BAR(1);} else {WAIT_BAR(0);} }while(0)
  for(;t+1<NT;t+=2){
    STEP(pB0,pB1,pA0,pA1,t,(t+3<NT),(t+1<NT),(t+1<NT));       ENDW(t);   RESC(); ROT();
    STEP(pA0,pA1,pB0,pB1,t+1,(t+4<NT),(t+2<NT),(t+2<NT));     ENDW(t+1); RESC(); ROT();
  }
  STEP(pB0,pB1,pA0,pA1,NT-1,false,false,false); RESC();
  { float sacc=pB0[0]+pB0[1]; _Pragma("unroll") for(int r=2;r<16;++r)sacc+=pB0[r]; _Pragma("unroll") for(int r=0;r<16;++r)sacc+=pB1[r]; l_reg+=sacc;
    pw0=(u32x4){PKW(pB0,0),PKW(pB0,2),PKW(pB0,4),PKW(pB0,6)};pw1=(u32x4){PKW(pB0,8),PKW(pB0,10),PKW(pB0,12),PKW(pB0,14)};pw2=(u32x4){PKW(pB1,0),PKW(pB1,2),PKW(pB1,4),PKW(pB1,6)};pw3=(u32x4){PKW(pB1,8),PKW(pB1,10),PKW(pB1,12),PKW(pB1,14)};
    SBAR(); pv(o,vb0+sl_cur,PAF(0),PAF(1),PAF(2),PAF(3)); }
  #undef PKW
  #undef PAF
  #undef VFR
  #undef PIN
  #undef MX3
  #undef GAPA
  #undef GAPB
  #undef EX
  #undef VRD
  #undef KRD
  #undef STEP
  #undef ENDW
  {auto rr=__builtin_amdgcn_permlane32_swap(__float_as_uint(l_reg),__float_as_uint(l_reg),false,false);l_reg=__uint_as_float(rr[0])+__uint_as_float(rr[1]);}
  if(hi==0)wsf[32+r32]=l_reg;asm volatile("s_waitcnt lgkmcnt(0)":::"memory");
  float rli[16];
  #pragma unroll
  for(int r=0;r<16;++r)rli[r]=__builtin_amdgcn_rcpf(wsf[32+crow(r,hi)]);
  bf16*Ow=Ou+(long)(wid*QBLK)*OP;
  { bf16*stg=(bf16*)(shm+LDS_OST)+wid*2048;
    #pragma unroll
    for(int r=0;r<16;++r){const int orow=crow(r,hi);
      #pragma unroll
      for(int d0=0;d0<2;++d0)stg[orow*64+d0*32+r32]=__float2bfloat16(o[d0][r]*rli[r]);}
    asm volatile("s_waitcnt lgkmcnt(0)":::"memory");
    #pragma unroll
    for(int i=0;i<4;++i){const int row=i*8+(lane>>3),ch=lane&7; const u32x4 v=*(const u32x4*)(stg+row*64+ch*8); ATTN_STORE16(Ow+(long)row*OP+ch*8,v);} }
  asm volatile("s_waitcnt lgkmcnt(0)\n\ts_barrier":::"memory");
  #undef DMA_K
  #undef DMA_V
  #undef CMASK
  #undef START
  #undef RESC
  #undef ROT
}
constexpr int W_K=0, W_V=NSLOT*SLOTB, W_WS=W_V+NSLOT*2*SLOTB, W_OST=W_WS+NW*64*4, W_BYTES=W_OST+NW*4096;
template<int THRL> __device__ __forceinline__ void attn_unit128(const bf16*Qu,const bf16*__restrict__ Kh,const bf16*__restrict__ Vh,bf16*Ou,int q0,int NT,float nsl2,char*shm){
  constexpr int OP=512;
  int tid_=threadIdx.x; asm volatile("":"+v"(tid_));
  const int tid=tid_,lane=tid&63,r32=lane&31,hi=lane>>5; const int wid=__builtin_amdgcn_readfirstlane(tid>>6);
  const bf16*Qw=Qu+(long)(wid*QBLK)*QP;
  const unsigned lds0=(unsigned)(uintptr_t)shm;
  float*wsf=(float*)(shm+W_WS)+wid*64;
  const bf16*ksrc=Kh+wid*512+lane*8;
  const bf16*vsrc=Vh+wid*512+lane*8;
  const unsigned kdst=lds0+W_K+wid*1024, vdst=lds0+W_V+wid*1024;
  #define DMA_K(t,slot) glds16(ksrc+(long)(t)*4096,(unsigned)__builtin_amdgcn_readfirstlane(kdst+(slot)))
  #define DMA_V(t,slot) do{ glds16(vsrc+(long)(t)*8192,(unsigned)__builtin_amdgcn_readfirstlane(vdst+2*(slot))); glds16(vsrc+(long)(t)*8192+4096,(unsigned)__builtin_amdgcn_readfirstlane(vdst+2*(slot)+8192)); }while(0)
  const int vb0=(int)(lds0+W_V)+((lane>>4)&1)*32+(lane&3)*8+(4*hi+((lane&15)>>2))*64;
  bf16x8 kf[8];
  const lds_cptr shm3=(lds_cptr)shm; const lds_cptr kp0=shm3+W_K+hi*1024+r32*16; const lds_cptr vp0=shm3+W_V+((lane>>4)&1)*32+(lane&3)*8+(4*hi+((lane&15)>>2))*64;
  DMA_K(0,0);DMA_V(0,0);DMA_K(1,SLOTB);
  bf16x8 qr[4];
  #pragma unroll
  for(int d0=0;d0<4;++d0)qr[d0]=*reinterpret_cast<const bf16x8*>(&Qw[(long)r32*QP+d0*16+hi*8]);
  float mhat=0.f,l_reg=0.f;f32x16 o[4];o[0]=f32x16{};o[1]=f32x16{};o[2]=f32x16{};o[3]=f32x16{};
  const float qf=(float)(q0+wid*QBLK+r32-4*hi);
  const int td=(q0>>6)+(wid>>1);
  #define CINIT(C0,C1,t) do{ const int tt_=(t); const float dq_=qf-(float)(64*tt_); \
    if(tt_==td){ _Pragma("unroll") for(int r=0;r<16;++r){ const float cr_=(float)((r&3)+8*(r>>2)); \
        C0[r]=__builtin_fmaf(nsl2,__builtin_fabsf(dq_-cr_),-mhat); C1[r]=__builtin_fmaf(nsl2,__builtin_fabsf(dq_-(cr_+32.f)),-mhat); } } \
    else { const float k_=(tt_<td)?-nsl2:nsl2; const float b_=__builtin_fmaf(-k_,dq_,-mhat); \
      _Pragma("unroll") for(int r=0;r<16;++r){ const float cr_=(float)((r&3)+8*(r>>2)); C0[r]=__builtin_fmaf(k_,cr_,b_); C1[r]=__builtin_fmaf(k_,cr_+32.f,b_); } } }while(0)
  bool resc=false;
  #define START(P0,P1) do{ const float rm=rowmax(P0,P1); resc=false; \
    { const float dl=rm; mhat=fadd_s(mhat,dl); \
      _Pragma("unroll") for(int r=0;r<16;++r){P0[r]=fsub_s(P0[r],dl);P1[r]=fsub_s(P1[r],dl);} } \
    _Pragma("unroll") for(int r=0;r<16;++r)P0[r]=__builtin_amdgcn_exp2f(P0[r]); }while(0)
  #define RESC() do{ if(resc){ asm volatile("s_waitcnt lgkmcnt(0)":::"memory"); \
      _Pragma("unroll") for(int d_=0;d_<4;++d_) _Pragma("unroll") for(int r=0;r<16;++r)o[d_][r]*=wsf[crow(r,hi)]; } }while(0)
  f32x16 pA0,pA1,pB0,pB1;
  int sl_prev=0,sl_cur=0,sl_next=SLOTB;
  #define ROT() do{sl_prev=sl_cur;sl_cur=sl_next;sl_next=(sl_next==(NSLOT-1)*SLOTB)?0:sl_next+SLOTB;}while(0)
  DMA_K(2,2*SLOTB);
  WAIT_BAR(4);
  CINIT(pA0,pA1,0);
  { const lds_cptr kb=kp0;
    #pragma unroll
    for(int d0=0;d0<4;++d0){ const bf16x8 b0=*(const __attribute__((address_space(3))) bf16x8*)(kb+d0*2048), b1=*(const __attribute__((address_space(3))) bf16x8*)(kb+d0*2048+512);
      pA0=__builtin_amdgcn_mfma_f32_32x32x16_bf16(b0,qr[d0],pA0,0,0,0); pA1=__builtin_amdgcn_mfma_f32_32x32x16_bf16(b1,qr[d0],pA1,0,0,0); } }
  asm volatile("s_nop 15\n\ts_nop 7":"+v"(pA0),"+v"(pA1));
  START(pA0,pA1);
  _Pragma("unroll") for(int r=0;r<16;++r)pA1[r]=__builtin_amdgcn_exp2f(pA1[r]);
  WAIT_BAR(0);
  DMA_K(3,0);DMA_V(1,SLOTB);
  ROT();
  kload8(kf,kp0+sl_cur);
  WAIT_BAR(3);
  s16x4 vlo[8],vhi[8]; u32x4 pw0,pw1,pw2,pw3;
  #define PKW(P,B) cvtpk_s(P[B],P[B+1])
  #define PAF(k) __builtin_bit_cast(bf16x8,pw##k)
  #define VFR(i) (bf16x8){vlo[i][0],vlo[i][1],vlo[i][2],vlo[i][3],vhi[i][0],vhi[i][1],vhi[i][2],vhi[i][3]}
  #define PIN(x) asm volatile("":"+v"(x))
  #define MX3(a,b,c) __builtin_fmaxf(__builtin_fmaxf((a),(b)),(c))
  #define GAPA(MF,A0,A1,A2,A3,W0,W1,PW) do{ MF; sacc+=A0; sacc+=A1; sacc+=A2; sacc+=A3; PIN(sacc); W0; W1; PIN(PW); SBAR(); }while(0)
  #define EX(v) __builtin_amdgcn_exp2f(v)
  #define GAPB(MF,X,B) do{ MF; X[B]=EX(X[B]); X[B+1]=EX(X[B+1]); PIN(X); SBAR(); }while(0)
  #define VRD(i) do{ vlo[i]=vtr(vp_+(((i)>>2)*4096+((i)&3)*1024)); vhi[i]=vtr(vp_+(((i)>>2)*4096+((i)&3)*1024+512)); }while(0)
  #define VRD2(i) do{ vlo[i]=vtr(vp_+(8192+((i)>>2)*4096+((i)&3)*1024)); vhi[i]=vtr(vp_+(8192+((i)>>2)*4096+((i)&3)*1024+512)); SBAR(); }while(0)
  #define KRD(G,j) do{ if(G){ kload2(kf,kp0+sl_next,j); SBAR(); } }while(0)
  #define STEP(C0,C1,P0,P1,t,GK,GV,GL) do{ SBAR(); \
    const lds_cptr vp_=vp0+2*sl_prev; \
    CINIT(C0,C1,t); SBAR(); \
    VRD(0); SBAR(); float sacc=(P0[0]+P0[1]); \
    GAPA(C0=__builtin_amdgcn_mfma_f32_32x32x16_bf16(kf[0],qr[0],C0,0,0,0), P0[2],P0[3],P0[4],P0[5],     pw0[0]=PKW(P0,0), pw0[1]=PKW(P0,2), pw0); \
    VRD(4); SBAR(); GAPA(C1=__builtin_amdgcn_mfma_f32_32x32x16_bf16(kf[1],qr[0],C1,0,0,0), P0[6],P0[7],P0[8],P0[9],     pw0[2]=PKW(P0,4), pw0[3]=PKW(P0,6), pw0); \
    VRD(1); SBAR(); GAPA(C0=__builtin_amdgcn_mfma_f32_32x32x16_bf16(kf[2],qr[1],C0,0,0,0),   P0[10],P0[11],P0[12],P0[13], pw1[0]=PKW(P0,8), pw1[1]=PKW(P0,10), pw1); \
    VRD(5); SBAR(); GAPA(C1=__builtin_amdgcn_mfma_f32_32x32x16_bf16(kf[3],qr[1],C1,0,0,0),   P0[14],P0[15],P1[0],P1[1],   pw1[2]=PKW(P0,12),pw1[3]=PKW(P0,14), pw1); \
    VRD(2); SBAR(); GAPA(C0=__builtin_amdgcn_mfma_f32_32x32x16_bf16(kf[4],qr[2],C0,0,0,0),   P1[2],P1[3],P1[4],P1[5],     pw2[0]=PKW(P1,0), pw2[1]=PKW(P1,2), pw2); \
    VRD(6); SBAR(); GAPA(C1=__builtin_amdgcn_mfma_f32_32x32x16_bf16(kf[5],qr[2],C1,0,0,0),   P1[6],P1[7],P1[8],P1[9],     pw2[2]=PKW(P1,4), pw2[3]=PKW(P1,6), pw2); \
    VRD(3); SBAR(); GAPA(C0=__builtin_amdgcn_mfma_f32_32x32x16_bf16(kf[6],qr[3],C0,0,0,0),   P1[10],P1[11],P1[12],P1[13], pw3[0]=PKW(P1,8), pw3[1]=PKW(P1,10), pw3); \
    VRD(7); SBAR(); GAPA(C1=__builtin_amdgcn_mfma_f32_32x32x16_bf16(kf[7],qr[3],C1,0,0,0),   P1[14],P1[15],0.f,0.f,       pw3[2]=PKW(P1,12),pw3[3]=PKW(P1,14), pw3); \
    l_reg+=sacc; \
    if(GK){DMA_K((t)+3,sl_cur);} if(GV){DMA_V((t)+1,sl_next);} \
    { float a=MX3(C0[0],C0[1],C1[0]),b=MX3(C0[2],C0[3],C1[1]); a=MX3(a,C1[2],C1[3]); \
      _Pragma("unroll") for(int r=4;r<16;r+=4){a=MX3(a,C0[r],C0[r+1]);b=MX3(b,C0[r+2],C0[r+3]);a=MX3(a,C1[r],C1[r+1]);b=MX3(b,C1[r+2],C1[r+3]);} \
      float rm=__builtin_fmaxf(a,b); { auto rr=__builtin_amdgcn_permlane32_swap(__float_as_uint(rm),__float_as_uint(rm),false,false); rm=__builtin_fmaxf(__uint_as_float(rr[0]),__uint_as_float(rr[1])); } \
      resc=false; \
      if(__builtin_expect(__any(rm>(float)THRL),0)){ const float dl=__builtin_fmaxf(rm,0.f); mhat+=dl; \
        _Pragma("unroll") for(int r=0;r<16;++r){C0[r]-=dl;C1[r]-=dl;} \
        const float f=__builtin_amdgcn_exp2f(-dl); l_reg*=f; if(hi==0)wsf[r32]=f; resc=true; } } \
    SBAR(); \
    GAPB(o[0]=__builtin_amdgcn_mfma_f32_32x32x16_bf16(PAF(0),VFR(0),o[0],0,0,0), C0,0); \
    GAPB(o[1]=__builtin_amdgcn_mfma_f32_32x32x16_bf16(PAF(0),VFR(4),o[1],0,0,0), C0,2);  VRD2(0); \
    GAPB(o[0]=__builtin_amdgcn_mfma_f32_32x32x16_bf16(PAF(1),VFR(1),o[0],0,0,0), C0,4);  VRD2(4); \
    GAPB(o[1]=__builtin_amdgcn_mfma_f32_32x32x16_bf16(PAF(1),VFR(5),o[1],0,0,0), C0,6);  VRD2(1); \
    GAPB(o[0]=__builtin_amdgcn_mfma_f32_32x32x16_bf16(PAF(2),VFR(2),o[0],0,0,0), C0,8);  VRD2(5); \
    GAPB(o[1]=__builtin_amdgcn_mfma_f32_32x32x16_bf16(PAF(2),VFR(6),o[1],0,0,0), C0,10); VRD2(2); \
    GAPB(o[0]=__builtin_amdgcn_mfma_f32_32x32x16_bf16(PAF(3),VFR(3),o[0],0,0,0), C0,12); VRD2(6); \
    GAPB(o[1]=__builtin_amdgcn_mfma_f32_32x32x16_bf16(PAF(3),VFR(7),o[1],0,0,0), C0,14); VRD2(3); VRD2(7); \
    GAPB(o[2]=__builtin_amdgcn_mfma_f32_32x32x16_bf16(PAF(0),VFR(0),o[2],0,0,0), C1,0); \
    GAPB(o[3]=__builtin_amdgcn_mfma_f32_32x32x16_bf16(PAF(0),VFR(4),o[3],0,0,0), C1,2); \
    KRD(GL,0); GAPB(o[2]=__builtin_amdgcn_mfma_f32_32x32x16_bf16(PAF(1),VFR(1),o[2],0,0,0), C1,4); \
    KRD(GL,1); GAPB(o[3]=__builtin_amdgcn_mfma_f32_32x32x16_bf16(PAF(1),VFR(5),o[3],0,0,0), C1,6); \
    KRD(GL,2); GAPB(o[2]=__builtin_amdgcn_mfma_f32_32x32x16_bf16(PAF(2),VFR(2),o[2],0,0,0), C1,8); \
    KRD(GL,3); GAPB(o[3]=__builtin_amdgcn_mfma_f32_32x32x16_bf16(PAF(2),VFR(6),o[3],0,0,0), C1,10); \
    GAPB(o[2]=__builtin_amdgcn_mfma_f32_32x32x16_bf16(PAF(3),VFR(3),o[2],0,0,0), C1,12); \
    GAPB(o[3]=__builtin_amdgcn_mfma_f32_32x32x16_bf16(PAF(3),VFR(7),o[3],0,0,0), C1,14); \
    }while(0)
  int t=1;
  for(;t+5<NT;t+=2){
    STEP(pB0,pB1,pA0,pA1,t,true,true,true);     WAIT_BAR(3); RESC(); ROT();
    STEP(pA0,pA1,pB0,pB1,t+1,true,true,true);   WAIT_BAR(3); RESC(); ROT();
  }
  #define ENDW(tt) do{ if((tt)+3<NT){WAIT_BAR(3);} else if((tt)+2<NT){WAIT_BAR(2);} else {WAIT_BAR(0);} }while(0)
  for(;t+1<NT;t+=2){
    STEP(pB0,pB1,pA0,pA1,t,(t+3<NT),(t+1<NT),(t+1<NT));       ENDW(t);   RESC(); ROT();
    STEP(pA0,pA1,pB0,pB1,t+1,(t+4<NT),(t+2<NT),(t+2<NT));     ENDW(t+1); RESC(); ROT();
  }
  STEP(pB0,pB1,pA0,pA1,NT-1,false,false,false); RESC();
  { float sacc=pB0[0]+pB0[1]; _Pragma("unroll") for(int r=2;r<16;++r)sacc+=pB0[r]; _Pragma("unroll") for(int r=0;r<16;++r)sacc+=pB1[r]; l_reg+=sacc;
    pw0=(u32x4){PKW(pB0,0),PKW(pB0,2),PKW(pB0,4),PKW(pB0,6)};pw1=(u32x4){PKW(pB0,8),PKW(pB0,10),PKW(pB0,12),PKW(pB0,14)};pw2=(u32x4){PKW(pB1,0),PKW(pB1,2),PKW(pB1,4),PKW(pB1,6)};pw3=(u32x4){PKW(pB1,8),PKW(pB1,10),PKW(pB1,12),PKW(pB1,14)};
    SBAR(); pv(o,vb0+2*sl_cur,PAF(0),PAF(1),PAF(2),PAF(3)); pv(o+2,vb0+2*sl_cur+8192,PAF(0),PAF(1),PAF(2),PAF(3)); }
  #undef PKW
  #undef PAF
  #undef VFR
  #undef PIN
  #undef MX3
  #undef GAPA
  #undef GAPB
  #undef EX
  #undef VRD
  #undef VRD2
  #undef KRD
  #undef STEP
  #undef ENDW
  {auto rr=__builtin_amdgcn_permlane32_swap(__float_as_uint(l_reg),__float_as_uint(l_reg),false,false);l_reg=__uint_as_float(rr[0])+__uint_as_float(rr[1]);}
  if(hi==0)wsf[32+r32]=l_reg;asm volatile("s_waitcnt lgkmcnt(0)":::"memory");
  float rli[16];
  #pragma unroll
  for(int r=0;r<16;++r)rli[r]=__builtin_amdgcn_rcpf(wsf[32+crow(r,hi)]);
  bf16*Ow=Ou+(long)(wid*QBLK)*OP;
  { bf16*stg=(bf16*)(shm+W_OST)+wid*2048;
    #pragma unroll
    for(int hf=0;hf<2;++hf){
      #pragma unroll
      for(int r=0;r<16;++r){const int orow=crow(r,hi);
        #pragma unroll
        for(int d0=0;d0<2;++d0)stg[orow*64+d0*32+r32]=__float2bfloat16(o[hf*2+d0][r]*rli[r]);}
      asm volatile("s_waitcnt lgkmcnt(0)":::"memory");
      #pragma unroll
      for(int i=0;i<4;++i){const int row=i*8+(lane>>3),ch=lane&7; const u32x4 v=*(const u32x4*)(stg+row*64+ch*8); ATTN_STORE16(Ow+(long)row*OP+hf*64+ch*8,v);}
      asm volatile("s_waitcnt lgkmcnt(0)":::"memory"); } }
  asm volatile("s_waitcnt lgkmcnt(0)\n\ts_barrier":::"memory");
  #undef DMA_K
  #undef DMA_V
  #undef CINIT
  #undef START
  #undef RESC
  #undef ROT
}
constexpr int ATTN_LDS_BYTES=LDS_BYTES;
constexpr int LDS_QW=W_BYTES;
template<int THRL=8> __device__ __forceinline__ void attn_phase(char*lds,const bf16*proj,const bf16*kimg,const bf16*vimg,bf16*od,unsigned*qctr,const unsigned*nrm){
  const int tid=threadIdx.x;
  volatile __attribute__((address_space(3))) unsigned* qw=(volatile __attribute__((address_space(3))) unsigned*)((__attribute__((address_space(3))) char*)lds+LDS_QW);
  unsigned mine=0; if(tid==0) mine=__hip_atomic_fetch_add(qctr,1u,__ATOMIC_RELAXED,__HIP_MEMORY_SCOPE_AGENT);
  for(;;){
    if(tid==0) qw[0]=mine;
    __syncthreads();
    const int u=(int)__builtin_amdgcn_readfirstlane(qw[0]);
    if(u>=512) break;
    if(tid==0) mine=__hip_atomic_fetch_add(qctr,1u,__ATOMIC_RELAXED,__HIP_MEMORY_SCOPE_AGENT);
    const int h=3-(u>>7), r=u&127, map=r>>6, b=(r>>5)&1, qb=r&31;
    const float sl2=__builtin_amdgcn_exp2f(-2.f*(float)(h+1))*1.4426950408889634f;
    const unsigned* nq=nrm+((b*16+2*h+map)*2), *nk=nrm+((b*16+8+2*h+map)*2);
    const float qn=__builtin_sqrtf(__uint_as_float(nq[0])+__uint_as_float(nq[1])), kn=__builtin_sqrtf(__uint_as_float(nk[0])+__uint_as_float(nk[1]));
    const float R=(2.f*qn*kn+48.f)/sl2; const int q0=qb*QB;
    int t_lo=(int)__builtin_fmaxf(__builtin_floorf(((float)q0-R)*(1.f/64.f)),0.f), t_hi=(int)__builtin_fminf(__builtin_floorf(((float)(q0+QB-1)+R)*(1.f/64.f)),(float)(SEQ/KVBLK-1));
    if(((t_hi-t_lo+1)&1)!=0){ if(t_lo>0)--t_lo; else ++t_hi; }
    const int nt=t_hi-t_lo+1; const long row0=(long)b*SEQ;
    attn_unit128<THRL>(proj+(row0+q0)*QP+h*128+map*64, kimg+((long)((b*4+h)*2+map)*128+t_lo)*4096, vimg+((long)(b*4+h)*128+t_lo)*8192,
                    od+((long)map*(2*SEQ)+row0+q0)*512+h*128, q0-t_lo*KVBLK, nt, -sl2, lds);
  }
}
template<int THRL=8> __device__ __forceinline__ void nat_phase(char*lds,const bf16*proj,bf16*concat,const float*rpb,unsigned*qctr){
  const int tid=threadIdx.x;
  volatile __attribute__((address_space(3))) unsigned* qw=(volatile __attribute__((address_space(3))) unsigned*)((__attribute__((address_space(3))) char*)lds+LDS_BYTES+64);
  unsigned mine=0; if(tid==0) mine=__hip_atomic_fetch_add(qctr,1u,__ATOMIC_RELAXED,__HIP_MEMORY_SCOPE_AGENT);
  for(;;){
    if(tid==0) qw[0]=mine;
    __syncthreads();
    const int u=(int)__builtin_amdgcn_readfirstlane(qw[0]);
    if(u>=512) break;
    if(tid==0) mine=__hip_atomic_fetch_add(qctr,1u,__ATOMIC_RELAXED,__HIP_MEMORY_SCOPE_AGENT);
    const int h=u&7,rb=u>>3,b=rb>>5,r0=(rb&31)*4;
    const int lo=min(max(r0-4,0),120), hi_=min(max(r0-1,0),120)+7; int nt=hi_-lo+1; nt+=nt&1;
    const long row0=(long)b*SEQ;
    __attribute__((address_space(3))) float* tb=(__attribute__((address_space(3))) float*)((__attribute__((address_space(3))) char*)lds+LDS_TB);
    if(tid<15*31) tb[tid]=rpb[h*15*31+tid]*1.4426950408889634f;
    attn_unit<1,1024,THRL>(proj+(row0+r0*64)*QP+1536+h*64, proj+(row0+lo*64)*KP+2048+h*64, proj+(row0+lo*64)*KP+2560+h*64,
                    concat+(row0+r0*64)*1024+512+h*64, r0, lo, nt, 0.f, lds); }
}
#undef SBAR
#undef WAIT_BAR
}
#define XB_TMO      128
#define XB_XCNT(j)  (256  + 64 * (j))
#define XB_XSUB(j)  (1280 + 64 * (j))
#define XB_XGEN(j)  (2304 + 64 * (j))
#define XB_TOP      3328
#define XB_TOPGEN   3392
#define XCD_BAR_WORDS 3456
#define XB_SPIN_CAP (1u << 18)

__device__ __forceinline__ unsigned xb_ld(unsigned* p)              { return __hip_atomic_load(p, __ATOMIC_RELAXED, __HIP_MEMORY_SCOPE_AGENT); }
__device__ __forceinline__ unsigned xb_add(unsigned* p, unsigned v) { return __hip_atomic_fetch_add(p, v, __ATOMIC_RELAXED, __HIP_MEMORY_SCOPE_AGENT); }
__device__ __forceinline__ unsigned xb_xcc_id() { return (unsigned)__builtin_amdgcn_s_getreg((3 << 11) | 20) & 0xFu; }
#define XB_SPIN(cond, bar) do { unsigned _sp = 0; while (cond) { __builtin_amdgcn_s_sleep(1); \
    if ((++_sp & 255u) == 0u) { if (xb_ld(&(bar)[XB_TMO])) break; if (_sp > XB_SPIN_CAP) { atomicAdd(&(bar)[XB_TMO], 1u); break; } } } } while (0)

struct XcdBarrier {
    unsigned* bar; unsigned x;
    volatile LAS unsigned* st;
};

__device__ __forceinline__ XcdBarrier xcd_barrier_post(unsigned* bar, volatile LAS unsigned* st) {
    XcdBarrier b; b.bar = bar; b.x = xb_xcc_id(); b.st = st;
    if (threadIdx.x == 0) (void)xb_add(&bar[XB_XCNT(b.x)], 1u);
    return b;
}
__device__ __forceinline__ void xcd_barrier_complete(unsigned* bar, unsigned x, unsigned& nloc, unsigned& nx) {
    const unsigned G = gridDim.x * gridDim.y * gridDim.z;
    unsigned sum, cnt, mine, sp = 0u;
    for (;;) {
        sum = 0u; cnt = 0u; mine = 0u;
#pragma unroll
        for (unsigned j = 0; j < 16; ++j) { const unsigned c = xb_ld(&bar[XB_XCNT(j)]); sum += c; cnt += (c > 0u) ? 1u : 0u; mine = (j == x) ? c : mine; }
        if (sum == G) break;
        __builtin_amdgcn_s_sleep(1);
        if ((++sp & 255u) == 0u) { if (xb_ld(&bar[XB_TMO])) break; if (sp > XB_SPIN_CAP) { atomicAdd(&bar[XB_TMO], 1u); break; } }
    }
    nloc = mine > 0u ? mine : 1u; nx = cnt > 0u ? cnt : 1u;
}

__device__ __forceinline__ void xcd_barrier(const XcdBarrier& b) {
    asm volatile("s_waitcnt vmcnt(0)" ::: "memory");
    __syncthreads();
    if (threadIdx.x == 0) {
        unsigned* bar = b.bar;
        __builtin_amdgcn_s_waitcnt(0);
        unsigned nloc = b.st[0], nx = b.st[1];
        if (nloc == 0u) { xcd_barrier_complete(bar, b.x, nloc, nx); b.st[0] = nloc; b.st[1] = nx; }
        const unsigned old = xb_add(&bar[XB_XSUB(b.x)], 1u);
        const unsigned gen = old / nloc;
        if (old + 1u == (gen + 1u) * nloc) {
            __builtin_amdgcn_fence(__ATOMIC_RELEASE, "agent");
            asm volatile("s_waitcnt vmcnt(0)" ::: "memory");
            const unsigned og = xb_add(&bar[XB_TOP], 1u);
            const unsigned tg = og / nx;
            if (og + 1u == (tg + 1u) * nx) xb_add(&bar[XB_TOPGEN], 1u);
            else XB_SPIN(xb_ld(&bar[XB_TOPGEN]) == tg, bar);
            __builtin_amdgcn_fence(__ATOMIC_ACQUIRE, "agent");
            xb_add(&bar[XB_XGEN(b.x)], 1u);
            asm volatile("s_waitcnt vmcnt(0)" ::: "memory");
        } else {
            XB_SPIN(xb_ld(&bar[XB_XGEN(b.x)]) == gen, bar);
            __builtin_amdgcn_fence(__ATOMIC_ACQUIRE, "agent");
            asm volatile("s_waitcnt vmcnt(0)" ::: "memory");
        }
    }
    __syncthreads();
}
__device__ __forceinline__ float wave_sum(float v) {
#pragma unroll
    for (int o = 1; o < 64; o <<= 1) v += __shfl_xor(v, o);
    return v;
}
__device__ __forceinline__ void p0_transpose_item(const float* W, int K, int N, bf16* WT, int row_off, LAS float* scr, int item, int lane) {
    const int nblk = N / 32, kb = item / nblk, nb = item % nblk, k0 = 64 * kb, n0 = 32 * nb;
#pragma unroll 8
    for (int i = 0; i < 32; ++i) { const int kk = 2 * i + (lane >> 5); scr[kk * 33 + (lane & 31)] = W[(size_t)(k0 + kk) * N + n0 + (lane & 31)]; }
    LDS_WAIT(); asm volatile("" ::: "memory");
    const int c = lane & 7;
#pragma unroll
    for (int j = 0; j < 4; ++j) { const int n = (lane >> 3) + 8 * j; const LAS float* s = scr + (8 * c) * 33 + n;
        v4u o; o.x = pk2(s[0 * 33], s[1 * 33]); o.y = pk2(s[2 * 33], s[3 * 33]); o.z = pk2(s[4 * 33], s[5 * 33]); o.w = pk2(s[6 * 33], s[7 * 33]);
        *(GAS v4u*)(WT + (size_t)(row_off + n0 + n) * K + k0 + 8 * c) = o; }
    LDS_WAIT(); asm volatile("" ::: "memory");
}
__device__ __forceinline__ unsigned pk4_fp8(float a, float b, float c, float d) {
    int w = 0; w = __builtin_amdgcn_cvt_pk_fp8_f32(__builtin_amdgcn_fmed3f(a, -448.f, 448.f), __builtin_amdgcn_fmed3f(b, -448.f, 448.f), w, false);
    w = __builtin_amdgcn_cvt_pk_fp8_f32(__builtin_amdgcn_fmed3f(c, -448.f, 448.f), __builtin_amdgcn_fmed3f(d, -448.f, 448.f), w, true); return (unsigned)w;
}
__device__ __forceinline__ void p0_transpose_item_f8(const float* W, int K, int N, unsigned char* WT, int row_off, LAS float* scr, int item, int lane, float SC) {
    const int nblk = N / 32, kb = item / nblk, nb = item % nblk, k0 = 64 * kb, n0 = 32 * nb;
#pragma unroll 8
    for (int i = 0; i < 32; ++i) { const int kk = 2 * i + (lane >> 5); scr[kk * 33 + (lane & 31)] = W[(size_t)(k0 + kk) * N + n0 + (lane & 31)]; }
    LDS_WAIT(); asm volatile("" ::: "memory");
    const int c = lane & 3;
#pragma unroll
    for (int j = 0; j < 2; ++j) { const int n = (lane >> 2) + 16 * j; const LAS float* s = scr + (16 * c) * 33 + n;
        v4u o; o.x = pk4_fp8(s[0 * 33] * SC, s[1 * 33] * SC, s[2 * 33] * SC, s[3 * 33] * SC); o.y = pk4_fp8(s[4 * 33] * SC, s[5 * 33] * SC, s[6 * 33] * SC, s[7 * 33] * SC);
        o.z = pk4_fp8(s[8 * 33] * SC, s[9 * 33] * SC, s[10 * 33] * SC, s[11 * 33] * SC); o.w = pk4_fp8(s[12 * 33] * SC, s[13 * 33] * SC, s[14 * 33] * SC, s[15 * 33] * SC);
        *(GAS v4u*)(WT + (size_t)(row_off + n0 + n) * K + k0 + 16 * c) = o; }
    LDS_WAIT(); asm volatile("" ::: "memory");
}
struct Params { const float* in[22]; float* out; unsigned char* ws; };

__device__ __forceinline__ float mod_val(const float* __restrict__ modp, const float* __restrict__ b_ada, int b, int j) {
    return b_ada[j] + ((modp[(0 * 2 + b) * 6144 + j] + modp[(1 * 2 + b) * 6144 + j]) + (modp[(2 * 2 + b) * 6144 + j] + modp[(3 * 2 + b) * 6144 + j]));
}

__device__ __forceinline__ int opaque_v(int i) { asm volatile("" : "+v"(i)); return i; }
__device__ __forceinline__ int opaque_i(int i) { asm volatile("" : "+s"(i)); return i; }
__device__ __forceinline__ unsigned char* launder_ws(unsigned char* p) { asm volatile("" : "+s"(p)); return p; }
__global__ void __launch_bounds__(NTHR, 2) mk_fwd(Params P) {
    extern __shared__ __attribute__((aligned(16))) unsigned char lds_raw[];
    LAS unsigned char* lds = (LAS unsigned char*)lds_raw;
    const int tid0 = threadIdx.x;
#define PH_TID const int tid = opaque_v(tid0), lane = tid & 63, wave = __builtin_amdgcn_readfirstlane(tid >> 6); const int bx = opaque_i((int)blockIdx.x), G = (int)gridDim.x, \
        vcu = (G % 8 == 0) ? (bx % 8) * (G / 8) + bx / 8 : bx, gw = vcu * NWAVES + wave, NGW = G * NWAVES; (void)lane; (void)gw; (void)NGW; (void)vcu; (void)bx
    unsigned char* const ws0 = P.ws;
#define WSP(name, type, off) type* name = (type*)(launder_ws(ws0) + (off))
#define INP(name, i) const float* name = P.in[opaque_i(i)]
    LAS int* tab = (LAS int*)(lds + TAB_OFF);

    for (int u = tid0; u < (LDS_BYTES - LDSCTL_OFF) / 4; u += NTHR) ((LAS unsigned*)(lds + LDSCTL_OFF))[u] = 0u;
    __syncthreads();
    XcdBarrier bar = xcd_barrier_post((unsigned*)((gu32*)(ws0 + WS_CTL) + CW_BAR), (volatile LAS unsigned*)(lds + MISC_OFF) + 8);

    if ((int)blockIdx.x < 192) {
        PH_TID;
        INP(cvec, 1); INP(w_ada, 2); WSP(modp, float, WS_MODP);
        LAS float* sl = (LAS float*)lds; LAS float* red = sl + 512;
        for (int it = bx; it < 192; it += G) {
            const int cc = it % 48, kq = it / 48, cl = tid & 127, ks = tid >> 7;
            { const float c0 = cvec[(tid >> 8) * 1024 + kq * 256 + (tid & 255)]; sl[tid] = c0 / (1.f + __expf(-c0)); }
            __syncthreads();
            float a0 = 0.f, a1 = 0.f; const float* wp = w_ada + (size_t)(kq * 256 + ks * 64) * 6144 + cc * 128 + cl;
#pragma unroll 8
            for (int kk = 0; kk < 64; ++kk) { const float w = wp[(size_t)kk * 6144]; a0 += sl[ks * 64 + kk] * w; a1 += sl[256 + ks * 64 + kk] * w; }
            red[(ks * 2 + 0) * 128 + cl] = a0; red[(ks * 2 + 1) * 128 + cl] = a1;
            __syncthreads();
            if (tid < 256) { const int b = tid >> 7; const float v = (red[(0 * 2 + b) * 128 + cl] + red[(1 * 2 + b) * 128 + cl]) + (red[(2 * 2 + b) * 128 + cl] + red[(3 * 2 + b) * 128 + cl]);
                modp[(kq * 2 + b) * 6144 + cc * 128 + cl] = v; }
            __syncthreads();
        }
    }
    for (int rep_ = 0; rep_ <= DUP_P0; ++rep_) {
        PH_TID;
        LAS float* scr = (LAS float*)(lds + RING_OFF + wave * 16384);
        INP(w_in, 6); INP(w_out, 7); WSP(win_t, bf16, WS_WIN); WSP(wout_t, bf16, WS_WOUT);
        constexpr int I_IN = 16 * 96, I_OUT = 16 * 32;
        for (int it = gw; it < I_IN + I_OUT; it += NGW) {
            if (it < I_IN) p0_transpose_item(w_in, D, NPROJ, win_t, 0, scr, it, lane); else p0_transpose_item(w_out, D, D, wout_t, 0, scr, it - I_IN, lane);
        }
    }
    xcd_barrier(bar);

    for (int xb_ = 0; xb_ < DUP_BAR; ++xb_) xcd_barrier(bar);
    for (int rep_ = 0; rep_ <= DUP_P1; ++rep_) {
        LAS float* mv = (LAS float*)lds;
        PH_TID;
        INP(x, 0); INP(b_ada, 3); INP(g_pre_mix, 4); WSP(modp, float, WS_MODP); WSP(xn, bf16, WS_XN);
        for (int i = tid; i < 4096; i += NTHR) mv[i] = mod_val(modp, b_ada, i >> 11, i & 2047);
        { WSP(modd, float, WS_MOD); for (int i = vcu * NTHR + tid; i < 2 * 6144; i += G * NTHR) modd[i] = mod_val(modp, b_ada, i / 6144, i % 6144); }
        __syncthreads();
        f32x4 nv[4];
#pragma unroll
        for (int i = 0; i < 4; ++i) nv[i] = *(const f32x4*)(x + (size_t)gw * D + i * 256 + lane * 4);
        for (int row = gw; row < M; row += NGW) {
            const int b = row / SEQ; const LAS float* sh = mv + b * 2048; const LAS float* sc = sh + 1024;
            f32x4 v[4]; float ss = 0.f;
#pragma unroll
            for (int i = 0; i < 4; ++i) { v[i] = nv[i]; ss += v[i].x * v[i].x + v[i].y * v[i].y + v[i].z * v[i].z + v[i].w * v[i].w; }
            { const int nrow = (row + NGW < M) ? row + NGW : row;
#pragma unroll
              for (int i = 0; i < 4; ++i) nv[i] = *(const f32x4*)(x + (size_t)nrow * D + i * 256 + lane * 4); }
            const float rstd = rsqrtf(wave_sum(ss) * (1.f / D) + RMS_EPS);
#pragma unroll
            for (int i = 0; i < 4; ++i) { const int c0 = i * 256 + lane * 4; float o[4];
#pragma unroll
                for (int e = 0; e < 4; ++e) o[e] = v[i][e] * rstd * g_pre_mix[c0 + e] * (1.f + sc[c0 + e]) + sh[c0 + e];
                uint2 w; w.x = pk2(o[0], o[1]); w.y = pk2(o[2], o[3]); *(uint2*)(xn + (size_t)row * D + c0) = w; }
        }
        __syncthreads();
    }
    xcd_barrier(bar);

    for (int rep_ = 0; rep_ <= DUP_P2; ++rep_) {
        PH_TID; WSP(xn, bf16, WS_XN); WSP(win_t, bf16, WS_WIN); WSP(proj, bf16, WS_PROJ);
        pg8::Gemm g{xn, win_t, M, NPROJ, D}; pg8::StaticOrder S; S.init(M, NPROJ, G, bx);
        WSP(kimg, bf16, WS_KIMG); WSP(vimg, bf16, WS_VIMG);
        pg8::EpiStoreBf16 E{proj, NPROJ, 512, attn_body::C2, 1536, 2048, (unsigned*)((gu32*)(launder_ws(ws0) + WS_CTL) + CW_NRM), kimg, vimg};
        pg8::gemm_phase<pg8::EpiStoreBf16, pg8::StaticOrder, true, true>(lds + RING_OFF, g, S, E);
    }
    xcd_barrier(bar);

#define CONV_DRAIN() do { PH_TID; INP(w1, 18); INP(w2, 20); WSP(w1_t, bf16, WS_W1T); WSP(w2_t, bf16, WS_W2T); gu32* ctlq = (gu32*)(launder_ws(ws0) + WS_CTL); \
        LAS float* scr = (LAS float*)(lds + RING_OFF + wave * 16384); volatile LAS unsigned* cqw = (volatile LAS unsigned*)(lds + LDSCTL_OFF + 8192); \
        constexpr int I_W1 = 16 * 64, I_W2 = 16 * 32, NCHK = NE * (I_W1 + I_W2) / 64; \
        for (;;) { if (tid == 0) cqw[0] = __hip_atomic_fetch_add((unsigned*)(ctlq + CW_CONVQ), 1u, __ATOMIC_RELAXED, __HIP_MEMORY_SCOPE_AGENT); \
            __syncthreads(); const int chk = (int)__builtin_amdgcn_readfirstlane(cqw[0]); __syncthreads(); if (chk >= NCHK) break; \
            for (int i8 = 0; i8 < 8; ++i8) { int r = chk * 64 + i8 * 8 + wave; \
                if (r < NE * I_W1) { const int e = r / I_W1; p0_transpose_item_f8(w1 + (size_t)e * D * 2048, D, 2048, (unsigned char*)w1_t, e * 2048, scr, r % I_W1, lane, 64.f); } \
                else { r -= NE * I_W1; const int e = r / I_W2; p0_transpose_item_f8(w2 + (size_t)e * FF * D, FF, D, (unsigned char*)w2_t, e * 1024, scr, r % I_W2, lane, 64.f); } } } \
        __syncthreads(); } while (0)
    const bool conv_first = ((((int)blockIdx.x) >> 3) & 3) == 3;
    if (conv_first) CONV_DRAIN();
    for (int rep_ = 0; rep_ <= DUP_ATT; ++rep_) {
        PH_TID; WSP(proj, bf16, WS_PROJ); WSP(od, bf16, WS_ODIFF);
        gu32* ctl = (gu32*)(launder_ws(ws0) + WS_CTL);
        WSP(kimg, bf16, WS_KIMG); WSP(vimg, bf16, WS_VIMG);
        attn_body::attn_phase<8>((char*)lds_raw, (const attn_body::bf16*)proj, (const attn_body::bf16*)kimg, (const attn_body::bf16*)vimg, (attn_body::bf16*)od, (unsigned*)(ctl + CW_ATTQ) + 64 * rep_, (const unsigned*)(ctl + CW_NRM));
    }
    if (!conv_first) CONV_DRAIN();
    for (int rep_ = 0; rep_ <= DUP_NAT; ++rep_) {
        PH_TID; INP(rpb, 13); WSP(proj, bf16, WS_PROJ); WSP(concat, bf16, WS_CONCAT);
        gu32* ctl = (gu32*)(launder_ws(ws0) + WS_CTL);
        attn_body::nat_phase<8>((char*)lds_raw, (const attn_body::bf16*)proj, (attn_body::bf16*)concat, rpb, (unsigned*)(ctl + CW_NATQ) + 64 * rep_);
    }
    xcd_barrier(bar);

    for (int rep_ = 0; rep_ <= DUP_P4; ++rep_) {
        PH_TID;
        INP(lq1, 8); INP(lk1, 9); INP(lq2, 10); INP(lk2, 11); INP(g_sub, 12); WSP(od, bf16, WS_ODIFF); WSP(concat, bf16, WS_CONCAT);
        float s1 = 0.f, s2 = 0.f;
        for (int i = 0; i < 64; ++i) { s1 += lq1[i] * lk1[i]; s2 += lq2[i] * lk2[i]; }
        const float lam_init = 0.2f, lam = __expf(s1) - __expf(s2) + lam_init;
        const int c0 = lane * 8;
        v4u na = *(const v4u*)(od + (size_t)gw * 512 + c0), nb = *(const v4u*)(od + ((size_t)M + gw) * 512 + c0);
        f32x4 gs0 = *(const f32x4*)(g_sub + (c0 & 127)), gs1 = *(const f32x4*)(g_sub + (c0 & 127) + 4);
        for (int row = gw; row < M; row += NGW) {
            const v4u a = na, bq = nb;
            { const int nrow = (row + NGW < M) ? row + NGW : row; na = *(const v4u*)(od + (size_t)nrow * 512 + c0); nb = *(const v4u*)(od + ((size_t)M + nrow) * 512 + c0); }
            float v[8]; float ss = 0.f;
#pragma unroll
            for (int e = 0; e < 4; ++e) { v[2 * e] = __uint_as_float(a[e] << 16) - lam * __uint_as_float(bq[e] << 16); v[2 * e + 1] = __uint_as_float(a[e] & 0xffff0000u) - lam * __uint_as_float(bq[e] & 0xffff0000u); }
#pragma unroll
            for (int e = 0; e < 8; ++e) ss += v[e] * v[e];
            ss += __shfl_xor(ss, 1); ss += __shfl_xor(ss, 2); ss += __shfl_xor(ss, 4); ss += __shfl_xor(ss, 8);
            const float rstd = rsqrtf(ss * (1.f / 128.f) + RMS_EPS); v4u w;
#pragma unroll
            for (int e = 0; e < 4; ++e) w[e] = pk2(v[2 * e] * rstd * (e < 2 ? gs0[2 * e] : gs1[2 * e - 4]) * (1.f - lam_init), v[2 * e + 1] * rstd * (e < 2 ? gs0[2 * e + 1] : gs1[2 * e - 3]) * (1.f - lam_init));
            *(v4u*)(concat + (size_t)row * D + c0) = w;
        }
    }
    xcd_barrier(bar);

    for (int rep_ = 0; rep_ <= DUP_P5; ++rep_) {
        PH_TID; WSP(concat, bf16, WS_CONCAT); WSP(wout_t, bf16, WS_WOUT); WSP(mix, float, WS_MIX);
        pg8::Gemm g{concat, wout_t, M, D, D}; pg8::StaticOrder S; S.init(M, D, G, bx);
        pg8::EpiStoreF32 E{mix, D};
        pg8::gemm_phase<pg8::EpiStoreF32, pg8::StaticOrder, true, true>(lds + RING_OFF, g, S, E);
    }
    xcd_barrier(bar);

    for (int rep_ = 0; rep_ <= DUP_P6; ++rep_) {
        PH_TID;
        INP(x, 0); INP(g_post_mix, 5); INP(g_pre_ffn, 14); INP(w_router, 16); INP(b_router, 17);
        WSP(modd, float, WS_MOD); WSP(mix, float, WS_MIX); WSP(x1, float, WS_X1); WSP(h2, bf16, WS_H2); WSP(topi, int, WS_TOPI); WSP(gate, float, WS_GATE); WSP(hist, int, WS_HIST);
        LAS float* wt = (LAS float*)lds;
        LAS int* ltop = (LAS int*)(lds + LDSCTL_OFF + 4096);
        for (int i = tid; i < 8192; i += NTHR) { const f32x4 w = *(const f32x4*)(w_router + (size_t)i * 4); const int k = i >> 3, e0 = (i & 7) * 4;
            wt[(e0 + 0) * 1024 + k] = w.x; wt[(e0 + 1) * 1024 + k] = w.y; wt[(e0 + 2) * 1024 + k] = w.z; wt[(e0 + 3) * 1024 + k] = w.w; }
        __syncthreads();
        const int my_e = (lane >> 1) & 31; const float my_b = b_router[my_e];
        for (int ch = bx; ch < NCHUNK; ch += G) {
            f32x4 nmv[4], nxv[4];
#pragma unroll
            for (int i = 0; i < 4; ++i) { nmv[i] = *(const f32x4*)(mix + (size_t)(ch * 64 + wave * 8) * D + i * 256 + lane * 4); nxv[i] = *(const f32x4*)(x + (size_t)(ch * 64 + wave * 8) * D + i * 256 + lane * 4); }
            for (int i8 = 0; i8 < 8; ++i8) {
                const int row = ch * 64 + wave * 8 + i8, b = row / SEQ;
                const float* gt1 = modd + b * 6144 + 2048; const float* sh2 = gt1 + 1024; const float* sc2 = gt1 + 2048;
                f32x4 mvv[4], xv[4]; float ss = 0.f;
#pragma unroll
                for (int i = 0; i < 4; ++i) { mvv[i] = nmv[i]; xv[i] = nxv[i];
                    ss += mvv[i].x * mvv[i].x + mvv[i].y * mvv[i].y + mvv[i].z * mvv[i].z + mvv[i].w * mvv[i].w; }
                { const int nrow = (i8 < 7) ? row + 1 : row;
#pragma unroll
                  for (int i = 0; i < 4; ++i) { nmv[i] = *(const f32x4*)(mix + (size_t)nrow * D + i * 256 + lane * 4); nxv[i] = *(const f32x4*)(x + (size_t)nrow * D + i * 256 + lane * 4); } }
                float rstd = rsqrtf(wave_sum(ss) * (1.f / D) + RMS_EPS); ss = 0.f;
#pragma unroll
                for (int i = 0; i < 4; ++i) { const int c0 = i * 256 + lane * 4; const f32x4 gg = *(const f32x4*)(gt1 + c0), gp = *(const f32x4*)(g_post_mix + c0);
#pragma unroll
                    for (int e = 0; e < 4; ++e) { xv[i][e] = xv[i][e] + gg[e] * (mvv[i][e] * rstd * gp[e]); ss += xv[i][e] * xv[i][e]; }
                    *(f32x4*)(x1 + (size_t)row * D + c0) = xv[i]; }
                rstd = rsqrtf(wave_sum(ss) * (1.f / D) + RMS_EPS);
                float lg[32];
#pragma unroll
                for (int e = 0; e < 32; ++e) lg[e] = 0.f;
#pragma unroll
                for (int i = 0; i < 4; ++i) { const int c0 = i * 256 + lane * 4; const f32x4 gf = *(const f32x4*)(g_pre_ffn + c0), s2 = *(const f32x4*)(sc2 + c0), h2s = *(const f32x4*)(sh2 + c0); float hv[4];
#pragma unroll
                    for (int j = 0; j < 4; ++j) hv[j] = xv[i][j] * rstd * gf[j] * (1.f + s2[j]) + h2s[j];
                    *(unsigned*)((unsigned char*)h2 + (size_t)row * D + c0) = pk4_fp8(hv[0], hv[1], hv[2], hv[3]);
#pragma unroll
                    for (int e = 0; e < 32; ++e) { const f32x4 wv = *(const LAS f32x4*)(wt + e * 1024 + c0); lg[e] += (hv[0] * wv.x + hv[1] * wv.y) + (hv[2] * wv.z + hv[3] * wv.w); } }
                { const bool b5 = lane & 32, b4 = lane & 16, b3 = lane & 8, b2 = lane & 4, b1 = lane & 2;
#pragma unroll
                  for (int e = 0; e < 16; ++e) { const float keep = b5 ? lg[e + 16] : lg[e], send = b5 ? lg[e] : lg[e + 16]; lg[e] = keep + __shfl_xor(send, 32); }
#pragma unroll
                  for (int e = 0; e < 8; ++e) { const float keep = b4 ? lg[e + 8] : lg[e], send = b4 ? lg[e] : lg[e + 8]; lg[e] = keep + __shfl_xor(send, 16); }
#pragma unroll
                  for (int e = 0; e < 4; ++e) { const float keep = b3 ? lg[e + 4] : lg[e], send = b3 ? lg[e] : lg[e + 4]; lg[e] = keep + __shfl_xor(send, 8); }
#pragma unroll
                  for (int e = 0; e < 2; ++e) { const float keep = b2 ? lg[e + 2] : lg[e], send = b2 ? lg[e] : lg[e + 2]; lg[e] = keep + __shfl_xor(send, 4); }
                  { const float keep = b1 ? lg[1] : lg[0], send = b1 ? lg[0] : lg[1]; lg[0] = keep + __shfl_xor(send, 2); }
                  lg[0] += __shfl_xor(lg[0], 1); }
                float cur = lg[0] + my_b; float tv[4]; int ti[4];
#pragma unroll
                for (int p = 0; p < 4; ++p) { float bv = cur; int bi = my_e;
#pragma unroll
                    for (int o = 1; o < 64; o <<= 1) { const float ov = __shfl_xor(bv, o); const int oi = __shfl_xor(bi, o); const bool take = (ov > bv) || (ov == bv && oi < bi); bv = take ? ov : bv; bi = take ? oi : bi; }
                    tv[p] = bv; ti[p] = bi; cur = (my_e == bi) ? -INFINITY : cur; }
                if (lane == 0) { const float e1 = __expf(tv[1] - tv[0]), e2 = __expf(tv[2] - tv[0]), e3 = __expf(tv[3] - tv[0]); const float rs = 1.f / (1.f + e1 + e2 + e3);
                    *(int4*)(topi + row * 4) = make_int4(ti[0], ti[1], ti[2], ti[3]); *(f32x4*)(gate + row * 4) = (f32x4){rs, e1 * rs, e2 * rs, e3 * rs};
                    const int lr = (wave * 8 + i8) * 4; ltop[lr] = ti[0]; ltop[lr + 1] = ti[1]; ltop[lr + 2] = ti[2]; ltop[lr + 3] = ti[3]; }
            }
            __syncthreads();
            if (tid < 32) { int cnt = 0; for (int i = 0; i < 256; ++i) cnt += (ltop[i] == tid) ? 1 : 0; hist[ch * 32 + tid] = cnt; }
            __syncthreads();
        }
    }
    xcd_barrier(bar);

    for (int rep_ = 0; rep_ <= DUP_P7; ++rep_) {
        LAS int* le = (LAS int*)(lds + 4096); LAS int* ld = (LAS int*)(lds + 8192);
        PH_TID;
        WSP(hist, int, WS_HIST); WSP(topi, int, WS_TOPI); WSP(dest, int, WS_DEST); WSP(h2, bf16, WS_H2); WSP(xbuf, bf16, WS_XBUF); gu32* ctl = (gu32*)(launder_ws(ws0) + WS_CTL);
        for (int ch = bx; ch < NCHUNK; ch += G) {
            { LAS int* part = (LAS int*)(lds + 12288);
              const int e = tid & 31, pt = tid >> 5; int tot = 0, base = 0;
#pragma unroll
              for (int j = 0; j < 16; ++j) { const int c2 = pt * 16 + j; const int hv = hist[c2 * 32 + e]; tot += hv; base += (c2 < ch) ? hv : 0; }
              part[(pt * 2 + 0) * 32 + e] = tot; part[(pt * 2 + 1) * 32 + e] = base;
              if (tid < 256) le[tid] = topi[ch * 256 + tid];
              __syncthreads();
              if (tid < 32) { int t2 = 0, b2 = 0;
#pragma unroll
                  for (int p = 0; p < 16; ++p) { t2 += part[(p * 2 + 0) * 32 + tid]; b2 += part[(p * 2 + 1) * 32 + tid]; }
                  tab[32 + tid] = b2; tab[tid] = (t2 + 255) & ~255; } }
            __syncthreads();
            if (tid == 0) { int off = 0; for (int e = 0; e < NE; ++e) { const int pad = tab[e]; tab[e] = off;
                    if (ch == 0) for (int tl = 0; tl < pad / 256; ++tl) ctl[CW_TILEEXP + off / 256 + tl] = (unsigned)e;
                    off += pad; }
                if (ch == 0) ctl[CW_TOTAL] = (unsigned)off; }
            __syncthreads();
            if (tid < 256) { const int e = le[tid]; int rank = 0; for (int i = 0; i < tid; ++i) rank += (le[i] == e) ? 1 : 0;
                const int dd = tab[e] + tab[32 + e] + rank; dest[ch * 256 + tid] = dd; ld[tid] = dd; }
            __syncthreads();
            for (int i = 0; i < 32; ++i) { const int a = wave * 32 + i; const int dd = ld[a]; const size_t tok = (size_t)(ch * 256 + a) >> 2;
                const v4u* src = (const v4u*)((const unsigned char*)h2 + tok * D); v4u* dst = (v4u*)((unsigned char*)xbuf + (size_t)dd * D);
                dst[lane] = src[lane]; }
            __syncthreads();
        }
    }
    xcd_barrier(bar);

    {
        PH_TID;
        gu32* ctl = (gu32*)(launder_ws(ws0) + WS_CTL);
        for (int i = tid; i < MAXTILES; i += NTHR) tab[64 + i] = (int)ctl[CW_TILEEXP + i];
        if (tid == 0) tab[352] = (int)ctl[CW_TOTAL];
        __syncthreads();
        const int ntile = __builtin_amdgcn_readfirstlane(tab[352]) >> 8;
        for (int rep_ = 0; rep_ <= DUP_G1; ++rep_) {
            INP(b1, 19); WSP(xbuf, bf16, WS_XBUF); WSP(w1_t, bf16, WS_W1T); WSP(act, bf16, WS_ACT);
            pg8::Gemm g{xbuf, w1_t, CAP, 2048, D}; pg8::MoeOrder<8> S{ntile * 8, G, vcu, (const LAS int*)(tab + 64)};
            pg8::EpiSwiglu E{(unsigned char*)act, b1};
            pg8::gemm_phase<pg8::EpiSwiglu, pg8::MoeOrder<8>, true, true, true>(lds + RING_OFF, g, S, E);
        }
        xcd_barrier(bar);
        for (int rep_ = 0; rep_ <= DUP_G2; ++rep_) {
            INP(b2, 21); WSP(act, bf16, WS_ACT); WSP(w2_t, bf16, WS_W2T); WSP(ybuf, bf16, WS_YBUF);
            pg8::Gemm g{act, w2_t, CAP, 1024, FF}; pg8::MoeOrder<4> S{ntile * 4, G, vcu, (const LAS int*)(tab + 64)};
            pg8::EpiY E{ybuf, b2};
            pg8::gemm_phase<pg8::EpiY, pg8::MoeOrder<4>, true, true, true>(lds + RING_OFF, g, S, E);
        }
    }
    xcd_barrier(bar);

    for (int rep_ = 0; rep_ <= DUP_P10; ++rep_) {
        PH_TID;
        INP(g_post_ffn, 15); WSP(modd, float, WS_MOD); WSP(x1, float, WS_X1); WSP(ybuf, bf16, WS_YBUF); WSP(dest, int, WS_DEST); WSP(gate, float, WS_GATE); float* out = P.out;
        int4 ndd = *(const int4*)(dest + gw * 4); f32x4 ngg = *(const f32x4*)(gate + gw * 4);
        uint2 ny[4][4]; f32x4 nx[4];
        { const int dda[4] = {ndd.x, ndd.y, ndd.z, ndd.w};
#pragma unroll
          for (int p = 0; p < 4; ++p)
#pragma unroll
              for (int i = 0; i < 4; ++i) ny[p][i] = *(const uint2*)(ybuf + (size_t)dda[p] * D + i * 256 + lane * 4);
#pragma unroll
          for (int i = 0; i < 4; ++i) nx[i] = *(const f32x4*)(x1 + (size_t)gw * D + i * 256 + lane * 4); }
        f32x4 cgg = ngg;
        { const int r1 = (gw + NGW < M) ? gw + NGW : gw; ndd = *(const int4*)(dest + r1 * 4); ngg = *(const f32x4*)(gate + r1 * 4); }
        for (int row = gw; row < M; row += NGW) {
            const int b = row / SEQ; const float* gt2 = modd + b * 6144 + 5120;
            float f[16]; float ss = 0.f;
#pragma unroll
            for (int i = 0; i < 16; ++i) f[i] = 0.f;
            const f32x4 gg = cgg; f32x4 xrow[4];
#pragma unroll
            for (int p = 0; p < 4; ++p) { const float gp = gg[p];
#pragma unroll
                for (int i = 0; i < 4; ++i) { const uint2 w = ny[p][i];
                    f[i * 4] += gp * __uint_as_float(w.x << 16); f[i * 4 + 1] += gp * __uint_as_float(w.x & 0xffff0000u); f[i * 4 + 2] += gp * __uint_as_float(w.y << 16); f[i * 4 + 3] += gp * __uint_as_float(w.y & 0xffff0000u); } }
#pragma unroll
            for (int i = 0; i < 4; ++i) xrow[i] = nx[i];
            { const int r1 = (row + NGW < M) ? row + NGW : row, r2 = (row + 2 * NGW < M) ? row + 2 * NGW : r1;
              const int dda[4] = {ndd.x, ndd.y, ndd.z, ndd.w}; cgg = ngg;
#pragma unroll
              for (int p = 0; p < 4; ++p)
#pragma unroll
                  for (int i = 0; i < 4; ++i) ny[p][i] = *(const uint2*)(ybuf + (size_t)dda[p] * D + i * 256 + lane * 4);
#pragma unroll
              for (int i = 0; i < 4; ++i) nx[i] = *(const f32x4*)(x1 + (size_t)r1 * D + i * 256 + lane * 4);
              ndd = *(const int4*)(dest + r2 * 4); ngg = *(const f32x4*)(gate + r2 * 4); }
#pragma unroll
            for (int i = 0; i < 16; ++i) ss += f[i] * f[i];
            const float rstd = rsqrtf(wave_sum(ss) * (1.f / D) + RMS_EPS);
#pragma unroll
            for (int i = 0; i < 4; ++i) { const int c0 = i * 256 + lane * 4; const f32x4 xv = xrow[i]; f32x4 ov;
#pragma unroll
                for (int e = 0; e < 4; ++e) ov[e] = xv[e] + gt2[c0 + e] * (f[i * 4 + e] * rstd * g_post_ffn[c0 + e]);
                *(f32x4*)(out + (size_t)row * D + c0) = ov; }
        }
    }
}

extern "C" void kernel_launch(void* const* d_in, const int* in_sizes, int n_in, void* d_out, int out_size, void* d_ws, size_t ws_size, hipStream_t stream) {
    static int grid = 0;
    if (grid == 0) {
        if (n_in != 22 || ws_size < WS_END) { fprintf(stderr, "kernel_launch: unexpected n_in %d / ws %zu\n", n_in, ws_size); grid = -1; return; }
        int dev = 0, cus = 0, per_cu = 0;
        if (hipGetDevice(&dev) != hipSuccess || hipDeviceGetAttribute(&cus, hipDeviceAttributeMultiprocessorCount, dev) != hipSuccess) { grid = -1; return; }
        if (hipFuncSetAttribute((const void*)mk_fwd, hipFuncAttributeMaxDynamicSharedMemorySize, LDS_BYTES) != hipSuccess) { fprintf(stderr, "kernel_launch: hipFuncSetAttribute failed\n"); grid = -1; return; }
        if (hipOccupancyMaxActiveBlocksPerMultiprocessor(&per_cu, (const void*)mk_fwd, NTHR, LDS_BYTES) != hipSuccess || per_cu < 1) { fprintf(stderr, "kernel_launch: occupancy query says %d\n", per_cu); }
        (void)hipGetLastError();
        grid = cus;
    }
    if (grid < 0) return;
    if (hipMemsetAsync((char*)d_ws + WS_CTL, 0, 1 * MiB, stream) != hipSuccess) return;
    Params p{};
    for (int i = 0; i < 22; ++i) p.in[i] = (const float*)d_in[i];
    p.out = (float*)d_out; p.ws = (unsigned char*)d_ws;
    hipLaunchKernelGGL(mk_fwd, dim3(grid), dim3(NTHR), LDS_BYTES, stream, p);
}
```

```cpp
#include <hip/hip_runtime.h>
#include <stdint.h>
#include <stdio.h>

#define GAS __attribute__((address_space(1)))
#define LAS __attribute__((address_space(3)))
typedef unsigned short bf16;
typedef unsigned v4u __attribute__((ext_vector_type(4)));
typedef float f32x4 __attribute__((ext_vector_type(4)));
typedef GAS unsigned gu32;
#define LDS_WAIT() asm volatile("s_waitcnt lgkmcnt(0)" ::: "memory")
#define VM_WAIT() asm volatile("s_waitcnt vmcnt(0)" ::: "memory")

#define DUP_P0 0
#define DUP_ATT 0
#define DUP_NAT 0
#define DUP_G1 0
#define DUP_G2 0
#define DUP_P2 0
#define DUP_P5 0
#define DUP_P1 0
#define DUP_P4 0
#define DUP_BAR 0
#define DUP_P3 0
#define PROBE_K (-1)
#define DUP_P6 0
#define DUP_P7 0
#define DUP_P10 0
constexpr int NB = 2, SEQ = 8192, D = 1024, M = NB * SEQ;
constexpr int NPROJ = 3072, NE = 32, TOPK = 4, FF = 1024;
constexpr int NASSIGN = M * TOPK;
constexpr int CAP = NASSIGN + NE * 256;
constexpr int MAXTILES = CAP / 256;
constexpr int NCHUNK = M / 64;
constexpr float RMS_EPS = 1e-6f;
constexpr int NWAVES = 8, NTHR = 512;

constexpr size_t MiB = 1u << 20;
constexpr size_t WS_CTL = 0;
constexpr size_t WS_MODP = 1 * MiB;
constexpr size_t WS_MOD = 1 * MiB + 512 * 1024;
constexpr size_t WS_HIST = 2 * MiB;
constexpr size_t WS_TOPI = 3 * MiB;
constexpr size_t WS_GATE = 3 * MiB + 512 * 1024;
constexpr size_t WS_DEST = 4 * MiB;
constexpr size_t WS_SRC = 5 * MiB;
constexpr size_t WS_WIN = 6 * MiB;
constexpr size_t WS_WOUT = 12 * MiB;
constexpr size_t WS_XN = 16 * MiB;
constexpr size_t WS_PROJ = 48 * MiB;
constexpr size_t WS_ODIFF = 144 * MiB;
constexpr size_t WS_CONCAT = 208 * MiB;
constexpr size_t WS_MIX = 240 * MiB;
constexpr size_t WS_X1 = 304 * MiB;
constexpr size_t WS_H2 = 368 * MiB;
constexpr size_t WS_ACT = 400 * MiB;
constexpr size_t WS_YBUF = 544 * MiB;
constexpr size_t WS_W1T = 688 * MiB;
constexpr size_t WS_W2T = 816 * MiB;
constexpr size_t WS_KIMG = 880 * MiB;
constexpr size_t WS_VIMG = 896 * MiB;
constexpr size_t WS_END = 912 * MiB;
constexpr int CW_TOTAL = 64;
constexpr int CW_TILEEXP = 128;
constexpr int CW_NRM = 512;
constexpr int CW_ATTQ = 1024;
constexpr int CW_NATQ = 1536;
constexpr int CW_CONVQ = 2048;
constexpr int CW_CMBQ = 2560;
constexpr int CW_CONVACT = 2816;
constexpr int CW_G1REM = 2944;
constexpr int CW_BAR = 4096;
constexpr int CW_GST = 3072;
constexpr int CW_DONE = 8192;

constexpr int RING_OFF = 0, RING_BYTES = 131072;
constexpr int LDSCTL_OFF = RING_BYTES, MISC_OFF = LDSCTL_OFF + 320, TAB_OFF = LDSCTL_OFF + 1024;
constexpr int LDS_BYTES = 155648;

__device__ __forceinline__ float bf2f(bf16 v) { return __uint_as_float(((unsigned)v) << 16); }
__device__ __forceinline__ unsigned f2bf(float f) { unsigned u = __builtin_bit_cast(unsigned, f); return (u + 0x7fffu + ((u >> 16) & 1u)) >> 16; }
__device__ __forceinline__ unsigned pk2(float lo, float hi) { return f2bf(lo) | (f2bf(hi) << 16); }
namespace pg8 {
#define PG8_LAS __attribute__((address_space(3)))
typedef unsigned short bf16_t;
typedef short bf16x8 __attribute__((ext_vector_type(8)));
typedef float f32x4 __attribute__((ext_vector_type(4)));
typedef unsigned u32x4 __attribute__((ext_vector_type(4)));
constexpr int BM = 256, BK = 64, HALF = 128, HTB = HALF * BK * 2  , STAGE_BYTES = 8 * HTB, NXCD = 8, WGM = 8;

__host__ __device__ __forceinline__ int lds_byte(int r, int c) { const int st = (r >> 4) * 2 + (c >> 5), rr = r & 15, cc = c & 31, ob = rr * 64 + cc * 2; return st * 1024 + (ob ^ (((ob >> 9) & 1) << 5)); }
__host__ __device__ __forceinline__ void stage_rc(int b, int& R, int& C) { const int st = b / 1024, sb = b % 1024, swz = sb ^ (((sb >> 9) & 1) << 5); R = (st >> 1) * 16 + swz / 64; C = (st & 1) * 32 + (swz % 64) / 2; }
__host__ __device__ __forceinline__ int perm32(int rho) { const int n = rho >> 4, i = rho & 15; return 8 * (i >> 2) + 4 * n + (i & 3); }

struct Unit { int pm, pn; };
struct Gemm { const bf16_t* A; const bf16_t* Bt; int M, N, K; };

struct StaticOrder {
    int nM, nN, nwg, G, c;
    __host__ __device__ void init(int M, int N, int G_, int c_) { nM = M / BM; nN = N / BM; nwg = nM * nN; G = G_; c = c_; }
    __host__ __device__ bool next(int i, Unit& u) const {
        const long L = (long)i * G + c; if (L >= nwg) return false;
        int wgid = (int)L; { const int q = nwg / NXCD, r = nwg % NXCD, xcd = wgid % NXCD, off = wgid / NXCD; wgid = (xcd < r ? xcd * (q + 1) : r * (q + 1) + (xcd - r) * q) + off; }
        const int nig = WGM * nN, gid = wgid / nig, fm = gid * WGM, gsz = (nM - fm) < WGM ? (nM - fm) : WGM;
        u.pm = fm + ((wgid % nig) % gsz); u.pn = (wgid % nig) / gsz; return true;
    }
    __device__ __forceinline__ void a_ready(const Unit&) const {}
    __device__ __forceinline__ void done(const Unit&) const {}
};

__device__ __forceinline__ unsigned cvt_pk_bf16(float lo, float hi) { unsigned r; asm volatile("v_cvt_pk_bf16_f32 %0, %1, %2" : "=v"(r) : "v"(lo), "v"(hi)); return r; }
struct EpiStoreBf16 {
    static constexpr bool PERM = true, AFTER_DRAIN = false;
    bf16_t* O; int ldc; int scale_cols; float scale0; int s2lo, s2hi; unsigned* nrm; bf16_t* kimg; bf16_t* vimg;
    __device__ __forceinline__ void operator()(const f32x4 (&acc)[2][2][4][2], const Unit& u, int wr, int wc, int fr, int fq) const {
        const int row0 = u.pm * BM + wr * 64 + fr, colt = u.pn * BM, col0 = colt + wc * 32 + 8 * fq; const float sc = (colt < scale_cols || (colt >= s2lo && colt < s2hi)) ? scale0 : 1.f;
        const bool isk = kimg && (colt >= 512 && colt < 1024), isv = kimg && (colt >= 1024 && colt < 1536); const bool donrm = nrm && (colt < 1024);
        float mx[2] = {0.f, 0.f};
#pragma unroll
        for (int ai = 0; ai < 2; ++ai)
#pragma unroll
            for (int m = 0; m < 4; ++m) { const int row = row0 + ai * HALF + m * 16; bf16_t* rowp = O + (size_t)row * ldc + col0;
                const int b = row >> 13, tile = (row & 8191) >> 6, rr = row & 63;
#pragma unroll
                for (int bj = 0; bj < 2; ++bj) { const f32x4 v0 = acc[ai][bj][m][0] * sc, v1 = acc[ai][bj][m][1] * sc;
                    u32x4 w; w.x = cvt_pk_bf16(v0[0], v0[1]); w.y = cvt_pk_bf16(v0[2], v0[3]); w.z = cvt_pk_bf16(v1[0], v1[1]); w.w = cvt_pk_bf16(v1[2], v1[3]);
                    if (isk) { const int c = col0 + bj * HALF - 512, hm = c >> 6, chunk = (c & 63) >> 3;
                        *(u32x4*)(kimg + ((size_t)((b * 8 + hm) * 128 + tile) * 4096 + chunk * 512 + rr * 8)) = w; }
                    else if (isv) { const int c = col0 + bj * HALF - 1024, h = c >> 7, e = c & 127;
                        *(u32x4*)(vimg + ((size_t)((b * 4 + h) * 128 + tile) * 8192 + (e >> 5) * 2048 + rr * 32 + (e & 31))) = w; }
                    else *(u32x4*)(rowp + bj * HALF) = w;
                    if (donrm) { float s = 0.f;
#pragma unroll
                        for (int j = 0; j < 4; ++j) { const float lo = __uint_as_float(w[j] << 16), hi = __uint_as_float(w[j] & 0xffff0000u); s += lo * lo + hi * hi; }
                        s += __shfl_xor(s, 16); s += __shfl_xor(s, 32); mx[bj] = fmaxf(mx[bj], s); } } }
        if (donrm) {
#pragma unroll
            for (int bj = 0; bj < 2; ++bj) { float v = mx[bj]; v = fmaxf(v, __shfl_xor(v, 1)); v = fmaxf(v, __shfl_xor(v, 2)); v = fmaxf(v, __shfl_xor(v, 4)); v = fmaxf(v, __shfl_xor(v, 8));
                if (fr == 0 && fq == 0) { const int g = (colt + bj * HALF + wc * 32) >> 6, b = u.pm >> 5; atomicMax(nrm + ((b * 16 + g) * 2 + (wc & 1)), __float_as_uint(v)); } }
        }
    }
};
struct EpiStoreF32 {
    static constexpr bool PERM = true, AFTER_DRAIN = false;
    float* O; int ldc;
    __device__ __forceinline__ void operator()(const f32x4 (&acc)[2][2][4][2], const Unit& u, int wr, int wc, int fr, int fq) const {
        const int row0 = u.pm * BM + wr * 64 + fr, col0 = u.pn * BM + wc * 32 + 8 * fq;
#pragma unroll
        for (int ai = 0; ai < 2; ++ai)
#pragma unroll
            for (int m = 0; m < 4; ++m) { float* rowp = O + (size_t)(row0 + ai * HALF + m * 16) * ldc + col0;
#pragma unroll
                for (int bj = 0; bj < 2; ++bj) { *(f32x4*)(rowp + bj * HALF) = acc[ai][bj][m][0]; *(f32x4*)(rowp + bj * HALF + 4) = acc[ai][bj][m][1]; } }
    }
};
struct EpiSwiglu {
    static constexpr bool PERM = true, AFTER_DRAIN = false;
    unsigned char* act; const float* b1;
    __device__ __forceinline__ void operator()(const f32x4 (&acc)[2][2][4][2], const Unit& u, int wr, int wc, int fr, int fq) const {
        const int e = u.pn >> 3, pnl = u.pn & 7, row0 = u.pm * BM + wr * 64 + fr, hc0 = pnl * BM + wc * 32 + 8 * fq;
        f32x4 bv[2][2];
#pragma unroll
        for (int bj = 0; bj < 2; ++bj)
#pragma unroll
            for (int n = 0; n < 2; ++n) bv[bj][n] = *(const f32x4*)(b1 + e * 2048 + hc0 + bj * HALF + 4 * n);
#pragma unroll
        for (int ai = 0; ai < 2; ++ai)
#pragma unroll
            for (int m = 0; m < 4; ++m) { unsigned char* rowp = act + (size_t)(row0 + ai * HALF + m * 16) * 1024 + (hc0 >> 1);
#pragma unroll
                for (int bj = 0; bj < 2; ++bj) { const f32x4 v0 = acc[ai][bj][m][0] + bv[bj][0], v1 = acc[ai][bj][m][1] + bv[bj][1];
                    float r[4];
                    const float gg[4] = {v0[0], v0[2], v1[0], v1[2]}, ll[4] = {v0[1], v0[3], v1[1], v1[3]};
#pragma unroll
                    for (int p = 0; p < 4; ++p) { float g = gg[p], l = ll[p];
                        g = fminf(g, 7.f); l = fminf(fmaxf(l, -7.f), 7.f);
                        r[p] = g * __builtin_amdgcn_rcpf(1.f + __expf(-1.702f * g)) * (l + 1.f); }
                    int w = 0; w = __builtin_amdgcn_cvt_pk_fp8_f32(r[0], r[1], w, false); w = __builtin_amdgcn_cvt_pk_fp8_f32(r[2], r[3], w, true);
                    *(int*)(rowp + bj * (HALF / 2)) = w; } }
    }
};
struct EpiY {
    static constexpr bool PERM = true, AFTER_DRAIN = false;
    bf16_t* y; const float* b2;
    __device__ __forceinline__ void operator()(const f32x4 (&acc)[2][2][4][2], const Unit& u, int wr, int wc, int fr, int fq) const {
        const int e = u.pn >> 2, pnl = u.pn & 3, row0 = u.pm * BM + wr * 64 + fr, col0 = pnl * BM + wc * 32 + 8 * fq;
        f32x4 bv[2][2];
#pragma unroll
        for (int bj = 0; bj < 2; ++bj)
#pragma unroll
            for (int n = 0; n < 2; ++n) bv[bj][n] = *(const f32x4*)(b2 + e * 1024 + col0 + bj * HALF + 4 * n);
#pragma unroll
        for (int ai = 0; ai < 2; ++ai)
#pragma unroll
            for (int m = 0; m < 4; ++m) { bf16_t* rowp = y + (size_t)(row0 + ai * HALF + m * 16) * 1024 + col0;
#pragma unroll
                for (int bj = 0; bj < 2; ++bj) { const f32x4 v0 = acc[ai][bj][m][0] + bv[bj][0], v1 = acc[ai][bj][m][1] + bv[bj][1];
                    u32x4 w; w.x = cvt_pk_bf16(v0[0], v0[1]); w.y = cvt_pk_bf16(v0[2], v0[3]); w.z = cvt_pk_bf16(v1[0], v1[1]); w.w = cvt_pk_bf16(v1[2], v1[3]);
                    *(u32x4*)(rowp + bj * HALF) = w; } }
    }
};
template <int NN> struct MoeOrder {
    int nunit, G, c; const PG8_LAS int* texp; const PG8_LAS int* rmap; int ibase;
    __device__ __forceinline__ bool next(int i, Unit& u) const {
        const int L = (i + ibase) * G + c; if (L >= nunit) return false;
        const int pm = L / NN, pnl = L % NN; u.pm = pm; u.pn = __builtin_amdgcn_readfirstlane(texp[pm]) * NN + pnl; return true;
    }
    __device__ __forceinline__ void a_ready(const Unit&) const {}
    __device__ __forceinline__ void done(const Unit&) const {}
};

struct MoeOrderY {
    int nunit, G, c; const PG8_LAS int* texp; int nfull, xL, mdep; unsigned* cnt; unsigned need;
    __device__ __forceinline__ bool next(int i, Unit& u) const {
        int L;
        if (i < nfull) { L = i * G + c; if (L >= nunit) return false; } else if (i == nfull && xL >= 0) L = xL; else return false;
        const int pm = L >> 2, pnl = L & 3; u.pm = pm; u.pn = __builtin_amdgcn_readfirstlane(texp[pm]) * 4 + pnl; return true;
    }
    __device__ __forceinline__ void a_ready(const Unit& u) const {
        if (cnt != nullptr && u.pm >= mdep) { unsigned sp = 0u;
            while (__hip_atomic_load(cnt, __ATOMIC_RELAXED, __HIP_MEMORY_SCOPE_AGENT) < need) { __builtin_amdgcn_s_sleep(2); if (++sp > (1u << 22)) break; }
            __builtin_amdgcn_fence(__ATOMIC_ACQUIRE, "agent"); }
    }
    __device__ __forceinline__ void done(const Unit&) const {}
};
typedef int i32x4_t __attribute__((ext_vector_type(4))); typedef int i32x8_t __attribute__((ext_vector_type(8)));
__device__ __forceinline__ void pg8_glds16(const void* sbase, unsigned voff, unsigned lds_dst) { unsigned keep;
    asm volatile("s_mov_b32 %0, m0\n\ts_mov_b32 m0, %3\n\ts_nop 0\n\tglobal_load_lds_dwordx4 %1, %2\n\ts_mov_b32 m0, %0" : "=&s"(keep) : "v"(voff), "s"(sbase), "s"(lds_dst) : "memory"); }
template <class Epi, class Sched, bool ALIGN_EPI = false, bool SP2 = false, bool FP8 = false, bool GATHER = false>
__device__ __forceinline__ void gemm_phase(PG8_LAS unsigned char* lds, const Gemm g, const Sched& S, const Epi& E) {
    int tid_ = threadIdx.x; asm volatile("" : "+v"(tid_));
    const int tid = tid_, wid = __builtin_amdgcn_readfirstlane(tid >> 6), lane = tid & 63, wr = wid >> 2, wc = wid & 3, fr = lane & 15, fq = lane >> 4;
    const int K = g.K, KB = FP8 ? K : 2 * K, nt = KB / (BK * 2);
    unsigned voffA[2], voffB[2];
#pragma unroll
    for (int i = 0; i < 2; ++i) { int R, C; stage_rc(tid * 16 + i * 8192, R, C); const int Rb = Epi::PERM ? ((R & ~31) + perm32(R & 31)) : R;
        voffA[i] = (unsigned)(R * KB + C * 2); voffB[i] = (unsigned)(Rb * KB + C * 2); }
    static_assert(!GATHER || SP2, "GATHER is implemented for the SP2 form");
    int R0_, C0_; stage_rc(tid * 16, R0_, C0_);
    unsigned gA_[2][2] = {{0u, 0u}, {0u, 0u}};
#define PG8_GLOAD(dst, uidx) do { if constexpr (GATHER) { _Pragma("unroll") for (int _h = 0; _h < 2; ++_h) _Pragma("unroll") for (int _i = 0; _i < 2; ++_i) dst[_h][_i] = (unsigned)S.rmap[(uidx) * 256 + _h * 128 + _i * 64 + R0_] * (unsigned)KB + (unsigned)(C0_ * 2); } } while (0)
    const size_t kstep = (size_t)(BK * 2);
    const size_t hstep = (size_t)HALF * KB;
    const size_t tstep = 2 * hstep;
    const unsigned ldsb = (unsigned)(uintptr_t)lds;
    const unsigned ldsw = (unsigned)wid * 1024u; const unsigned ldsbw = (unsigned)__builtin_amdgcn_readfirstlane(ldsb + ldsw);
    const int aoff = lds_byte(wr * 64 + fr, fq * 8), boff = lds_byte(wc * 32 + fr, fq * 8);
#define PG8_CAT(x, y) __builtin_shufflevector(__builtin_bit_cast(i32x4_t, x), __builtin_bit_cast(i32x4_t, y), 0, 1, 2, 3, 4, 5, 6, 7)
#define PG8_SA(b, h) (((b) * 2 + (h)) * HTB)
#define PG8_SB(b, h) ((4 + (b) * 2 + (h)) * HTB)
#define PG8_STAGE(bufoff, gbase, voff) do { _Pragma("unroll") for (int _i = 0; _i < 2; ++_i) \
        pg8_glds16((const void*)((const char*)(gbase) + (size_t)_i * 64 * KB), (voff)[0], ldsbw + (unsigned)((bufoff) + _i * 8192)); } while (0)
#define PG8_STAGE_A(bufoff, kp, h, NX) do { if constexpr (GATHER) { _Pragma("unroll") for (int _i = 0; _i < 2; ++_i) pg8_glds16((const void*)(kp), gA_[h][_i], ldsbw + (unsigned)((bufoff) + _i * 8192)); } \
    else { PG8_STAGE(bufoff, (kp) + (size_t)(h) * hstep, voffA); } } while (0)
#define PG8_LDA(dst, b, h) do { if constexpr (FP8) { _Pragma("unroll") for (int m = 0; m < 4; ++m) dst##8[m] = PG8_CAT(*(const PG8_LAS bf16x8*)(lds + PG8_SA(b, h) + aoff + m * 2048), *(const PG8_LAS bf16x8*)(lds + PG8_SA(b, h) + aoff + m * 2048 + 1024)); } \
    else { _Pragma("unroll") for (int m = 0; m < 4; ++m) _Pragma("unroll") for (int k = 0; k < 2; ++k) dst[m][k] = *(const PG8_LAS bf16x8*)(lds + PG8_SA(b, h) + aoff + m * 2048 + k * 1024); } } while (0)
#define PG8_LDB(dst, b, h) do { if constexpr (FP8) { _Pragma("unroll") for (int n = 0; n < 2; ++n) dst##8[n] = PG8_CAT(*(const PG8_LAS bf16x8*)(lds + PG8_SB(b, h) + boff + n * 2048), *(const PG8_LAS bf16x8*)(lds + PG8_SB(b, h) + boff + n * 2048 + 1024)); } \
    else { _Pragma("unroll") for (int n = 0; n < 2; ++n) _Pragma("unroll") for (int k = 0; k < 2; ++k) dst[n][k] = *(const PG8_LAS bf16x8*)(lds + PG8_SB(b, h) + boff + n * 2048 + k * 1024); } } while (0)
#define PG8_MMA(ai, bj, At, Bt) do { __builtin_amdgcn_s_setprio(1); if constexpr (FP8) { _Pragma("unroll") for (int m = 0; m < 4; ++m) _Pragma("unroll") for (int n = 0; n < 2; ++n) \
        acc[ai][bj][m][n] = __builtin_amdgcn_mfma_scale_f32_16x16x128_f8f6f4(Bt##8[n], At##8[m], acc[ai][bj][m][n], 0, 0, 0, 0x7c7c7c7c, 0, 0x7c7c7c7c); } \
    else { _Pragma("unroll") for (int m = 0; m < 4; ++m) _Pragma("unroll") for (int n = 0; n < 2; ++n) _Pragma("unroll") for (int k = 0; k < 2; ++k) \
        acc[ai][bj][m][n] = __builtin_amdgcn_mfma_f32_16x16x32_bf16(Bt[n][k], At[m][k], acc[ai][bj][m][n], 0, 0, 0); } __builtin_amdgcn_s_setprio(0); } while (0)
#define PG8_WAIT_V(n) asm volatile("s_waitcnt vmcnt(" #n ")" ::: "memory")
#define PG8_WAIT_L(n) asm volatile("s_waitcnt lgkmcnt(" #n ")" ::: "memory")
#define PG8_BAR __builtin_amdgcn_s_barrier()
#define PG8_SCHED __builtin_amdgcn_sched_barrier(0)
    Unit cur, nxt; int ui = 0;
    if (!S.next(0, cur)) return;
    f32x4 acc[2][2][4][2];
#pragma unroll
    for (int a = 0; a < 2; ++a)
#pragma unroll
        for (int b = 0; b < 2; ++b)
#pragma unroll
            for (int m = 0; m < 4; ++m)
#pragma unroll
                for (int n = 0; n < 2; ++n) acc[a][b][m][n] = (f32x4){0.f, 0.f, 0.f, 0.f};
    bf16x8 At[4][2], B0[2][2], B1[2][2]; i32x8_t At8[4], B08[2], B18[2];
    const char* cA = (const char*)g.A + (GATHER ? (size_t)0 : (size_t)cur.pm * tstep); const char* cB = (const char*)g.Bt + (size_t)cur.pn * tstep;
    S.a_ready(cur); PG8_GLOAD(gA_, 0);
    if constexpr (SP2) {
        PG8_STAGE(PG8_SB(0, 0), cB, voffB); PG8_STAGE(PG8_SB(0, 1), cB + hstep, voffB); PG8_STAGE_A(PG8_SA(0, 0), cA, 0, false); PG8_STAGE_A(PG8_SA(0, 1), cA, 1, false);
        if (wr == 1) PG8_BAR;
        PG8_WAIT_V(2); PG8_BAR;
        PG8_STAGE(PG8_SB(1, 0), cB + kstep, voffB); PG8_STAGE_A(PG8_SA(1, 0), cA + kstep, 0, false); PG8_STAGE(PG8_SB(1, 1), cB + hstep + kstep, voffB);
        PG8_WAIT_V(6); PG8_BAR;
    } else {
        PG8_STAGE(PG8_SB(0, 0), cB, voffB); PG8_STAGE(PG8_SA(0, 0), cA, voffA); PG8_STAGE(PG8_SB(0, 1), cB + hstep, voffB); PG8_STAGE(PG8_SA(0, 1), cA + hstep, voffA);
        if (wr == 1) PG8_BAR;
        PG8_WAIT_V(4); PG8_BAR;
        PG8_STAGE(PG8_SB(1, 0), cB + kstep, voffB); PG8_STAGE(PG8_SA(1, 0), cA + kstep, voffA); PG8_STAGE(PG8_SB(1, 1), cB + hstep + kstep, voffB);
        PG8_WAIT_V(6); PG8_BAR;
    }
    for (;;) {
        const bool has_next = S.next(ui + 1, nxt);
                const char* nA = (has_next && !GATHER) ? (const char*)g.A + (size_t)nxt.pm * tstep : cA; const char* nB = has_next ? (const char*)g.Bt + (size_t)nxt.pn * tstep : cB;
#pragma clang loop unroll(disable)
        for (int t = 0; t < nt; t += 2) {
            const bool last = (t == nt - 2);
            const char* a1 = cA + (size_t)(t + 1) * kstep;
            const char* a2 = last ? nA : cA + (size_t)(t + 2) * kstep; const char* b2 = last ? nB : cB + (size_t)(t + 2) * kstep;
            const char* a3 = a2 + kstep; const char* b3 = b2 + kstep;
            if (last && has_next) S.a_ready(nxt);
            if constexpr (SP2) {
            PG8_LDB(B0, 0, 0); PG8_LDB(B1, 0, 1); PG8_SCHED; PG8_LDA(At, 0, 0); PG8_STAGE_A(PG8_SA(1, 1), a1, 1, false);
            if constexpr (GATHER) { if (last) { PG8_GLOAD(gA_, has_next ? ui + 1 : ui); } }
            PG8_WAIT_V(8); PG8_WAIT_L(0); PG8_BAR; PG8_MMA(0, 0, At, B0); PG8_MMA(0, 1, At, B1); PG8_BAR; PG8_SCHED;
            PG8_LDA(At, 0, 1); PG8_STAGE(PG8_SB(0, 0), b2, voffB); PG8_STAGE(PG8_SB(0, 1), b2 + hstep, voffB); PG8_STAGE_A(PG8_SA(0, 0), a2, 0, last);
            PG8_WAIT_V(8); PG8_WAIT_L(0); PG8_BAR; PG8_MMA(1, 0, At, B0); PG8_MMA(1, 1, At, B1); PG8_BAR; PG8_SCHED;
            PG8_LDB(B0, 1, 0); PG8_LDB(B1, 1, 1); PG8_SCHED; PG8_LDA(At, 1, 0); PG8_STAGE_A(PG8_SA(0, 1), a2, 1, last);
            PG8_WAIT_V(8); PG8_WAIT_L(0); PG8_BAR; PG8_MMA(0, 0, At, B0); PG8_MMA(0, 1, At, B1); PG8_BAR; PG8_SCHED;
            PG8_LDA(At, 1, 1); PG8_STAGE(PG8_SB(1, 0), b3, voffB); PG8_STAGE(PG8_SB(1, 1), b3 + hstep, voffB); PG8_STAGE_A(PG8_SA(1, 0), a3, 0, last);
            PG8_WAIT_V(8); PG8_WAIT_L(0); PG8_BAR; PG8_MMA(1, 0, At, B0); PG8_MMA(1, 1, At, B1); PG8_BAR; PG8_SCHED;
            } else {
            PG8_LDB(B0, 0, 0); PG8_SCHED; PG8_LDA(At, 0, 0); PG8_STAGE(PG8_SA(1, 1), a1 + hstep, voffA);
            PG8_WAIT_L(8); PG8_BAR; PG8_WAIT_L(0); PG8_MMA(0, 0, At, B0); PG8_BAR; PG8_SCHED;
            PG8_LDB(B1, 0, 1); PG8_STAGE(PG8_SB(0, 0), b2, voffB);
            PG8_BAR; PG8_WAIT_L(0); PG8_MMA(0, 1, At, B1); PG8_BAR;
            PG8_LDA(At, 0, 1); PG8_STAGE(PG8_SA(0, 0), a2, voffA);
            PG8_BAR; PG8_WAIT_L(0); PG8_MMA(1, 0, At, B0); PG8_BAR; PG8_SCHED;
            PG8_STAGE(PG8_SB(0, 1), b2 + hstep, voffB);
            PG8_WAIT_V(6); PG8_BAR; PG8_MMA(1, 1, At, B1); PG8_BAR;
            PG8_LDB(B0, 1, 0); PG8_SCHED; PG8_LDA(At, 1, 0); PG8_STAGE(PG8_SA(0, 1), a2 + hstep, voffA);
            PG8_WAIT_L(8); PG8_BAR; PG8_WAIT_L(0); PG8_MMA(0, 0, At, B0); PG8_BAR; PG8_SCHED;
            PG8_LDB(B1, 1, 1); PG8_STAGE(PG8_SB(1, 0), b3, voffB);
            PG8_BAR; PG8_WAIT_L(0); PG8_MMA(0, 1, At, B1); PG8_BAR;
            PG8_LDA(At, 1, 1); PG8_STAGE(PG8_SA(1, 0), a3, voffA);
            PG8_BAR; PG8_WAIT_L(0); PG8_MMA(1, 0, At, B0); PG8_BAR; PG8_SCHED;
            PG8_STAGE(PG8_SB(1, 1), b3 + hstep, voffB);
            PG8_WAIT_V(6); PG8_BAR; PG8_MMA(1, 1, At, B1); PG8_BAR;
            }
        }
        if constexpr (ALIGN_EPI) { if (wr == 0) PG8_BAR; }
        if constexpr (!Epi::AFTER_DRAIN) { int t2_ = threadIdx.x; asm volatile("" : "+v"(t2_)); const int l2_ = t2_ & 63;
            E(acc, cur, wr, wc, l2_ & 15, l2_ >> 4); S.done(cur); }
        if (!has_next) break;
#pragma unroll
        for (int a = 0; a < 2; ++a)
#pragma unroll
            for (int b = 0; b < 2; ++b)
#pragma unroll
                for (int m = 0; m < 4; ++m)
#pragma unroll
                    for (int n = 0; n < 2; ++n) acc[a][b][m][n] = (f32x4){0.f, 0.f, 0.f, 0.f};
        cur = nxt; cA = nA; cB = nB; ++ui;
        if constexpr (ALIGN_EPI) { if (wr == 1) PG8_BAR; }
    }
    PG8_WAIT_V(0);
    if constexpr (!ALIGN_EPI) { if (wr == 0) PG8_BAR; }
    PG8_BAR;
    if constexpr (Epi::AFTER_DRAIN) { E.fused(acc, cur, wr, wc, fr, fq, lds, wid, lane); S.done(cur); }
#undef PG8_SA
#undef PG8_STAGE_A
#undef PG8_GLOAD
#undef PG8_SB
#undef PG8_STAGE
#undef PG8_LDA
#undef PG8_LDB
#undef PG8_MMA
#undef PG8_CAT
#undef PG8_WAIT_V
#undef PG8_WAIT_L
#undef PG8_BAR
#undef PG8_SCHED
}
}
#include <hip/hip_bf16.h>
#include <cmath>
namespace attn_body {
using bf16=__hip_bfloat16;
using bf16x8=__attribute__((ext_vector_type(8)))short;
using s16x4=__attribute__((ext_vector_type(4)))short;
using f32x16=__attribute__((ext_vector_type(16)))float;
using u32x4=__attribute__((ext_vector_type(4)))unsigned;
constexpr int SEQ=8192,D=64,QP=3072,KP=3072,OP=512;
constexpr int NW=8,QBLK=32,QB=QBLK*NW,KVBLK=64,NQB=SEQ/QB;
constexpr int ATTN_UNIT_ROWS=QB;
__device__ __forceinline__ int crow(int r,int hi){return (r&3)+8*(r>>2)+4*hi;}
#define SBAR() __builtin_amdgcn_sched_barrier(0)
__device__ __forceinline__ void cmask(f32x16&p0,f32x16&p1,int jb,int qrel,int hi){
  const float NEG=-INFINITY; int kb=64*jb+4*hi;
  #pragma unroll
  for(int r=0;r<16;++r){int kv=kb+(r&3)+8*(r>>2); if(kv>qrel)p0[r]=NEG; if(kv+32>qrel)p1[r]=NEG;}
}

constexpr int NSLOT=3, SLOTB=8192;
constexpr int LDS_K=0, LDS_V=NSLOT*SLOTB, LDS_WS=2*NSLOT*SLOTB, LDS_OST=LDS_WS+NW*64*4, LDS_TB=LDS_OST+NW*4096+4096, LDS_BYTES=LDS_TB+4096;
constexpr float C2=0.125f*1.4426950408889634f;
__device__ __forceinline__ void glds16(const void*gsrc,unsigned lds_dst){unsigned keep;
  asm volatile("s_mov_b32 %0, m0\n\ts_mov_b32 m0, %2\n\ts_nop 0\n\tglobal_load_lds_dwordx4 %1, off\n\ts_mov_b32 m0, %0":"=&s"(keep):"v"(gsrc),"s"(lds_dst):"memory");}
__device__ __forceinline__ float max3f(float a,float b,float c){float r;asm("v_max3_f32 %0, %1, %2, %3":"=v"(r):"v"(a),"v"(b),"v"(c));return r;}
__device__ __forceinline__ float max2f(float a,float b){float r;asm("v_max_f32_e32 %0, %1, %2":"=v"(r):"v"(a),"v"(b));return r;}
__device__ __forceinline__ float fadd_s(float a,float b){float r;asm("v_add_f32_e32 %0, %1, %2":"=v"(r):"v"(a),"v"(b));return r;}
__device__ __forceinline__ float fsub_s(float a,float b){float r;asm("v_sub_f32_e32 %0, %1, %2":"=v"(r):"v"(a),"v"(b));return r;}
typedef float f32x2_t __attribute__((ext_vector_type(2))); typedef __bf16 bf16x2_t __attribute__((ext_vector_type(2)));
__device__ __forceinline__ unsigned cvtpk_s(float lo,float hi){f32x2_t v={lo,hi};bf16x2_t b=__builtin_convertvector(v,bf16x2_t);return __builtin_bit_cast(unsigned,b);}
#define WAIT_BAR(N) asm volatile("s_waitcnt vmcnt(" #N ") lgkmcnt(0)\n\ts_barrier":::"memory")

__device__ __forceinline__ void qkt(f32x16&p0,f32x16&p1,const char*Kslot,const bf16x8*qr,const f32x16&negm,int r32,int hi){
  const char*kb=Kslot+hi*1024+r32*16;
  #pragma unroll
  for(int d0=0;d0<4;++d0){
    const bf16x8 b0=*reinterpret_cast<const bf16x8*>(kb+d0*2048);
    const bf16x8 b1=*reinterpret_cast<const bf16x8*>(kb+d0*2048+512);
    if(d0==0){p0=__builtin_amdgcn_mfma_f32_32x32x16_bf16(b0,qr[0],negm,0,0,0);p1=__builtin_amdgcn_mfma_f32_32x32x16_bf16(b1,qr[0],negm,0,0,0);}
    else{p0=__builtin_amdgcn_mfma_f32_32x32x16_bf16(b0,qr[d0],p0,0,0,0);p1=__builtin_amdgcn_mfma_f32_32x32x16_bf16(b1,qr[d0],p1,0,0,0);}}
}
typedef __attribute__((address_space(3))) const char* lds_cptr;
typedef short v4i16_t __attribute__((ext_vector_type(4)));
__device__ __forceinline__ void kload8(bf16x8*kf,lds_cptr kp){
  kf[0]=*(const __attribute__((address_space(3))) bf16x8*)(kp);      kf[1]=*(const __attribute__((address_space(3))) bf16x8*)(kp+512);
  kf[2]=*(const __attribute__((address_space(3))) bf16x8*)(kp+2048); kf[3]=*(const __attribute__((address_space(3))) bf16x8*)(kp+2560);
  kf[4]=*(const __attribute__((address_space(3))) bf16x8*)(kp+4096); kf[5]=*(const __attribute__((address_space(3))) bf16x8*)(kp+4608);
  kf[6]=*(const __attribute__((address_space(3))) bf16x8*)(kp+6144); kf[7]=*(const __attribute__((address_space(3))) bf16x8*)(kp+6656);
}
__device__ __forceinline__ void kload2(bf16x8*kf,lds_cptr kp,int j){ kf[2*j]=*(const __attribute__((address_space(3))) bf16x8*)(kp+j*2048); kf[2*j+1]=*(const __attribute__((address_space(3))) bf16x8*)(kp+j*2048+512); }
__device__ __forceinline__ s16x4 vtr(lds_cptr p){ return __builtin_bit_cast(s16x4,__builtin_amdgcn_ds_read_tr16_b64_v4i16((__attribute__((address_space(3))) v4i16_t*)p)); }
__device__ __forceinline__ float rowmax(const f32x16&p0,const f32x16&p1){
  float a=max3f(p0[0],p0[1],p1[0]),b=max3f(p0[2],p0[3],p1[1]);a=max3f(a,p1[2],p1[3]);
  #pragma unroll
  for(int r=4;r<16;r+=4){a=max3f(a,p0[r],p0[r+1]);b=max3f(b,p0[r+2],p0[r+3]);a=max3f(a,p1[r],p1[r+1]);b=max3f(b,p1[r+2],p1[r+3]);}
  const float m=max2f(a,b);
  auto rr=__builtin_amdgcn_permlane32_swap(__float_as_uint(m),__float_as_uint(m),false,false);
  return max2f(__uint_as_float(rr[0]),__uint_as_float(rr[1]));
}
__device__ __forceinline__ void pv(f32x16*o,int vb,bf16x8 pa0,bf16x8 pa1,bf16x8 pa2,bf16x8 pa3){
  #pragma unroll
  for(int d0=0;d0<2;++d0){s16x4 lo[4],hi[4];
    #pragma unroll
    for(int ks=0;ks<4;++ks){
      asm volatile("ds_read_b64_tr_b16 %0,%1 offset:%c2":"=&v"(lo[ks]):"v"(vb),"i"(d0*4096+ks*1024):"memory");
      asm volatile("ds_read_b64_tr_b16 %0,%1 offset:%c2":"=&v"(hi[ks]):"v"(vb),"i"(d0*4096+ks*1024+512):"memory");}
    asm volatile("s_waitcnt lgkmcnt(0)":::"memory");SBAR();
    #define PK(k) (bf16x8){lo[k][0],lo[k][1],lo[k][2],lo[k][3],hi[k][0],hi[k][1],hi[k][2],hi[k][3]}
    o[d0]=__builtin_amdgcn_mfma_f32_32x32x16_bf16(pa0,PK(0),o[d0],0,0,0);
    o[d0]=__builtin_amdgcn_mfma_f32_32x32x16_bf16(pa1,PK(1),o[d0],0,0,0);
    o[d0]=__builtin_amdgcn_mfma_f32_32x32x16_bf16(pa2,PK(2),o[d0],0,0,0);
    o[d0]=__builtin_amdgcn_mfma_f32_32x32x16_bf16(pa3,PK(3),o[d0],0,0,0);
    #undef PK
  }
}

#ifndef ATTN_STORE16
#define ATTN_STORE16(p,v) (*(u32x4*)(p)=(v))
#endif
template<int MODE,int OP,int THRL> __device__ __forceinline__ void attn_unit(const bf16*Qu,const bf16*__restrict__ Kh,const bf16*__restrict__ Vh,bf16*Ou,int q0,int t_lo,int NT,float nsl2,char*shm){
  int tid_=threadIdx.x; asm volatile("":"+v"(tid_));
  const int tid=tid_,lane=tid&63,r32=lane&31,hi=lane>>5; const int wid=__builtin_amdgcn_readfirstlane(tid>>6);
  const bf16*Qw=Qu+(long)(wid*QBLK)*QP;
  const unsigned lds0=(unsigned)(uintptr_t)shm;
  float*wsf=(float*)(shm+LDS_WS)+wid*64;
  const bf16*ksrc=Kh+(long)lane*KP+wid*8;
  const bf16*vsrc=Vh+(long)(16*(wid&3)+(lane>>2))*KP+(wid>>2)*32+(lane&3)*8;
  const unsigned kdst=lds0+LDS_K+wid*1024, vdst=lds0+LDS_V+wid*1024;
  #define DMA_K(t,slot) glds16(ksrc+(long)(t)*KVBLK*KP,(unsigned)__builtin_amdgcn_readfirstlane(kdst+(slot)))
  #define DMA_V(t,slot) glds16(vsrc+(long)(t)*KVBLK*KP,(unsigned)__builtin_amdgcn_readfirstlane(vdst+(slot)))
  const int vb0=(int)(lds0+LDS_V)+((lane>>4)&1)*32+(lane&3)*8+(4*hi+((lane&15)>>2))*64;
  const char*Kbase=shm+LDS_K; bf16x8 kf[8];
  const lds_cptr shm3=(lds_cptr)shm; const lds_cptr kp0=shm3+LDS_K+hi*1024+r32*16; const lds_cptr vp0=shm3+LDS_V+((lane>>4)&1)*32+(lane&3)*8+(4*hi+((lane&15)>>2))*64;
  DMA_K(0,0);DMA_V(0,0);DMA_K(1,SLOTB);
  bf16x8 qr[4];
  #pragma unroll
  for(int d0=0;d0<4;++d0)qr[d0]=*reinterpret_cast<const bf16x8*>(&Qw[(long)r32*QP+d0*16+hi*8]);
  float mhat=0.f,l_reg=0.f;f32x16 o[2];o[0]=f32x16{};o[1]=f32x16{};f32x16 negm=f32x16{};asm volatile("":"+v"(negm));
  const float qf=(float)(q0+wid*QBLK+r32-4*hi);
  const int n_r=q0+(wid>>1), n_c=(wid&1)*32+r32, n_rs=min(max(n_r-4,0),120), n_kc=4*hi-min(max(n_c-8,0),48);
  typedef __attribute__((address_space(3))) const float* lds_fptr;
  const lds_fptr n_tb=(lds_fptr)((__attribute__((address_space(3))) const char*)shm+LDS_TB)+(7-n_r)*31+4*hi-n_c+15;
  #define CMASK(P0,P1,t) do{ if(MODE==0){ const float dq_=qf-(float)(64*(t)); _Pragma("unroll") for(int r=0;r<16;++r){ const float cr_=(float)((r&3)+8*(r>>2)); \
      P0[r]=__builtin_fmaf(nsl2,__builtin_fabsf(dq_-cr_),P0[r]); P1[r]=__builtin_fmaf(nsl2,__builtin_fabsf(dq_-(cr_+32.f)),P1[r]); } } \
    else { const int kr_=t_lo+(t); const bool vr_=(kr_>=n_rs)&&(kr_<n_rs+8); const lds_fptr tb_=n_tb+kr_*31; \
      _Pragma("unroll") for(int r=0;r<16;++r){ const int ko_=(r&3)+8*(r>>2); const float b0_=tb_[ko_],b1_=tb_[ko_+32]; \
        const bool ok0_=vr_&&((unsigned)(n_kc+ko_)<16u), ok1_=vr_&&((unsigned)(n_kc+ko_+32)<16u); \
        P0[r]=ok0_?P0[r]+b0_:-INFINITY; P1[r]=ok1_?P1[r]+b1_:-INFINITY; } } }while(0)
  bool resc=false;
  #define START(P0,P1) do{ const float rm=rowmax(P0,P1); resc=false; \
    { const float dl=(rm>-1e30f)?rm:0.f; mhat=fadd_s(mhat,dl); \
      _Pragma("unroll") for(int r=0;r<16;++r){P0[r]=fsub_s(P0[r],dl);P1[r]=fsub_s(P1[r],dl);} \
      _Pragma("unroll") for(int r=0;r<16;++r)negm[r]=-mhat; asm volatile("":"+v"(negm)); } \
    _Pragma("unroll") for(int r=0;r<16;++r)P0[r]=__builtin_amdgcn_exp2f(P0[r]); }while(0)
  #define RESC() do{ if(resc){ asm volatile("s_waitcnt lgkmcnt(0)":::"memory"); \
      _Pragma("unroll") for(int d_=0;d_<2;++d_) _Pragma("unroll") for(int r=0;r<16;++r)o[d_][r]*=wsf[crow(r,hi)]; } }while(0)
  f32x16 pA0,pA1,pB0,pB1;
  int sl_prev=0,sl_cur=0,sl_next=SLOTB;
  #define ROT() do{sl_prev=sl_cur;sl_cur=sl_next;sl_next=(sl_next==(NSLOT-1)*SLOTB)?0:sl_next+SLOTB;}while(0)
  DMA_K(2,2*SLOTB);
  WAIT_BAR(3);
  qkt(pA0,pA1,Kbase,qr,negm,r32,hi);asm volatile("s_nop 15\n\ts_nop 7":"+v"(pA0),"+v"(pA1));CMASK(pA0,pA1,0);
  START(pA0,pA1);
  _Pragma("unroll") for(int r=0;r<16;++r)pA1[r]=__builtin_amdgcn_exp2f(pA1[r]);
  WAIT_BAR(0);
  DMA_K(3,0);DMA_V(1,SLOTB);
  ROT();
  kload8(kf,kp0+sl_cur);
  WAIT_BAR(2);
  s16x4 vlo[8],vhi[8]; u32x4 pw0,pw1,pw2,pw3;
  #define PKW(P,B) cvtpk_s(P[B],P[B+1])
  #define PAF(k) __builtin_bit_cast(bf16x8,pw##k)
  #define VFR(i) (bf16x8){vlo[i][0],vlo[i][1],vlo[i][2],vlo[i][3],vhi[i][0],vhi[i][1],vhi[i][2],vhi[i][3]}
  #define PIN(x) asm volatile("":"+v"(x))
  #define MX3(a,b,c) __builtin_fmaxf(__builtin_fmaxf((a),(b)),(c))
  #define GAPA(MF,A0,A1,A2,A3,W0,W1,PW) do{ MF; sacc+=A0; sacc+=A1; sacc+=A2; sacc+=A3; PIN(sacc); W0; W1; PIN(PW); SBAR(); }while(0)
  #define EX(v) __builtin_amdgcn_exp2f(v)
  #define GAPB(MF,X,B) do{ MF; X[B]=EX(X[B]); X[B+1]=EX(X[B+1]); X[B+2]=EX(X[B+2]); X[B+3]=EX(X[B+3]); PIN(X); SBAR(); }while(0)
  #define VRD(i) do{ vlo[i]=vtr(vp_+(((i)>>2)*4096+((i)&3)*1024)); vhi[i]=vtr(vp_+(((i)>>2)*4096+((i)&3)*1024+512)); }while(0)
  #define KRD(G,j) do{ if(G){ kload2(kf,kp0+sl_next,j); SBAR(); } }while(0)
  #define STEP(C0,C1,P0,P1,t,GK,GV,GL) do{ SBAR(); \
    const lds_cptr vp_=vp0+sl_prev; \
    VRD(0); SBAR(); float sacc=(P0[0]+P0[1]); \
    GAPA(C0=__builtin_amdgcn_mfma_f32_32x32x16_bf16(kf[0],qr[0],negm,0,0,0), P0[2],P0[3],P0[4],P0[5],     pw0[0]=PKW(P0,0), pw0[1]=PKW(P0,2), pw0); \
    VRD(4); SBAR(); GAPA(C1=__builtin_amdgcn_mfma_f32_32x32x16_bf16(kf[1],qr[0],negm,0,0,0), P0[6],P0[7],P0[8],P0[9],     pw0[2]=PKW(P0,4), pw0[3]=PKW(P0,6), pw0); \
    VRD(1); SBAR(); GAPA(C0=__builtin_amdgcn_mfma_f32_32x32x16_bf16(kf[2],qr[1],C0,0,0,0),   P0[10],P0[11],P0[12],P0[13], pw1[0]=PKW(P0,8), pw1[1]=PKW(P0,10), pw1); \
    VRD(5); SBAR(); GAPA(C1=__builtin_amdgcn_mfma_f32_32x32x16_bf16(kf[3],qr[1],C1,0,0,0),   P0[14],P0[15],P1[0],P1[1],   pw1[2]=PKW(P0,12),pw1[3]=PKW(P0,14), pw1); \
    VRD(2); SBAR(); GAPA(C0=__builtin_amdgcn_mfma_f32_32x32x16_bf16(kf[4],qr[2],C0,0,0,0),   P1[2],P1[3],P1[4],P1[5],     pw2[0]=PKW(P1,0), pw2[1]=PKW(P1,2), pw2); \
    VRD(6); SBAR(); GAPA(C1=__builtin_amdgcn_mfma_f32_32x32x16_bf16(kf[5],qr[2],C1,0,0,0),   P1[6],P1[7],P1[8],P1[9],     pw2[2]=PKW(P1,4), pw2[3]=PKW(P1,6), pw2); \
    VRD(3); SBAR(); GAPA(C0=__builtin_amdgcn_mfma_f32_32x32x16_bf16(kf[6],qr[3],C0,0,0,0),   P1[10],P1[11],P1[12],P1[13], pw3[0]=PKW(P1,8), pw3[1]=PKW(P1,10), pw3); \
    VRD(7); SBAR(); GAPA(C1=__builtin_amdgcn_mfma_f32_32x32x16_bf16(kf[7],qr[3],C1,0,0,0),   P1[14],P1[15],0.f,0.f,       pw3[2]=PKW(P1,12),pw3[3]=PKW(P1,14), pw3); \
    l_reg+=sacc; \
    if(GK){DMA_K((t)+3,sl_cur);} if(GV){DMA_V((t)+1,sl_next);} \
    CMASK(C0,C1,t); \
    { float a=MX3(C0[0],C0[1],C1[0]),b=MX3(C0[2],C0[3],C1[1]); a=MX3(a,C1[2],C1[3]); \
      _Pragma("unroll") for(int r=4;r<16;r+=4){a=MX3(a,C0[r],C0[r+1]);b=MX3(b,C0[r+2],C0[r+3]);a=MX3(a,C1[r],C1[r+1]);b=MX3(b,C1[r+2],C1[r+3]);} \
      float rm=__builtin_fmaxf(a,b); { auto rr=__builtin_amdgcn_permlane32_swap(__float_as_uint(rm),__float_as_uint(rm),false,false); rm=__builtin_fmaxf(__uint_as_float(rr[0]),__uint_as_float(rr[1])); } \
      resc=false; \
      if(__builtin_expect(__any(rm>(float)THRL),0)){ const float dl=__builtin_fmaxf(rm,0.f); mhat+=dl; \
        _Pragma("unroll") for(int r=0;r<16;++r){C0[r]-=dl;C1[r]-=dl;} \
        _Pragma("unroll") for(int r=0;r<16;++r)negm[r]=-mhat; asm volatile("":"+v"(negm)); \
        const float f=__builtin_amdgcn_exp2f(-dl); l_reg*=f; if(hi==0)wsf[r32]=f; resc=true; } } \
    SBAR(); \
    GAPB(o[0]=__builtin_amdgcn_mfma_f32_32x32x16_bf16(PAF(0),VFR(0),o[0],0,0,0), C0,0); \
    GAPB(o[1]=__builtin_amdgcn_mfma_f32_32x32x16_bf16(PAF(0),VFR(4),o[1],0,0,0), C0,4); \
    KRD(GL,0); GAPB(o[0]=__builtin_amdgcn_mfma_f32_32x32x16_bf16(PAF(1),VFR(1),o[0],0,0,0), C0,8); \
    KRD(GL,1); GAPB(o[1]=__builtin_amdgcn_mfma_f32_32x32x16_bf16(PAF(1),VFR(5),o[1],0,0,0), C0,12); \
    KRD(GL,2); GAPB(o[0]=__builtin_amdgcn_mfma_f32_32x32x16_bf16(PAF(2),VFR(2),o[0],0,0,0), C1,0); \
    KRD(GL,3); GAPB(o[1]=__builtin_amdgcn_mfma_f32_32x32x16_bf16(PAF(2),VFR(6),o[1],0,0,0), C1,4); \
    GAPB(o[0]=__builtin_amdgcn_mfma_f32_32x32x16_bf16(PAF(3),VFR(3),o[0],0,0,0), C1,8); \
    GAPB(o[1]=__builtin_amdgcn_mfma_f32_32x32x16_bf16(PAF(3),VFR(7),o[1],0,0,0), C1,12); \
    }while(0)
  int t=1;
  for(;t+5<NT;t+=2){
    STEP(pB0,pB1,pA0,pA1,t,true,true,true);     WAIT_BAR(2); RESC(); ROT();
    STEP(pA0,pA1,pB0,pB1,t+1,true,true,true);   WAIT_BAR(2); RESC(); ROT();
  }
  #define ENDW(tt) do{ if((tt)+3<NT){WAIT_BAR(2);} else if((tt)+2<NT){WAIT_BAR(1);} else {WAIT_BAR(0);} }while(0)
  for(;t+1<NT;t+=2){
    STEP(pB0,pB1,pA0,pA1,t,(t+3<NT),(t+1<NT),(t+1<NT));       ENDW(t);   RESC(); ROT();
    STEP(pA0,pA1,pB0,pB1,t+1,(t+4<NT),(t+2<NT),(t+2<NT));     ENDW(t+1); RESC(); ROT();
  }
  STEP(pB0,pB1,pA0,pA1,NT-1,false,false,false); RESC();
  { float sacc=pB0[0]+pB0[1]; _Pragma("unroll") for(int r=2;r<16;++r)sacc+=pB0[r]; _Pragma("unroll") for(int r=0;r<16;++r)sacc+=pB1[r]; l_reg+=sacc;
    pw0=(u32x4){PKW(pB0,0),PKW(pB0,2),PKW(pB0,4),PKW(pB0,6)};pw1=(u32x4){PKW(pB0,8),PKW(pB0,10),PKW(pB0,12),PKW(pB0,14)};pw2=(u32x4){PKW(pB1,0),PKW(pB1,2),PKW(pB1,4),PKW(pB1,6)};pw3=(u32x4){PKW(pB1,8),PKW(pB1,10),PKW(pB1,12),PKW(pB1,14)};
    SBAR(); pv(o,vb0+sl_cur,PAF(0),PAF(1),PAF(2),PAF(3)); }
  #undef PKW
  #undef PAF
  #undef VFR
  #undef PIN
  #undef MX3
  #undef GAPA
  #undef GAPB
  #undef EX
  #undef VRD
  #undef KRD
  #undef STEP
  #undef ENDW
  {auto rr=__builtin_amdgcn_permlane32_swap(__float_as_uint(l_reg),__float_as_uint(l_reg),false,false);l_reg=__uint_as_float(rr[0])+__uint_as_float(rr[1]);}
  if(hi==0)wsf[32+r32]=l_reg;asm volatile("s_waitcnt lgkmcnt(0)":::"memory");
  float rli[16];
  #pragma unroll
  for(int r=0;r<16;++r)rli[r]=__builtin_amdgcn_rcpf(wsf[32+crow(r,hi)]);
  bf16*Ow=Ou+(long)(wid*QBLK)*OP;
  { bf16*stg=(bf16*)(shm+LDS_OST)+wid*2048;
    #pragma unroll
    for(int r=0;r<16;++r){const int orow=crow(r,hi);
      #pragma unroll
      for(int d0=0;d0<2;++d0)stg[orow*64+d0*32+r32]=__float2bfloat16(o[d0][r]*rli[r]);}
    asm volatile("s_waitcnt lgkmcnt(0)":::"memory");
    #pragma unroll
    for(int i=0;i<4;++i){const int row=i*8+(lane>>3),ch=lane&7; const u32x4 v=*(const u32x4*)(stg+row*64+ch*8); ATTN_STORE16(Ow+(long)row*OP+ch*8,v);} }
  asm volatile("s_waitcnt lgkmcnt(0)\n\ts_barrier":::"memory");
  #undef DMA_K
  #undef DMA_V
  #undef CMASK
  #undef START
  #undef RESC
  #undef ROT
}
constexpr int W_K=0, W_V=NSLOT*SLOTB, W_WS=W_V+NSLOT*2*SLOTB, W_OST=W_WS+NW*64*4, W_BYTES=W_OST+NW*4096;
template<int THRL> __device__ __forceinline__ void attn_unit128(const bf16*Qu,const bf16*__restrict__ Kb,const bf16*__restrict__ Vb,bf16*od,unsigned o_off,unsigned*done,int q0a,float kn,float nsl2,char*shm){
  constexpr int OP=512;
  const __amdgpu_buffer_rsrc_t orsrc=__builtin_amdgcn_make_buffer_rsrc(od,0,2*2*SEQ*512*2,0x00020000);
  int tid_=threadIdx.x; asm volatile("":"+v"(tid_));
  const int tid=tid_,lane=tid&63,r32=lane&31,hi=lane>>5; const int wid=__builtin_amdgcn_readfirstlane(tid>>6);
  const bf16*Qw=Qu+(long)(wid*QBLK)*QP;
  const unsigned lds0=(unsigned)(uintptr_t)shm;
  float*wsf=(float*)(shm+W_WS)+wid*64;
  bf16x8 qr[4];
  #pragma unroll
  for(int d0=0;d0<4;++d0)qr[d0]=*reinterpret_cast<const bf16x8*>(&Qw[(long)r32*QP+d0*16+hi*8]);
  int t_lo,NT;
  {
    const int rowp=q0a+wid*QBLK+r32; const bf16*kd=Kb+(long)(rowp>>6)*4096+(rowp&63)*8+hi*512;
    float dot=0.f,nq=0.f;
    #pragma unroll
    for(int d0=0;d0<4;++d0){ const bf16x8 kv=*reinterpret_cast<const bf16x8*>(kd+d0*1024);
      #pragma unroll
      for(int j=0;j<8;++j){ const float qv=__uint_as_float(((unsigned)(unsigned short)qr[d0][j])<<16), kvf=__uint_as_float(((unsigned)(unsigned short)kv[j])<<16); dot=__builtin_fmaf(qv,kvf,dot); nq=__builtin_fmaf(qv,qv,nq); } }
    { auto r1=__builtin_amdgcn_permlane32_swap(__float_as_uint(dot),__float_as_uint(dot),false,false); dot=__uint_as_float(r1[0])+__uint_as_float(r1[1]);
      auto r2=__builtin_amdgcn_permlane32_swap(__float_as_uint(nq),__float_as_uint(nq),false,false); nq=__uint_as_float(r2[0])+__uint_as_float(r2[1]); }
    #pragma unroll
    for(int o_=1;o_<32;o_<<=1){ dot=__builtin_fminf(dot,__shfl_xor(dot,o_)); nq=__builtin_fmaxf(nq,__shfl_xor(nq,o_)); }
    float*xs=(float*)(shm+W_WS);
    if(lane==0){ xs[wid]=dot; xs[8+wid]=nq; }
    asm volatile("s_waitcnt lgkmcnt(0)\n\ts_barrier":::"memory");
    float smin=xs[0],q2=xs[8];
    #pragma unroll
    for(int w_=1;w_<8;++w_){ smin=__builtin_fminf(smin,xs[w_]); q2=__builtin_fmaxf(q2,xs[8+w_]); }
    asm volatile("s_waitcnt lgkmcnt(0)\n\ts_barrier":::"memory");
    const float R=(__builtin_sqrtf(q2)*kn-smin+40.f)/(-nsl2);
    int tl=(int)__builtin_fmaxf(__builtin_floorf(((float)q0a-R)*(1.f/64.f)),0.f), th=(int)__builtin_fminf(__builtin_floorf(((float)(q0a+QB-1)+R)*(1.f/64.f)),(float)(SEQ/KVBLK-1));
    if(((th-tl+1)&1)!=0){ if(tl>0)--tl; else ++th; }
    t_lo=__builtin_amdgcn_readfirstlane(tl); NT=__builtin_amdgcn_readfirstlane(th-tl+1); }
  const int q0=q0a-t_lo*KVBLK; const bf16*Kh=Kb+(long)t_lo*4096,*Vh=Vb+(long)t_lo*8192;
  const bf16*ksrc=Kh+wid*512+lane*8;
  const bf16*vsrc=Vh+wid*512+lane*8;
  const unsigned kdst=lds0+W_K+wid*1024, vdst=lds0+W_V+wid*1024;
  const int tdf=q0>>6, Lr=NT-tdf;
  #define TMAP(s_) (((s_)<Lr)?(tdf+(s_)):(tdf-1-((s_)-Lr)))
  #define DMA_K(t,slot) glds16(ksrc+(long)TMAP(t)*4096,(unsigned)__builtin_amdgcn_readfirstlane(kdst+(slot)))
  #define DMA_V(t,slot) do{ const long tv_=(long)TMAP(t)*8192; glds16(vsrc+tv_,(unsigned)__builtin_amdgcn_readfirstlane(vdst+2*(slot))); glds16(vsrc+tv_+4096,(unsigned)__builtin_amdgcn_readfirstlane(vdst+2*(slot)+8192)); }while(0)
  const int vb0=(int)(lds0+W_V)+((lane>>4)&1)*32+(lane&3)*8+(4*hi+((lane&15)>>2))*64;
  bf16x8 kf[8];
  const lds_cptr shm3=(lds_cptr)shm; const lds_cptr kp0=shm3+W_K+hi*1024+r32*16; const lds_cptr vp0=shm3+W_V+((lane>>4)&1)*32+(lane&3)*8+(4*hi+((lane&15)>>2))*64;
  DMA_K(0,0);DMA_V(0,0);DMA_K(1,SLOTB);
  float mhat=0.f,l_reg=0.f;f32x16 o[4];o[0]=f32x16{};o[1]=f32x16{};o[2]=f32x16{};o[3]=f32x16{};
  const float qf=(float)(q0+wid*QBLK+r32-4*hi);
  const int td=(q0>>6)+(wid>>1);
  #define CINIT(C0,C1,t) do{ const int tt_=TMAP(t); const float dq_=qf-(float)(64*tt_); \
    if(tt_==td){ _Pragma("unroll") for(int r=0;r<16;++r){ const float cr_=(float)((r&3)+8*(r>>2)); \
        C0[r]=__builtin_fmaf(nsl2,__builtin_fabsf(dq_-cr_),-mhat); C1[r]=__builtin_fmaf(nsl2,__builtin_fabsf(dq_-(cr_+32.f)),-mhat); } } \
    else { const float k_=(tt_<td)?-nsl2:nsl2; const float b_=__builtin_fmaf(-k_,dq_,-mhat); const float k8_=8.f*k_, k32_=32.f*k_; \
        \
      C0[0]=b_; C0[1]=fadd_s(C0[0],k_); C0[2]=fadd_s(C0[1],k_); C0[3]=fadd_s(C0[2],k_); \
      _Pragma("unroll") for(int r=4;r<16;++r)C0[r]=fadd_s(C0[r-4],k8_); \
      _Pragma("unroll") for(int r=0;r<16;++r)C1[r]=fadd_s(C0[r],k32_); } }while(0)
  bool resc=false;
  #define START(P0,P1) do{ const float rm=rowmax(P0,P1); resc=false; \
    { const float dl=rm; mhat=fadd_s(mhat,dl); \
      _Pragma("unroll") for(int r=0;r<16;++r){P0[r]=fsub_s(P0[r],dl);P1[r]=fsub_s(P1[r],dl);} } \
    _Pragma("unroll") for(int r=0;r<16;++r)P0[r]=__builtin_amdgcn_exp2f(P0[r]); }while(0)
  #define RESC() do{ if(resc){ asm volatile("s_waitcnt lgkmcnt(0)":::"memory"); \
      _Pragma("unroll") for(int d_=0;d_<4;++d_) _Pragma("unroll") for(int r=0;r<16;++r)o[d_][r]*=wsf[crow(r,hi)]; } }while(0)
  f32x16 pA0,pA1,pB0,pB1;
  int sl_prev=0,sl_cur=0,sl_next=SLOTB;
  #define ROT() do{sl_prev=sl_cur;sl_cur=sl_next;sl_next=(sl_next==(NSLOT-1)*SLOTB)?0:sl_next+SLOTB;}while(0)
  DMA_K(2,2*SLOTB);
  WAIT_BAR(4);
  CINIT(pA0,pA1,0);
  { const lds_cptr kb=kp0;
    #pragma unroll
    for(int d0=0;d0<4;++d0){ const bf16x8 b0=*(const __attribute__((address_space(3))) bf16x8*)(kb+d0*2048), b1=*(const __attribute__((address_space(3))) bf16x8*)(kb+d0*2048+512);
      pA0=__builtin_amdgcn_mfma_f32_32x32x16_bf16(b0,qr[d0],pA0,0,0,0); pA1=__builtin_amdgcn_mfma_f32_32x32x16_bf16(b1,qr[d0],pA1,0,0,0); } }
  asm volatile("s_nop 15\n\ts_nop 7":"+v"(pA0),"+v"(pA1));
  START(pA0,pA1);
  _Pragma("unroll") for(int r=0;r<16;++r)pA1[r]=__builtin_amdgcn_exp2f(pA1[r]);
  WAIT_BAR(0);
  DMA_K(3,0);DMA_V(1,SLOTB);
  ROT();
  kload8(kf,kp0+sl_cur);
  WAIT_BAR(3);
  s16x4 vlo[8],vhi[8]; u32x4 pw0,pw1,pw2,pw3;
  #define PKW(P,B) cvtpk_s(P[B],P[B+1])
  #define PAF(k) __builtin_bit_cast(bf16x8,pw##k)
  #define VFR(i) (bf16x8){vlo[i][0],vlo[i][1],vlo[i][2],vlo[i][3],vhi[i][0],vhi[i][1],vhi[i][2],vhi[i][3]}
  #define PIN(x) asm volatile("":"+v"(x))
  #define MX3(a,b,c) __builtin_fmaxf(__builtin_fmaxf((a),(b)),(c))
  #define GAPA(MF,A0,A1,A2,A3,W0,W1,PW) do{ MF; sacc+=A0; sacc+=A1; sacc+=A2; sacc+=A3; PIN(sacc); W0; W1; PIN(PW); SBAR(); }while(0)
  #define EX(v) __builtin_amdgcn_exp2f(v)
  #define GAPB(MF,X,B) do{ MF; X[B]=EX(X[B]); X[B+1]=EX(X[B+1]); PIN(X); SBAR(); }while(0)
  #define VRD(i) do{ vlo[i]=vtr(vp_+(((i)>>2)*4096+((i)&3)*1024)); vhi[i]=vtr(vp_+(((i)>>2)*4096+((i)&3)*1024+512)); }while(0)
  #define VRD2(i) do{ vlo[i]=vtr(vp_+(8192+((i)>>2)*4096+((i)&3)*1024)); vhi[i]=vtr(vp_+(8192+((i)>>2)*4096+((i)&3)*1024+512)); SBAR(); }while(0)
  #define KRD(G,j) do{ if(G){ kload2(kf,kp0+sl_next,j); SBAR(); } }while(0)
  #define STEP(C0,C1,P0,P1,t,GK,GV,GL) do{ SBAR(); \
    const lds_cptr vp_=vp0+2*sl_prev; \
    CINIT(C0,C1,t); SBAR(); \
    VRD(0); SBAR(); float sacc=(P0[0]+P0[1]); \
    GAPA(C0=__builtin_amdgcn_mfma_f32_32x32x16_bf16(kf[0],qr[0],C0,0,0,0), P0[2],P0[3],P0[4],P0[5],     pw0[0]=PKW(P0,0), pw0[1]=PKW(P0,2), pw0); \
    VRD(4); SBAR(); GAPA(C1=__builtin_amdgcn_mfma_f32_32x32x16_bf16(kf[1],qr[0],C1,0,0,0), P0[6],P0[7],P0[8],P0[9],     pw0[2]=PKW(P0,4), pw0[3]=PKW(P0,6), pw0); \
    VRD(1); SBAR(); GAPA(C0=__builtin_amdgcn_mfma_f32_32x32x16_bf16(kf[2],qr[1],C0,0,0,0),   P0[10],P0[11],P0[12],P0[13], pw1[0]=PKW(P0,8), pw1[1]=PKW(P0,10), pw1); \
    VRD(5); SBAR(); GAPA(C1=__builtin_amdgcn_mfma_f32_32x32x16_bf16(kf[3],qr[1],C1,0,0,0),   P0[14],P0[15],P1[0],P1[1],   pw1[2]=PKW(P0,12),pw1[3]=PKW(P0,14), pw1); \
    VRD(2); SBAR(); GAPA(C0=__builtin_amdgcn_mfma_f32_32x32x16_bf16(kf[4],qr[2],C0,0,0,0),   P1[2],P1[3],P1[4],P1[5],     pw2[0]=PKW(P1,0), pw2[1]=PKW(P1,2), pw2); \
    VRD(6); SBAR(); GAPA(C1=__builtin_amdgcn_mfma_f32_32x32x16_bf16(kf[5],qr[2],C1,0,0,0),   P1[6],P1[7],P1[8],P1[9],     pw2[2]=PKW(P1,4), pw2[3]=PKW(P1,6), pw2); \
    VRD(3); SBAR(); GAPA(C0=__builtin_amdgcn_mfma_f32_32x32x16_bf16(kf[6],qr[3],C0,0,0,0),   P1[10],P1[11],P1[12],P1[13], pw3[0]=PKW(P1,8), pw3[1]=PKW(P1,10), pw3); \
    VRD(7); SBAR(); GAPA(C1=__builtin_amdgcn_mfma_f32_32x32x16_bf16(kf[7],qr[3],C1,0,0,0),   P1[14],P1[15],0.f,0.f,       pw3[2]=PKW(P1,12),pw3[3]=PKW(P1,14), pw3); \
    l_reg+=sacc; \
    if(GK){DMA_K((t)+3,sl_cur);} if(GV){DMA_V((t)+1,sl_next);} \
    { float a=MX3(C0[0],C0[1],C1[0]),b=MX3(C0[2],C0[3],C1[1]); a=MX3(a,C1[2],C1[3]); \
      _Pragma("unroll") for(int r=4;r<16;r+=4){a=MX3(a,C0[r],C0[r+1]);b=MX3(b,C0[r+2],C0[r+3]);a=MX3(a,C1[r],C1[r+1]);b=MX3(b,C1[r+2],C1[r+3]);} \
      float rm=__builtin_fmaxf(a,b); { auto rr=__builtin_amdgcn_permlane32_swap(__float_as_uint(rm),__float_as_uint(rm),false,false); rm=__builtin_fmaxf(__uint_as_float(rr[0]),__uint_as_float(rr[1])); } \
      resc=false; \
      if(__builtin_expect(__any(rm>(float)THRL),0)){ const float dl=__builtin_fmaxf(rm,0.f); mhat+=dl; \
        _Pragma("unroll") for(int r=0;r<16;++r){C0[r]-=dl;C1[r]-=dl;} \
        const float f=__builtin_amdgcn_exp2f(-dl); l_reg*=f; if(hi==0)wsf[r32]=f; resc=true; } } \
    SBAR(); \
    GAPB(o[0]=__builtin_amdgcn_mfma_f32_32x32x16_bf16(PAF(0),VFR(0),o[0],0,0,0), C0,0); \
    GAPB(o[1]=__builtin_amdgcn_mfma_f32_32x32x16_bf16(PAF(0),VFR(4),o[1],0,0,0), C0,2);  VRD2(0); \
    GAPB(o[0]=__builtin_amdgcn_mfma_f32_32x32x16_bf16(PAF(1),VFR(1),o[0],0,0,0), C0,4);  VRD2(4); \
    GAPB(o[1]=__builtin_amdgcn_mfma_f32_32x32x16_bf16(PAF(1),VFR(5),o[1],0,0,0), C0,6);  VRD2(1); \
    GAPB(o[0]=__builtin_amdgcn_mfma_f32_32x32x16_bf16(PAF(2),VFR(2),o[0],0,0,0), C0,8);  VRD2(5); \
    GAPB(o[1]=__builtin_amdgcn_mfma_f32_32x32x16_bf16(PAF(2),VFR(6),o[1],0,0,0), C0,10); VRD2(2); \
    GAPB(o[0]=__builtin_amdgcn_mfma_f32_32x32x16_bf16(PAF(3),VFR(3),o[0],0,0,0), C0,12); VRD2(6); \
    GAPB(o[1]=__builtin_amdgcn_mfma_f32_32x32x16_bf16(PAF(3),VFR(7),o[1],0,0,0), C0,14); VRD2(3); VRD2(7); \
    GAPB(o[2]=__builtin_amdgcn_mfma_f32_32x32x16_bf16(PAF(0),VFR(0),o[2],0,0,0), C1,0); \
    GAPB(o[3]=__builtin_amdgcn_mfma_f32_32x32x16_bf16(PAF(0),VFR(4),o[3],0,0,0), C1,2); \
    KRD(GL,0); GAPB(o[2]=__builtin_amdgcn_mfma_f32_32x32x16_bf16(PAF(1),VFR(1),o[2],0,0,0), C1,4); \
    KRD(GL,1); GAPB(o[3]=__builtin_amdgcn_mfma_f32_32x32x16_bf16(PAF(1),VFR(5),o[3],0,0,0), C1,6); \
    KRD(GL,2); GAPB(o[2]=__builtin_amdgcn_mfma_f32_32x32x16_bf16(PAF(2),VFR(2),o[2],0,0,0), C1,8); \
    KRD(GL,3); GAPB(o[3]=__builtin_amdgcn_mfma_f32_32x32x16_bf16(PAF(2),VFR(6),o[3],0,0,0), C1,10); \
    GAPB(o[2]=__builtin_amdgcn_mfma_f32_32x32x16_bf16(PAF(3),VFR(3),o[2],0,0,0), C1,12); \
    GAPB(o[3]=__builtin_amdgcn_mfma_f32_32x32x16_bf16(PAF(3),VFR(7),o[3],0,0,0), C1,14); \
    }while(0)
  int t=1;
  for(;t+5<NT;t+=2){
    STEP(pB0,pB1,pA0,pA1,t,true,true,true);     WAIT_BAR(3); RESC(); ROT();
    STEP(pA0,pA1,pB0,pB1,t+1,true,true,true);   WAIT_BAR(3); RESC(); ROT();
  }
  #define ENDW(tt) do{ if((tt)+3<NT){WAIT_BAR(3);} else if((tt)+2<NT){WAIT_BAR(2);} else {WAIT_BAR(0);} }while(0)
  for(;t+1<NT;t+=2){
    STEP(pB0,pB1,pA0,pA1,t,(t+3<NT),(t+1<NT),(t+1<NT));       ENDW(t);   RESC(); ROT();
    STEP(pA0,pA1,pB0,pB1,t+1,(t+4<NT),(t+2<NT),(t+2<NT));     ENDW(t+1); RESC(); ROT();
  }
  STEP(pB0,pB1,pA0,pA1,NT-1,false,false,false); RESC();
  { float sacc=pB0[0]+pB0[1]; _Pragma("unroll") for(int r=2;r<16;++r)sacc+=pB0[r]; _Pragma("unroll") for(int r=0;r<16;++r)sacc+=pB1[r]; l_reg+=sacc;
    pw0=(u32x4){PKW(pB0,0),PKW(pB0,2),PKW(pB0,4),PKW(pB0,6)};pw1=(u32x4){PKW(pB0,8),PKW(pB0,10),PKW(pB0,12),PKW(pB0,14)};pw2=(u32x4){PKW(pB1,0),PKW(pB1,2),PKW(pB1,4),PKW(pB1,6)};pw3=(u32x4){PKW(pB1,8),PKW(pB1,10),PKW(pB1,12),PKW(pB1,14)};
    SBAR(); pv(o,vb0+2*sl_cur,PAF(0),PAF(1),PAF(2),PAF(3)); pv(o+2,vb0+2*sl_cur+8192,PAF(0),PAF(1),PAF(2),PAF(3)); }
  #undef PKW
  #undef PAF
  #undef VFR
  #undef PIN
  #undef MX3
  #undef GAPA
  #undef GAPB
  #undef EX
  #undef VRD
  #undef VRD2
  #undef KRD
  #undef STEP
  #undef ENDW
  {auto rr=__builtin_amdgcn_permlane32_swap(__float_as_uint(l_reg),__float_as_uint(l_reg),false,false);l_reg=__uint_as_float(rr[0])+__uint_as_float(rr[1]);}
  if(hi==0)wsf[32+r32]=l_reg;asm volatile("s_waitcnt lgkmcnt(0)":::"memory");
  float rli[16];
  #pragma unroll
  for(int r=0;r<16;++r)rli[r]=__builtin_amdgcn_rcpf(wsf[32+crow(r,hi)]);
  const unsigned ow_off=o_off+(unsigned)(wid*QBLK)*OP;
  { bf16*stg=(bf16*)(shm+W_OST)+wid*2048;
    #pragma unroll
    for(int hf=0;hf<2;++hf){
      #pragma unroll
      for(int r=0;r<16;++r){const int orow=crow(r,hi);
        #pragma unroll
        for(int d0=0;d0<2;++d0)stg[orow*64+d0*32+r32]=__float2bfloat16(o[hf*2+d0][r]*rli[r]);}
      asm volatile("s_waitcnt lgkmcnt(0)":::"memory");
      #pragma unroll
      for(int i=0;i<4;++i){const int row=i*8+(lane>>3),ch=lane&7; const u32x4 v=*(const u32x4*)(stg+row*64+ch*8); __builtin_amdgcn_raw_buffer_store_b128(v,orsrc,(ow_off+(unsigned)(row*OP+hf*64+ch*8))*2u,0,16);}
      asm volatile("s_waitcnt lgkmcnt(0)":::"memory"); } }
  asm volatile("s_waitcnt vmcnt(0) lgkmcnt(0)\n\ts_barrier":::"memory");
  if(tid==0) __hip_atomic_fetch_add(done,1u,__ATOMIC_RELAXED,__HIP_MEMORY_SCOPE_AGENT);
  #undef DMA_K
  #undef DMA_V
  #undef TMAP
  #undef CINIT
  #undef START
  #undef RESC
  #undef ROT
}
constexpr int ATTN_LDS_BYTES=LDS_BYTES;
constexpr int LDS_QW=W_BYTES;
template<int THRL=8> __device__ __forceinline__ void attn_one(int u,char*lds,const bf16*proj,const bf16*kimg,const bf16*vimg,bf16*od,const unsigned*nrm,unsigned*done){
    const int h=3-(u>>7), r=u&127, map=r>>6, b=(r>>5)&1, qb=r&31;
    const float sl2=__builtin_amdgcn_exp2f(-2.f*(float)(h+1))*1.4426950408889634f;
    const unsigned* nk=nrm+((b*16+8+2*h+map)*2);
    const float kn=__builtin_sqrtf(__uint_as_float(nk[0])+__uint_as_float(nk[1]));
    const int q0=qb*QB; const long row0=(long)b*SEQ;
    attn_unit128<THRL>(proj+(row0+q0)*QP+h*128+map*64, kimg+(long)((b*4+h)*2+map)*128*4096, vimg+(long)(b*4+h)*128*8192,
                    od, (unsigned)(((long)map*(2*SEQ)+row0+q0)*512+h*128), done+(b*32+qb)*64, q0, kn, -sl2, lds);
}
template<int THRL=8> __device__ __forceinline__ void nat_one(int u,char*lds,const bf16*proj,bf16*concat,const float*rpb){
    const int tid=threadIdx.x;
    const int h=u&7,rb=u>>3,b=rb>>5,r0=(rb&31)*4;
    const int lo=min(max(r0-4,0),120), hi_=min(max(r0-1,0),120)+7; int nt=hi_-lo+1; nt+=nt&1;
    const long row0=(long)b*SEQ;
    __attribute__((address_space(3))) float* tb=(__attribute__((address_space(3))) float*)((__attribute__((address_space(3))) char*)lds+LDS_TB);
    if(tid<15*31) tb[tid]=rpb[h*15*31+tid]*1.4426950408889634f;
    attn_unit<1,1024,THRL>(proj+(row0+r0*64)*QP+1536+h*64, proj+(row0+lo*64)*KP+2048+h*64, proj+(row0+lo*64)*KP+2560+h*64,
                    concat+(row0+r0*64)*1024+512+h*64, r0, lo, nt, 0.f, lds);
}
#undef SBAR
#undef WAIT_BAR
}
#define XB_TMO      128
#define XB_XCNT(j)  (256  + 64 * (j))
#define XB_XSUB(j)  (1280 + 64 * (j))
#define XB_XGEN(j)  (2304 + 64 * (j))
#define XB_TOP      3328
#define XB_TOPGEN   3392
#define XCD_BAR_WORDS 3456
#define XB_SPIN_CAP (1u << 18)

__device__ __forceinline__ unsigned xb_ld(unsigned* p)              { return __hip_atomic_load(p, __ATOMIC_RELAXED, __HIP_MEMORY_SCOPE_AGENT); }
__device__ __forceinline__ unsigned xb_add(unsigned* p, unsigned v) { return __hip_atomic_fetch_add(p, v, __ATOMIC_RELAXED, __HIP_MEMORY_SCOPE_AGENT); }
__device__ __forceinline__ unsigned xb_xcc_id() { return (unsigned)__builtin_amdgcn_s_getreg((3 << 11) | 20) & 0xFu; }
#define XB_SPIN(cond, bar) do { unsigned _sp = 0; while (cond) { __builtin_amdgcn_s_sleep(1); \
    if ((++_sp & 255u) == 0u) { if (xb_ld(&(bar)[XB_TMO])) break; if (_sp > XB_SPIN_CAP) { atomicAdd(&(bar)[XB_TMO], 1u); break; } } } } while (0)

struct XcdBarrier {
    unsigned* bar; unsigned x;
    volatile LAS unsigned* st;
};

__device__ __forceinline__ XcdBarrier xcd_barrier_post(unsigned* bar, volatile LAS unsigned* st) {
    XcdBarrier b; b.bar = bar; b.x = xb_xcc_id(); b.st = st;
    if (threadIdx.x == 0) (void)xb_add(&bar[XB_XCNT(b.x)], 1u);
    return b;
}
__device__ __forceinline__ void xcd_barrier_complete(unsigned* bar, unsigned x, unsigned& nloc, unsigned& nx) {
    const unsigned G = gridDim.x * gridDim.y * gridDim.z;
    unsigned sum, cnt, mine, sp = 0u;
    for (;;) {
        sum = 0u; cnt = 0u; mine = 0u;
#pragma unroll
        for (unsigned j = 0; j < 16; ++j) { const unsigned c = xb_ld(&bar[XB_XCNT(j)]); sum += c; cnt += (c > 0u) ? 1u : 0u; mine = (j == x) ? c : mine; }
        if (sum == G) break;
        __builtin_amdgcn_s_sleep(1);
        if ((++sp & 255u) == 0u) { if (xb_ld(&bar[XB_TMO])) break; if (sp > XB_SPIN_CAP) { atomicAdd(&bar[XB_TMO], 1u); break; } }
    }
    nloc = mine > 0u ? mine : 1u; nx = cnt > 0u ? cnt : 1u;
}

__device__ __forceinline__ void xcd_barrier(const XcdBarrier& b) {
    asm volatile("s_waitcnt vmcnt(0)" ::: "memory");
    __syncthreads();
    if (threadIdx.x == 0) {
        unsigned* bar = b.bar;
        __builtin_amdgcn_s_waitcnt(0);
        unsigned nloc = b.st[0], nx = b.st[1];
        if (nloc == 0u) { xcd_barrier_complete(bar, b.x, nloc, nx); b.st[0] = nloc; b.st[1] = nx; }
        const unsigned old = xb_add(&bar[XB_XSUB(b.x)], 1u);
        const unsigned gen = old / nloc;
        if (old + 1u == (gen + 1u) * nloc) {
            __builtin_amdgcn_fence(__ATOMIC_RELEASE, "agent");
            asm volatile("s_waitcnt vmcnt(0)" ::: "memory");
            const unsigned og = xb_add(&bar[XB_TOP], 1u);
            const unsigned tg = og / nx;
            if (og + 1u == (tg + 1u) * nx) xb_add(&bar[XB_TOPGEN], 1u);
            else XB_SPIN(xb_ld(&bar[XB_TOPGEN]) == tg, bar);
            __builtin_amdgcn_fence(__ATOMIC_ACQUIRE, "agent");
            xb_add(&bar[XB_XGEN(b.x)], 1u);
            asm volatile("s_waitcnt vmcnt(0)" ::: "memory");
        } else {
            XB_SPIN(xb_ld(&bar[XB_XGEN(b.x)]) == gen, bar);
            __builtin_amdgcn_fence(__ATOMIC_ACQUIRE, "agent");
            asm volatile("s_waitcnt vmcnt(0)" ::: "memory");
        }
    }
    __syncthreads();
}
template <int CTRL> __device__ __forceinline__ float dpp_mov(float v) { return __builtin_bit_cast(float, __builtin_amdgcn_update_dpp(0, __builtin_bit_cast(int, v), CTRL, 0xF, 0xF, true)); }
__device__ __forceinline__ float wave_sum(float v) {
    v += dpp_mov<0xB1>(v); v += dpp_mov<0x4E>(v); v += dpp_mov<0x141>(v); v += dpp_mov<0x140>(v);
    { auto r = __builtin_amdgcn_permlane16_swap(__float_as_uint(v), __float_as_uint(v), false, false); v = __uint_as_float(r[0]) + __uint_as_float(r[1]); }
    { auto r = __builtin_amdgcn_permlane32_swap(__float_as_uint(v), __float_as_uint(v), false, false); v = __uint_as_float(r[0]) + __uint_as_float(r[1]); }
    return v;
}
__device__ __forceinline__ void p0_transpose_item(const float* W, int K, int N, bf16* WT, int row_off, LAS float* scr, int item, int lane) {
    const int nblk = N / 32, kb = item / nblk, nb = item % nblk, k0 = 64 * kb, n0 = 32 * nb;
#pragma unroll 8
    for (int i = 0; i < 32; ++i) { const int kk = 2 * i + (lane >> 5); scr[kk * 33 + (lane & 31)] = W[(size_t)(k0 + kk) * N + n0 + (lane & 31)]; }
    LDS_WAIT(); asm volatile("" ::: "memory");
    const int c = lane & 7;
#pragma unroll
    for (int j = 0; j < 4; ++j) { const int n = (lane >> 3) + 8 * j; const LAS float* s = scr + (8 * c) * 33 + n;
        v4u o; o.x = pk2(s[0 * 33], s[1 * 33]); o.y = pk2(s[2 * 33], s[3 * 33]); o.z = pk2(s[4 * 33], s[5 * 33]); o.w = pk2(s[6 * 33], s[7 * 33]);
        *(GAS v4u*)(WT + (size_t)(row_off + n0 + n) * K + k0 + 8 * c) = o; }
    LDS_WAIT(); asm volatile("" ::: "memory");
}
__device__ __forceinline__ unsigned pk4_fp8(float a, float b, float c, float d) {
    int w = 0; w = __builtin_amdgcn_cvt_pk_fp8_f32(__builtin_amdgcn_fmed3f(a, -448.f, 448.f), __builtin_amdgcn_fmed3f(b, -448.f, 448.f), w, false);
    w = __builtin_amdgcn_cvt_pk_fp8_f32(__builtin_amdgcn_fmed3f(c, -448.f, 448.f), __builtin_amdgcn_fmed3f(d, -448.f, 448.f), w, true); return (unsigned)w;
}
__device__ __forceinline__ void p0_transpose_item_f8(const float* W, int K, int N, unsigned char* WT, int row_off, LAS float* scr, int item, int lane, float SC) {
    const int nblk = N / 32, kb = item / nblk, nb = item % nblk, k0 = 64 * kb, n0 = 32 * nb;
#pragma unroll 8
    for (int i = 0; i < 32; ++i) { const int kk = 2 * i + (lane >> 5); scr[kk * 33 + (lane & 31)] = W[(size_t)(k0 + kk) * N + n0 + (lane & 31)]; }
    LDS_WAIT(); asm volatile("" ::: "memory");
    const int c = lane & 3;
#pragma unroll
    for (int j = 0; j < 2; ++j) { const int n = (lane >> 2) + 16 * j; const LAS float* s = scr + (16 * c) * 33 + n;
        v4u o; o.x = pk4_fp8(s[0 * 33] * SC, s[1 * 33] * SC, s[2 * 33] * SC, s[3 * 33] * SC); o.y = pk4_fp8(s[4 * 33] * SC, s[5 * 33] * SC, s[6 * 33] * SC, s[7 * 33] * SC);
        o.z = pk4_fp8(s[8 * 33] * SC, s[9 * 33] * SC, s[10 * 33] * SC, s[11 * 33] * SC); o.w = pk4_fp8(s[12 * 33] * SC, s[13 * 33] * SC, s[14 * 33] * SC, s[15 * 33] * SC);
        *(GAS v4u*)(WT + (size_t)(row_off + n0 + n) * K + k0 + 16 * c) = o; }
    LDS_WAIT(); asm volatile("" ::: "memory");
}
struct ConvItem { const float* W; unsigned char* WT; int N, row_off, k0, n0; };
__device__ __forceinline__ ConvItem conv_decode(int r, const float* w1, const float* w2, unsigned char* w1t, unsigned char* w2t) {
    ConvItem c; constexpr int I_W1 = 16 * 64, I_W2 = 16 * 32;
    if (r < NE * I_W1) { const int e = r / I_W1, it = r % I_W1; c.W = w1 + (size_t)e * D * 2048; c.WT = w1t; c.N = 2048; c.row_off = e * 2048; c.k0 = 64 * (it / 64); c.n0 = 32 * (it % 64); }
    else { r -= NE * I_W1; const int e = r / I_W2, it = r % I_W2; c.W = w2 + (size_t)e * FF * D; c.WT = w2t; c.N = 1024; c.row_off = e * 1024; c.k0 = 64 * (it / 32); c.n0 = 32 * (it % 32); }
    return c;
}
__device__ __forceinline__ void conv_load(const ConvItem& c, f32x4 (&buf)[8], int lane) {
#pragma unroll
    for (int i = 0; i < 8; ++i) buf[i] = *(const GAS f32x4*)(c.W + (size_t)(c.k0 + i * 8 + (lane >> 3)) * c.N + c.n0 + (lane & 7) * 4);
}
__device__ __forceinline__ void conv_store(const ConvItem& c, const f32x4 (&buf)[8], LAS float* scr, int lane, float SC) {
#pragma unroll
    for (int i = 0; i < 8; ++i) { LAS float* p = scr + (i * 8 + (lane >> 3)) * 33 + (lane & 7) * 4; p[0] = buf[i].x; p[1] = buf[i].y; p[2] = buf[i].z; p[3] = buf[i].w; }
    LDS_WAIT(); asm volatile("" ::: "memory");
    const int cc = lane & 3;
#pragma unroll
    for (int j = 0; j < 2; ++j) { const int n = (lane >> 2) + 16 * j; const LAS float* s = scr + (16 * cc) * 33 + n;
        v4u o; o.x = pk4_fp8(s[0 * 33] * SC, s[1 * 33] * SC, s[2 * 33] * SC, s[3 * 33] * SC); o.y = pk4_fp8(s[4 * 33] * SC, s[5 * 33] * SC, s[6 * 33] * SC, s[7 * 33] * SC);
        o.z = pk4_fp8(s[8 * 33] * SC, s[9 * 33] * SC, s[10 * 33] * SC, s[11 * 33] * SC); o.w = pk4_fp8(s[12 * 33] * SC, s[13 * 33] * SC, s[14 * 33] * SC, s[15 * 33] * SC);
        *(GAS v4u*)(c.WT + (size_t)(c.row_off + c.n0 + n) * 1024 + c.k0 + 16 * cc) = o; }
    LDS_WAIT(); asm volatile("" ::: "memory");
}
__device__ __forceinline__ void conv_dma(const ConvItem& c, unsigned lds_dst, int lane) {
    const float* src = c.W + (size_t)(c.k0 + (lane >> 3)) * c.N + c.n0 + (lane & 7) * 4;
#pragma unroll
    for (int i = 0; i < 8; ++i) { unsigned keep;
        asm volatile("s_mov_b32 %0, m0\n\ts_mov_b32 m0, %2\n\ts_nop 0\n\tglobal_load_lds_dwordx4 %1, off nt\n\ts_mov_b32 m0, %0" : "=&s"(keep) : "v"(src + (size_t)i * 8 * c.N), "s"(lds_dst + i * 1024) : "memory"); }
}
__device__ __forceinline__ void conv_emit(const ConvItem& c, const LAS float* buf, int lane, float SC) {
    const int cc = lane & 3;
#pragma unroll
    for (int j = 0; j < 2; ++j) { const int n = (lane >> 2) + 16 * j; const LAS float* s = buf + (16 * cc) * 32 + n;
        v4u o; o.x = pk4_fp8(s[0 * 32] * SC, s[1 * 32] * SC, s[2 * 32] * SC, s[3 * 32] * SC); o.y = pk4_fp8(s[4 * 32] * SC, s[5 * 32] * SC, s[6 * 32] * SC, s[7 * 32] * SC);
        o.z = pk4_fp8(s[8 * 32] * SC, s[9 * 32] * SC, s[10 * 32] * SC, s[11 * 32] * SC); o.w = pk4_fp8(s[12 * 32] * SC, s[13 * 32] * SC, s[14 * 32] * SC, s[15 * 32] * SC);
        __builtin_nontemporal_store(o, (GAS v4u*)(c.WT + (size_t)(c.row_off + c.n0 + n) * 1024 + c.k0 + 16 * cc)); }
    LDS_WAIT(); asm volatile("" ::: "memory");
}
struct Params { const float* in[22]; float* out; unsigned char* ws; };

__device__ __forceinline__ float mod_val(const float* __restrict__ modp, const float* __restrict__ b_ada, int b, int j) {
    return b_ada[j] + ((modp[(0 * 2 + b) * 6144 + j] + modp[(1 * 2 + b) * 6144 + j]) + (modp[(2 * 2 + b) * 6144 + j] + modp[(3 * 2 + b) * 6144 + j]));
}

__device__ __forceinline__ int opaque_v(int i) { asm volatile("" : "+v"(i)); return i; }
__device__ __forceinline__ int opaque_i(int i) { asm volatile("" : "+s"(i)); return i; }
__device__ __forceinline__ unsigned char* launder_ws(unsigned char* p) { GAS unsigned char* g = (GAS unsigned char*)p; asm volatile("" : "+s"(g)); return (unsigned char*)g; }
#if PROBE_K >= 0
#define GSTAMP(k) do { if (threadIdx.x == 0) atomicMax((unsigned*)((gu32*)(P.ws + WS_CTL) + CW_GST + (k)), (unsigned)__builtin_amdgcn_s_memrealtime()); } while (0)
#define STAMP(k) do { if (blockIdx.x == 0 && threadIdx.x == 0) ((volatile LAS unsigned long long*)(lds + LDSCTL_OFF + 512))[k] = __builtin_amdgcn_s_memrealtime(); } while (0)
#define ARRIVE(k) do { if (threadIdx.x == 0) { const unsigned d_ = (unsigned)(__builtin_amdgcn_s_memrealtime() - ((volatile LAS unsigned long long*)(lds + LDSCTL_OFF + 512))[15]); atomicAdd((unsigned*)((gu32*)(P.ws + WS_CTL) + CW_GST + 2 * (k)), d_); atomicMax((unsigned*)((gu32*)(P.ws + WS_CTL) + CW_GST + 2 * (k) + 1), d_); } } while (0)
#define PROBE_END() do { if (blockIdx.x == 0 && threadIdx.x == 0) { volatile LAS unsigned long long* st_ = (volatile LAS unsigned long long*)(lds + LDSCTL_OFF + 512); const unsigned long long dl_ = (PROBE_K >= 300) ? (unsigned long long)(__hip_atomic_load((unsigned*)((gu32*)(P.ws + WS_CTL) + CW_GST + 2 * (PROBE_K % 100) + 1), __ATOMIC_RELAXED, __HIP_MEMORY_SCOPE_AGENT) - __hip_atomic_load((unsigned*)((gu32*)(P.ws + WS_CTL) + CW_GST + 2 * (PROBE_K % 100)), __ATOMIC_RELAXED, __HIP_MEMORY_SCOPE_AGENT) / gridDim.x) : (PROBE_K >= 100) ? (unsigned long long)(__hip_atomic_load((unsigned*)((gu32*)(P.ws + WS_CTL) + CW_GST + (PROBE_K % 100)), __ATOMIC_RELAXED, __HIP_MEMORY_SCOPE_AGENT) - (unsigned)st_[0]) : st_[PROBE_K % 100] - st_[0]; \
        const unsigned long long te_ = __builtin_amdgcn_s_memrealtime() + dl_; while (__builtin_amdgcn_s_memrealtime() < te_) __builtin_amdgcn_s_sleep(8); } } while (0)
#else
#define STAMP(k) do {} while (0)
#define GSTAMP(k) do {} while (0)
#define PROBE_END() do {} while (0)
#define ARRIVE(k) do {} while (0)
#endif
__global__ void __launch_bounds__(NTHR, 2) mk_fwd(Params P) {
    extern __shared__ __attribute__((aligned(16))) unsigned char lds_raw[];
    LAS unsigned char* lds = (LAS unsigned char*)lds_raw;
    const int tid0 = threadIdx.x;
#define PH_TID const int tid = opaque_v(tid0), lane = tid & 63, wave = __builtin_amdgcn_readfirstlane(tid >> 6); const int bx = opaque_i((int)blockIdx.x), G = (int)gridDim.x, \
        vcu = (G % 8 == 0) ? (bx % 8) * (G / 8) + bx / 8 : bx, gw = vcu * NWAVES + wave, NGW = G * NWAVES; (void)lane; (void)gw; (void)NGW; (void)vcu; (void)bx
    unsigned char* const ws0 = P.ws;
#define WSP(name, type, off) type* name = (type*)(launder_ws(ws0) + (off))
#define INP(name, i) const float* name = (const float*)(const GAS float*)P.in[opaque_i(i)]
    LAS int* tab = (LAS int*)(lds + TAB_OFF);

    for (int u = tid0; u < (LDS_BYTES - LDSCTL_OFF) / 4; u += NTHR) ((LAS unsigned*)(lds + LDSCTL_OFF))[u] = 0u;
    __syncthreads();
    STAMP(0);
#if PROBE_K >= 0
    if (threadIdx.x == 0) ((volatile LAS unsigned long long*)(lds + LDSCTL_OFF + 512))[15] = __builtin_amdgcn_s_memrealtime();
#endif
    (void)xcd_barrier_post((unsigned*)((gu32*)(ws0 + WS_CTL) + CW_BAR), (volatile LAS unsigned*)(lds + MISC_OFF) + 8);
#define GRID_BARRIER() do { XcdBarrier b_; b_.bar = (unsigned*)((gu32*)(launder_ws(ws0) + WS_CTL) + CW_BAR); b_.x = xb_xcc_id(); b_.st = (volatile LAS unsigned*)(lds + MISC_OFF) + 8; xcd_barrier(b_); } while (0)

    if ((int)blockIdx.x < 192) {
        PH_TID;
        INP(cvec, 1); INP(w_ada, 2); WSP(modp, float, WS_MODP);
        LAS float* sl = (LAS float*)lds; LAS float* red = sl + 512;
        for (int it = bx; it < 192; it += G) {
            const int cc = it % 48, kq = it / 48, cl = tid & 127, ks = tid >> 7;
            { const float c0 = cvec[(tid >> 8) * 1024 + kq * 256 + (tid & 255)]; sl[tid] = c0 / (1.f + __expf(-c0)); }
            __syncthreads();
            float a0 = 0.f, a1 = 0.f; const float* wp = w_ada + (size_t)(kq * 256 + ks * 64) * 6144 + cc * 128 + cl;
#pragma unroll 8
            for (int kk = 0; kk < 64; ++kk) { const float w = wp[(size_t)kk * 6144]; a0 += sl[ks * 64 + kk] * w; a1 += sl[256 + ks * 64 + kk] * w; }
            red[(ks * 2 + 0) * 128 + cl] = a0; red[(ks * 2 + 1) * 128 + cl] = a1;
            __syncthreads();
            if (tid < 256) { const int b = tid >> 7; const float v = (red[(0 * 2 + b) * 128 + cl] + red[(1 * 2 + b) * 128 + cl]) + (red[(2 * 2 + b) * 128 + cl] + red[(3 * 2 + b) * 128 + cl]);
                modp[(kq * 2 + b) * 6144 + cc * 128 + cl] = v; }
            __syncthreads();
        }
    }
    for (int rep_ = 0; rep_ <= DUP_P0; ++rep_) {
        PH_TID;
        LAS float* scr = (LAS float*)(lds + RING_OFF + wave * 16384);
        INP(w_in, 6); INP(w_out, 7); WSP(win_t, bf16, WS_WIN); WSP(wout_t, bf16, WS_WOUT);
        constexpr int I_IN = 16 * 96, I_OUT = 16 * 32;
        for (int it = gw; it < I_IN + I_OUT; it += NGW) {
            if (it < I_IN) p0_transpose_item(w_in, D, NPROJ, win_t, 0, scr, it, lane); else p0_transpose_item(w_out, D, D, wout_t, 0, scr, it - I_IN, lane);
        }
    }
    ARRIVE(1); GRID_BARRIER(); STAMP(1);

    for (int xb_ = 0; xb_ < DUP_BAR; ++xb_) GRID_BARRIER();
    for (int rep_ = 0; rep_ <= DUP_P1; ++rep_) {
        LAS float* mv = (LAS float*)lds;
        PH_TID;
        INP(x, 0); INP(b_ada, 3); INP(g_pre_mix, 4); WSP(modp, float, WS_MODP); WSP(xn, bf16, WS_XN);
        f32x4 gpm[4];
#pragma unroll
        for (int i = 0; i < 4; ++i) gpm[i] = *(const f32x4*)(g_pre_mix + i * 256 + lane * 4);
        f32x4 nv[4];
#pragma unroll
        for (int i = 0; i < 4; ++i) nv[i] = *(const f32x4*)(x + (size_t)gw * D + i * 256 + lane * 4);
        for (int i = tid; i < 4096; i += NTHR) mv[i] = mod_val(modp, b_ada, i >> 11, i & 2047);
        { WSP(modd, float, WS_MOD); for (int i = vcu * NTHR + tid; i < 2 * 6144; i += G * NTHR) modd[i] = mod_val(modp, b_ada, i / 6144, i % 6144); }
        __syncthreads();
        for (int row = gw; row < M; row += NGW) {
            const int b = row / SEQ; const LAS float* sh = mv + b * 2048; const LAS float* sc = sh + 1024;
            f32x4 v[4]; float ss = 0.f;
#pragma unroll
            for (int i = 0; i < 4; ++i) { v[i] = nv[i]; ss += v[i].x * v[i].x + v[i].y * v[i].y + v[i].z * v[i].z + v[i].w * v[i].w; }
            { const int nrow = (row + NGW < M) ? row + NGW : row;
#pragma unroll
              for (int i = 0; i < 4; ++i) nv[i] = *(const f32x4*)(x + (size_t)nrow * D + i * 256 + lane * 4); }
            const float rstd = rsqrtf(wave_sum(ss) * (1.f / D) + RMS_EPS);
#pragma unroll
            for (int i = 0; i < 4; ++i) { const int c0 = i * 256 + lane * 4; float o[4];
#pragma unroll
                for (int e = 0; e < 4; ++e) o[e] = v[i][e] * rstd * gpm[i][e] * (1.f + sc[c0 + e]) + sh[c0 + e];
                uint2 w; w.x = pk2(o[0], o[1]); w.y = pk2(o[2], o[3]); *(uint2*)(xn + (size_t)row * D + c0) = w; }
        }
        __syncthreads();
    }
    ARRIVE(2); GRID_BARRIER(); STAMP(2);

    for (int rep_ = 0; rep_ <= DUP_P2; ++rep_) {
        PH_TID; WSP(xn, bf16, WS_XN); WSP(win_t, bf16, WS_WIN); WSP(proj, bf16, WS_PROJ);
        pg8::Gemm g{xn, win_t, M, NPROJ, D}; pg8::StaticOrder S; S.init(M, NPROJ, G, bx);
        WSP(kimg, bf16, WS_KIMG); WSP(vimg, bf16, WS_VIMG);
        pg8::EpiStoreBf16 E{proj, NPROJ, 512, attn_body::C2, 1536, 2048, (unsigned*)((gu32*)(launder_ws(ws0) + WS_CTL) + CW_NRM), kimg, vimg};
        pg8::gemm_phase<pg8::EpiStoreBf16, pg8::StaticOrder, true, true>(lds + RING_OFF, g, S, E);
    }
    ARRIVE(3); GRID_BARRIER(); STAMP(3);

    for (int rep3_ = 0; rep3_ <= DUP_P3; ++rep3_) {
        constexpr int NCHK = NE * (16 * 64 + 16 * 32) / 64; constexpr unsigned CONV_LIMIT = 80; constexpr int NCV = 12;
        bool first = true;
        for (;;) {
            { PH_TID; gu32* ctl = (gu32*)(launder_ws(ws0) + WS_CTL); volatile LAS unsigned* qw = (volatile LAS unsigned*)(lds + LDSCTL_OFF + 8192);
              if (tid == 0) { unsigned kind = 3u, id = 0u, held = 0u;
                  const bool g256 = (G == 256); const int xg = bx & 7, jg = bx >> 3; const bool convcu = g256 && xg >= 4 && jg >= 32 - NCV;
                  if (first) { qw[4] = 0u; qw[5] = 0u; qw[6] = 0u; if (convcu) __hip_atomic_fetch_add((unsigned*)(ctl + CW_CONVACT), 1u, __ATOMIC_RELAXED, __HIP_MEMORY_SCOPE_AGENT); }
                  if (first && g256 && !convcu) { kind = 0u; id = (unsigned)((xg << 5) | (xg < 4 ? jg : NCV / 2 + jg)); }
                  else {
                      if (convcu && !qw[5]) { id = __hip_atomic_fetch_add((unsigned*)(ctl + CW_CONVQ) + 64 * rep3_, 1u, __ATOMIC_RELAXED, __HIP_MEMORY_SCOPE_AGENT); if (id < (unsigned)NCHK) kind = 1u; else qw[5] = 1u; }
                      if (kind == 3u && !qw[4]) { const unsigned q = __hip_atomic_fetch_add((unsigned*)(ctl + CW_ATTQ) + 64 * rep3_, 1u, __ATOMIC_RELAXED, __HIP_MEMORY_SCOPE_AGENT);
                          if (!g256) id = q; else if (q < 4u * NCV) { const unsigned k = q >> 2; id = 128u + ((q & 3u) << 5) + ((k & 1u) ? (32u - NCV / 2) + (k >> 1) : (NCV / 2 - 1u) - (k >> 1)); } else id = (256u - 4u * NCV) + q;
                          if (id < 512u) kind = 0u; else qw[4] = 1u; }
                      if (kind == 3u && !qw[5]) { bool take = qw[6] != 0u;
                          if (!take) { const unsigned old = __hip_atomic_fetch_add((unsigned*)(ctl + CW_CONVACT), 1u, __ATOMIC_RELAXED, __HIP_MEMORY_SCOPE_AGENT);
                              if (old < CONV_LIMIT) { take = true; held = 1u; } else __hip_atomic_fetch_sub((unsigned*)(ctl + CW_CONVACT), 1u, __ATOMIC_RELAXED, __HIP_MEMORY_SCOPE_AGENT); }
                          if (take) { id = __hip_atomic_fetch_add((unsigned*)(ctl + CW_CONVQ) + 64 * rep3_, 1u, __ATOMIC_RELAXED, __HIP_MEMORY_SCOPE_AGENT);
                              if (id < (unsigned)NCHK) kind = 1u; else { qw[5] = 1u; if (held) { __hip_atomic_fetch_sub((unsigned*)(ctl + CW_CONVACT), 1u, __ATOMIC_RELAXED, __HIP_MEMORY_SCOPE_AGENT); held = 0u; } } } }
                      if (kind == 3u && !qw[6]) { id = __hip_atomic_fetch_add((unsigned*)(ctl + CW_NATQ) + 64 * rep3_, 1u, __ATOMIC_RELAXED, __HIP_MEMORY_SCOPE_AGENT); if (id < 512u) kind = 2u; else qw[6] = 1u; }
                      if (kind == 3u && !qw[5]) { id = __hip_atomic_fetch_add((unsigned*)(ctl + CW_CONVQ) + 64 * rep3_, 1u, __ATOMIC_RELAXED, __HIP_MEMORY_SCOPE_AGENT); if (id < (unsigned)NCHK) kind = 1u; else qw[5] = 1u; }
                  }
                  qw[0] = kind; qw[1] = id; qw[2] = held; }
              __syncthreads(); }
            first = false;
            const int kind = (int)__builtin_amdgcn_readfirstlane(((volatile LAS unsigned*)(lds + LDSCTL_OFF + 8192))[0]);
            if (kind == 3) break;
            if (kind == 0) { const int ua = (int)__builtin_amdgcn_readfirstlane(((volatile LAS unsigned*)(lds + LDSCTL_OFF + 8192))[1]);
                WSP(proj, bf16, WS_PROJ); WSP(od, bf16, WS_ODIFF); WSP(kimg, bf16, WS_KIMG); WSP(vimg, bf16, WS_VIMG); gu32* ctl = (gu32*)(launder_ws(ws0) + WS_CTL);
                attn_body::attn_one<8>(ua, (char*)lds_raw, (const attn_body::bf16*)proj, (const attn_body::bf16*)kimg, (const attn_body::bf16*)vimg, (attn_body::bf16*)od, (const unsigned*)(ctl + CW_NRM), (unsigned*)(ctl + CW_DONE)); }
            else if (kind == 1) { PH_TID; volatile LAS unsigned* qw = (volatile LAS unsigned*)(lds + LDSCTL_OFF + 8192); const int chk = (int)__builtin_amdgcn_readfirstlane(qw[1]);
                INP(w1, 18); INP(w2, 20); WSP(w1_t, bf16, WS_W1T); WSP(w2_t, bf16, WS_W2T);
                LAS float* scr = (LAS float*)(lds + RING_OFF + wave * 16384);
                const unsigned sb_ = (unsigned)__builtin_amdgcn_readfirstlane((unsigned)(uintptr_t)scr);
                ConvItem ci = conv_decode(chk * 64 + wave, w1, w2, (unsigned char*)w1_t, (unsigned char*)w2_t); conv_dma(ci, sb_, lane);
                for (int i8 = 0; i8 < 8; ++i8) { ConvItem ni = ci;
                    if (i8 < 7) { ni = conv_decode(chk * 64 + (i8 + 1) * 8 + wave, w1, w2, (unsigned char*)w1_t, (unsigned char*)w2_t); conv_dma(ni, sb_ + ((i8 + 1) & 1) * 8192, lane);
                        asm volatile("s_waitcnt vmcnt(8)" ::: "memory"); } else { asm volatile("s_waitcnt vmcnt(0)" ::: "memory"); }
                    conv_emit(ci, scr + (i8 & 1) * 2048, lane, 64.f); ci = ni; }
                if (tid == 0 && qw[2]) { gu32* ctl = (gu32*)(launder_ws(ws0) + WS_CTL); __hip_atomic_fetch_sub((unsigned*)(ctl + CW_CONVACT), 1u, __ATOMIC_RELAXED, __HIP_MEMORY_SCOPE_AGENT); } }
            else { const int nu = (int)__builtin_amdgcn_readfirstlane(((volatile LAS unsigned*)(lds + LDSCTL_OFF + 8192))[1]);
                INP(rpb, 13); WSP(proj, bf16, WS_PROJ); WSP(concat, bf16, WS_CONCAT);
                attn_body::nat_one<8>(nu, (char*)lds_raw, (const attn_body::bf16*)proj, (attn_body::bf16*)concat, rpb); }
            __syncthreads();
        }
    {
        PH_TID;
        INP(lq1, 8); INP(lk1, 9); INP(lq2, 10); INP(lk2, 11); INP(g_sub, 12); WSP(od, bf16, WS_ODIFF); WSP(concat, bf16, WS_CONCAT); gu32* ctl = (gu32*)(launder_ws(ws0) + WS_CTL);
        volatile LAS unsigned* qw = (volatile LAS unsigned*)(lds + LDSCTL_OFF + 8192 + 64);
        float s1 = 0.f, s2 = 0.f;
        for (int i = 0; i < 64; ++i) { s1 += lq1[i] * lk1[i]; s2 += lq2[i] * lk2[i]; }
        const float lam_init = 0.2f, lam = __expf(s1) - __expf(s2) + lam_init;
        const int c0 = lane * 8;
        const f32x4 gs0 = *(const f32x4*)(g_sub + (c0 & 127)), gs1 = *(const f32x4*)(g_sub + (c0 & 127) + 4);
        for (;;) {
            if (tid == 0) qw[0] = __hip_atomic_fetch_add((unsigned*)(ctl + CW_CMBQ) + 64 * rep3_, 1u, __ATOMIC_RELAXED, __HIP_MEMORY_SCOPE_AGENT);
            __syncthreads(); const int u = (int)__builtin_amdgcn_readfirstlane(qw[0]); __syncthreads();
            if (u >= 64) break;
            if (tid == 0) { unsigned sp = 0; while (__hip_atomic_load((unsigned*)(ctl + CW_DONE) + u * 64, __ATOMIC_RELAXED, __HIP_MEMORY_SCOPE_AGENT) < 8u) { __builtin_amdgcn_s_sleep(2); if (++sp > (1u << 22)) break; }
                __builtin_amdgcn_fence(__ATOMIC_ACQUIRE, "agent"); asm volatile("s_waitcnt vmcnt(0)" ::: "memory"); }
            __syncthreads();
            const int rbase = u * 256 + wave * 32;
            v4u na = *(const v4u*)(od + (size_t)rbase * 512 + c0), nb = *(const v4u*)(od + ((size_t)M + rbase) * 512 + c0);
            for (int i = 0; i < 32; ++i) { const int row = rbase + i; const v4u a = na, bq = nb;
                { const int nrow = (i < 31) ? row + 1 : row; na = *(const v4u*)(od + (size_t)nrow * 512 + c0); nb = *(const v4u*)(od + ((size_t)M + nrow) * 512 + c0); }
                float v[8]; float ss = 0.f;
#pragma unroll
                for (int e = 0; e < 4; ++e) { v[2 * e] = __uint_as_float(a[e] << 16) - lam * __uint_as_float(bq[e] << 16); v[2 * e + 1] = __uint_as_float(a[e] & 0xffff0000u) - lam * __uint_as_float(bq[e] & 0xffff0000u); }
#pragma unroll
                for (int e = 0; e < 8; ++e) ss += v[e] * v[e];
                ss += __shfl_xor(ss, 1); ss += __shfl_xor(ss, 2); ss += __shfl_xor(ss, 4); ss += __shfl_xor(ss, 8);
                const float rstd = rsqrtf(ss * (1.f / 128.f) + RMS_EPS); v4u w;
#pragma unroll
                for (int e = 0; e < 4; ++e) w[e] = pk2(v[2 * e] * rstd * (e < 2 ? gs0[2 * e] : gs1[2 * e - 4]) * (1.f - lam_init), v[2 * e + 1] * rstd * (e < 2 ? gs0[2 * e + 1] : gs1[2 * e - 3]) * (1.f - lam_init));
                *(v4u*)(concat + (size_t)row * D + c0) = w; }
        }
    }
    }
    ARRIVE(4); GRID_BARRIER(); STAMP(4);

    for (int rep_ = 0; rep_ <= DUP_P5; ++rep_) {
        PH_TID; WSP(concat, bf16, WS_CONCAT); WSP(wout_t, bf16, WS_WOUT); WSP(mix, bf16, WS_MIX);
        pg8::Gemm g{concat, wout_t, M, D, D}; pg8::StaticOrder S; S.init(M, D, G, bx);
        pg8::EpiStoreBf16 E{mix, D, 0, 1.f, 0, 0, nullptr, nullptr, nullptr};
        pg8::gemm_phase<pg8::EpiStoreBf16, pg8::StaticOrder, true, true>(lds + RING_OFF, g, S, E);
    }
    ARRIVE(5); GRID_BARRIER(); STAMP(5);

    for (int rep_ = 0; rep_ <= DUP_P6; ++rep_) {
        PH_TID;
        INP(x, 0); INP(g_post_mix, 5); INP(g_pre_ffn, 14); INP(w_router, 16); INP(b_router, 17);
        WSP(modd, float, WS_MOD); WSP(mix, bf16, WS_MIX); WSP(x1, bf16, WS_X1); WSP(h2, bf16, WS_H2); WSP(topi, int, WS_TOPI); WSP(gate, float, WS_GATE); WSP(hist, int, WS_HIST);
        LAS float* wt = (LAS float*)lds;
        LAS int* ltop = (LAS int*)(lds + LDSCTL_OFF + 4096);
        for (int i = tid; i < 8192; i += NTHR) { const int k = (i & 31) + 32 * (i >> 8), e0 = ((i >> 5) & 7) * 4; const f32x4 w = *(const f32x4*)(w_router + (size_t)k * 32 + e0);
            wt[(e0 + 0) * 1024 + k] = w.x; wt[(e0 + 1) * 1024 + k] = w.y; wt[(e0 + 2) * 1024 + k] = w.z; wt[(e0 + 3) * 1024 + k] = w.w; }
        __syncthreads();
        const int my_e = (lane >> 1) & 31; const float my_b = b_router[my_e];
        for (int ch = bx; ch < NCHUNK; ch += G) {
            LAS float* cst = (LAS float*)(lds + LDSCTL_OFF + 10240);
            { const float* mb = modd + ((ch * 64) / SEQ) * 6144;
              for (int i = tid; i < 1024; i += NTHR) { cst[i] = mb[2048 + i] * g_post_mix[i]; cst[1024 + i] = g_pre_ffn[i] * (1.f + mb[4096 + i]); cst[2048 + i] = mb[3072 + i]; }
              __syncthreads(); }
            uint2 nmv[4]; f32x4 nxv[4];
#pragma unroll
            for (int i = 0; i < 4; ++i) { nmv[i] = *(const uint2*)(mix + (size_t)(ch * 64 + wave * 8) * D + i * 256 + lane * 4); nxv[i] = *(const f32x4*)(x + (size_t)(ch * 64 + wave * 8) * D + i * 256 + lane * 4); }
            for (int i8 = 0; i8 < 8; ++i8) {
                const int row = ch * 64 + wave * 8 + i8, b = row / SEQ;
                f32x4 mvv[4], xv[4]; float ss = 0.f;
#pragma unroll
                for (int i = 0; i < 4; ++i) { mvv[i] = (f32x4){__uint_as_float(nmv[i].x << 16), __uint_as_float(nmv[i].x & 0xffff0000u), __uint_as_float(nmv[i].y << 16), __uint_as_float(nmv[i].y & 0xffff0000u)}; xv[i] = nxv[i];
                    ss += mvv[i].x * mvv[i].x + mvv[i].y * mvv[i].y + mvv[i].z * mvv[i].z + mvv[i].w * mvv[i].w; }
                { const int nrow = (i8 < 7) ? row + 1 : row;
#pragma unroll
                  for (int i = 0; i < 4; ++i) { nmv[i] = *(const uint2*)(mix + (size_t)nrow * D + i * 256 + lane * 4); nxv[i] = *(const f32x4*)(x + (size_t)nrow * D + i * 256 + lane * 4); } }
                float rstd = rsqrtf(wave_sum(ss) * (1.f / D) + RMS_EPS); ss = 0.f;
#pragma unroll
                for (int i = 0; i < 4; ++i) { const int c0 = i * 256 + lane * 4; const f32x4 gg = *(const LAS f32x4*)(cst + c0);
#pragma unroll
                    for (int e = 0; e < 4; ++e) { xv[i][e] = xv[i][e] + gg[e] * (mvv[i][e] * rstd); ss += xv[i][e] * xv[i][e]; }
                    *(uint2*)(x1 + (size_t)row * D + c0) = make_uint2(pk2(xv[i][0], xv[i][1]), pk2(xv[i][2], xv[i][3])); }
                rstd = rsqrtf(wave_sum(ss) * (1.f / D) + RMS_EPS);
                float lg[32];
#pragma unroll
                for (int e = 0; e < 32; ++e) lg[e] = 0.f;
#pragma unroll
                for (int i = 0; i < 4; ++i) { const int c0 = i * 256 + lane * 4; const f32x4 gf = *(const LAS f32x4*)(cst + 1024 + c0), h2s = *(const LAS f32x4*)(cst + 2048 + c0); float hv[4];
#pragma unroll
                    for (int j = 0; j < 4; ++j) hv[j] = xv[i][j] * rstd * gf[j] + h2s[j];
                    *(unsigned*)((unsigned char*)h2 + (size_t)row * D + c0) = pk4_fp8(hv[0], hv[1], hv[2], hv[3]);
#pragma unroll
                    for (int e8 = 0; e8 < 32; e8 += 8) { f32x4 wv[8];
#pragma unroll
                        for (int j = 0; j < 8; ++j) wv[j] = *(const LAS f32x4*)(wt + (e8 + j) * 1024 + c0);
#pragma unroll
                        for (int j = 0; j < 8; ++j) lg[e8 + j] += (hv[0] * wv[j].x + hv[1] * wv[j].y) + (hv[2] * wv[j].z + hv[3] * wv[j].w); } }
                { const bool b5 = lane & 32, b4 = lane & 16, b3 = lane & 8, b2 = lane & 4, b1 = lane & 2;
#pragma unroll
                  for (int e = 0; e < 16; ++e) { const float keep = b5 ? lg[e + 16] : lg[e], send = b5 ? lg[e] : lg[e + 16]; lg[e] = keep + __shfl_xor(send, 32); }
#pragma unroll
                  for (int e = 0; e < 8; ++e) { const float keep = b4 ? lg[e + 8] : lg[e], send = b4 ? lg[e] : lg[e + 8]; lg[e] = keep + __shfl_xor(send, 16); }
#pragma unroll
                  for (int e = 0; e < 4; ++e) { const float keep = b3 ? lg[e + 4] : lg[e], send = b3 ? lg[e] : lg[e + 4]; lg[e] = keep + __shfl_xor(send, 8); }
#pragma unroll
                  for (int e = 0; e < 2; ++e) { const float keep = b2 ? lg[e + 2] : lg[e], send = b2 ? lg[e] : lg[e + 2]; lg[e] = keep + __shfl_xor(send, 4); }
                  { const float keep = b1 ? lg[1] : lg[0], send = b1 ? lg[0] : lg[1]; lg[0] = keep + __shfl_xor(send, 2); }
                  lg[0] += __shfl_xor(lg[0], 1); }
                float tv[4]; int ti[4];
                { LAS float* lgs = (LAS float*)(lds + LDSCTL_OFF + 6144) + wave * 48;
                  const float cur = lg[0] + my_b;
                  if ((lane & 1) == 0) lgs[my_e] = cur;
                  LDS_WAIT(); asm volatile("" ::: "memory");
                  int rank = 0;
#pragma unroll
                  for (int e4 = 0; e4 < 8; ++e4) { const f32x4 o = *(const LAS f32x4*)(lgs + e4 * 4);
#pragma unroll
                      for (int j = 0; j < 4; ++j) { const int oe = e4 * 4 + j; rank += ((o[j] > cur) || (o[j] == cur && oe < my_e)) ? 1 : 0; } }
                  if ((lane & 1) == 0 && rank < 4) { lgs[32 + rank] = cur; ((LAS int*)lgs)[36 + rank] = my_e; }
                  LDS_WAIT(); asm volatile("" ::: "memory");
                  const f32x4 tvv = *(const LAS f32x4*)(lgs + 32); const v4u tii = *(const LAS v4u*)(lgs + 36);
                  tv[0] = tvv.x; tv[1] = tvv.y; tv[2] = tvv.z; tv[3] = tvv.w; ti[0] = (int)tii.x; ti[1] = (int)tii.y; ti[2] = (int)tii.z; ti[3] = (int)tii.w;
                  LDS_WAIT(); asm volatile("" ::: "memory"); }
                if (lane == 0) { const float e1 = __expf(tv[1] - tv[0]), e2 = __expf(tv[2] - tv[0]), e3 = __expf(tv[3] - tv[0]); const float rs = 1.f / (1.f + e1 + e2 + e3);
                    *(int4*)(topi + row * 4) = make_int4(ti[0], ti[1], ti[2], ti[3]); *(f32x4*)(gate + row * 4) = (f32x4){rs, e1 * rs, e2 * rs, e3 * rs};
                    const int lr = (wave * 8 + i8) * 4; ltop[lr] = ti[0]; ltop[lr + 1] = ti[1]; ltop[lr + 2] = ti[2]; ltop[lr + 3] = ti[3]; }
            }
            __syncthreads();
            { LAS int* lh = (LAS int*)(lds + LDSCTL_OFF + 5632);
              if (tid < 32) lh[tid] = 0;
              __syncthreads();
              if (tid < 256) (void)__hip_atomic_fetch_add(lh + ltop[tid], 1, __ATOMIC_RELAXED, __HIP_MEMORY_SCOPE_WORKGROUP);
              __syncthreads();
              if (tid < 32) hist[ch * 32 + tid] = lh[tid]; }
            __syncthreads();
        }
    }
    ARRIVE(6); GRID_BARRIER(); STAMP(6);

    for (int rep_ = 0; rep_ <= DUP_P7; ++rep_) {
        LAS int* le = (LAS int*)(lds + 4096); LAS int* ld = (LAS int*)(lds + 8192);
        PH_TID;
        WSP(hist, int, WS_HIST); WSP(topi, int, WS_TOPI); WSP(dest, int, WS_DEST); WSP(srcm, int, WS_SRC); gu32* ctl = (gu32*)(launder_ws(ws0) + WS_CTL);
        for (int ch = bx; ch < NCHUNK; ch += G) {
            { LAS int* part = (LAS int*)(lds + 12288);
              const int e = tid & 31, pt = tid >> 5; int tot = 0, base = 0;
#pragma unroll
              for (int j = 0; j < 16; ++j) { const int c2 = pt * 16 + j; const int hv = hist[c2 * 32 + e]; tot += hv; base += (c2 < ch) ? hv : 0; }
              part[(pt * 2 + 0) * 32 + e] = tot; part[(pt * 2 + 1) * 32 + e] = base;
              if (tid < 256) le[tid] = topi[ch * 256 + tid];
              __syncthreads();
              if (tid < 32) { int t2 = 0, b2 = 0;
#pragma unroll
                  for (int p = 0; p < 16; ++p) { t2 += part[(p * 2 + 0) * 32 + tid]; b2 += part[(p * 2 + 1) * 32 + tid]; }
                  tab[32 + tid] = b2; tab[tid] = (t2 + 255) & ~255; ld[tid] = t2; } }
            __syncthreads();
            if (tid == 0) { int off = 0; for (int e = 0; e < NE; ++e) { const int pad = tab[e]; tab[e] = off;
                    if (ch == 0) for (int tl = 0; tl < pad / 256; ++tl) ctl[CW_TILEEXP + off / 256 + tl] = (unsigned)e;
                    off += pad; }
                if (ch == 0) ctl[CW_TOTAL] = (unsigned)off; }
            __syncthreads();
            if (ch == 0) { for (int e = 0; e < NE; ++e) { const int c_ = ld[e], pd_ = ((c_ + 255) & ~255) - c_; if (tid < pd_) srcm[tab[e] + c_ + tid] = 0; } }
            {
              LAS int* wc = (LAS int*)(lds + 16384);
              int my_e = 0, rin = 0;
              if (tid < 256) { my_e = le[tid];
#pragma unroll 4
                  for (int e = 0; e < 32; ++e) { const unsigned long long m = __ballot(my_e == e); if (my_e == e) rin = __popcll(m & ((1ull << lane) - 1ull)); if (lane == e) wc[wave * 32 + e] = __popcll(m); } }
              __syncthreads();
              if (tid < 256) { int rank = rin; for (int w = 0; w < wave; ++w) rank += wc[w * 32 + my_e];
                  const int dd = tab[my_e] + tab[32 + my_e] + rank; dest[ch * 256 + tid] = dd; srcm[dd] = (ch * 256 + tid) >> 2; } }
            __syncthreads();
        }
    }
    ARRIVE(7); GRID_BARRIER(); STAMP(7);

    {
        PH_TID;
        gu32* ctl = (gu32*)(launder_ws(ws0) + WS_CTL);
        for (int i = tid; i < MAXTILES; i += NTHR) tab[64 + i] = (int)ctl[CW_TILEEXP + i];
        if (tid == 0) tab[352] = (int)ctl[CW_TOTAL];
        __syncthreads();
        const int ntile = __builtin_amdgcn_readfirstlane(tab[352]) >> 8;
        LAS int* rm = (LAS int*)(lds + LDSCTL_OFF + 2560);
        { WSP(srcm, int, WS_SRC); const int nun = ntile * 8;
          for (int idx = tid; idx < 21 * 256; idx += NTHR) { const int L = (idx >> 8) * G + vcu; if (L < nun) rm[idx] = srcm[(L >> 3) * 256 + (idx & 255)]; }
          __syncthreads(); }
        const int nG1 = ntile * 8, R1 = nG1 / G, r1 = nG1 - R1 * G;
        const bool fast = (DUP_G1 == 0) && (DUP_G2 == 0) && (R1 > 0) && ((R1 & 1) == 0) && (r1 > 0) && (r1 + r1 / 2 <= G) && (R1 < 20);
        for (int pass = 0; pass < (fast ? 2 : 1); ++pass) {
            if (pass == 0 || vcu < r1) {
                INP(b1, 19); WSP(h2, bf16, WS_H2); WSP(w1_t, bf16, WS_W1T); WSP(act, bf16, WS_ACT);
                pg8::Gemm g{h2, w1_t, CAP, 2048, D}; pg8::MoeOrder<8> S{(fast && pass == 0) ? R1 * G : nG1, G, vcu, (const LAS int*)(tab + 64), (const LAS int*)rm + (pass ? R1 * 256 : 0), pass ? R1 : 0};
                pg8::EpiSwiglu E{(unsigned char*)act, b1};
                pg8::gemm_phase<pg8::EpiSwiglu, pg8::MoeOrder<8>, true, true, true, true>(lds + RING_OFF, g, S, E);
                if (pass == 1) {
                    asm volatile("s_waitcnt vmcnt(0)" ::: "memory"); __syncthreads();
                    if (tid == 0) { __builtin_amdgcn_fence(__ATOMIC_RELEASE, "agent"); asm volatile("s_waitcnt vmcnt(0)" ::: "memory");
                        __hip_atomic_fetch_add((unsigned*)(ctl + CW_G1REM), 1u, __ATOMIC_RELAXED, __HIP_MEMORY_SCOPE_AGENT); } }
            }
            if (pass == 0) { ARRIVE(8); GRID_BARRIER(); STAMP(8); }
        }
        {
            INP(b2, 21); WSP(act, bf16, WS_ACT); WSP(w2_t, bf16, WS_W2T); WSP(ybuf, bf16, WS_YBUF);
            pg8::Gemm g{act, w2_t, CAP, 1024, FF};
            pg8::MoeOrderY S{ntile * 4, G, vcu, (const LAS int*)(tab + 64), fast ? R1 / 2 : (1 << 20), (fast && vcu >= r1 && vcu - r1 < r1 / 2) ? (R1 / 2) * G + (vcu - r1) : -1, fast ? (R1 * G) / 8 : (1 << 30),
                             fast ? (unsigned*)(ctl + CW_G1REM) : (unsigned*)nullptr, (unsigned)r1};
            pg8::EpiY E{ybuf, b2};
            pg8::gemm_phase<pg8::EpiY, pg8::MoeOrderY, true, true, true>(lds + RING_OFF, g, S, E);
        }
    }
    ARRIVE(9); GRID_BARRIER(); STAMP(9);

    for (int rep_ = 0; rep_ <= DUP_P10; ++rep_) {
        PH_TID;
        INP(g_post_ffn, 15); WSP(modd, float, WS_MOD); WSP(x1, bf16, WS_X1); WSP(ybuf, bf16, WS_YBUF); WSP(dest, int, WS_DEST); WSP(gate, float, WS_GATE); float* out = P.out;
        f32x4 cgt[2][4], cgo[4];
#pragma unroll
        for (int i = 0; i < 4; ++i) { const int c0 = i * 256 + lane * 4; cgt[0][i] = *(const f32x4*)(modd + 5120 + c0); cgt[1][i] = *(const f32x4*)(modd + 6144 + 5120 + c0); cgo[i] = *(const f32x4*)(g_post_ffn + c0); }
        LAS int* wd = (LAS int*)(lds + wave * 512);
#define P10_LOAD(Y, X, r_) do { const int rr_ = (r_); const v4u dq_ = *(const LAS v4u*)(wd + (rr_ & 7) * 8); const int rw_ = row0_ + rr_ * NGW; \
            _Pragma("unroll") for (int p = 0; p < 4; ++p) _Pragma("unroll") for (int i = 0; i < 4; ++i) Y[p][i] = *(const uint2*)(ybuf + (size_t)dq_[p] * D + i * 256 + lane * 4); \
            _Pragma("unroll") for (int i = 0; i < 4; ++i) X[i] = *(const uint2*)(x1 + (size_t)(rw_ < M ? rw_ : row0_) * D + i * 256 + lane * 4); } while (0)
#define P10_ROW(Y, X, r_) do { const int rr_ = (r_); const int row = row0_ + rr_ * NGW; if (row < M) { const int b = row / SEQ; const f32x4 gg = __builtin_bit_cast(f32x4, *(const LAS v4u*)(wd + (rr_ & 7) * 8 + 4)); \
            float f[16]; float ss = 0.f; _Pragma("unroll") for (int i = 0; i < 16; ++i) f[i] = 0.f; \
            _Pragma("unroll") for (int p = 0; p < 4; ++p) { const float gp = gg[p]; _Pragma("unroll") for (int i = 0; i < 4; ++i) { const uint2 w = Y[p][i]; \
                f[i * 4] += gp * __uint_as_float(w.x << 16); f[i * 4 + 1] += gp * __uint_as_float(w.x & 0xffff0000u); f[i * 4 + 2] += gp * __uint_as_float(w.y << 16); f[i * 4 + 3] += gp * __uint_as_float(w.y & 0xffff0000u); } } \
            _Pragma("unroll") for (int i = 0; i < 16; ++i) ss += f[i] * f[i]; \
            const float rstd = rsqrtf(wave_sum(ss) * (1.f / D) + RMS_EPS); \
            _Pragma("unroll") for (int i = 0; i < 4; ++i) { const int c0 = i * 256 + lane * 4; const f32x4 xv = (f32x4){__uint_as_float(X[i].x << 16), __uint_as_float(X[i].x & 0xffff0000u), __uint_as_float(X[i].y << 16), __uint_as_float(X[i].y & 0xffff0000u)}; f32x4 ov; \
                _Pragma("unroll") for (int e = 0; e < 4; ++e) ov[e] = xv[e] + (b ? cgt[1][i][e] : cgt[0][i][e]) * (f[i * 4 + e] * rstd * cgo[i][e]); \
                *(f32x4*)(out + (size_t)row * D + c0) = ov; } } } while (0)
        for (int row0_ = gw; row0_ < M; row0_ += 8 * NGW) {
            if (lane < 8) { const int rw = row0_ + lane * NGW; v4u dv = {0u, 0u, 0u, 0u}, gv = {0u, 0u, 0u, 0u}; if (rw < M) { dv = *(const v4u*)(dest + rw * 4); gv = *(const v4u*)(gate + rw * 4); }
                *(LAS v4u*)(wd + lane * 8) = dv; *(LAS v4u*)(wd + lane * 8 + 4) = gv; }
            LDS_WAIT(); asm volatile("" ::: "memory");
            uint2 yA[4][4], yB[4][4]; uint2 xA[4], xB[4];
            P10_LOAD(yA, xA, 0); P10_LOAD(yB, xB, 1);
#pragma unroll
            for (int k = 0; k < 4; ++k) {
                P10_ROW(yA, xA, 2 * k); if (k < 3) P10_LOAD(yA, xA, 2 * k + 2);
                P10_ROW(yB, xB, 2 * k + 1); if (k < 3) P10_LOAD(yB, xB, 2 * k + 3);
            }
            LDS_WAIT(); asm volatile("" ::: "memory");
        }
#undef P10_LOAD
#undef P10_ROW
    }
    PROBE_END();
}

extern "C" void kernel_launch(void* const* d_in, const int* in_sizes, int n_in, void* d_out, int out_size, void* d_ws, size_t ws_size, hipStream_t stream) {
    static int grid = 0;
    if (grid == 0) {
        if (n_in != 22 || ws_size < WS_END) { fprintf(stderr, "kernel_launch: unexpected n_in %d / ws %zu\n", n_in, ws_size); grid = -1; return; }
        int dev = 0, cus = 0, per_cu = 0;
        if (hipGetDevice(&dev) != hipSuccess || hipDeviceGetAttribute(&cus, hipDeviceAttributeMultiprocessorCount, dev) != hipSuccess) { grid = -1; return; }
        if (hipFuncSetAttribute((const void*)mk_fwd, hipFuncAttributeMaxDynamicSharedMemorySize, LDS_BYTES) != hipSuccess) { fprintf(stderr, "kernel_launch: hipFuncSetAttribute failed\n"); grid = -1; return; }
        if (hipOccupancyMaxActiveBlocksPerMultiprocessor(&per_cu, (const void*)mk_fwd, NTHR, LDS_BYTES) != hipSuccess || per_cu < 1) { fprintf(stderr, "kernel_launch: occupancy query says %d\n", per_cu); }
        (void)hipGetLastError();
        grid = cus;
    }
    if (grid < 0) return;
    if (hipMemsetAsync((char*)d_ws + WS_CTL, 0, 1 * MiB, stream) != hipSuccess) return;
    Params p{};
    for (int i = 0; i < 22; ++i) p.in[i] = (const float*)d_in[i];
    p.out = (float*)d_out; p.ws = (unsigned char*)d_ws;
    hipLaunchKernelGGL(mk_fwd, dim3(grid), dim3(NTHR), LDS_BYTES, stream, p);
}
```

```cpp
#include <hip/hip_runtime.h>
#include <stdint.h>
#include <stdio.h>

#define GAS __attribute__((address_space(1)))
#define LAS __attribute__((address_space(3)))
typedef unsigned short bf16;
typedef unsigned v4u __attribute__((ext_vector_type(4)));
typedef float f32x4 __attribute__((ext_vector_type(4)));
typedef GAS unsigned gu32;
#define LDS_WAIT() asm volatile("s_waitcnt lgkmcnt(0)" ::: "memory")
#define VM_WAIT() asm volatile("s_waitcnt vmcnt(0)" ::: "memory")

#define DUP_P0 0
#define DUP_ATT 0
#define DUP_NAT 0
#define DUP_G1 0
#define DUP_G2 0
#define DUP_P2 0
#define DUP_P5 0
#define DUP_P1 0
#define DUP_P4 0
#define DUP_BAR 0
#define DUP_P3 0
#define PROBE_K (-1)
#define DUP_P6 0
#define DUP_P7 0
#define DUP_P10 0
constexpr int NB = 2, SEQ = 8192, D = 1024, M = NB * SEQ;
constexpr int NPROJ = 3072, NE = 32, TOPK = 4, FF = 1024;
constexpr int NASSIGN = M * TOPK;
constexpr int CAP = NASSIGN + NE * 256;
constexpr int MAXTILES = CAP / 256;
constexpr int NCHUNK = M / 64;
constexpr float RMS_EPS = 1e-6f;
constexpr int NWAVES = 8, NTHR = 512;

constexpr size_t MiB = 1u << 20;
constexpr size_t WS_CTL = 0;
constexpr size_t WS_MODP = 1 * MiB;
constexpr size_t WS_MOD = 1 * MiB + 512 * 1024;
constexpr size_t WS_HIST = 2 * MiB;
constexpr size_t WS_TOPI = 3 * MiB;
constexpr size_t WS_GATE = 3 * MiB + 512 * 1024;
constexpr size_t WS_DEST = 4 * MiB;
constexpr size_t WS_SRC = 5 * MiB;
constexpr size_t WS_WIN = 6 * MiB;
constexpr size_t WS_WOUT = 12 * MiB;
constexpr size_t WS_XN = 16 * MiB;
constexpr size_t WS_PROJ = 48 * MiB;
constexpr size_t WS_ODIFF = 144 * MiB;
constexpr size_t WS_CONCAT = 208 * MiB;
constexpr size_t WS_MIX = 240 * MiB;
constexpr size_t WS_X1 = 304 * MiB;
constexpr size_t WS_H2 = 368 * MiB;
constexpr size_t WS_ACT = 400 * MiB;
constexpr size_t WS_YBUF = 544 * MiB;
constexpr size_t WS_W1T = 688 * MiB;
constexpr size_t WS_W2T = 816 * MiB;
constexpr size_t WS_KIMG = 880 * MiB;
constexpr size_t WS_VIMG = 896 * MiB;
constexpr size_t WS_END = 912 * MiB;
constexpr int CW_TOTAL = 64;
constexpr int CW_TILEEXP = 128;
constexpr int CW_NRM = 512;
constexpr int CW_ATTQ = 1024;
constexpr int CW_NATQ = 1536;
constexpr int CW_CONVQ = 2048;
constexpr int CW_CMBQ = 2560;
constexpr int CW_CONVACT = 2816;
constexpr int CW_G1REM = 2944;
constexpr int CW_BAR = 4096;
constexpr int CW_GST = 3072;
constexpr int CW_DONE = 8192;

constexpr int RING_OFF = 0, RING_BYTES = 131072;
constexpr int LDSCTL_OFF = RING_BYTES, MISC_OFF = LDSCTL_OFF + 320, TAB_OFF = LDSCTL_OFF + 1024;
constexpr int LDS_BYTES = 155648;

__device__ __forceinline__ float bf2f(bf16 v) { return __uint_as_float(((unsigned)v) << 16); }
__device__ __forceinline__ unsigned f2bf(float f) { unsigned u = __builtin_bit_cast(unsigned, f); return (u + 0x7fffu + ((u >> 16) & 1u)) >> 16; }
__device__ __forceinline__ unsigned pk2(float lo, float hi) { return f2bf(lo) | (f2bf(hi) << 16); }
namespace pg8 {
#define PG8_LAS __attribute__((address_space(3)))
typedef unsigned short bf16_t;
typedef short bf16x8 __attribute__((ext_vector_type(8)));
typedef float f32x4 __attribute__((ext_vector_type(4)));
typedef unsigned u32x4 __attribute__((ext_vector_type(4)));
constexpr int BM = 256, BK = 64, HALF = 128, HTB = HALF * BK * 2  , STAGE_BYTES = 8 * HTB, NXCD = 8, WGM = 8;

__host__ __device__ __forceinline__ int lds_byte(int r, int c) { const int st = (r >> 4) * 2 + (c >> 5), rr = r & 15, cc = c & 31, ob = rr * 64 + cc * 2; return st * 1024 + (ob ^ (((ob >> 9) & 1) << 5)); }
__host__ __device__ __forceinline__ void stage_rc(int b, int& R, int& C) { const int st = b / 1024, sb = b % 1024, swz = sb ^ (((sb >> 9) & 1) << 5); R = (st >> 1) * 16 + swz / 64; C = (st & 1) * 32 + (swz % 64) / 2; }
__host__ __device__ __forceinline__ int perm32(int rho) { const int n = rho >> 4, i = rho & 15; return 8 * (i >> 2) + 4 * n + (i & 3); }

struct Unit { int pm, pn; };
struct Gemm { const bf16_t* A; const bf16_t* Bt; int M, N, K; };

struct StaticOrder {
    int nM, nN, nwg, G, c;
    __host__ __device__ void init(int M, int N, int G_, int c_) { nM = M / BM; nN = N / BM; nwg = nM * nN; G = G_; c = c_; }
    __host__ __device__ bool next(int i, Unit& u) const {
        const long L = (long)i * G + c; if (L >= nwg) return false;
        int wgid = (int)L; { const int q = nwg / NXCD, r = nwg % NXCD, xcd = wgid % NXCD, off = wgid / NXCD; wgid = (xcd < r ? xcd * (q + 1) : r * (q + 1) + (xcd - r) * q) + off; }
        const int nig = WGM * nN, gid = wgid / nig, fm = gid * WGM, gsz = (nM - fm) < WGM ? (nM - fm) : WGM;
        u.pm = fm + ((wgid % nig) % gsz); u.pn = (wgid % nig) / gsz; return true;
    }
    __device__ __forceinline__ void a_ready(const Unit&) const {}
    __device__ __forceinline__ void done(const Unit&) const {}
};

__device__ __forceinline__ unsigned cvt_pk_bf16(float lo, float hi) { unsigned r; asm volatile("v_cvt_pk_bf16_f32 %0, %1, %2" : "=v"(r) : "v"(lo), "v"(hi)); return r; }
struct EpiStoreBf16 {
    static constexpr bool PERM = true, AFTER_DRAIN = false;
    bf16_t* O; int ldc; int scale_cols; float scale0; int s2lo, s2hi; unsigned* nrm; bf16_t* kimg; bf16_t* vimg;
    __device__ __forceinline__ void operator()(const f32x4 (&acc)[2][2][4][2], const Unit& u, int wr, int wc, int fr, int fq) const {
        const int row0 = u.pm * BM + wr * 64 + fr, colt = u.pn * BM, col0 = colt + wc * 32 + 8 * fq; const float sc = (colt < scale_cols || (colt >= s2lo && colt < s2hi)) ? scale0 : 1.f;
        const bool isk = kimg && (colt >= 512 && colt < 1024), isv = kimg && (colt >= 1024 && colt < 1536); const bool donrm = nrm && (colt < 1024);
        float mx[2] = {0.f, 0.f};
#pragma unroll
        for (int ai = 0; ai < 2; ++ai)
#pragma unroll
            for (int m = 0; m < 4; ++m) { const int row = row0 + ai * HALF + m * 16; bf16_t* rowp = O + (size_t)row * ldc + col0;
                const int b = row >> 13, tile = (row & 8191) >> 6, rr = row & 63;
#pragma unroll
                for (int bj = 0; bj < 2; ++bj) { const f32x4 v0 = acc[ai][bj][m][0] * sc, v1 = acc[ai][bj][m][1] * sc;
                    u32x4 w; w.x = cvt_pk_bf16(v0[0], v0[1]); w.y = cvt_pk_bf16(v0[2], v0[3]); w.z = cvt_pk_bf16(v1[0], v1[1]); w.w = cvt_pk_bf16(v1[2], v1[3]);
                    if (isk) { const int c = col0 + bj * HALF - 512, hm = c >> 6, chunk = (c & 63) >> 3;
                        *(u32x4*)(kimg + ((size_t)((b * 8 + hm) * 128 + tile) * 4096 + chunk * 512 + rr * 8)) = w; }
                    else if (isv) { const int c = col0 + bj * HALF - 1024, h = c >> 7, e = c & 127;
                        *(u32x4*)(vimg + ((size_t)((b * 4 + h) * 128 + tile) * 8192 + (e >> 5) * 2048 + rr * 32 + (e & 31))) = w; }
                    else *(u32x4*)(rowp + bj * HALF) = w;
                    if (donrm) { float s = 0.f;
#pragma unroll
                        for (int j = 0; j < 4; ++j) { const float lo = __uint_as_float(w[j] << 16), hi = __uint_as_float(w[j] & 0xffff0000u); s += lo * lo + hi * hi; }
                        s += __shfl_xor(s, 16); s += __shfl_xor(s, 32); mx[bj] = fmaxf(mx[bj], s); } } }
        if (donrm) {
#pragma unroll
            for (int bj = 0; bj < 2; ++bj) { float v = mx[bj]; v = fmaxf(v, __shfl_xor(v, 1)); v = fmaxf(v, __shfl_xor(v, 2)); v = fmaxf(v, __shfl_xor(v, 4)); v = fmaxf(v, __shfl_xor(v, 8));
                if (fr == 0 && fq == 0) { const int g = (colt + bj * HALF + wc * 32) >> 6, b = u.pm >> 5; atomicMax(nrm + ((b * 16 + g) * 2 + (wc & 1)), __float_as_uint(v)); } }
        }
    }
};
struct EpiStoreF32 {
    static constexpr bool PERM = true, AFTER_DRAIN = false;
    float* O; int ldc;
    __device__ __forceinline__ void operator()(const f32x4 (&acc)[2][2][4][2], const Unit& u, int wr, int wc, int fr, int fq) const {
        const int row0 = u.pm * BM + wr * 64 + fr, col0 = u.pn * BM + wc * 32 + 8 * fq;
#pragma unroll
        for (int ai = 0; ai < 2; ++ai)
#pragma unroll
            for (int m = 0; m < 4; ++m) { float* rowp = O + (size_t)(row0 + ai * HALF + m * 16) * ldc + col0;
#pragma unroll
                for (int bj = 0; bj < 2; ++bj) { *(f32x4*)(rowp + bj * HALF) = acc[ai][bj][m][0]; *(f32x4*)(rowp + bj * HALF + 4) = acc[ai][bj][m][1]; } }
    }
};
struct EpiSwiglu {
    static constexpr bool PERM = true, AFTER_DRAIN = false;
    unsigned char* act; const float* b1;
    __device__ __forceinline__ void operator()(const f32x4 (&acc)[2][2][4][2], const Unit& u, int wr, int wc, int fr, int fq) const {
        const int e = u.pn >> 3, pnl = u.pn & 7, row0 = u.pm * BM + wr * 64 + fr, hc0 = pnl * BM + wc * 32 + 8 * fq;
        f32x4 bv[2][2];
#pragma unroll
        for (int bj = 0; bj < 2; ++bj)
#pragma unroll
            for (int n = 0; n < 2; ++n) bv[bj][n] = *(const f32x4*)(b1 + e * 2048 + hc0 + bj * HALF + 4 * n);
#pragma unroll
        for (int ai = 0; ai < 2; ++ai)
#pragma unroll
            for (int m = 0; m < 4; ++m) { unsigned char* rowp = act + (size_t)(row0 + ai * HALF + m * 16) * 1024 + (hc0 >> 1);
#pragma unroll
                for (int bj = 0; bj < 2; ++bj) { const f32x4 v0 = acc[ai][bj][m][0] + bv[bj][0], v1 = acc[ai][bj][m][1] + bv[bj][1];
                    float r[4];
                    const float gg[4] = {v0[0], v0[2], v1[0], v1[2]}, ll[4] = {v0[1], v0[3], v1[1], v1[3]};
#pragma unroll
                    for (int p = 0; p < 4; ++p) { float g = gg[p], l = ll[p];
                        g = fminf(g, 7.f); l = fminf(fmaxf(l, -7.f), 7.f);
                        r[p] = g * __builtin_amdgcn_rcpf(1.f + __expf(-1.702f * g)) * (l + 1.f); }
                    int w = 0; w = __builtin_amdgcn_cvt_pk_fp8_f32(r[0], r[1], w, false); w = __builtin_amdgcn_cvt_pk_fp8_f32(r[2], r[3], w, true);
                    *(int*)(rowp + bj * (HALF / 2)) = w; } }
    }
};
struct EpiY {
    static constexpr bool PERM = true, AFTER_DRAIN = false;
    bf16_t* y; const float* b2;
    __device__ __forceinline__ void operator()(const f32x4 (&acc)[2][2][4][2], const Unit& u, int wr, int wc, int fr, int fq) const {
        const int e = u.pn >> 2, pnl = u.pn & 3, row0 = u.pm * BM + wr * 64 + fr, col0 = pnl * BM + wc * 32 + 8 * fq;
        f32x4 bv[2][2];
#pragma unroll
        for (int bj = 0; bj < 2; ++bj)
#pragma unroll
            for (int n = 0; n < 2; ++n) bv[bj][n] = *(const f32x4*)(b2 + e * 1024 + col0 + bj * HALF + 4 * n);
#pragma unroll
        for (int ai = 0; ai < 2; ++ai)
#pragma unroll
            for (int m = 0; m < 4; ++m) { bf16_t* rowp = y + (size_t)(row0 + ai * HALF + m * 16) * 1024 + col0;
#pragma unroll
                for (int bj = 0; bj < 2; ++bj) { const f32x4 v0 = acc[ai][bj][m][0] + bv[bj][0], v1 = acc[ai][bj][m][1] + bv[bj][1];
                    u32x4 w; w.x = cvt_pk_bf16(v0[0], v0[1]); w.y = cvt_pk_bf16(v0[2], v0[3]); w.z = cvt_pk_bf16(v1[0], v1[1]); w.w = cvt_pk_bf16(v1[2], v1[3]);
                    *(u32x4*)(rowp + bj * HALF) = w; } }
    }
};
template <int NN> struct MoeOrder {
    int nunit, G, c; const PG8_LAS int* texp; const PG8_LAS int* rmap;
    __device__ __forceinline__ bool next(int i, Unit& u) const {
        const int L = i * G + c; if (L >= nunit) return false;
        const int pm = L / NN, pnl = L % NN; u.pm = pm; u.pn = __builtin_amdgcn_readfirstlane(texp[pm]) * NN + pnl; return true;
    }
    __device__ __forceinline__ void a_ready(const Unit&) const {}
    __device__ __forceinline__ void done(const Unit&) const {}
};
typedef int i32x4_t __attribute__((ext_vector_type(4))); typedef int i32x8_t __attribute__((ext_vector_type(8)));
__device__ __forceinline__ void pg8_glds16(const void* sbase, unsigned voff, unsigned lds_dst) { unsigned keep;
    asm volatile("s_mov_b32 %0, m0\n\ts_mov_b32 m0, %3\n\ts_nop 0\n\tglobal_load_lds_dwordx4 %1, %2\n\ts_mov_b32 m0, %0" : "=&s"(keep) : "v"(voff), "s"(sbase), "s"(lds_dst) : "memory"); }
template <class Epi, class Sched, bool ALIGN_EPI = false, bool SP2 = false, bool FP8 = false, bool GATHER = false>
__device__ __forceinline__ void gemm_phase(PG8_LAS unsigned char* lds, const Gemm g, const Sched& S, const Epi& E) {
    int tid_ = threadIdx.x; asm volatile("" : "+v"(tid_));
    const int tid = tid_, wid = __builtin_amdgcn_readfirstlane(tid >> 6), lane = tid & 63, wr = wid >> 2, wc = wid & 3, fr = lane & 15, fq = lane >> 4;
    const int K = g.K, KB = FP8 ? K : 2 * K, nt = KB / (BK * 2);
    unsigned voffA[2], voffB[2];
#pragma unroll
    for (int i = 0; i < 2; ++i) { int R, C; stage_rc(tid * 16 + i * 8192, R, C); const int Rb = Epi::PERM ? ((R & ~31) + perm32(R & 31)) : R;
        voffA[i] = (unsigned)(R * KB + C * 2); voffB[i] = (unsigned)(Rb * KB + C * 2); }
    static_assert(!GATHER || SP2, "GATHER is implemented for the SP2 form");
    int R0_, C0_; stage_rc(tid * 16, R0_, C0_);
    unsigned gA_[2][2] = {{0u, 0u}, {0u, 0u}};
#define PG8_GLOAD(dst, uidx) do { if constexpr (GATHER) { _Pragma("unroll") for (int _h = 0; _h < 2; ++_h) _Pragma("unroll") for (int _i = 0; _i < 2; ++_i) dst[_h][_i] = (unsigned)S.rmap[(uidx) * 256 + _h * 128 + _i * 64 + R0_] * (unsigned)KB + (unsigned)(C0_ * 2); } } while (0)
    const size_t kstep = (size_t)(BK * 2);
    const size_t hstep = (size_t)HALF * KB;
    const size_t tstep = 2 * hstep;
    const unsigned ldsb = (unsigned)(uintptr_t)lds;
    const unsigned ldsw = (unsigned)wid * 1024u; const unsigned ldsbw = (unsigned)__builtin_amdgcn_readfirstlane(ldsb + ldsw);
    const int aoff = lds_byte(wr * 64 + fr, fq * 8), boff = lds_byte(wc * 32 + fr, fq * 8);
#define PG8_CAT(x, y) __builtin_shufflevector(__builtin_bit_cast(i32x4_t, x), __builtin_bit_cast(i32x4_t, y), 0, 1, 2, 3, 4, 5, 6, 7)
#define PG8_SA(b, h) (((b) * 2 + (h)) * HTB)
#define PG8_SB(b, h) ((4 + (b) * 2 + (h)) * HTB)
#define PG8_STAGE(bufoff, gbase, voff) do { _Pragma("unroll") for (int _i = 0; _i < 2; ++_i) \
        pg8_glds16((const void*)((const char*)(gbase) + (size_t)_i * 64 * KB), (voff)[0], ldsbw + (unsigned)((bufoff) + _i * 8192)); } while (0)
#define PG8_STAGE_A(bufoff, kp, h, NX) do { if constexpr (GATHER) { _Pragma("unroll") for (int _i = 0; _i < 2; ++_i) pg8_glds16((const void*)(kp), gA_[h][_i], ldsbw + (unsigned)((bufoff) + _i * 8192)); } \
    else { PG8_STAGE(bufoff, (kp) + (size_t)(h) * hstep, voffA); } } while (0)
#define PG8_LDA(dst, b, h) do { if constexpr (FP8) { _Pragma("unroll") for (int m = 0; m < 4; ++m) dst##8[m] = PG8_CAT(*(const PG8_LAS bf16x8*)(lds + PG8_SA(b, h) + aoff + m * 2048), *(const PG8_LAS bf16x8*)(lds + PG8_SA(b, h) + aoff + m * 2048 + 1024)); } \
    else { _Pragma("unroll") for (int m = 0; m < 4; ++m) _Pragma("unroll") for (int k = 0; k < 2; ++k) dst[m][k] = *(const PG8_LAS bf16x8*)(lds + PG8_SA(b, h) + aoff + m * 2048 + k * 1024); } } while (0)
#define PG8_LDB(dst, b, h) do { if constexpr (FP8) { _Pragma("unroll") for (int n = 0; n < 2; ++n) dst##8[n] = PG8_CAT(*(const PG8_LAS bf16x8*)(lds + PG8_SB(b, h) + boff + n * 2048), *(const PG8_LAS bf16x8*)(lds + PG8_SB(b, h) + boff + n * 2048 + 1024)); } \
    else { _Pragma("unroll") for (int n = 0; n < 2; ++n) _Pragma("unroll") for (int k = 0; k < 2; ++k) dst[n][k] = *(const PG8_LAS bf16x8*)(lds + PG8_SB(b, h) + boff + n * 2048 + k * 1024); } } while (0)
#define PG8_MMA(ai, bj, At, Bt) do { __builtin_amdgcn_s_setprio(1); if constexpr (FP8) { _Pragma("unroll") for (int m = 0; m < 4; ++m) _Pragma("unroll") for (int n = 0; n < 2; ++n) \
        acc[ai][bj][m][n] = __builtin_amdgcn_mfma_scale_f32_16x16x128_f8f6f4(Bt##8[n], At##8[m], acc[ai][bj][m][n], 0, 0, 0, 0x7c7c7c7c, 0, 0x7c7c7c7c); } \
    else { _Pragma("unroll") for (int m = 0; m < 4; ++m) _Pragma("unroll") for (int n = 0; n < 2; ++n) _Pragma("unroll") for (int k = 0; k < 2; ++k) \
        acc[ai][bj][m][n] = __builtin_amdgcn_mfma_f32_16x16x32_bf16(Bt[n][k], At[m][k], acc[ai][bj][m][n], 0, 0, 0); } __builtin_amdgcn_s_setprio(0); } while (0)
#define PG8_WAIT_V(n) asm volatile("s_waitcnt vmcnt(" #n ")" ::: "memory")
#define PG8_WAIT_L(n) asm volatile("s_waitcnt lgkmcnt(" #n ")" ::: "memory")
#define PG8_BAR __builtin_amdgcn_s_barrier()
#define PG8_SCHED __builtin_amdgcn_sched_barrier(0)
    Unit cur, nxt; int ui = 0;
    if (!S.next(0, cur)) return;
    f32x4 acc[2][2][4][2];
#pragma unroll
    for (int a = 0; a < 2; ++a)
#pragma unroll
        for (int b = 0; b < 2; ++b)
#pragma unroll
            for (int m = 0; m < 4; ++m)
#pragma unroll
                for (int n = 0; n < 2; ++n) acc[a][b][m][n] = (f32x4){0.f, 0.f, 0.f, 0.f};
    bf16x8 At[4][2], B0[2][2], B1[2][2]; i32x8_t At8[4], B08[2], B18[2];
    const char* cA = (const char*)g.A + (GATHER ? (size_t)0 : (size_t)cur.pm * tstep); const char* cB = (const char*)g.Bt + (size_t)cur.pn * tstep;
    S.a_ready(cur); PG8_GLOAD(gA_, 0);
    if constexpr (SP2) {
        PG8_STAGE(PG8_SB(0, 0), cB, voffB); PG8_STAGE(PG8_SB(0, 1), cB + hstep, voffB); PG8_STAGE_A(PG8_SA(0, 0), cA, 0, false); PG8_STAGE_A(PG8_SA(0, 1), cA, 1, false);
        if (wr == 1) PG8_BAR;
        PG8_WAIT_V(2); PG8_BAR;
        PG8_STAGE(PG8_SB(1, 0), cB + kstep, voffB); PG8_STAGE_A(PG8_SA(1, 0), cA + kstep, 0, false); PG8_STAGE(PG8_SB(1, 1), cB + hstep + kstep, voffB);
        PG8_WAIT_V(6); PG8_BAR;
    } else {
        PG8_STAGE(PG8_SB(0, 0), cB, voffB); PG8_STAGE(PG8_SA(0, 0), cA, voffA); PG8_STAGE(PG8_SB(0, 1), cB + hstep, voffB); PG8_STAGE(PG8_SA(0, 1), cA + hstep, voffA);
        if (wr == 1) PG8_BAR;
        PG8_WAIT_V(4); PG8_BAR;
        PG8_STAGE(PG8_SB(1, 0), cB + kstep, voffB); PG8_STAGE(PG8_SA(1, 0), cA + kstep, voffA); PG8_STAGE(PG8_SB(1, 1), cB + hstep + kstep, voffB);
        PG8_WAIT_V(6); PG8_BAR;
    }
    for (;;) {
        const bool has_next = S.next(ui + 1, nxt);
                const char* nA = (has_next && !GATHER) ? (const char*)g.A + (size_t)nxt.pm * tstep : cA; const char* nB = has_next ? (const char*)g.Bt + (size_t)nxt.pn * tstep : cB;
#pragma clang loop unroll(disable)
        for (int t = 0; t < nt; t += 2) {
            const bool last = (t == nt - 2);
            const char* a1 = cA + (size_t)(t + 1) * kstep;
            const char* a2 = last ? nA : cA + (size_t)(t + 2) * kstep; const char* b2 = last ? nB : cB + (size_t)(t + 2) * kstep;
            const char* a3 = a2 + kstep; const char* b3 = b2 + kstep;
            if (last && has_next) S.a_ready(nxt);
            if constexpr (SP2) {
            PG8_LDB(B0, 0, 0); PG8_LDB(B1, 0, 1); PG8_SCHED; PG8_LDA(At, 0, 0); PG8_STAGE_A(PG8_SA(1, 1), a1, 1, false);
            if constexpr (GATHER) { if (last) { PG8_GLOAD(gA_, has_next ? ui + 1 : ui); } }
            PG8_WAIT_V(8); PG8_WAIT_L(0); PG8_BAR; PG8_MMA(0, 0, At, B0); PG8_MMA(0, 1, At, B1); PG8_BAR; PG8_SCHED;
            PG8_LDA(At, 0, 1); PG8_STAGE(PG8_SB(0, 0), b2, voffB); PG8_STAGE(PG8_SB(0, 1), b2 + hstep, voffB); PG8_STAGE_A(PG8_SA(0, 0), a2, 0, last);
            PG8_WAIT_V(8); PG8_WAIT_L(0); PG8_BAR; PG8_MMA(1, 0, At, B0); PG8_MMA(1, 1, At, B1); PG8_BAR; PG8_SCHED;
            PG8_LDB(B0, 1, 0); PG8_LDB(B1, 1, 1); PG8_SCHED; PG8_LDA(At, 1, 0); PG8_STAGE_A(PG8_SA(0, 1), a2, 1, last);
            PG8_WAIT_V(8); PG8_WAIT_L(0); PG8_BAR; PG8_MMA(0, 0, At, B0); PG8_MMA(0, 1, At, B1); PG8_BAR; PG8_SCHED;
            PG8_LDA(At, 1, 1); PG8_STAGE(PG8_SB(1, 0), b3, voffB); PG8_STAGE(PG8_SB(1, 1), b3 + hstep, voffB); PG8_STAGE_A(PG8_SA(1, 0), a3, 0, last);
            PG8_WAIT_V(8); PG8_WAIT_L(0); PG8_BAR; PG8_MMA(1, 0, At, B0); PG8_MMA(1, 1, At, B1); PG8_BAR; PG8_SCHED;
            } else {
            PG8_LDB(B0, 0, 0); PG8_SCHED; PG8_LDA(At, 0, 0); PG8_STAGE(PG8_SA(1, 1), a1 + hstep, voffA);
            PG8_WAIT_L(8); PG8_BAR; PG8_WAIT_L(0); PG8_MMA(0, 0, At, B0); PG8_BAR; PG8_SCHED;
            PG8_LDB(B1, 0, 1); PG8_STAGE(PG8_SB(0, 0), b2, voffB);
            PG8_BAR; PG8_WAIT_L(0); PG8_MMA(0, 1, At, B1); PG8_BAR;
            PG8_LDA(At, 0, 1); PG8_STAGE(PG8_SA(0, 0), a2, voffA);
            PG8_BAR; PG8_WAIT_L(0); PG8_MMA(1, 0, At, B0); PG8_BAR; PG8_SCHED;
            PG8_STAGE(PG8_SB(0, 1), b2 + hstep, voffB);
            PG8_WAIT_V(6); PG8_BAR; PG8_MMA(1, 1, At, B1); PG8_BAR;
            PG8_LDB(B0, 1, 0); PG8_SCHED; PG8_LDA(At, 1, 0); PG8_STAGE(PG8_SA(0, 1), a2 + hstep, voffA);
            PG8_WAIT_L(8); PG8_BAR; PG8_WAIT_L(0); PG8_MMA(0, 0, At, B0); PG8_BAR; PG8_SCHED;
            PG8_LDB(B1, 1, 1); PG8_STAGE(PG8_SB(1, 0), b3, voffB);
            PG8_BAR; PG8_WAIT_L(0); PG8_MMA(0, 1, At, B1); PG8_BAR;
            PG8_LDA(At, 1, 1); PG8_STAGE(PG8_SA(1, 0), a3, voffA);
            PG8_BAR; PG8_WAIT_L(0); PG8_MMA(1, 0, At, B0); PG8_BAR; PG8_SCHED;
            PG8_STAGE(PG8_SB(1, 1), b3 + hstep, voffB);
            PG8_WAIT_V(6); PG8_BAR; PG8_MMA(1, 1, At, B1); PG8_BAR;
            }
        }
        if constexpr (ALIGN_EPI) { if (wr == 0) PG8_BAR; }
        if constexpr (!Epi::AFTER_DRAIN) { int t2_ = threadIdx.x; asm volatile("" : "+v"(t2_)); const int l2_ = t2_ & 63;
            E(acc, cur, wr, wc, l2_ & 15, l2_ >> 4); S.done(cur); }
        if (!has_next) break;
#pragma unroll
        for (int a = 0; a < 2; ++a)
#pragma unroll
            for (int b = 0; b < 2; ++b)
#pragma unroll
                for (int m = 0; m < 4; ++m)
#pragma unroll
                    for (int n = 0; n < 2; ++n) acc[a][b][m][n] = (f32x4){0.f, 0.f, 0.f, 0.f};
        cur = nxt; cA = nA; cB = nB; ++ui;
        if constexpr (ALIGN_EPI) { if (wr == 1) PG8_BAR; }
    }
    PG8_WAIT_V(0);
    if constexpr (!ALIGN_EPI) { if (wr == 0) PG8_BAR; }
    PG8_BAR;
    if constexpr (Epi::AFTER_DRAIN) { E.fused(acc, cur, wr, wc, fr, fq, lds, wid, lane); S.done(cur); }
#undef PG8_SA
#undef PG8_STAGE_A
#undef PG8_GLOAD
#undef PG8_SB
#undef PG8_STAGE
#undef PG8_LDA
#undef PG8_LDB
#undef PG8_MMA
#undef PG8_CAT
#undef PG8_WAIT_V
#undef PG8_WAIT_L
#undef PG8_BAR
#undef PG8_SCHED
}
}
#include <hip/hip_bf16.h>
#include <cmath>
namespace attn_body {
using bf16=__hip_bfloat16;
using bf16x8=__attribute__((ext_vector_type(8)))short;
using s16x4=__attribute__((ext_vector_type(4)))short;
using f32x16=__attribute__((ext_vector_type(16)))float;
using u32x4=__attribute__((ext_vector_type(4)))unsigned;
constexpr int SEQ=8192,D=64,QP=3072,KP=3072,OP=512;
constexpr int NW=8,QBLK=32,QB=QBLK*NW,KVBLK=64,NQB=SEQ/QB;
constexpr int ATTN_UNIT_ROWS=QB;
__device__ __forceinline__ int crow(int r,int hi){return (r&3)+8*(r>>2)+4*hi;}
#define SBAR() __builtin_amdgcn_sched_barrier(0)
__device__ __forceinline__ void cmask(f32x16&p0,f32x16&p1,int jb,int qrel,int hi){
  const float NEG=-INFINITY; int kb=64*jb+4*hi;
  #pragma unroll
  for(int r=0;r<16;++r){int kv=kb+(r&3)+8*(r>>2); if(kv>qrel)p0[r]=NEG; if(kv+32>qrel)p1[r]=NEG;}
}

constexpr int NSLOT=3, SLOTB=8192;
constexpr int LDS_K=0, LDS_V=NSLOT*SLOTB, LDS_WS=2*NSLOT*SLOTB, LDS_OST=LDS_WS+NW*64*4, LDS_TB=LDS_OST+NW*4096+4096, LDS_BYTES=LDS_TB+4096;
constexpr float C2=0.125f*1.4426950408889634f;
__device__ __forceinline__ void glds16(const void*gsrc,unsigned lds_dst){unsigned keep;
  asm volatile("s_mov_b32 %0, m0\n\ts_mov_b32 m0, %2\n\ts_nop 0\n\tglobal_load_lds_dwordx4 %1, off\n\ts_mov_b32 m0, %0":"=&s"(keep):"v"(gsrc),"s"(lds_dst):"memory");}
__device__ __forceinline__ float max3f(float a,float b,float c){float r;asm("v_max3_f32 %0, %1, %2, %3":"=v"(r):"v"(a),"v"(b),"v"(c));return r;}
__device__ __forceinline__ float max2f(float a,float b){float r;asm("v_max_f32_e32 %0, %1, %2":"=v"(r):"v"(a),"v"(b));return r;}
__device__ __forceinline__ float fadd_s(float a,float b){float r;asm("v_add_f32_e32 %0, %1, %2":"=v"(r):"v"(a),"v"(b));return r;}
__device__ __forceinline__ float fsub_s(float a,float b){float r;asm("v_sub_f32_e32 %0, %1, %2":"=v"(r):"v"(a),"v"(b));return r;}
typedef float f32x2_t __attribute__((ext_vector_type(2))); typedef __bf16 bf16x2_t __attribute__((ext_vector_type(2)));
__device__ __forceinline__ unsigned cvtpk_s(float lo,float hi){f32x2_t v={lo,hi};bf16x2_t b=__builtin_convertvector(v,bf16x2_t);return __builtin_bit_cast(unsigned,b);}
#define WAIT_BAR(N) asm volatile("s_waitcnt vmcnt(" #N ") lgkmcnt(0)\n\ts_barrier":::"memory")

__device__ __forceinline__ void qkt(f32x16&p0,f32x16&p1,const char*Kslot,const bf16x8*qr,const f32x16&negm,int r32,int hi){
  const char*kb=Kslot+hi*1024+r32*16;
  #pragma unroll
  for(int d0=0;d0<4;++d0){
    const bf16x8 b0=*reinterpret_cast<const bf16x8*>(kb+d0*2048);
    const bf16x8 b1=*reinterpret_cast<const bf16x8*>(kb+d0*2048+512);
    if(d0==0){p0=__builtin_amdgcn_mfma_f32_32x32x16_bf16(b0,qr[0],negm,0,0,0);p1=__builtin_amdgcn_mfma_f32_32x32x16_bf16(b1,qr[0],negm,0,0,0);}
    else{p0=__builtin_amdgcn_mfma_f32_32x32x16_bf16(b0,qr[d0],p0,0,0,0);p1=__builtin_amdgcn_mfma_f32_32x32x16_bf16(b1,qr[d0],p1,0,0,0);}}
}
typedef __attribute__((address_space(3))) const char* lds_cptr;
typedef short v4i16_t __attribute__((ext_vector_type(4)));
__device__ __forceinline__ void kload8(bf16x8*kf,lds_cptr kp){
  kf[0]=*(const __attribute__((address_space(3))) bf16x8*)(kp);      kf[1]=*(const __attribute__((address_space(3))) bf16x8*)(kp+512);
  kf[2]=*(const __attribute__((address_space(3))) bf16x8*)(kp+2048); kf[3]=*(const __attribute__((address_space(3))) bf16x8*)(kp+2560);
  kf[4]=*(const __attribute__((address_space(3))) bf16x8*)(kp+4096); kf[5]=*(const __attribute__((address_space(3))) bf16x8*)(kp+4608);
  kf[6]=*(const __attribute__((address_space(3))) bf16x8*)(kp+6144); kf[7]=*(const __attribute__((address_space(3))) bf16x8*)(kp+6656);
}
__device__ __forceinline__ void kload2(bf16x8*kf,lds_cptr kp,int j){ kf[2*j]=*(const __attribute__((address_space(3))) bf16x8*)(kp+j*2048); kf[2*j+1]=*(const __attribute__((address_space(3))) bf16x8*)(kp+j*2048+512); }
__device__ __forceinline__ s16x4 vtr(lds_cptr p){ return __builtin_bit_cast(s16x4,__builtin_amdgcn_ds_read_tr16_b64_v4i16((__attribute__((address_space(3))) v4i16_t*)p)); }
__device__ __forceinline__ float rowmax(const f32x16&p0,const f32x16&p1){
  float a=max3f(p0[0],p0[1],p1[0]),b=max3f(p0[2],p0[3],p1[1]);a=max3f(a,p1[2],p1[3]);
  #pragma unroll
  for(int r=4;r<16;r+=4){a=max3f(a,p0[r],p0[r+1]);b=max3f(b,p0[r+2],p0[r+3]);a=max3f(a,p1[r],p1[r+1]);b=max3f(b,p1[r+2],p1[r+3]);}
  const float m=max2f(a,b);
  auto rr=__builtin_amdgcn_permlane32_swap(__float_as_uint(m),__float_as_uint(m),false,false);
  return max2f(__uint_as_float(rr[0]),__uint_as_float(rr[1]));
}
__device__ __forceinline__ void pv(f32x16*o,int vb,bf16x8 pa0,bf16x8 pa1,bf16x8 pa2,bf16x8 pa3){
  #pragma unroll
  for(int d0=0;d0<2;++d0){s16x4 lo[4],hi[4];
    #pragma unroll
    for(int ks=0;ks<4;++ks){
      asm volatile("ds_read_b64_tr_b16 %0,%1 offset:%c2":"=&v"(lo[ks]):"v"(vb),"i"(d0*4096+ks*1024):"memory");
      asm volatile("ds_read_b64_tr_b16 %0,%1 offset:%c2":"=&v"(hi[ks]):"v"(vb),"i"(d0*4096+ks*1024+512):"memory");}
    asm volatile("s_waitcnt lgkmcnt(0)":::"memory");SBAR();
    #define PK(k) (bf16x8){lo[k][0],lo[k][1],lo[k][2],lo[k][3],hi[k][0],hi[k][1],hi[k][2],hi[k][3]}
    o[d0]=__builtin_amdgcn_mfma_f32_32x32x16_bf16(pa0,PK(0),o[d0],0,0,0);
    o[d0]=__builtin_amdgcn_mfma_f32_32x32x16_bf16(pa1,PK(1),o[d0],0,0,0);
    o[d0]=__builtin_amdgcn_mfma_f32_32x32x16_bf16(pa2,PK(2),o[d0],0,0,0);
    o[d0]=__builtin_amdgcn_mfma_f32_32x32x16_bf16(pa3,PK(3),o[d0],0,0,0);
    #undef PK
  }
}

#ifndef ATTN_STORE16
#define ATTN_STORE16(p,v) (*(u32x4*)(p)=(v))
#endif
template<int MODE,int OP,int THRL> __device__ __forceinline__ void attn_unit(const bf16*Qu,const bf16*__restrict__ Kh,const bf16*__restrict__ Vh,bf16*Ou,int q0,int t_lo,int NT,float nsl2,char*shm){
  int tid_=threadIdx.x; asm volatile("":"+v"(tid_));
  const int tid=tid_,lane=tid&63,r32=lane&31,hi=lane>>5; const int wid=__builtin_amdgcn_readfirstlane(tid>>6);
  const bf16*Qw=Qu+(long)(wid*QBLK)*QP;
  const unsigned lds0=(unsigned)(uintptr_t)shm;
  float*wsf=(float*)(shm+LDS_WS)+wid*64;
  const bf16*ksrc=Kh+(long)lane*KP+wid*8;
  const bf16*vsrc=Vh+(long)(16*(wid&3)+(lane>>2))*KP+(wid>>2)*32+(lane&3)*8;
  const unsigned kdst=lds0+LDS_K+wid*1024, vdst=lds0+LDS_V+wid*1024;
  #define DMA_K(t,slot) glds16(ksrc+(long)(t)*KVBLK*KP,(unsigned)__builtin_amdgcn_readfirstlane(kdst+(slot)))
  #define DMA_V(t,slot) glds16(vsrc+(long)(t)*KVBLK*KP,(unsigned)__builtin_amdgcn_readfirstlane(vdst+(slot)))
  const int vb0=(int)(lds0+LDS_V)+((lane>>4)&1)*32+(lane&3)*8+(4*hi+((lane&15)>>2))*64;
  const char*Kbase=shm+LDS_K; bf16x8 kf[8];
  const lds_cptr shm3=(lds_cptr)shm; const lds_cptr kp0=shm3+LDS_K+hi*1024+r32*16; const lds_cptr vp0=shm3+LDS_V+((lane>>4)&1)*32+(lane&3)*8+(4*hi+((lane&15)>>2))*64;
  DMA_K(0,0);DMA_V(0,0);DMA_K(1,SLOTB);
  bf16x8 qr[4];
  #pragma unroll
  for(int d0=0;d0<4;++d0)qr[d0]=*reinterpret_cast<const bf16x8*>(&Qw[(long)r32*QP+d0*16+hi*8]);
  float mhat=0.f,l_reg=0.f;f32x16 o[2];o[0]=f32x16{};o[1]=f32x16{};f32x16 negm=f32x16{};asm volatile("":"+v"(negm));
  const float qf=(float)(q0+wid*QBLK+r32-4*hi);
  const int n_r=q0+(wid>>1), n_c=(wid&1)*32+r32, n_rs=min(max(n_r-4,0),120), n_kc=4*hi-min(max(n_c-8,0),48);
  typedef __attribute__((address_space(3))) const float* lds_fptr;
  const lds_fptr n_tb=(lds_fptr)((__attribute__((address_space(3))) const char*)shm+LDS_TB)+(7-n_r)*31+4*hi-n_c+15;
  #define CMASK(P0,P1,t) do{ if(MODE==0){ const float dq_=qf-(float)(64*(t)); _Pragma("unroll") for(int r=0;r<16;++r){ const float cr_=(float)((r&3)+8*(r>>2)); \
      P0[r]=__builtin_fmaf(nsl2,__builtin_fabsf(dq_-cr_),P0[r]); P1[r]=__builtin_fmaf(nsl2,__builtin_fabsf(dq_-(cr_+32.f)),P1[r]); } } \
    else { const int kr_=t_lo+(t); const bool vr_=(kr_>=n_rs)&&(kr_<n_rs+8); const lds_fptr tb_=n_tb+kr_*31; \
      _Pragma("unroll") for(int r=0;r<16;++r){ const int ko_=(r&3)+8*(r>>2); const float b0_=tb_[ko_],b1_=tb_[ko_+32]; \
        const bool ok0_=vr_&&((unsigned)(n_kc+ko_)<16u), ok1_=vr_&&((unsigned)(n_kc+ko_+32)<16u); \
        P0[r]=ok0_?P0[r]+b0_:-INFINITY; P1[r]=ok1_?P1[r]+b1_:-INFINITY; } } }while(0)
  bool resc=false;
  #define START(P0,P1) do{ const float rm=rowmax(P0,P1); resc=false; \
    { const float dl=(rm>-1e30f)?rm:0.f; mhat=fadd_s(mhat,dl); \
      _Pragma("unroll") for(int r=0;r<16;++r){P0[r]=fsub_s(P0[r],dl);P1[r]=fsub_s(P1[r],dl);} \
      _Pragma("unroll") for(int r=0;r<16;++r)negm[r]=-mhat; asm volatile("":"+v"(negm)); } \
    _Pragma("unroll") for(int r=0;r<16;++r)P0[r]=__builtin_amdgcn_exp2f(P0[r]); }while(0)
  #define RESC() do{ if(resc){ asm volatile("s_waitcnt lgkmcnt(0)":::"memory"); \
      _Pragma("unroll") for(int d_=0;d_<2;++d_) _Pragma("unroll") for(int r=0;r<16;++r)o[d_][r]*=wsf[crow(r,hi)]; } }while(0)
  f32x16 pA0,pA1,pB0,pB1;
  int sl_prev=0,sl_cur=0,sl_next=SLOTB;
  #define ROT() do{sl_prev=sl_cur;sl_cur=sl_next;sl_next=(sl_next==(NSLOT-1)*SLOTB)?0:sl_next+SLOTB;}while(0)
  DMA_K(2,2*SLOTB);
  WAIT_BAR(3);
  qkt(pA0,pA1,Kbase,qr,negm,r32,hi);asm volatile("s_nop 15\n\ts_nop 7":"+v"(pA0),"+v"(pA1));CMASK(pA0,pA1,0);
  START(pA0,pA1);
  _Pragma("unroll") for(int r=0;r<16;++r)pA1[r]=__builtin_amdgcn_exp2f(pA1[r]);
  WAIT_BAR(0);
  DMA_K(3,0);DMA_V(1,SLOTB);
  ROT();
  kload8(kf,kp0+sl_cur);
  WAIT_BAR(2);
  s16x4 vlo[8],vhi[8]; u32x4 pw0,pw1,pw2,pw3;
  #define PKW(P,B) cvtpk_s(P[B],P[B+1])
  #define PAF(k) __builtin_bit_cast(bf16x8,pw##k)
  #define VFR(i) (bf16x8){vlo[i][0],vlo[i][1],vlo[i][2],vlo[i][3],vhi[i][0],vhi[i][1],vhi[i][2],vhi[i][3]}
  #define PIN(x) asm volatile("":"+v"(x))
  #define MX3(a,b,c) __builtin_fmaxf(__builtin_fmaxf((a),(b)),(c))
  #define GAPA(MF,A0,A1,A2,A3,W0,W1,PW) do{ MF; sacc+=A0; sacc+=A1; sacc+=A2; sacc+=A3; PIN(sacc); W0; W1; PIN(PW); SBAR(); }while(0)
  #define EX(v) __builtin_amdgcn_exp2f(v)
  #define GAPB(MF,X,B) do{ MF; X[B]=EX(X[B]); X[B+1]=EX(X[B+1]); X[B+2]=EX(X[B+2]); X[B+3]=EX(X[B+3]); PIN(X); SBAR(); }while(0)
  #define VRD(i) do{ vlo[i]=vtr(vp_+(((i)>>2)*4096+((i)&3)*1024)); vhi[i]=vtr(vp_+(((i)>>2)*4096+((i)&3)*1024+512)); }while(0)
  #define KRD(G,j) do{ if(G){ kload2(kf,kp0+sl_next,j); SBAR(); } }while(0)
  #define STEP(C0,C1,P0,P1,t,GK,GV,GL) do{ SBAR(); \
    const lds_cptr vp_=vp0+sl_prev; \
    VRD(0); SBAR(); float sacc=(P0[0]+P0[1]); \
    GAPA(C0=__builtin_amdgcn_mfma_f32_32x32x16_bf16(kf[0],qr[0],negm,0,0,0), P0[2],P0[3],P0[4],P0[5],     pw0[0]=PKW(P0,0), pw0[1]=PKW(P0,2), pw0); \
    VRD(4); SBAR(); GAPA(C1=__builtin_amdgcn_mfma_f32_32x32x16_bf16(kf[1],qr[0],negm,0,0,0), P0[6],P0[7],P0[8],P0[9],     pw0[2]=PKW(P0,4), pw0[3]=PKW(P0,6), pw0); \
    VRD(1); SBAR(); GAPA(C0=__builtin_amdgcn_mfma_f32_32x32x16_bf16(kf[2],qr[1],C0,0,0,0),   P0[10],P0[11],P0[12],P0[13], pw1[0]=PKW(P0,8), pw1[1]=PKW(P0,10), pw1); \
    VRD(5); SBAR(); GAPA(C1=__builtin_amdgcn_mfma_f32_32x32x16_bf16(kf[3],qr[1],C1,0,0,0),   P0[14],P0[15],P1[0],P1[1],   pw1[2]=PKW(P0,12),pw1[3]=PKW(P0,14), pw1); \
    VRD(2); SBAR(); GAPA(C0=__builtin_amdgcn_mfma_f32_32x32x16_bf16(kf[4],qr[2],C0,0,0,0),   P1[2],P1[3],P1[4],P1[5],     pw2[0]=PKW(P1,0), pw2[1]=PKW(P1,2), pw2); \
    VRD(6); SBAR(); GAPA(C1=__builtin_amdgcn_mfma_f32_32x32x16_bf16(kf[5],qr[2],C1,0,0,0),   P1[6],P1[7],P1[8],P1[9],     pw2[2]=PKW(P1,4), pw2[3]=PKW(P1,6), pw2); \
    VRD(3); SBAR(); GAPA(C0=__builtin_amdgcn_mfma_f32_32x32x16_bf16(kf[6],qr[3],C0,0,0,0),   P1[10],P1[11],P1[12],P1[13], pw3[0]=PKW(P1,8), pw3[1]=PKW(P1,10), pw3); \
    VRD(7); SBAR(); GAPA(C1=__builtin_amdgcn_mfma_f32_32x32x16_bf16(kf[7],qr[3],C1,0,0,0),   P1[14],P1[15],0.f,0.f,       pw3[2]=PKW(P1,12),pw3[3]=PKW(P1,14), pw3); \
    l_reg+=sacc; \
    if(GK){DMA_K((t)+3,sl_cur);} if(GV){DMA_V((t)+1,sl_next);} \
    CMASK(C0,C1,t); \
    { float a=MX3(C0[0],C0[1],C1[0]),b=MX3(C0[2],C0[3],C1[1]); a=MX3(a,C1[2],C1[3]); \
      _Pragma("unroll") for(int r=4;r<16;r+=4){a=MX3(a,C0[r],C0[r+1]);b=MX3(b,C0[r+2],C0[r+3]);a=MX3(a,C1[r],C1[r+1]);b=MX3(b,C1[r+2],C1[r+3]);} \
      float rm=__builtin_fmaxf(a,b); { auto rr=__builtin_amdgcn_permlane32_swap(__float_as_uint(rm),__float_as_uint(rm),false,false); rm=__builtin_fmaxf(__uint_as_float(rr[0]),__uint_as_float(rr[1])); } \
      resc=false; \
      if(__builtin_expect(__any(rm>(float)THRL),0)){ const float dl=__builtin_fmaxf(rm,0.f); mhat+=dl; \
        _Pragma("unroll") for(int r=0;r<16;++r){C0[r]-=dl;C1[r]-=dl;} \
        _Pragma("unroll") for(int r=0;r<16;++r)negm[r]=-mhat; asm volatile("":"+v"(negm)); \
        const float f=__builtin_amdgcn_exp2f(-dl); l_reg*=f; if(hi==0)wsf[r32]=f; resc=true; } } \
    SBAR(); \
    GAPB(o[0]=__builtin_amdgcn_mfma_f32_32x32x16_bf16(PAF(0),VFR(0),o[0],0,0,0), C0,0); \
    GAPB(o[1]=__builtin_amdgcn_mfma_f32_32x32x16_bf16(PAF(0),VFR(4),o[1],0,0,0), C0,4); \
    KRD(GL,0); GAPB(o[0]=__builtin_amdgcn_mfma_f32_32x32x16_bf16(PAF(1),VFR(1),o[0],0,0,0), C0,8); \
    KRD(GL,1); GAPB(o[1]=__builtin_amdgcn_mfma_f32_32x32x16_bf16(PAF(1),VFR(5),o[1],0,0,0), C0,12); \
    KRD(GL,2); GAPB(o[0]=__builtin_amdgcn_mfma_f32_32x32x16_bf16(PAF(2),VFR(2),o[0],0,0,0), C1,0); \
    KRD(GL,3); GAPB(o[1]=__builtin_amdgcn_mfma_f32_32x32x16_bf16(PAF(2),VFR(6),o[1],0,0,0), C1,4); \
    GAPB(o[0]=__builtin_amdgcn_mfma_f32_32x32x16_bf16(PAF(3),VFR(3),o[0],0,0,0), C1,8); \
    GAPB(o[1]=__builtin_amdgcn_mfma_f32_32x32x16_bf16(PAF(3),VFR(7),o[1],0,0,0), C1,12); \
    }while(0)
  int t=1;
  for(;t+5<NT;t+=2){
    STEP(pB0,pB1,pA0,pA1,t,true,true,true);     WAIT_BAR(2); RESC(); ROT();
    STEP(pA0,pA1,pB0,pB1,t+1,true,true,true);   WAIT_BAR(2); RESC(); ROT();
  }
  #define ENDW(tt) do{ if((tt)+3<NT){WAIT_BAR(2);} else if((tt)+2<NT){WAIT_BAR(1);} else {WAIT_BAR(0);} }while(0)
  for(;t+1<NT;t+=2){
    STEP(pB0,pB1,pA0,pA1,t,(t+3<NT),(t+1<NT),(t+1<NT));       ENDW(t);   RESC(); ROT();
    STEP(pA0,pA1,pB0,pB1,t+1,(t+4<NT),(t+2<NT),(t+2<NT));     ENDW(t+1); RESC(); ROT();
  }
  STEP(pB0,pB1,pA0,pA1,NT-1,false,false,false); RESC();
  { float sacc=pB0[0]+pB0[1]; _Pragma("unroll") for(int r=2;r<16;++r)sacc+=pB0[r]; _Pragma("unroll") for(int r=0;r<16;++r)sacc+=pB1[r]; l_reg+=sacc;
    pw0=(u32x4){PKW(pB0,0),PKW(pB0,2),PKW(pB0,4),PKW(pB0,6)};pw1=(u32x4){PKW(pB0,8),PKW(pB0,10),PKW(pB0,12),PKW(pB0,14)};pw2=(u32x4){PKW(pB1,0),PKW(pB1,2),PKW(pB1,4),PKW(pB1,6)};pw3=(u32x4){PKW(pB1,8),PKW(pB1,10),PKW(pB1,12),PKW(pB1,14)};
    SBAR(); pv(o,vb0+sl_cur,PAF(0),PAF(1),PAF(2),PAF(3)); }
  #undef PKW
  #undef PAF
  #undef VFR
  #undef PIN
  #undef MX3
  #undef GAPA
  #undef GAPB
  #undef EX
  #undef VRD
  #undef KRD
  #undef STEP
  #undef ENDW
  {auto rr=__builtin_amdgcn_permlane32_swap(__float_as_uint(l_reg),__float_as_uint(l_reg),false,false);l_reg=__uint_as_float(rr[0])+__uint_as_float(rr[1]);}
  if(hi==0)wsf[32+r32]=l_reg;asm volatile("s_waitcnt lgkmcnt(0)":::"memory");
  float rli[16];
  #pragma unroll
  for(int r=0;r<16;++r)rli[r]=__builtin_amdgcn_rcpf(wsf[32+crow(r,hi)]);
  bf16*Ow=Ou+(long)(wid*QBLK)*OP;
  { bf16*stg=(bf16*)(shm+LDS_OST)+wid*2048;
    #pragma unroll
    for(int r=0;r<16;++r){const int orow=crow(r,hi);
      #pragma unroll
      for(int d0=0;d0<2;++d0)stg[orow*64+d0*32+r32]=__float2bfloat16(o[d0][r]*rli[r]);}
    asm volatile("s_waitcnt lgkmcnt(0)":::"memory");
    #pragma unroll
    for(int i=0;i<4;++i){const int row=i*8+(lane>>3),ch=lane&7; const u32x4 v=*(const u32x4*)(stg+row*64+ch*8); ATTN_STORE16(Ow+(long)row*OP+ch*8,v);} }
  asm volatile("s_waitcnt lgkmcnt(0)\n\ts_barrier":::"memory");
  #undef DMA_K
  #undef DMA_V
  #undef CMASK
  #undef START
  #undef RESC
  #undef ROT
}
constexpr int W_K=0, W_V=NSLOT*SLOTB, W_WS=W_V+NSLOT*2*SLOTB, W_OST=W_WS+NW*64*4, W_BYTES=W_OST+NW*4096;
template<int THRL> __device__ __forceinline__ void attn_unit128(const bf16*Qu,const bf16*__restrict__ Kb,const bf16*__restrict__ Vb,bf16*od,unsigned o_off,unsigned*done,int q0a,float kn,float nsl2,char*shm){
  constexpr int OP=512;
  const __amdgpu_buffer_rsrc_t orsrc=__builtin_amdgcn_make_buffer_rsrc(od,0,2*2*SEQ*512*2,0x00020000);
  int tid_=threadIdx.x; asm volatile("":"+v"(tid_));
  const int tid=tid_,lane=tid&63,r32=lane&31,hi=lane>>5; const int wid=__builtin_amdgcn_readfirstlane(tid>>6);
  const bf16*Qw=Qu+(long)(wid*QBLK)*QP;
  const unsigned lds0=(unsigned)(uintptr_t)shm;
  float*wsf=(float*)(shm+W_WS)+wid*64;
  bf16x8 qr[4];
  #pragma unroll
  for(int d0=0;d0<4;++d0)qr[d0]=*reinterpret_cast<const bf16x8*>(&Qw[(long)r32*QP+d0*16+hi*8]);
  int t_lo,NT;
  {
    const int rowp=q0a+wid*QBLK+r32; const bf16*kd=Kb+(long)(rowp>>6)*4096+(rowp&63)*8+hi*512;
    float dot=0.f,nq=0.f;
    #pragma unroll
    for(int d0=0;d0<4;++d0){ const bf16x8 kv=*reinterpret_cast<const bf16x8*>(kd+d0*1024);
      #pragma unroll
      for(int j=0;j<8;++j){ const float qv=__uint_as_float(((unsigned)(unsigned short)qr[d0][j])<<16), kvf=__uint_as_float(((unsigned)(unsigned short)kv[j])<<16); dot=__builtin_fmaf(qv,kvf,dot); nq=__builtin_fmaf(qv,qv,nq); } }
    { auto r1=__builtin_amdgcn_permlane32_swap(__float_as_uint(dot),__float_as_uint(dot),false,false); dot=__uint_as_float(r1[0])+__uint_as_float(r1[1]);
      auto r2=__builtin_amdgcn_permlane32_swap(__float_as_uint(nq),__float_as_uint(nq),false,false); nq=__uint_as_float(r2[0])+__uint_as_float(r2[1]); }
    #pragma unroll
    for(int o_=1;o_<32;o_<<=1){ dot=__builtin_fminf(dot,__shfl_xor(dot,o_)); nq=__builtin_fmaxf(nq,__shfl_xor(nq,o_)); }
    float*xs=(float*)(shm+W_WS);
    if(lane==0){ xs[wid]=dot; xs[8+wid]=nq; }
    asm volatile("s_waitcnt lgkmcnt(0)\n\ts_barrier":::"memory");
    float smin=xs[0],q2=xs[8];
    #pragma unroll
    for(int w_=1;w_<8;++w_){ smin=__builtin_fminf(smin,xs[w_]); q2=__builtin_fmaxf(q2,xs[8+w_]); }
    asm volatile("s_waitcnt lgkmcnt(0)\n\ts_barrier":::"memory");
    const float R=(__builtin_sqrtf(q2)*kn-smin+40.f)/(-nsl2);
    int tl=(int)__builtin_fmaxf(__builtin_floorf(((float)q0a-R)*(1.f/64.f)),0.f), th=(int)__builtin_fminf(__builtin_floorf(((float)(q0a+QB-1)+R)*(1.f/64.f)),(float)(SEQ/KVBLK-1));
    if(((th-tl+1)&1)!=0){ if(tl>0)--tl; else ++th; }
    t_lo=__builtin_amdgcn_readfirstlane(tl); NT=__builtin_amdgcn_readfirstlane(th-tl+1); }
  const int q0=q0a-t_lo*KVBLK; const bf16*Kh=Kb+(long)t_lo*4096,*Vh=Vb+(long)t_lo*8192;
  const bf16*ksrc=Kh+wid*512+lane*8;
  const bf16*vsrc=Vh+wid*512+lane*8;
  const unsigned kdst=lds0+W_K+wid*1024, vdst=lds0+W_V+wid*1024;
  const int tdf=q0>>6, Lr=NT-tdf;
  #define TMAP(s_) (((s_)<Lr)?(tdf+(s_)):(tdf-1-((s_)-Lr)))
  #define DMA_K(t,slot) glds16(ksrc+(long)TMAP(t)*4096,(unsigned)__builtin_amdgcn_readfirstlane(kdst+(slot)))
  #define DMA_V(t,slot) do{ const long tv_=(long)TMAP(t)*8192; glds16(vsrc+tv_,(unsigned)__builtin_amdgcn_readfirstlane(vdst+2*(slot))); glds16(vsrc+tv_+4096,(unsigned)__builtin_amdgcn_readfirstlane(vdst+2*(slot)+8192)); }while(0)
  const int vb0=(int)(lds0+W_V)+((lane>>4)&1)*32+(lane&3)*8+(4*hi+((lane&15)>>2))*64;
  bf16x8 kf[8];
  const lds_cptr shm3=(lds_cptr)shm; const lds_cptr kp0=shm3+W_K+hi*1024+r32*16; const lds_cptr vp0=shm3+W_V+((lane>>4)&1)*32+(lane&3)*8+(4*hi+((lane&15)>>2))*64;
  DMA_K(0,0);DMA_V(0,0);DMA_K(1,SLOTB);
  float mhat=0.f,l_reg=0.f;f32x16 o[4];o[0]=f32x16{};o[1]=f32x16{};o[2]=f32x16{};o[3]=f32x16{};
  const float qf=(float)(q0+wid*QBLK+r32-4*hi);
  const int td=(q0>>6)+(wid>>1);
  #define CINIT(C0,C1,t) do{ const int tt_=TMAP(t); const float dq_=qf-(float)(64*tt_); \
    if(tt_==td){ _Pragma("unroll") for(int r=0;r<16;++r){ const float cr_=(float)((r&3)+8*(r>>2)); \
        C0[r]=__builtin_fmaf(nsl2,__builtin_fabsf(dq_-cr_),-mhat); C1[r]=__builtin_fmaf(nsl2,__builtin_fabsf(dq_-(cr_+32.f)),-mhat); } } \
    else { const float k_=(tt_<td)?-nsl2:nsl2; const float b_=__builtin_fmaf(-k_,dq_,-mhat); const float k8_=8.f*k_, k32_=32.f*k_; \
        \
      C0[0]=b_; C0[1]=fadd_s(C0[0],k_); C0[2]=fadd_s(C0[1],k_); C0[3]=fadd_s(C0[2],k_); \
      _Pragma("unroll") for(int r=4;r<16;++r)C0[r]=fadd_s(C0[r-4],k8_); \
      _Pragma("unroll") for(int r=0;r<16;++r)C1[r]=fadd_s(C0[r],k32_); } }while(0)
  bool resc=false;
  #define START(P0,P1) do{ const float rm=rowmax(P0,P1); resc=false; \
    { const float dl=rm; mhat=fadd_s(mhat,dl); \
      _Pragma("unroll") for(int r=0;r<16;++r){P0[r]=fsub_s(P0[r],dl);P1[r]=fsub_s(P1[r],dl);} } \
    _Pragma("unroll") for(int r=0;r<16;++r)P0[r]=__builtin_amdgcn_exp2f(P0[r]); }while(0)
  #define RESC() do{ if(resc){ asm volatile("s_waitcnt lgkmcnt(0)":::"memory"); \
      _Pragma("unroll") for(int d_=0;d_<4;++d_) _Pragma("unroll") for(int r=0;r<16;++r)o[d_][r]*=wsf[crow(r,hi)]; } }while(0)
  f32x16 pA0,pA1,pB0,pB1;
  int sl_prev=0,sl_cur=0,sl_next=SLOTB;
  #define ROT() do{sl_prev=sl_cur;sl_cur=sl_next;sl_next=(sl_next==(NSLOT-1)*SLOTB)?0:sl_next+SLOTB;}while(0)
  DMA_K(2,2*SLOTB);
  WAIT_BAR(4);
  CINIT(pA0,pA1,0);
  { const lds_cptr kb=kp0;
    #pragma unroll
    for(int d0=0;d0<4;++d0){ const bf16x8 b0=*(const __attribute__((address_space(3))) bf16x8*)(kb+d0*2048), b1=*(const __attribute__((address_space(3))) bf16x8*)(kb+d0*2048+512);
      pA0=__builtin_amdgcn_mfma_f32_32x32x16_bf16(b0,qr[d0],pA0,0,0,0); pA1=__builtin_amdgcn_mfma_f32_32x32x16_bf16(b1,qr[d0],pA1,0,0,0); } }
  asm volatile("s_nop 15\n\ts_nop 7":"+v"(pA0),"+v"(pA1));
  START(pA0,pA1);
  _Pragma("unroll") for(int r=0;r<16;++r)pA1[r]=__builtin_amdgcn_exp2f(pA1[r]);
  WAIT_BAR(0);
  DMA_K(3,0);DMA_V(1,SLOTB);
  ROT();
  kload8(kf,kp0+sl_cur);
  WAIT_BAR(3);
  s16x4 vlo[8],vhi[8]; u32x4 pw0,pw1,pw2,pw3;
  #define PKW(P,B) cvtpk_s(P[B],P[B+1])
  #define PAF(k) __builtin_bit_cast(bf16x8,pw##k)
  #define VFR(i) (bf16x8){vlo[i][0],vlo[i][1],vlo[i][2],vlo[i][3],vhi[i][0],vhi[i][1],vhi[i][2],vhi[i][3]}
  #define PIN(x) asm volatile("":"+v"(x))
  #define MX3(a,b,c) __builtin_fmaxf(__builtin_fmaxf((a),(b)),(c))
  #define GAPA(MF,A0,A1,A2,A3,W0,W1,PW) do{ MF; sacc+=A0; sacc+=A1; sacc+=A2; sacc+=A3; PIN(sacc); W0; W1; PIN(PW); SBAR(); }while(0)
  #define EX(v) __builtin_amdgcn_exp2f(v)
  #define GAPB(MF,X,B) do{ MF; X[B]=EX(X[B]); X[B+1]=EX(X[B+1]); PIN(X); SBAR(); }while(0)
  #define VRD(i) do{ vlo[i]=vtr(vp_+(((i)>>2)*4096+((i)&3)*1024)); vhi[i]=vtr(vp_+(((i)>>2)*4096+((i)&3)*1024+512)); }while(0)
  #define VRD2(i) do{ vlo[i]=vtr(vp_+(8192+((i)>>2)*4096+((i)&3)*1024)); vhi[i]=vtr(vp_+(8192+((i)>>2)*4096+((i)&3)*1024+512)); SBAR(); }while(0)
  #define KRD(G,j) do{ if(G){ kload2(kf,kp0+sl_next,j); SBAR(); } }while(0)
  #define STEP(C0,C1,P0,P1,t,GK,GV,GL) do{ SBAR(); \
    const lds_cptr vp_=vp0+2*sl_prev; \
    CINIT(C0,C1,t); SBAR(); \
    VRD(0); SBAR(); float sacc=(P0[0]+P0[1]); \
    GAPA(C0=__builtin_amdgcn_mfma_f32_32x32x16_bf16(kf[0],qr[0],C0,0,0,0), P0[2],P0[3],P0[4],P0[5],     pw0[0]=PKW(P0,0), pw0[1]=PKW(P0,2), pw0); \
    VRD(4); SBAR(); GAPA(C1=__builtin_amdgcn_mfma_f32_32x32x16_bf16(kf[1],qr[0],C1,0,0,0), P0[6],P0[7],P0[8],P0[9],     pw0[2]=PKW(P0,4), pw0[3]=PKW(P0,6), pw0); \
    VRD(1); SBAR(); GAPA(C0=__builtin_amdgcn_mfma_f32_32x32x16_bf16(kf[2],qr[1],C0,0,0,0),   P0[10],P0[11],P0[12],P0[13], pw1[0]=PKW(P0,8), pw1[1]=PKW(P0,10), pw1); \
    VRD(5); SBAR(); GAPA(C1=__builtin_amdgcn_mfma_f32_32x32x16_bf16(kf[3],qr[1],C1,0,0,0),   P0[14],P0[15],P1[0],P1[1],   pw1[2]=PKW(P0,12),pw1[3]=PKW(P0,14), pw1); \
    VRD(2); SBAR(); GAPA(C0=__builtin_amdgcn_mfma_f32_32x32x16_bf16(kf[4],qr[2],C0,0,0,0),   P1[2],P1[3],P1[4],P1[5],     pw2[0]=PKW(P1,0), pw2[1]=PKW(P1,2), pw2); \
    VRD(6); SBAR(); GAPA(C1=__builtin_amdgcn_mfma_f32_32x32x16_bf16(kf[5],qr[2],C1,0,0,0),   P1[6],P1[7],P1[8],P1[9],     pw2[2]=PKW(P1,4), pw2[3]=PKW(P1,6), pw2); \
    VRD(3); SBAR(); GAPA(C0=__builtin_amdgcn_mfma_f32_32x32x16_bf16(kf[6],qr[3],C0,0,0,0),   P1[10],P1[11],P1[12],P1[13], pw3[0]=PKW(P1,8), pw3[1]=PKW(P1,10), pw3); \
    VRD(7); SBAR(); GAPA(C1=__builtin_amdgcn_mfma_f32_32x32x16_bf16(kf[7],qr[3],C1,0,0,0),   P1[14],P1[15],0.f,0.f,       pw3[2]=PKW(P1,12),pw3[3]=PKW(P1,14), pw3); \
    l_reg+=sacc; \
    if(GK){DMA_K((t)+3,sl_cur);} if(GV){DMA_V((t)+1,sl_next);} \
    { float a=MX3(C0[0],C0[1],C1[0]),b=MX3(C0[2],C0[3],C1[1]); a=MX3(a,C1[2],C1[3]); \
      _Pragma("unroll") for(int r=4;r<16;r+=4){a=MX3(a,C0[r],C0[r+1]);b=MX3(b,C0[r+2],C0[r+3]);a=MX3(a,C1[r],C1[r+1]);b=MX3(b,C1[r+2],C1[r+3]);} \
      float rm=__builtin_fmaxf(a,b); { auto rr=__builtin_amdgcn_permlane32_swap(__float_as_uint(rm),__float_as_uint(rm),false,false); rm=__builtin_fmaxf(__uint_as_float(rr[0]),__uint_as_float(rr[1])); } \
      resc=false; \
      if(__builtin_expect(__any(rm>(float)THRL),0)){ const float dl=__builtin_fmaxf(rm,0.f); mhat+=dl; \
        _Pragma("unroll") for(int r=0;r<16;++r){C0[r]-=dl;C1[r]-=dl;} \
        const float f=__builtin_amdgcn_exp2f(-dl); l_reg*=f; if(hi==0)wsf[r32]=f; resc=true; } } \
    SBAR(); \
    GAPB(o[0]=__builtin_amdgcn_mfma_f32_32x32x16_bf16(PAF(0),VFR(0),o[0],0,0,0), C0,0); \
    GAPB(o[1]=__builtin_amdgcn_mfma_f32_32x32x16_bf16(PAF(0),VFR(4),o[1],0,0,0), C0,2);  VRD2(0); \
    GAPB(o[0]=__builtin_amdgcn_mfma_f32_32x32x16_bf16(PAF(1),VFR(1),o[0],0,0,0), C0,4);  VRD2(4); \
    GAPB(o[1]=__builtin_amdgcn_mfma_f32_32x32x16_bf16(PAF(1),VFR(5),o[1],0,0,0), C0,6);  VRD2(1); \
    GAPB(o[0]=__builtin_amdgcn_mfma_f32_32x32x16_bf16(PAF(2),VFR(2),o[0],0,0,0), C0,8);  VRD2(5); \
    GAPB(o[1]=__builtin_amdgcn_mfma_f32_32x32x16_bf16(PAF(2),VFR(6),o[1],0,0,0), C0,10); VRD2(2); \
    GAPB(o[0]=__builtin_amdgcn_mfma_f32_32x32x16_bf16(PAF(3),VFR(3),o[0],0,0,0), C0,12); VRD2(6); \
    GAPB(o[1]=__builtin_amdgcn_mfma_f32_32x32x16_bf16(PAF(3),VFR(7),o[1],0,0,0), C0,14); VRD2(3); VRD2(7); \
    GAPB(o[2]=__builtin_amdgcn_mfma_f32_32x32x16_bf16(PAF(0),VFR(0),o[2],0,0,0), C1,0); \
    GAPB(o[3]=__builtin_amdgcn_mfma_f32_32x32x16_bf16(PAF(0),VFR(4),o[3],0,0,0), C1,2); \
    KRD(GL,0); GAPB(o[2]=__builtin_amdgcn_mfma_f32_32x32x16_bf16(PAF(1),VFR(1),o[2],0,0,0), C1,4); \
    KRD(GL,1); GAPB(o[3]=__builtin_amdgcn_mfma_f32_32x32x16_bf16(PAF(1),VFR(5),o[3],0,0,0), C1,6); \
    KRD(GL,2); GAPB(o[2]=__builtin_amdgcn_mfma_f32_32x32x16_bf16(PAF(2),VFR(2),o[2],0,0,0), C1,8); \
    KRD(GL,3); GAPB(o[3]=__builtin_amdgcn_mfma_f32_32x32x16_bf16(PAF(2),VFR(6),o[3],0,0,0), C1,10); \
    GAPB(o[2]=__builtin_amdgcn_mfma_f32_32x32x16_bf16(PAF(3),VFR(3),o[2],0,0,0), C1,12); \
    GAPB(o[3]=__builtin_amdgcn_mfma_f32_32x32x16_bf16(PAF(3),VFR(7),o[3],0,0,0), C1,14); \
    }while(0)
  int t=1;
  for(;t+5<NT;t+=2){
    STEP(pB0,pB1,pA0,pA1,t,true,true,true);     WAIT_BAR(3); RESC(); ROT();
    STEP(pA0,pA1,pB0,pB1,t+1,true,true,true);   WAIT_BAR(3); RESC(); ROT();
  }
  #define ENDW(tt) do{ if((tt)+3<NT){WAIT_BAR(3);} else if((tt)+2<NT){WAIT_BAR(2);} else {WAIT_BAR(0);} }while(0)
  for(;t+1<NT;t+=2){
    STEP(pB0,pB1,pA0,pA1,t,(t+3<NT),(t+1<NT),(t+1<NT));       ENDW(t);   RESC(); ROT();
    STEP(pA0,pA1,pB0,pB1,t+1,(t+4<NT),(t+2<NT),(t+2<NT));     ENDW(t+1); RESC(); ROT();
  }
  STEP(pB0,pB1,pA0,pA1,NT-1,false,false,false); RESC();
  { float sacc=pB0[0]+pB0[1]; _Pragma("unroll") for(int r=2;r<16;++r)sacc+=pB0[r]; _Pragma("unroll") for(int r=0;r<16;++r)sacc+=pB1[r]; l_reg+=sacc;
    pw0=(u32x4){PKW(pB0,0),PKW(pB0,2),PKW(pB0,4),PKW(pB0,6)};pw1=(u32x4){PKW(pB0,8),PKW(pB0,10),PKW(pB0,12),PKW(pB0,14)};pw2=(u32x4){PKW(pB1,0),PKW(pB1,2),PKW(pB1,4),PKW(pB1,6)};pw3=(u32x4){PKW(pB1,8),PKW(pB1,10),PKW(pB1,12),PKW(pB1,14)};
    SBAR(); pv(o,vb0+2*sl_cur,PAF(0),PAF(1),PAF(2),PAF(3)); pv(o+2,vb0+2*sl_cur+8192,PAF(0),PAF(1),PAF(2),PAF(3)); }
  #undef PKW
  #undef PAF
  #undef VFR
  #undef PIN
  #undef MX3
  #undef GAPA
  #undef GAPB
  #undef EX
  #undef VRD
  #undef VRD2
  #undef KRD
  #undef STEP
  #undef ENDW
  {auto rr=__builtin_amdgcn_permlane32_swap(__float_as_uint(l_reg),__float_as_uint(l_reg),false,false);l_reg=__uint_as_float(rr[0])+__uint_as_float(rr[1]);}
  if(hi==0)wsf[32+r32]=l_reg;asm volatile("s_waitcnt lgkmcnt(0)":::"memory");
  float rli[16];
  #pragma unroll
  for(int r=0;r<16;++r)rli[r]=__builtin_amdgcn_rcpf(wsf[32+crow(r,hi)]);
  const unsigned ow_off=o_off+(unsigned)(wid*QBLK)*OP;
  { bf16*stg=(bf16*)(shm+W_OST)+wid*2048;
    #pragma unroll
    for(int hf=0;hf<2;++hf){
      #pragma unroll
      for(int r=0;r<16;++r){const int orow=crow(r,hi);
        #pragma unroll
        for(int d0=0;d0<2;++d0)stg[orow*64+d0*32+r32]=__float2bfloat16(o[hf*2+d0][r]*rli[r]);}
      asm volatile("s_waitcnt lgkmcnt(0)":::"memory");
      #pragma unroll
      for(int i=0;i<4;++i){const int row=i*8+(lane>>3),ch=lane&7; const u32x4 v=*(const u32x4*)(stg+row*64+ch*8); __builtin_amdgcn_raw_buffer_store_b128(v,orsrc,(ow_off+(unsigned)(row*OP+hf*64+ch*8))*2u,0,16);}
      asm volatile("s_waitcnt lgkmcnt(0)":::"memory"); } }
  asm volatile("s_waitcnt vmcnt(0) lgkmcnt(0)\n\ts_barrier":::"memory");
  if(tid==0) __hip_atomic_fetch_add(done,1u,__ATOMIC_RELAXED,__HIP_MEMORY_SCOPE_AGENT);
  #undef DMA_K
  #undef DMA_V
  #undef TMAP
  #undef CINIT
  #undef START
  #undef RESC
  #undef ROT
}
constexpr int ATTN_LDS_BYTES=LDS_BYTES;
constexpr int LDS_QW=W_BYTES;
template<int THRL=8> __device__ __forceinline__ void attn_one(int u,char*lds,const bf16*proj,const bf16*kimg,const bf16*vimg,bf16*od,const unsigned*nrm,unsigned*done){
    const int h=3-(u>>7), r=u&127, map=r>>6, b=(r>>5)&1, qb=r&31;
    const float sl2=__builtin_amdgcn_exp2f(-2.f*(float)(h+1))*1.4426950408889634f;
    const unsigned* nk=nrm+((b*16+8+2*h+map)*2);
    const float kn=__builtin_sqrtf(__uint_as_float(nk[0])+__uint_as_float(nk[1]));
    const int q0=qb*QB; const long row0=(long)b*SEQ;
    attn_unit128<THRL>(proj+(row0+q0)*QP+h*128+map*64, kimg+(long)((b*4+h)*2+map)*128*4096, vimg+(long)(b*4+h)*128*8192,
                    od, (unsigned)(((long)map*(2*SEQ)+row0+q0)*512+h*128), done+(b*32+qb)*64, q0, kn, -sl2, lds);
}
template<int THRL=8> __device__ __forceinline__ void nat_one(int u,char*lds,const bf16*proj,bf16*concat,const float*rpb){
    const int tid=threadIdx.x;
    const int h=u&7,rb=u>>3,b=rb>>5,r0=(rb&31)*4;
    const int lo=min(max(r0-4,0),120), hi_=min(max(r0-1,0),120)+7; int nt=hi_-lo+1; nt+=nt&1;
    const long row0=(long)b*SEQ;
    __attribute__((address_space(3))) float* tb=(__attribute__((address_space(3))) float*)((__attribute__((address_space(3))) char*)lds+LDS_TB);
    if(tid<15*31) tb[tid]=rpb[h*15*31+tid]*1.4426950408889634f;
    attn_unit<1,1024,THRL>(proj+(row0+r0*64)*QP+1536+h*64, proj+(row0+lo*64)*KP+2048+h*64, proj+(row0+lo*64)*KP+2560+h*64,
                    concat+(row0+r0*64)*1024+512+h*64, r0, lo, nt, 0.f, lds);
}
#undef SBAR
#undef WAIT_BAR
}
#define XB_TMO      128
#define XB_XCNT(j)  (256  + 64 * (j))
#define XB_XSUB(j)  (1280 + 64 * (j))
#define XB_XGEN(j)  (2304 + 64 * (j))
#define XB_TOP      3328
#define XB_TOPGEN   3392
#define XCD_BAR_WORDS 3456
#define XB_SPIN_CAP (1u << 18)

__device__ __forceinline__ unsigned xb_ld(unsigned* p)              { return __hip_atomic_load(p, __ATOMIC_RELAXED, __HIP_MEMORY_SCOPE_AGENT); }
__device__ __forceinline__ unsigned xb_add(unsigned* p, unsigned v) { return __hip_atomic_fetch_add(p, v, __ATOMIC_RELAXED, __HIP_MEMORY_SCOPE_AGENT); }
__device__ __forceinline__ unsigned xb_xcc_id() { return (unsigned)__builtin_amdgcn_s_getreg((3 << 11) | 20) & 0xFu; }
#define XB_SPIN(cond, bar) do { unsigned _sp = 0; while (cond) { __builtin_amdgcn_s_sleep(1); \
    if ((++_sp & 255u) == 0u) { if (xb_ld(&(bar)[XB_TMO])) break; if (_sp > XB_SPIN_CAP) { atomicAdd(&(bar)[XB_TMO], 1u); break; } } } } while (0)

struct XcdBarrier {
    unsigned* bar; unsigned x;
    volatile LAS unsigned* st;
};

__device__ __forceinline__ XcdBarrier xcd_barrier_post(unsigned* bar, volatile LAS unsigned* st) {
    XcdBarrier b; b.bar = bar; b.x = xb_xcc_id(); b.st = st;
    if (threadIdx.x == 0) (void)xb_add(&bar[XB_XCNT(b.x)], 1u);
    return b;
}
__device__ __forceinline__ void xcd_barrier_complete(unsigned* bar, unsigned x, unsigned& nloc, unsigned& nx) {
    const unsigned G = gridDim.x * gridDim.y * gridDim.z;
    unsigned sum, cnt, mine, sp = 0u;
    for (;;) {
        sum = 0u; cnt = 0u; mine = 0u;
#pragma unroll
        for (unsigned j = 0; j < 16; ++j) { const unsigned c = xb_ld(&bar[XB_XCNT(j)]); sum += c; cnt += (c > 0u) ? 1u : 0u; mine = (j == x) ? c : mine; }
        if (sum == G) break;
        __builtin_amdgcn_s_sleep(1);
        if ((++sp & 255u) == 0u) { if (xb_ld(&bar[XB_TMO])) break; if (sp > XB_SPIN_CAP) { atomicAdd(&bar[XB_TMO], 1u); break; } }
    }
    nloc = mine > 0u ? mine : 1u; nx = cnt > 0u ? cnt : 1u;
}

__device__ __forceinline__ void xcd_barrier(const XcdBarrier& b) {
    asm volatile("s_waitcnt vmcnt(0)" ::: "memory");
    __syncthreads();
    if (threadIdx.x == 0) {
        unsigned* bar = b.bar;
        __builtin_amdgcn_s_waitcnt(0);
        unsigned nloc = b.st[0], nx = b.st[1];
        if (nloc == 0u) { xcd_barrier_complete(bar, b.x, nloc, nx); b.st[0] = nloc; b.st[1] = nx; }
        const unsigned old = xb_add(&bar[XB_XSUB(b.x)], 1u);
        const unsigned gen = old / nloc;
        if (old + 1u == (gen + 1u) * nloc) {
            __builtin_amdgcn_fence(__ATOMIC_RELEASE, "agent");
            asm volatile("s_waitcnt vmcnt(0)" ::: "memory");
            const unsigned og = xb_add(&bar[XB_TOP], 1u);
            const unsigned tg = og / nx;
            if (og + 1u == (tg + 1u) * nx) xb_add(&bar[XB_TOPGEN], 1u);
            else XB_SPIN(xb_ld(&bar[XB_TOPGEN]) == tg, bar);
            __builtin_amdgcn_fence(__ATOMIC_ACQUIRE, "agent");
            xb_add(&bar[XB_XGEN(b.x)], 1u);
            asm volatile("s_waitcnt vmcnt(0)" ::: "memory");
        } else {
            XB_SPIN(xb_ld(&bar[XB_XGEN(b.x)]) == gen, bar);
            __builtin_amdgcn_fence(__ATOMIC_ACQUIRE, "agent");
            asm volatile("s_waitcnt vmcnt(0)" ::: "memory");
        }
    }
    __syncthreads();
}
template <int CTRL> __device__ __forceinline__ float dpp_mov(float v) { return __builtin_bit_cast(float, __builtin_amdgcn_update_dpp(0, __builtin_bit_cast(int, v), CTRL, 0xF, 0xF, true)); }
__device__ __forceinline__ float wave_sum(float v) {
    v += dpp_mov<0xB1>(v); v += dpp_mov<0x4E>(v); v += dpp_mov<0x141>(v); v += dpp_mov<0x140>(v);
    { auto r = __builtin_amdgcn_permlane16_swap(__float_as_uint(v), __float_as_uint(v), false, false); v = __uint_as_float(r[0]) + __uint_as_float(r[1]); }
    { auto r = __builtin_amdgcn_permlane32_swap(__float_as_uint(v), __float_as_uint(v), false, false); v = __uint_as_float(r[0]) + __uint_as_float(r[1]); }
    return v;
}
__device__ __forceinline__ void p0_transpose_item(const float* W, int K, int N, bf16* WT, int row_off, LAS float* scr, int item, int lane) {
    const int nblk = N / 32, kb = item / nblk, nb = item % nblk, k0 = 64 * kb, n0 = 32 * nb;
#pragma unroll 8
    for (int i = 0; i < 32; ++i) { const int kk = 2 * i + (lane >> 5); scr[kk * 33 + (lane & 31)] = W[(size_t)(k0 + kk) * N + n0 + (lane & 31)]; }
    LDS_WAIT(); asm volatile("" ::: "memory");
    const int c = lane & 7;
#pragma unroll
    for (int j = 0; j < 4; ++j) { const int n = (lane >> 3) + 8 * j; const LAS float* s = scr + (8 * c) * 33 + n;
        v4u o; o.x = pk2(s[0 * 33], s[1 * 33]); o.y = pk2(s[2 * 33], s[3 * 33]); o.z = pk2(s[4 * 33], s[5 * 33]); o.w = pk2(s[6 * 33], s[7 * 33]);
        *(GAS v4u*)(WT + (size_t)(row_off + n0 + n) * K + k0 + 8 * c) = o; }
    LDS_WAIT(); asm volatile("" ::: "memory");
}
__device__ __forceinline__ unsigned pk4_fp8(float a, float b, float c, float d) {
    int w = 0; w = __builtin_amdgcn_cvt_pk_fp8_f32(__builtin_amdgcn_fmed3f(a, -448.f, 448.f), __builtin_amdgcn_fmed3f(b, -448.f, 448.f), w, false);
    w = __builtin_amdgcn_cvt_pk_fp8_f32(__builtin_amdgcn_fmed3f(c, -448.f, 448.f), __builtin_amdgcn_fmed3f(d, -448.f, 448.f), w, true); return (unsigned)w;
}
__device__ __forceinline__ void p0_transpose_item_f8(const float* W, int K, int N, unsigned char* WT, int row_off, LAS float* scr, int item, int lane, float SC) {
    const int nblk = N / 32, kb = item / nblk, nb = item % nblk, k0 = 64 * kb, n0 = 32 * nb;
#pragma unroll 8
    for (int i = 0; i < 32; ++i) { const int kk = 2 * i + (lane >> 5); scr[kk * 33 + (lane & 31)] = W[(size_t)(k0 + kk) * N + n0 + (lane & 31)]; }
    LDS_WAIT(); asm volatile("" ::: "memory");
    const int c = lane & 3;
#pragma unroll
    for (int j = 0; j < 2; ++j) { const int n = (lane >> 2) + 16 * j; const LAS float* s = scr + (16 * c) * 33 + n;
        v4u o; o.x = pk4_fp8(s[0 * 33] * SC, s[1 * 33] * SC, s[2 * 33] * SC, s[3 * 33] * SC); o.y = pk4_fp8(s[4 * 33] * SC, s[5 * 33] * SC, s[6 * 33] * SC, s[7 * 33] * SC);
        o.z = pk4_fp8(s[8 * 33] * SC, s[9 * 33] * SC, s[10 * 33] * SC, s[11 * 33] * SC); o.w = pk4_fp8(s[12 * 33] * SC, s[13 * 33] * SC, s[14 * 33] * SC, s[15 * 33] * SC);
        *(GAS v4u*)(WT + (size_t)(row_off + n0 + n) * K + k0 + 16 * c) = o; }
    LDS_WAIT(); asm volatile("" ::: "memory");
}
struct ConvItem { const float* W; unsigned char* WT; int N, row_off, k0, n0; };
__device__ __forceinline__ ConvItem conv_decode(int r, const float* w1, const float* w2, unsigned char* w1t, unsigned char* w2t) {
    ConvItem c; constexpr int I_W1 = 16 * 64, I_W2 = 16 * 32;
    if (r < NE * I_W1) { const int e = r / I_W1, it = r % I_W1; c.W = w1 + (size_t)e * D * 2048; c.WT = w1t; c.N = 2048; c.row_off = e * 2048; c.k0 = 64 * (it / 64); c.n0 = 32 * (it % 64); }
    else { r -= NE * I_W1; const int e = r / I_W2, it = r % I_W2; c.W = w2 + (size_t)e * FF * D; c.WT = w2t; c.N = 1024; c.row_off = e * 1024; c.k0 = 64 * (it / 32); c.n0 = 32 * (it % 32); }
    return c;
}
__device__ __forceinline__ void conv_load(const ConvItem& c, f32x4 (&buf)[8], int lane) {
#pragma unroll
    for (int i = 0; i < 8; ++i) buf[i] = *(const GAS f32x4*)(c.W + (size_t)(c.k0 + i * 8 + (lane >> 3)) * c.N + c.n0 + (lane & 7) * 4);
}
__device__ __forceinline__ void conv_store(const ConvItem& c, const f32x4 (&buf)[8], LAS float* scr, int lane, float SC) {
#pragma unroll
    for (int i = 0; i < 8; ++i) { LAS float* p = scr + (i * 8 + (lane >> 3)) * 33 + (lane & 7) * 4; p[0] = buf[i].x; p[1] = buf[i].y; p[2] = buf[i].z; p[3] = buf[i].w; }
    LDS_WAIT(); asm volatile("" ::: "memory");
    const int cc = lane & 3;
#pragma unroll
    for (int j = 0; j < 2; ++j) { const int n = (lane >> 2) + 16 * j; const LAS float* s = scr + (16 * cc) * 33 + n;
        v4u o; o.x = pk4_fp8(s[0 * 33] * SC, s[1 * 33] * SC, s[2 * 33] * SC, s[3 * 33] * SC); o.y = pk4_fp8(s[4 * 33] * SC, s[5 * 33] * SC, s[6 * 33] * SC, s[7 * 33] * SC);
        o.z = pk4_fp8(s[8 * 33] * SC, s[9 * 33] * SC, s[10 * 33] * SC, s[11 * 33] * SC); o.w = pk4_fp8(s[12 * 33] * SC, s[13 * 33] * SC, s[14 * 33] * SC, s[15 * 33] * SC);
        *(GAS v4u*)(c.WT + (size_t)(c.row_off + c.n0 + n) * 1024 + c.k0 + 16 * cc) = o; }
    LDS_WAIT(); asm volatile("" ::: "memory");
}
__device__ __forceinline__ void conv_dma(const ConvItem& c, unsigned lds_dst, int lane) {
    const float* src = c.W + (size_t)(c.k0 + (lane >> 3)) * c.N + c.n0 + (lane & 7) * 4;
#pragma unroll
    for (int i = 0; i < 8; ++i) { unsigned keep;
        asm volatile("s_mov_b32 %0, m0\n\ts_mov_b32 m0, %2\n\ts_nop 0\n\tglobal_load_lds_dwordx4 %1, off nt\n\ts_mov_b32 m0, %0" : "=&s"(keep) : "v"(src + (size_t)i * 8 * c.N), "s"(lds_dst + i * 1024) : "memory"); }
}
__device__ __forceinline__ void conv_emit(const ConvItem& c, const LAS float* buf, int lane, float SC) {
    const int cc = lane & 3;
#pragma unroll
    for (int j = 0; j < 2; ++j) { const int n = (lane >> 2) + 16 * j; const LAS float* s = buf + (16 * cc) * 32 + n;
        v4u o; o.x = pk4_fp8(s[0 * 32] * SC, s[1 * 32] * SC, s[2 * 32] * SC, s[3 * 32] * SC); o.y = pk4_fp8(s[4 * 32] * SC, s[5 * 32] * SC, s[6 * 32] * SC, s[7 * 32] * SC);
        o.z = pk4_fp8(s[8 * 32] * SC, s[9 * 32] * SC, s[10 * 32] * SC, s[11 * 32] * SC); o.w = pk4_fp8(s[12 * 32] * SC, s[13 * 32] * SC, s[14 * 32] * SC, s[15 * 32] * SC);
        __builtin_nontemporal_store(o, (GAS v4u*)(c.WT + (size_t)(c.row_off + c.n0 + n) * 1024 + c.k0 + 16 * cc)); }
    LDS_WAIT(); asm volatile("" ::: "memory");
}
struct Params { const float* in[22]; float* out; unsigned char* ws; };

__device__ __forceinline__ float mod_val(const float* __restrict__ modp, const float* __restrict__ b_ada, int b, int j) {
    return b_ada[j] + ((modp[(0 * 2 + b) * 6144 + j] + modp[(1 * 2 + b) * 6144 + j]) + (modp[(2 * 2 + b) * 6144 + j] + modp[(3 * 2 + b) * 6144 + j]));
}

__device__ __forceinline__ int opaque_v(int i) { asm volatile("" : "+v"(i)); return i; }
__device__ __forceinline__ int opaque_i(int i) { asm volatile("" : "+s"(i)); return i; }
__device__ __forceinline__ unsigned char* launder_ws(unsigned char* p) { GAS unsigned char* g = (GAS unsigned char*)p; asm volatile("" : "+s"(g)); return (unsigned char*)g; }
#if PROBE_K >= 0
#define GSTAMP(k) do { if (threadIdx.x == 0) atomicMax((unsigned*)((gu32*)(P.ws + WS_CTL) + CW_GST + (k)), (unsigned)__builtin_amdgcn_s_memrealtime()); } while (0)
#define STAMP(k) do { if (blockIdx.x == 0 && threadIdx.x == 0) ((volatile LAS unsigned long long*)(lds + LDSCTL_OFF + 512))[k] = __builtin_amdgcn_s_memrealtime(); } while (0)
#define ARRIVE(k) do { if (threadIdx.x == 0) { const unsigned d_ = (unsigned)(__builtin_amdgcn_s_memrealtime() - ((volatile LAS unsigned long long*)(lds + LDSCTL_OFF + 512))[15]); atomicAdd((unsigned*)((gu32*)(P.ws + WS_CTL) + CW_GST + 2 * (k)), d_); atomicMax((unsigned*)((gu32*)(P.ws + WS_CTL) + CW_GST + 2 * (k) + 1), d_); } } while (0)
#define PROBE_END() do { if (blockIdx.x == 0 && threadIdx.x == 0) { volatile LAS unsigned long long* st_ = (volatile LAS unsigned long long*)(lds + LDSCTL_OFF + 512); const unsigned long long dl_ = (PROBE_K >= 300) ? (unsigned long long)(__hip_atomic_load((unsigned*)((gu32*)(P.ws + WS_CTL) + CW_GST + 2 * (PROBE_K % 100) + 1), __ATOMIC_RELAXED, __HIP_MEMORY_SCOPE_AGENT) - __hip_atomic_load((unsigned*)((gu32*)(P.ws + WS_CTL) + CW_GST + 2 * (PROBE_K % 100)), __ATOMIC_RELAXED, __HIP_MEMORY_SCOPE_AGENT) / gridDim.x) : (PROBE_K >= 100) ? (unsigned long long)(__hip_atomic_load((unsigned*)((gu32*)(P.ws + WS_CTL) + CW_GST + (PROBE_K % 100)), __ATOMIC_RELAXED, __HIP_MEMORY_SCOPE_AGENT) - (unsigned)st_[0]) : st_[PROBE_K % 100] - st_[0]; \
        const unsigned long long te_ = __builtin_amdgcn_s_memrealtime() + dl_; while (__builtin_amdgcn_s_memrealtime() < te_) __builtin_amdgcn_s_sleep(8); } } while (0)
#else
#define STAMP(k) do {} while (0)
#define GSTAMP(k) do {} while (0)
#define PROBE_END() do {} while (0)
#define ARRIVE(k) do {} while (0)
#endif
__global__ void __launch_bounds__(NTHR, 2) mk_fwd(Params P) {
    extern __shared__ __attribute__((aligned(16))) unsigned char lds_raw[];
    LAS unsigned char* lds = (LAS unsigned char*)lds_raw;
    const int tid0 = threadIdx.x;
#define PH_TID const int tid = opaque_v(tid0), lane = tid & 63, wave = __builtin_amdgcn_readfirstlane(tid >> 6); const int bx = opaque_i((int)blockIdx.x), G = (int)gridDim.x, \
        vcu = (G % 8 == 0) ? (bx % 8) * (G / 8) + bx / 8 : bx, gw = vcu * NWAVES + wave, NGW = G * NWAVES; (void)lane; (void)gw; (void)NGW; (void)vcu; (void)bx
    unsigned char* const ws0 = P.ws;
#define WSP(name, type, off) type* name = (type*)(launder_ws(ws0) + (off))
#define INP(name, i) const float* name = (const float*)(const GAS float*)P.in[opaque_i(i)]
    LAS int* tab = (LAS int*)(lds + TAB_OFF);

    for (int u = tid0; u < (LDS_BYTES - LDSCTL_OFF) / 4; u += NTHR) ((LAS unsigned*)(lds + LDSCTL_OFF))[u] = 0u;
    __syncthreads();
    STAMP(0);
#if PROBE_K >= 0
    if (threadIdx.x == 0) ((volatile LAS unsigned long long*)(lds + LDSCTL_OFF + 512))[15] = __builtin_amdgcn_s_memrealtime();
#endif
    (void)xcd_barrier_post((unsigned*)((gu32*)(ws0 + WS_CTL) + CW_BAR), (volatile LAS unsigned*)(lds + MISC_OFF) + 8);
#define GRID_BARRIER() do { XcdBarrier b_; b_.bar = (unsigned*)((gu32*)(launder_ws(ws0) + WS_CTL) + CW_BAR); b_.x = xb_xcc_id(); b_.st = (volatile LAS unsigned*)(lds + MISC_OFF) + 8; xcd_barrier(b_); } while (0)

    if ((int)blockIdx.x < 192) {
        PH_TID;
        INP(cvec, 1); INP(w_ada, 2); WSP(modp, float, WS_MODP);
        LAS float* sl = (LAS float*)lds; LAS float* red = sl + 512;
        for (int it = bx; it < 192; it += G) {
            const int cc = it % 48, kq = it / 48, cl = tid & 127, ks = tid >> 7;
            { const float c0 = cvec[(tid >> 8) * 1024 + kq * 256 + (tid & 255)]; sl[tid] = c0 / (1.f + __expf(-c0)); }
            __syncthreads();
            float a0 = 0.f, a1 = 0.f; const float* wp = w_ada + (size_t)(kq * 256 + ks * 64) * 6144 + cc * 128 + cl;
#pragma unroll 8
            for (int kk = 0; kk < 64; ++kk) { const float w = wp[(size_t)kk * 6144]; a0 += sl[ks * 64 + kk] * w; a1 += sl[256 + ks * 64 + kk] * w; }
            red[(ks * 2 + 0) * 128 + cl] = a0; red[(ks * 2 + 1) * 128 + cl] = a1;
            __syncthreads();
            if (tid < 256) { const int b = tid >> 7; const float v = (red[(0 * 2 + b) * 128 + cl] + red[(1 * 2 + b) * 128 + cl]) + (red[(2 * 2 + b) * 128 + cl] + red[(3 * 2 + b) * 128 + cl]);
                modp[(kq * 2 + b) * 6144 + cc * 128 + cl] = v; }
            __syncthreads();
        }
    }
    for (int rep_ = 0; rep_ <= DUP_P0; ++rep_) {
        PH_TID;
        LAS float* scr = (LAS float*)(lds + RING_OFF + wave * 16384);
        INP(w_in, 6); INP(w_out, 7); WSP(win_t, bf16, WS_WIN); WSP(wout_t, bf16, WS_WOUT);
        constexpr int I_IN = 16 * 96, I_OUT = 16 * 32;
        for (int it = gw; it < I_IN + I_OUT; it += NGW) {
            if (it < I_IN) p0_transpose_item_f8(w_in, D, NPROJ, (unsigned char*)win_t, 0, scr, it, lane, 64.f);
             else p0_transpose_item(w_out, D, D, wout_t, 0, scr, it - I_IN, lane);
        }
    }
    ARRIVE(1); GRID_BARRIER(); STAMP(1);

    for (int xb_ = 0; xb_ < DUP_BAR; ++xb_) GRID_BARRIER();
    for (int rep_ = 0; rep_ <= DUP_P1; ++rep_) {
        LAS float* mv = (LAS float*)lds;
        PH_TID;
        INP(x, 0); INP(b_ada, 3); INP(g_pre_mix, 4); WSP(modp, float, WS_MODP); WSP(xn, bf16, WS_XN);
        f32x4 gpm[4];
#pragma unroll
        for (int i = 0; i < 4; ++i) gpm[i] = *(const f32x4*)(g_pre_mix + i * 256 + lane * 4);
        f32x4 nv[4];
#pragma unroll
        for (int i = 0; i < 4; ++i) nv[i] = *(const f32x4*)(x + (size_t)gw * D + i * 256 + lane * 4);
        for (int i = tid; i < 4096; i += NTHR) mv[i] = mod_val(modp, b_ada, i >> 11, i & 2047);
        { WSP(modd, float, WS_MOD); for (int i = vcu * NTHR + tid; i < 2 * 6144; i += G * NTHR) modd[i] = mod_val(modp, b_ada, i / 6144, i % 6144); }
        __syncthreads();
        for (int row = gw; row < M; row += NGW) {
            const int b = row / SEQ; const LAS float* sh = mv + b * 2048; const LAS float* sc = sh + 1024;
            f32x4 v[4]; float ss = 0.f;
#pragma unroll
            for (int i = 0; i < 4; ++i) { v[i] = nv[i]; ss += v[i].x * v[i].x + v[i].y * v[i].y + v[i].z * v[i].z + v[i].w * v[i].w; }
            { const int nrow = (row + NGW < M) ? row + NGW : row;
#pragma unroll
              for (int i = 0; i < 4; ++i) nv[i] = *(const f32x4*)(x + (size_t)nrow * D + i * 256 + lane * 4); }
            const float rstd = rsqrtf(wave_sum(ss) * (1.f / D) + RMS_EPS);
#pragma unroll
            for (int i = 0; i < 4; ++i) { const int c0 = i * 256 + lane * 4; float o[4];
#pragma unroll
                for (int e = 0; e < 4; ++e) o[e] = v[i][e] * rstd * gpm[i][e] * (1.f + sc[c0 + e]) + sh[c0 + e];
                *(unsigned*)((unsigned char*)xn + (size_t)row * D + c0) = pk4_fp8(o[0], o[1], o[2], o[3]); }
        }
        __syncthreads();
    }
    ARRIVE(2); GRID_BARRIER(); STAMP(2);

    for (int rep_ = 0; rep_ <= DUP_P2; ++rep_) {
        PH_TID; WSP(xn, bf16, WS_XN); WSP(win_t, bf16, WS_WIN); WSP(proj, bf16, WS_PROJ);
        pg8::Gemm g{xn, win_t, M, NPROJ, D}; pg8::StaticOrder S; S.init(M, NPROJ, G, bx);
        WSP(kimg, bf16, WS_KIMG); WSP(vimg, bf16, WS_VIMG);
        pg8::EpiStoreBf16 E{proj, NPROJ, 512, attn_body::C2, 1536, 2048, (unsigned*)((gu32*)(launder_ws(ws0) + WS_CTL) + CW_NRM), kimg, vimg};
        pg8::gemm_phase<pg8::EpiStoreBf16, pg8::StaticOrder, true, true, true>(lds + RING_OFF, g, S, E);
    }
    ARRIVE(3); GRID_BARRIER(); STAMP(3);

    for (int rep3_ = 0; rep3_ <= DUP_P3; ++rep3_) {
        constexpr int NCHK = NE * (16 * 64 + 16 * 32) / 64; constexpr unsigned CONV_LIMIT = 80; constexpr int NCV = 12;
        bool first = true;
        for (;;) {
            { PH_TID; gu32* ctl = (gu32*)(launder_ws(ws0) + WS_CTL); volatile LAS unsigned* qw = (volatile LAS unsigned*)(lds + LDSCTL_OFF + 8192);
              if (tid == 0) { unsigned kind = 3u, id = 0u, held = 0u;
                  const bool g256 = (G == 256); const int xg = bx & 7, jg = bx >> 3; const bool convcu = g256 && xg >= 4 && jg >= 32 - NCV;
                  if (first) { qw[4] = 0u; qw[5] = 0u; qw[6] = 0u; if (convcu) __hip_atomic_fetch_add((unsigned*)(ctl + CW_CONVACT), 1u, __ATOMIC_RELAXED, __HIP_MEMORY_SCOPE_AGENT); }
                  if (first && g256 && !convcu) { kind = 0u; id = (unsigned)((xg << 5) | (xg < 4 ? jg : NCV / 2 + jg)); }
                  else {
                      if (convcu && !qw[5]) { id = __hip_atomic_fetch_add((unsigned*)(ctl + CW_CONVQ) + 64 * rep3_, 1u, __ATOMIC_RELAXED, __HIP_MEMORY_SCOPE_AGENT); if (id < (unsigned)NCHK) kind = 1u; else qw[5] = 1u; }
                      if (kind == 3u && !qw[4]) { const unsigned q = __hip_atomic_fetch_add((unsigned*)(ctl + CW_ATTQ) + 64 * rep3_, 1u, __ATOMIC_RELAXED, __HIP_MEMORY_SCOPE_AGENT);
                          if (!g256) id = q; else if (q < 4u * NCV) { const unsigned k = q >> 2; id = 128u + ((q & 3u) << 5) + ((k & 1u) ? (32u - NCV / 2) + (k >> 1) : (NCV / 2 - 1u) - (k >> 1)); } else id = (256u - 4u * NCV) + q;
                          if (id < 512u) kind = 0u; else qw[4] = 1u; }
                      if (kind == 3u && !qw[5]) { bool take = qw[6] != 0u;
                          if (!take) { const unsigned old = __hip_atomic_fetch_add((unsigned*)(ctl + CW_CONVACT), 1u, __ATOMIC_RELAXED, __HIP_MEMORY_SCOPE_AGENT);
                              if (old < CONV_LIMIT) { take = true; held = 1u; } else __hip_atomic_fetch_sub((unsigned*)(ctl + CW_CONVACT), 1u, __ATOMIC_RELAXED, __HIP_MEMORY_SCOPE_AGENT); }
                          if (take) { id = __hip_atomic_fetch_add((unsigned*)(ctl + CW_CONVQ) + 64 * rep3_, 1u, __ATOMIC_RELAXED, __HIP_MEMORY_SCOPE_AGENT);
                              if (id < (unsigned)NCHK) kind = 1u; else { qw[5] = 1u; if (held) { __hip_atomic_fetch_sub((unsigned*)(ctl + CW_CONVACT), 1u, __ATOMIC_RELAXED, __HIP_MEMORY_SCOPE_AGENT); held = 0u; } } } }
                      if (kind == 3u && !qw[6]) { id = __hip_atomic_fetch_add((unsigned*)(ctl + CW_NATQ) + 64 * rep3_, 1u, __ATOMIC_RELAXED, __HIP_MEMORY_SCOPE_AGENT); if (id < 512u) kind = 2u; else qw[6] = 1u; }
                      if (kind == 3u && !qw[5]) { id = __hip_atomic_fetch_add((unsigned*)(ctl + CW_CONVQ) + 64 * rep3_, 1u, __ATOMIC_RELAXED, __HIP_MEMORY_SCOPE_AGENT); if (id < (unsigned)NCHK) kind = 1u; else qw[5] = 1u; }
                  }
                  qw[0] = kind; qw[1] = id; qw[2] = held; }
              __syncthreads(); }
            first = false;
            const int kind = (int)__builtin_amdgcn_readfirstlane(((volatile LAS unsigned*)(lds + LDSCTL_OFF + 8192))[0]);
            if (kind == 3) break;
            if (kind == 0) { const int ua = (int)__builtin_amdgcn_readfirstlane(((volatile LAS unsigned*)(lds + LDSCTL_OFF + 8192))[1]);
                WSP(proj, bf16, WS_PROJ); WSP(od, bf16, WS_ODIFF); WSP(kimg, bf16, WS_KIMG); WSP(vimg, bf16, WS_VIMG); gu32* ctl = (gu32*)(launder_ws(ws0) + WS_CTL);
                attn_body::attn_one<8>(ua, (char*)lds_raw, (const attn_body::bf16*)proj, (const attn_body::bf16*)kimg, (const attn_body::bf16*)vimg, (attn_body::bf16*)od, (const unsigned*)(ctl + CW_NRM), (unsigned*)(ctl + CW_DONE)); }
            else if (kind == 1) { PH_TID; volatile LAS unsigned* qw = (volatile LAS unsigned*)(lds + LDSCTL_OFF + 8192); const int chk = (int)__builtin_amdgcn_readfirstlane(qw[1]);
                INP(w1, 18); INP(w2, 20); WSP(w1_t, bf16, WS_W1T); WSP(w2_t, bf16, WS_W2T);
                LAS float* scr = (LAS float*)(lds + RING_OFF + wave * 16384);
                const unsigned sb_ = (unsigned)__builtin_amdgcn_readfirstlane((unsigned)(uintptr_t)scr);
                ConvItem ci = conv_decode(chk * 64 + wave, w1, w2, (unsigned char*)w1_t, (unsigned char*)w2_t); conv_dma(ci, sb_, lane);
                for (int i8 = 0; i8 < 8; ++i8) { ConvItem ni = ci;
                    if (i8 < 7) { ni = conv_decode(chk * 64 + (i8 + 1) * 8 + wave, w1, w2, (unsigned char*)w1_t, (unsigned char*)w2_t); conv_dma(ni, sb_ + ((i8 + 1) & 1) * 8192, lane);
                        asm volatile("s_waitcnt vmcnt(8)" ::: "memory"); } else { asm volatile("s_waitcnt vmcnt(0)" ::: "memory"); }
                    conv_emit(ci, scr + (i8 & 1) * 2048, lane, 64.f); ci = ni; }
                if (tid == 0 && qw[2]) { gu32* ctl = (gu32*)(launder_ws(ws0) + WS_CTL); __hip_atomic_fetch_sub((unsigned*)(ctl + CW_CONVACT), 1u, __ATOMIC_RELAXED, __HIP_MEMORY_SCOPE_AGENT); } }
            else { const int nu = (int)__builtin_amdgcn_readfirstlane(((volatile LAS unsigned*)(lds + LDSCTL_OFF + 8192))[1]);
                INP(rpb, 13); WSP(proj, bf16, WS_PROJ); WSP(concat, bf16, WS_CONCAT);
                attn_body::nat_one<8>(nu, (char*)lds_raw, (const attn_body::bf16*)proj, (attn_body::bf16*)concat, rpb); }
            __syncthreads();
        }
    {
        PH_TID;
        INP(lq1, 8); INP(lk1, 9); INP(lq2, 10); INP(lk2, 11); INP(g_sub, 12); WSP(od, bf16, WS_ODIFF); WSP(concat, bf16, WS_CONCAT); gu32* ctl = (gu32*)(launder_ws(ws0) + WS_CTL);
        volatile LAS unsigned* qw = (volatile LAS unsigned*)(lds + LDSCTL_OFF + 8192 + 64);
        float s1 = 0.f, s2 = 0.f;
        for (int i = 0; i < 64; ++i) { s1 += lq1[i] * lk1[i]; s2 += lq2[i] * lk2[i]; }
        const float lam_init = 0.2f, lam = __expf(s1) - __expf(s2) + lam_init;
        const int c0 = lane * 8;
        const f32x4 gs0 = *(const f32x4*)(g_sub + (c0 & 127)), gs1 = *(const f32x4*)(g_sub + (c0 & 127) + 4);
        for (;;) {
            if (tid == 0) qw[0] = __hip_atomic_fetch_add((unsigned*)(ctl + CW_CMBQ) + 64 * rep3_, 1u, __ATOMIC_RELAXED, __HIP_MEMORY_SCOPE_AGENT);
            __syncthreads(); const int u = (int)__builtin_amdgcn_readfirstlane(qw[0]); __syncthreads();
            if (u >= 64) break;
            if (tid == 0) { unsigned sp = 0; while (__hip_atomic_load((unsigned*)(ctl + CW_DONE) + u * 64, __ATOMIC_RELAXED, __HIP_MEMORY_SCOPE_AGENT) < 8u) { __builtin_amdgcn_s_sleep(2); if (++sp > (1u << 22)) break; }
                __builtin_amdgcn_fence(__ATOMIC_ACQUIRE, "agent"); asm volatile("s_waitcnt vmcnt(0)" ::: "memory"); }
            __syncthreads();
            const int rbase = u * 256 + wave * 32;
            v4u na = *(const v4u*)(od + (size_t)rbase * 512 + c0), nb = *(const v4u*)(od + ((size_t)M + rbase) * 512 + c0);
            for (int i = 0; i < 32; ++i) { const int row = rbase + i; const v4u a = na, bq = nb;
                { const int nrow = (i < 31) ? row + 1 : row; na = *(const v4u*)(od + (size_t)nrow * 512 + c0); nb = *(const v4u*)(od + ((size_t)M + nrow) * 512 + c0); }
                float v[8]; float ss = 0.f;
#pragma unroll
                for (int e = 0; e < 4; ++e) { v[2 * e] = __uint_as_float(a[e] << 16) - lam * __uint_as_float(bq[e] << 16); v[2 * e + 1] = __uint_as_float(a[e] & 0xffff0000u) - lam * __uint_as_float(bq[e] & 0xffff0000u); }
#pragma unroll
                for (int e = 0; e < 8; ++e) ss += v[e] * v[e];
                ss += __shfl_xor(ss, 1); ss += __shfl_xor(ss, 2); ss += __shfl_xor(ss, 4); ss += __shfl_xor(ss, 8);
                const float rstd = rsqrtf(ss * (1.f / 128.f) + RMS_EPS); v4u w;
#pragma unroll
                for (int e = 0; e < 4; ++e) w[e] = pk2(v[2 * e] * rstd * (e < 2 ? gs0[2 * e] : gs1[2 * e - 4]) * (1.f - lam_init), v[2 * e + 1] * rstd * (e < 2 ? gs0[2 * e + 1] : gs1[2 * e - 3]) * (1.f - lam_init));
                *(v4u*)(concat + (size_t)row * D + c0) = w; }
        }
    }
    }
    ARRIVE(4); GRID_BARRIER(); STAMP(4);

    for (int rep_ = 0; rep_ <= DUP_P5; ++rep_) {
        PH_TID; WSP(concat, bf16, WS_CONCAT); WSP(wout_t, bf16, WS_WOUT); WSP(mix, bf16, WS_MIX);
        pg8::Gemm g{concat, wout_t, M, D, D}; pg8::StaticOrder S; S.init(M, D, G, bx);
        pg8::EpiStoreBf16 E{mix, D, 0, 1.f, 0, 0, nullptr, nullptr, nullptr};
        pg8::gemm_phase<pg8::EpiStoreBf16, pg8::StaticOrder, true, true>(lds + RING_OFF, g, S, E);
    }
    ARRIVE(5); GRID_BARRIER(); STAMP(5);

    for (int rep_ = 0; rep_ <= DUP_P6; ++rep_) {
        PH_TID;
        INP(x, 0); INP(g_post_mix, 5); INP(g_pre_ffn, 14); INP(w_router, 16); INP(b_router, 17);
        WSP(modd, float, WS_MOD); WSP(mix, bf16, WS_MIX); WSP(x1, bf16, WS_X1); WSP(h2, bf16, WS_H2); WSP(topi, int, WS_TOPI); WSP(gate, float, WS_GATE); WSP(hist, int, WS_HIST);
        LAS float* wt = (LAS float*)lds;
        LAS int* ltop = (LAS int*)(lds + LDSCTL_OFF + 4096);
        for (int i = tid; i < 8192; i += NTHR) { const int k = (i & 31) + 32 * (i >> 8), e0 = ((i >> 5) & 7) * 4; const f32x4 w = *(const f32x4*)(w_router + (size_t)k * 32 + e0);
            wt[(e0 + 0) * 1024 + k] = w.x; wt[(e0 + 1) * 1024 + k] = w.y; wt[(e0 + 2) * 1024 + k] = w.z; wt[(e0 + 3) * 1024 + k] = w.w; }
        __syncthreads();
        const int my_e = (lane >> 1) & 31; const float my_b = b_router[my_e];
        for (int ch = bx; ch < NCHUNK; ch += G) {
            LAS float* cst = (LAS float*)(lds + LDSCTL_OFF + 10240);
            { const float* mb = modd + ((ch * 64) / SEQ) * 6144;
              for (int i = tid; i < 1024; i += NTHR) { cst[i] = mb[2048 + i] * g_post_mix[i]; cst[1024 + i] = g_pre_ffn[i] * (1.f + mb[4096 + i]); cst[2048 + i] = mb[3072 + i]; }
              __syncthreads(); }
            uint2 nmv[4]; f32x4 nxv[4];
#pragma unroll
            for (int i = 0; i < 4; ++i) { nmv[i] = *(const uint2*)(mix + (size_t)(ch * 64 + wave * 8) * D + i * 256 + lane * 4); nxv[i] = *(const f32x4*)(x + (size_t)(ch * 64 + wave * 8) * D + i * 256 + lane * 4); }
            for (int i8 = 0; i8 < 8; ++i8) {
                const int row = ch * 64 + wave * 8 + i8, b = row / SEQ;
                f32x4 mvv[4], xv[4]; float ss = 0.f;
#pragma unroll
                for (int i = 0; i < 4; ++i) { mvv[i] = (f32x4){__uint_as_float(nmv[i].x << 16), __uint_as_float(nmv[i].x & 0xffff0000u), __uint_as_float(nmv[i].y << 16), __uint_as_float(nmv[i].y & 0xffff0000u)}; xv[i] = nxv[i];
                    ss += mvv[i].x * mvv[i].x + mvv[i].y * mvv[i].y + mvv[i].z * mvv[i].z + mvv[i].w * mvv[i].w; }
                { const int nrow = (i8 < 7) ? row + 1 : row;
#pragma unroll
                  for (int i = 0; i < 4; ++i) { nmv[i] = *(const uint2*)(mix + (size_t)nrow * D + i * 256 + lane * 4); nxv[i] = *(const f32x4*)(x + (size_t)nrow * D + i * 256 + lane * 4); } }
                float rstd = rsqrtf(wave_sum(ss) * (1.f / D) + RMS_EPS); ss = 0.f;
#pragma unroll
                for (int i = 0; i < 4; ++i) { const int c0 = i * 256 + lane * 4; const f32x4 gg = *(const LAS f32x4*)(cst + c0);
#pragma unroll
                    for (int e = 0; e < 4; ++e) { xv[i][e] = xv[i][e] + gg[e] * (mvv[i][e] * rstd); ss += xv[i][e] * xv[i][e]; }
                    *(uint2*)(x1 + (size_t)row * D + c0) = make_uint2(pk2(xv[i][0], xv[i][1]), pk2(xv[i][2], xv[i][3])); }
                rstd = rsqrtf(wave_sum(ss) * (1.f / D) + RMS_EPS);
                float lg[32];
#pragma unroll
                for (int e = 0; e < 32; ++e) lg[e] = 0.f;
#pragma unroll
                for (int i = 0; i < 4; ++i) { const int c0 = i * 256 + lane * 4; const f32x4 gf = *(const LAS f32x4*)(cst + 1024 + c0), h2s = *(const LAS f32x4*)(cst + 2048 + c0); float hv[4];
#pragma unroll
                    for (int j = 0; j < 4; ++j) hv[j] = xv[i][j] * rstd * gf[j] + h2s[j];
                    *(unsigned*)((unsigned char*)h2 + (size_t)row * D + c0) = pk4_fp8(hv[0], hv[1], hv[2], hv[3]);
#pragma unroll
                    for (int e8 = 0; e8 < 32; e8 += 8) { f32x4 wv[8];
#pragma unroll
                        for (int j = 0; j < 8; ++j) wv[j] = *(const LAS f32x4*)(wt + (e8 + j) * 1024 + c0);
#pragma unroll
                        for (int j = 0; j < 8; ++j) lg[e8 + j] += (hv[0] * wv[j].x + hv[1] * wv[j].y) + (hv[2] * wv[j].z + hv[3] * wv[j].w); } }
                { const bool b5 = lane & 32, b4 = lane & 16, b3 = lane & 8, b2 = lane & 4, b1 = lane & 2;
#pragma unroll
                  for (int e = 0; e < 16; ++e) { const float keep = b5 ? lg[e + 16] : lg[e], send = b5 ? lg[e] : lg[e + 16]; lg[e] = keep + __shfl_xor(send, 32); }
#pragma unroll
                  for (int e = 0; e < 8; ++e) { const float keep = b4 ? lg[e + 8] : lg[e], send = b4 ? lg[e] : lg[e + 8]; lg[e] = keep + __shfl_xor(send, 16); }
#pragma unroll
                  for (int e = 0; e < 4; ++e) { const float keep = b3 ? lg[e + 4] : lg[e], send = b3 ? lg[e] : lg[e + 4]; lg[e] = keep + __shfl_xor(send, 8); }
#pragma unroll
                  for (int e = 0; e < 2; ++e) { const float keep = b2 ? lg[e + 2] : lg[e], send = b2 ? lg[e] : lg[e + 2]; lg[e] = keep + __shfl_xor(send, 4); }
                  { const float keep = b1 ? lg[1] : lg[0], send = b1 ? lg[0] : lg[1]; lg[0] = keep + __shfl_xor(send, 2); }
                  lg[0] += __shfl_xor(lg[0], 1); }
                float tv[4]; int ti[4];
                { LAS float* lgs = (LAS float*)(lds + LDSCTL_OFF + 6144) + wave * 48;
                  const float cur = lg[0] + my_b;
                  if ((lane & 1) == 0) lgs[my_e] = cur;
                  LDS_WAIT(); asm volatile("" ::: "memory");
                  int rank = 0;
#pragma unroll
                  for (int e4 = 0; e4 < 8; ++e4) { const f32x4 o = *(const LAS f32x4*)(lgs + e4 * 4);
#pragma unroll
                      for (int j = 0; j < 4; ++j) { const int oe = e4 * 4 + j; rank += ((o[j] > cur) || (o[j] == cur && oe < my_e)) ? 1 : 0; } }
                  if ((lane & 1) == 0 && rank < 4) { lgs[32 + rank] = cur; ((LAS int*)lgs)[36 + rank] = my_e; }
                  LDS_WAIT(); asm volatile("" ::: "memory");
                  const f32x4 tvv = *(const LAS f32x4*)(lgs + 32); const v4u tii = *(const LAS v4u*)(lgs + 36);
                  tv[0] = tvv.x; tv[1] = tvv.y; tv[2] = tvv.z; tv[3] = tvv.w; ti[0] = (int)tii.x; ti[1] = (int)tii.y; ti[2] = (int)tii.z; ti[3] = (int)tii.w;
                  LDS_WAIT(); asm volatile("" ::: "memory"); }
                if (lane == 0) { const float e1 = __expf(tv[1] - tv[0]), e2 = __expf(tv[2] - tv[0]), e3 = __expf(tv[3] - tv[0]); const float rs = 1.f / (1.f + e1 + e2 + e3);
                    *(int4*)(topi + row * 4) = make_int4(ti[0], ti[1], ti[2], ti[3]); *(f32x4*)(gate + row * 4) = (f32x4){rs, e1 * rs, e2 * rs, e3 * rs};
                    const int lr = (wave * 8 + i8) * 4; ltop[lr] = ti[0]; ltop[lr + 1] = ti[1]; ltop[lr + 2] = ti[2]; ltop[lr + 3] = ti[3]; }
            }
            __syncthreads();
            { LAS int* lh = (LAS int*)(lds + LDSCTL_OFF + 5632);
              if (tid < 32) lh[tid] = 0;
              __syncthreads();
              if (tid < 256) (void)__hip_atomic_fetch_add(lh + ltop[tid], 1, __ATOMIC_RELAXED, __HIP_MEMORY_SCOPE_WORKGROUP);
              __syncthreads();
              if (tid < 32) hist[ch * 32 + tid] = lh[tid]; }
            __syncthreads();
        }
    }
    ARRIVE(6); GRID_BARRIER(); STAMP(6);

    for (int rep_ = 0; rep_ <= DUP_P7; ++rep_) {
        LAS int* le = (LAS int*)(lds + 4096); LAS int* ld = (LAS int*)(lds + 8192);
        PH_TID;
        WSP(hist, int, WS_HIST); WSP(topi, int, WS_TOPI); WSP(dest, int, WS_DEST); WSP(srcm, int, WS_SRC); gu32* ctl = (gu32*)(launder_ws(ws0) + WS_CTL);
        for (int ch = bx; ch < NCHUNK; ch += G) {
            { LAS int* part = (LAS int*)(lds + 12288);
              const int e = tid & 31, pt = tid >> 5; int tot = 0, base = 0;
#pragma unroll
              for (int j = 0; j < 16; ++j) { const int c2 = pt * 16 + j; const int hv = hist[c2 * 32 + e]; tot += hv; base += (c2 < ch) ? hv : 0; }
              part[(pt * 2 + 0) * 32 + e] = tot; part[(pt * 2 + 1) * 32 + e] = base;
              if (tid < 256) le[tid] = topi[ch * 256 + tid];
              __syncthreads();
              if (tid < 32) { int t2 = 0, b2 = 0;
#pragma unroll
                  for (int p = 0; p < 16; ++p) { t2 += part[(p * 2 + 0) * 32 + tid]; b2 += part[(p * 2 + 1) * 32 + tid]; }
                  tab[32 + tid] = b2; tab[tid] = (t2 + 255) & ~255; ld[tid] = t2; } }
            __syncthreads();
            if (tid == 0) { int off = 0; for (int e = 0; e < NE; ++e) { const int pad = tab[e]; tab[e] = off;
                    if (ch == 0) for (int tl = 0; tl < pad / 256; ++tl) ctl[CW_TILEEXP + off / 256 + tl] = (unsigned)e;
                    off += pad; }
                if (ch == 0) ctl[CW_TOTAL] = (unsigned)off; }
            __syncthreads();
            if (ch == 0) { for (int e = 0; e < NE; ++e) { const int c_ = ld[e], pd_ = ((c_ + 255) & ~255) - c_; if (tid < pd_) srcm[tab[e] + c_ + tid] = 0; } }
            {
              LAS int* wc = (LAS int*)(lds + 16384);
              int my_e = 0, rin = 0;
              if (tid < 256) { my_e = le[tid];
#pragma unroll 4
                  for (int e = 0; e < 32; ++e) { const unsigned long long m = __ballot(my_e == e); if (my_e == e) rin = __popcll(m & ((1ull << lane) - 1ull)); if (lane == e) wc[wave * 32 + e] = __popcll(m); } }
              __syncthreads();
              if (tid < 256) { int rank = rin; for (int w = 0; w < wave; ++w) rank += wc[w * 32 + my_e];
                  const int dd = tab[my_e] + tab[32 + my_e] + rank; dest[ch * 256 + tid] = dd; srcm[dd] = (ch * 256 + tid) >> 2; } }
            __syncthreads();
        }
    }
    ARRIVE(7); GRID_BARRIER(); STAMP(7);

    {
        PH_TID;
        gu32* ctl = (gu32*)(launder_ws(ws0) + WS_CTL);
        for (int i = tid; i < MAXTILES; i += NTHR) tab[64 + i] = (int)ctl[CW_TILEEXP + i];
        if (tid == 0) tab[352] = (int)ctl[CW_TOTAL];
        __syncthreads();
        const int ntile = __builtin_amdgcn_readfirstlane(tab[352]) >> 8;
        LAS int* rm = (LAS int*)(lds + LDSCTL_OFF + 2560);
        { WSP(srcm, int, WS_SRC); const int nun = ntile * 8;
          for (int idx = tid; idx < 21 * 256; idx += NTHR) { const int L = (idx >> 8) * G + vcu; if (L < nun) rm[idx] = srcm[(L >> 3) * 256 + (idx & 255)]; }
          __syncthreads(); }
        for (int rep_ = 0; rep_ <= DUP_G1; ++rep_) {
            INP(b1, 19); WSP(h2, bf16, WS_H2); WSP(w1_t, bf16, WS_W1T); WSP(act, bf16, WS_ACT);
            pg8::Gemm g{h2, w1_t, CAP, 2048, D}; pg8::MoeOrder<8> S{ntile * 8, G, vcu, (const LAS int*)(tab + 64), (const LAS int*)rm};
            pg8::EpiSwiglu E{(unsigned char*)act, b1};
            pg8::gemm_phase<pg8::EpiSwiglu, pg8::MoeOrder<8>, true, true, true, true>(lds + RING_OFF, g, S, E);
        }
        ARRIVE(8); GRID_BARRIER(); STAMP(8);
        for (int rep_ = 0; rep_ <= DUP_G2; ++rep_) {
            INP(b2, 21); WSP(act, bf16, WS_ACT); WSP(w2_t, bf16, WS_W2T); WSP(ybuf, bf16, WS_YBUF);
            pg8::Gemm g{act, w2_t, CAP, 1024, FF}; pg8::MoeOrder<4> S{ntile * 4, G, vcu, (const LAS int*)(tab + 64), (const LAS int*)nullptr};
            pg8::EpiY E{ybuf, b2};
            pg8::gemm_phase<pg8::EpiY, pg8::MoeOrder<4>, true, true, true>(lds + RING_OFF, g, S, E);
        }
    }
    ARRIVE(9); GRID_BARRIER(); STAMP(9);

    for (int rep_ = 0; rep_ <= DUP_P10; ++rep_) {
        PH_TID;
        INP(g_post_ffn, 15); WSP(modd, float, WS_MOD); WSP(x1, bf16, WS_X1); WSP(ybuf, bf16, WS_YBUF); WSP(dest, int, WS_DEST); WSP(gate, float, WS_GATE); float* out = P.out;
        f32x4 cgt[2][4], cgo[4];
#pragma unroll
        for (int i = 0; i < 4; ++i) { const int c0 = i * 256 + lane * 4; cgt[0][i] = *(const f32x4*)(modd + 5120 + c0); cgt[1][i] = *(const f32x4*)(modd + 6144 + 5120 + c0); cgo[i] = *(const f32x4*)(g_post_ffn + c0); }
        LAS int* wd = (LAS int*)(lds + wave * 512);
#define P10_LOAD(Y, X, r_) do { const int rr_ = (r_); const v4u dq_ = *(const LAS v4u*)(wd + (rr_ & 7) * 8); const int rw_ = row0_ + rr_ * NGW; \
            _Pragma("unroll") for (int p = 0; p < 4; ++p) _Pragma("unroll") for (int i = 0; i < 4; ++i) Y[p][i] = *(const uint2*)(ybuf + (size_t)dq_[p] * D + i * 256 + lane * 4); \
            _Pragma("unroll") for (int i = 0; i < 4; ++i) X[i] = *(const uint2*)(x1 + (size_t)(rw_ < M ? rw_ : row0_) * D + i * 256 + lane * 4); } while (0)
#define P10_ROW(Y, X, r_) do { const int rr_ = (r_); const int row = row0_ + rr_ * NGW; if (row < M) { const int b = row / SEQ; const f32x4 gg = __builtin_bit_cast(f32x4, *(const LAS v4u*)(wd + (rr_ & 7) * 8 + 4)); \
            float f[16]; float ss = 0.f; _Pragma("unroll") for (int i = 0; i < 16; ++i) f[i] = 0.f; \
            _Pragma("unroll") for (int p = 0; p < 4; ++p) { const float gp = gg[p]; _Pragma("unroll") for (int i = 0; i < 4; ++i) { const uint2 w = Y[p][i]; \
                f[i * 4] += gp * __uint_as_float(w.x << 16); f[i * 4 + 1] += gp * __uint_as_float(w.x & 0xffff0000u); f[i * 4 + 2] += gp * __uint_as_float(w.y << 16); f[i * 4 + 3] += gp * __uint_as_float(w.y & 0xffff0000u); } } \
            _Pragma("unroll") for (int i = 0; i < 16; ++i) ss += f[i] * f[i]; \
            const float rstd = rsqrtf(wave_sum(ss) * (1.f / D) + RMS_EPS); \
            _Pragma("unroll") for (int i = 0; i < 4; ++i) { const int c0 = i * 256 + lane * 4; const f32x4 xv = (f32x4){__uint_as_float(X[i].x << 16), __uint_as_float(X[i].x & 0xffff0000u), __uint_as_float(X[i].y << 16), __uint_as_float(X[i].y & 0xffff0000u)}; f32x4 ov; \
                _Pragma("unroll") for (int e = 0; e < 4; ++e) ov[e] = xv[e] + (b ? cgt[1][i][e] : cgt[0][i][e]) * (f[i * 4 + e] * rstd * cgo[i][e]); \
                *(f32x4*)(out + (size_t)row * D + c0) = ov; } } } while (0)
        for (int row0_ = gw; row0_ < M; row0_ += 8 * NGW) {
            if (lane < 8) { const int rw = row0_ + lane * NGW; v4u dv = {0u, 0u, 0u, 0u}, gv = {0u, 0u, 0u, 0u}; if (rw < M) { dv = *(const v4u*)(dest + rw * 4); gv = *(const v4u*)(gate + rw * 4); }
                *(LAS v4u*)(wd + lane * 8) = dv; *(LAS v4u*)(wd + lane * 8 + 4) = gv; }
            LDS_WAIT(); asm volatile("" ::: "memory");
            uint2 yA[4][4], yB[4][4]; uint2 xA[4], xB[4];
            P10_LOAD(yA, xA, 0); P10_LOAD(yB, xB, 1);
#pragma unroll
            for (int k = 0; k < 4; ++k) {
                P10_ROW(yA, xA, 2 * k); if (k < 3) P10_LOAD(yA, xA, 2 * k + 2);
                P10_ROW(yB, xB, 2 * k + 1); if (k < 3) P10_LOAD(yB, xB, 2 * k + 3);
            }
            LDS_WAIT(); asm volatile("" ::: "memory");
        }
#undef P10_LOAD
#undef P10_ROW
    }
    PROBE_END();
}

extern "C" void kernel_launch(void* const* d_in, const int* in_sizes, int n_in, void* d_out, int out_size, void* d_ws, size_t ws_size, hipStream_t stream) {
    static int grid = 0;
    if (grid == 0) {
        if (n_in != 22 || ws_size < WS_END) { fprintf(stderr, "kernel_launch: unexpected n_in %d / ws %zu\n", n_in, ws_size); grid = -1; return; }
        int dev = 0, cus = 0, per_cu = 0;
        if (hipGetDevice(&dev) != hipSuccess || hipDeviceGetAttribute(&cus, hipDeviceAttributeMultiprocessorCount, dev) != hipSuccess) { grid = -1; return; }
        if (hipFuncSetAttribute((const void*)mk_fwd, hipFuncAttributeMaxDynamicSharedMemorySize, LDS_BYTES) != hipSuccess) { fprintf(stderr, "kernel_launch: hipFuncSetAttribute failed\n"); grid = -1; return; }
        if (hipOccupancyMaxActiveBlocksPerMultiprocessor(&per_cu, (const void*)mk_fwd, NTHR, LDS_BYTES) != hipSuccess || per_cu < 1) { fprintf(stderr, "kernel_launch: occupancy query says %d\n", per_cu); }
        (void)hipGetLastError();
        grid = cus;
    }
    if (grid < 0) return;
    if (hipMemsetAsync((char*)d_ws + WS_CTL, 0, 1 * MiB, stream) != hipSuccess) return;
    Params p{};
    for (int i = 0; i < 22; ++i) p.in[i] = (const float*)d_in[i];
    p.out = (float*)d_out; p.ws = (unsigned char*)d_ws;
    hipLaunchKernelGGL(mk_fwd, dim3(grid), dim3(NTHR), LDS_BYTES, stream, p);
}
```
